# Optimizing an MI355X kernel written in HIP

```python
import math
import jax, jax.numpy as jnp
from jax import lax
import numpy as np

D_MODEL = 1024
BATCH = 8
SEQ = 2048
DEPTH = 1
DEC_BATCH = 128
DEC_SEQ = 4
PAST_LEN = 16384
PAGE_SIZE = 128

D_MIX = D_MODEL
D_A = D_MIX // 2
D_B = D_MIX - D_A
H_A = 4
DK_A = D_A // H_A
DV_A = D_A // H_A
N_BLK_B = 8
BLK_B = D_B // N_BLK_B
CONV_W = 4
LRU_C = 8.0
D_FF = 2816
CHUNK = 64
EPS = 1e-6
D_IN = 4 * D_A + 2 * D_B

kernel_name = "hymba_hgrn2_rglru_macaron_step"


def rmsnorm(x, g):
    xf = x.astype(jnp.float32)
    y = xf * lax.rsqrt(jnp.mean(xf * xf, axis=-1, keepdims=True) + EPS)
    return (y * g.astype(jnp.float32)).astype(x.dtype)


def swiglu(x, wg, wu, wd):
    return (jax.nn.silu(x @ wg) * (x @ wu)) @ wd


def hgrn2_chunked(q, logf, k, v, s0):
    b, t, h, dk = q.shape
    dv = v.shape[-1]
    c = math.gcd(t, CHUNK)
    n = t // c

    def to_chunks(a):
        return a.astype(jnp.float32).reshape(b, n, c, h, a.shape[-1]).transpose(1, 0, 3, 2, 4)

    qc, gc, kc, vc = to_chunks(q), to_chunks(logf), to_chunks(k), to_chunks(v)
    causal = jnp.tril(jnp.ones((c, c), dtype=bool))[:, :, None]

    def step(s, inp):
        qi, gi, ki, vi = inp
        cum = jnp.cumsum(gi, axis=2)
        diff = cum[:, :, :, None, :] - cum[:, :, None, :, :]
        decay = jnp.exp(jnp.where(causal, diff, -jnp.inf))
        scores = jnp.einsum('bhtk,bhsk,bhtsk->bhts', qi, ki, decay)
        o = (jnp.einsum('bhts,bhsv->bhtv', scores, vi)
             + jnp.einsum('bhtk,bhkv->bhtv', qi * jnp.exp(cum), s))
        last = cum[:, :, -1:, :]
        s_new = (jnp.exp(last[:, :, 0, :])[..., None] * s
                 + jnp.einsum('bhsk,bhsv->bhkv', ki * jnp.exp(last - cum), vi))
        return s_new, o

    s_fin, o = lax.scan(step, s0.astype(jnp.float32), (qc, gc, kc, vc))
    o = o.transpose(1, 0, 3, 2, 4).reshape(b, t, h, dv)
    return o, s_fin


def causal_conv(x, buf, w, bias):
    t = x.shape[1]
    xp = jnp.concatenate([buf.astype(x.dtype), x], axis=1)
    y = bias + sum(xp[:, j:j + t] * w[j] for j in range(CONV_W))
    return y, xp[:, -(CONV_W - 1):]


def block_diag(x, w, bias):
    b, t, _ = x.shape
    xb = x.reshape(b, t, N_BLK_B, BLK_B)
    return (jnp.einsum('btni,nij->btnj', xb, w) + bias).reshape(b, t, D_B)


def rglru(x, h0, w_a, b_a, w_x, b_x, lam, is_start):
    xf = x.astype(jnp.float32)
    r = jax.nn.sigmoid(block_diag(xf, w_a.astype(jnp.float32), b_a.astype(jnp.float32)))
    i = jax.nn.sigmoid(block_diag(xf, w_x.astype(jnp.float32), b_x.astype(jnp.float32)))
    log_a = -LRU_C * r * jax.nn.softplus(-lam.astype(jnp.float32))
    a = jnp.exp(log_a)
    mult = jnp.sqrt(-jnp.expm1(2.0 * log_a))
    if is_start:
        mult = mult.at[:, 0].set(1.0)
    u = mult * i * xf
    if h0 is not None:
        u = u.at[:, 0].add(a[:, 0] * h0.astype(jnp.float32))

    def comb(c1, c2):
        a1, b1 = c1
        a2, b2 = c2
        return a1 * a2, a2 * b1 + b2

    _, h = lax.associative_scan(comb, (a, u), axis=1)
    return h, h[:, -1]


def mixer(xn, lb, w_in, hgrn_norm, conv_w, conv_b, lru_wa, lru_ba, lru_wx, lru_bx, lru_lambda, w_o,
          s_hgrn, h_lru, conv_buf, is_start):
    b, t, _ = xn.shape
    proj = xn @ w_in
    q, fz, iv, g, xb, yb = jnp.split(proj, [D_A, 2 * D_A, 3 * D_A, 4 * D_A, 4 * D_A + D_B], axis=-1)
    f = lb + (1.0 - lb) * jax.nn.sigmoid(fz.astype(jnp.float32))
    logf = jnp.log(f)
    k = 1.0 - f
    qh = jax.nn.silu(q).reshape(b, t, H_A, DK_A)
    o_a, s_new = hgrn2_chunked(qh, logf.reshape(b, t, H_A, DK_A), k.reshape(b, t, H_A, DK_A),
                               iv.reshape(b, t, H_A, DV_A), s_hgrn)
    o_a = rmsnorm(o_a, hgrn_norm.reshape(H_A, DV_A)).reshape(b, t, D_A)
    o_a = (o_a * jax.nn.sigmoid(g.astype(jnp.float32))).astype(xn.dtype)
    xc, buf_new = causal_conv(xb, conv_buf, conv_w, conv_b)
    h, h_last = rglru(xc, h_lru, lru_wa, lru_ba, lru_wx, lru_bx, lru_lambda, is_start)
    o_b = (h * jax.nn.gelu(yb.astype(jnp.float32), approximate=True)).astype(xn.dtype)
    y = jnp.concatenate([o_a, o_b], axis=-1) @ w_o
    return y, s_new, h_last, buf_new


def trunk(x, s_hgrn, h_lru, conv_buf, is_start, ffn1_norm, ffn1_wg, ffn1_wu, ffn1_wd, mix_norm, w_in,
          hgrn_lb, hgrn_norm, conv_w, conv_b, lru_wa, lru_ba, lru_wx, lru_bx, lru_lambda, w_o,
          ffn2_norm, ffn2_wg, ffn2_wu, ffn2_wd, final_norm):
    lb_all = jnp.cumsum(jax.nn.softmax(hgrn_lb.astype(jnp.float32), axis=0), axis=0)
    ns_h, ns_l, ns_c = [], [], []
    for l in range(DEPTH):
        x = x + 0.5 * swiglu(rmsnorm(x, ffn1_norm[l]), ffn1_wg[l], ffn1_wu[l], ffn1_wd[l])
        m, s_new, h_last, buf_new = mixer(
            rmsnorm(x, mix_norm[l]), lb_all[l], w_in[l], hgrn_norm[l], conv_w[l], conv_b[l],
            lru_wa[l], lru_ba[l], lru_wx[l], lru_bx[l], lru_lambda[l], w_o[l],
            s_hgrn[l], None if h_lru is None else h_lru[l], conv_buf[l], is_start)
        x = x + m
        x = x + 0.5 * swiglu(rmsnorm(x, ffn2_norm[l]), ffn2_wg[l], ffn2_wu[l], ffn2_wd[l])
        ns_h.append(s_new)
        ns_l.append(h_last)
        ns_c.append(buf_new)
    return rmsnorm(x, final_norm), jnp.stack(ns_h), jnp.stack(ns_l), jnp.stack(ns_c)


def setup_inputs(seed: int = 0) -> dict:
    key = jax.random.key(seed)
    ks = jax.random.split(key, 32)
    f32 = jnp.float32

    def nrm(k, shape, scale):
        return jax.random.normal(k, shape, f32) * scale

    u = jax.random.uniform(ks[20], (DEPTH, D_B), f32, 0.9, 0.999)
    a_base = u ** (1.0 / LRU_C)
    lru_lambda = jnp.log(a_base) - jnp.log1p(-a_base)
    return {
        "x_prompt": nrm(ks[0], (BATCH, SEQ, D_MODEL), 1.0),
        "x_sample": nrm(ks[1], (DEC_BATCH, DEC_SEQ, D_MODEL), 1.0),
        "state_hgrn": nrm(ks[2], (DEPTH, DEC_BATCH, H_A, DK_A, DV_A), 0.5),
        "state_lru": nrm(ks[3], (DEPTH, DEC_BATCH, D_B), 0.5),
        "state_conv": nrm(ks[4], (DEPTH, DEC_BATCH, CONV_W - 1, D_B), 1.0),
        "ffn1_norm": 1.0 + nrm(ks[5], (DEPTH, D_MODEL), 0.02),
        "ffn1_wg": nrm(ks[6], (DEPTH, D_MODEL, D_FF), D_MODEL ** -0.5),
        "ffn1_wu": nrm(ks[7], (DEPTH, D_MODEL, D_FF), D_MODEL ** -0.5),
        "ffn1_wd": nrm(ks[8], (DEPTH, D_FF, D_MODEL), D_FF ** -0.5),
        "mix_norm": 1.0 + nrm(ks[9], (DEPTH, D_MODEL), 0.02),
        "w_in": nrm(ks[10], (DEPTH, D_MODEL, D_IN), D_MODEL ** -0.5),
        "hgrn_lb": nrm(ks[11], (DEPTH + 1, D_A), 0.1),
        "hgrn_norm": 1.0 + nrm(ks[12], (DEPTH, D_A), 0.02),
        "conv_w": nrm(ks[13], (DEPTH, CONV_W, D_B), CONV_W ** -0.5),
        "conv_b": nrm(ks[14], (DEPTH, D_B), 0.01),
        "lru_wa": nrm(ks[15], (DEPTH, N_BLK_B, BLK_B, BLK_B), BLK_B ** -0.5),
        "lru_ba": nrm(ks[16], (DEPTH, N_BLK_B, BLK_B), 0.01),
        "lru_wx": nrm(ks[17], (DEPTH, N_BLK_B, BLK_B, BLK_B), BLK_B ** -0.5),
        "lru_bx": nrm(ks[18], (DEPTH, N_BLK_B, BLK_B), 0.01),
        "lru_lambda": lru_lambda,
        "w_o": nrm(ks[19], (DEPTH, D_MIX, D_MODEL), D_MIX ** -0.5),
        "ffn2_norm": 1.0 + nrm(ks[21], (DEPTH, D_MODEL), 0.02),
        "ffn2_wg": nrm(ks[22], (DEPTH, D_MODEL, D_FF), D_MODEL ** -0.5),
        "ffn2_wu": nrm(ks[23], (DEPTH, D_MODEL, D_FF), D_MODEL ** -0.5),
        "ffn2_wd": nrm(ks[24], (DEPTH, D_FF, D_MODEL), D_FF ** -0.5),
        "final_norm": 1.0 + nrm(ks[25], (D_MODEL,), 0.02),
    }


def reference(x_prompt, x_sample, state_hgrn, state_lru, state_conv, ffn1_norm, ffn1_wg, ffn1_wu, ffn1_wd,
              mix_norm, w_in, hgrn_lb, hgrn_norm, conv_w, conv_b, lru_wa, lru_ba, lru_wx, lru_bx, lru_lambda,
              w_o, ffn2_norm, ffn2_wg, ffn2_wu, ffn2_wd, final_norm):
    weights = (ffn1_norm, ffn1_wg, ffn1_wu, ffn1_wd, mix_norm, w_in, hgrn_lb, hgrn_norm, conv_w, conv_b,
               lru_wa, lru_ba, lru_wx, lru_bx, lru_lambda, w_o, ffn2_norm, ffn2_wg, ffn2_wu, ffn2_wd, final_norm)
    s0_p = jnp.zeros((DEPTH, BATCH, H_A, DK_A, DV_A), jnp.float32)
    buf0_p = jnp.zeros((DEPTH, BATCH, CONV_W - 1, D_B), x_prompt.dtype)
    y_prompt, hgrn_p, lru_p, conv_p = trunk(x_prompt, s0_p, None, buf0_p, True, *weights)
    y_sample, hgrn_s, lru_s, conv_s = trunk(x_sample, state_hgrn, state_lru, state_conv, False, *weights)
    return (y_prompt, y_sample, hgrn_p, lru_p, conv_p, hgrn_s, lru_s, conv_s)
```

```cpp
#include <hip/hip_runtime.h>
#include <hip/hip_cooperative_groups.h>
#include <cstdio>
#include <cstdint>
namespace cg = cooperative_groups;

#ifndef MK_NPH
#define MK_NPH 11
#endif
#ifndef MK_PER_PHASE
#define MK_PER_PHASE 0
#endif

#define LAS __attribute__((address_space(3)))
typedef unsigned short bf16_t;
typedef short bf16x8 __attribute__((ext_vector_type(8)));
typedef float f32x4 __attribute__((ext_vector_type(4)));
typedef unsigned u32x4 __attribute__((ext_vector_type(4)));
typedef unsigned u32x2 __attribute__((ext_vector_type(2)));

constexpr int T_ALL = 16896, TP = 16384, DM = 1024, DFF = 2816, DIN = 3072, DH = 512;
constexpr int SEQ = 2048, NB = 8, NCH = 32, DECB = 128;
constexpr float EPS = 1e-6f;

constexpr size_t OUT_Y = 0, OUT_HP = 17301504, OUT_LP = 17825792, OUT_CP = 17829888, OUT_HS = 17842176, OUT_LS = 26230784, OUT_CS = 26296320;

constexpr size_t WS_WG1 = 0;
constexpr size_t WS_WD1 = WS_WG1 + (size_t)5632 * 1024 * 2;
constexpr size_t WS_WIN = WS_WD1 + (size_t)1024 * 2816 * 2;
constexpr size_t WS_WO  = WS_WIN + (size_t)3072 * 1024 * 2;
constexpr size_t WS_WG2 = WS_WO + (size_t)1024 * 1024 * 2;
constexpr size_t WS_WD2 = WS_WG2 + (size_t)5632 * 1024 * 2;
constexpr size_t WS_WAT = WS_WD2 + (size_t)1024 * 2816 * 2;
constexpr size_t WS_WXT = WS_WAT + 65536;
constexpr size_t WS_SS0 = WS_WXT + 65536;
constexpr size_t SS_BYTES = (size_t)T_ALL * 16 * 4;
constexpr size_t WS_SS1 = WS_SS0 + SS_BYTES, WS_SS2 = WS_SS1 + SS_BYTES, WS_SS3 = WS_SS2 + SS_BYTES;
constexpr size_t WS_DC  = WS_SS3 + SS_BYTES;
constexpr size_t WS_ACH = WS_DC + (size_t)1024 * 128 * 4;
constexpr size_t WS_UCH = WS_ACH + (size_t)NB * NCH * 512 * 4;
constexpr size_t WS_HST = WS_UCH + (size_t)NB * NCH * 512 * 4;
constexpr size_t WS_B0  = WS_HST + (size_t)NB * NCH * 512 * 4;
constexpr size_t WS_R   = WS_B0 + (size_t)T_ALL * 1024 * 2;
constexpr size_t WS_H   = WS_R;
constexpr size_t WS_B1  = WS_H + (size_t)T_ALL * 2816 * 2;
constexpr size_t WS_Q   = WS_R;
constexpr size_t WS_V   = WS_Q + (size_t)T_ALL * 512 * 2;
constexpr size_t WS_SG  = WS_V + (size_t)T_ALL * 512 * 2;
constexpr size_t WS_GY  = WS_SG + (size_t)T_ALL * 512 * 2;
constexpr size_t WS_FZ  = WS_GY + (size_t)T_ALL * 512 * 2;
constexpr size_t WS_XB  = WS_FZ + (size_t)T_ALL * 512 * 4;
constexpr size_t WS_LT  = WS_XB + (size_t)T_ALL * 512 * 4;
constexpr size_t WS_END = WS_LT + (size_t)1024 * 16384 * 2;
static_assert(WS_END <= 268435456, "workspace budget");
static_assert(WS_B1 + (size_t)T_ALL * 1024 * 2 <= WS_END, "B1 inside R");

constexpr int LDS_BYTES = 131072;

typedef __bf16 nbf16x2 __attribute__((ext_vector_type(2)));
typedef float f32x2 __attribute__((ext_vector_type(2)));
__device__ __forceinline__ unsigned cvt_pk_bf16(float lo, float hi) { const nbf16x2 r = __builtin_convertvector((f32x2){lo, hi}, nbf16x2); return __builtin_bit_cast(unsigned, r); }
__device__ __forceinline__ bf16_t f2bf(float f) { return (bf16_t)(cvt_pk_bf16(f, 0.f) & 0xffffu); }
__device__ __forceinline__ float bf2f(bf16_t b) { return __uint_as_float(((unsigned)b) << 16); }
__device__ __forceinline__ float bflo(unsigned w) { return __uint_as_float(w << 16); }
__device__ __forceinline__ float bfhi(unsigned w) { return __uint_as_float(w & 0xffff0000u); }
__device__ __forceinline__ float sigm(float x) { return __builtin_amdgcn_rcpf(1.f + __expf(-x)); }
__device__ __forceinline__ float rowscale(const float* ss, int row) {
    const f32x4* p = (const f32x4*)(ss + (size_t)row * 16);
    const f32x4 a = p[0], b = p[1], c = p[2], d = p[3];
    const float s = (((a.x + a.y) + (a.z + a.w)) + ((b.x + b.y) + (b.z + b.w))) + (((c.x + c.y) + (c.z + c.w)) + ((d.x + d.y) + (d.z + d.w)));
    return rsqrtf(s * (1.f / 1024.f) + EPS);
}
__device__ __forceinline__ float wave_sum(float v) {
#pragma unroll
    for (int o = 1; o < 64; o <<= 1) v += __shfl_xor(v, o);
    return v;
}
#define LDS_WAIT() asm volatile("s_waitcnt lgkmcnt(0)" ::: "memory")

namespace pg8 {
constexpr int BM = 256, BK = 64, HALF = 128, HTB = HALF * BK * 2, STAGE_BYTES = 8 * HTB, NXCD = 8, WGM = 8;
__host__ __device__ __forceinline__ int lds_byte(int r, int c) { const int st = (r >> 4) * 2 + (c >> 5), rr = r & 15, cc = c & 31, ob = rr * 64 + cc * 2; return st * 1024 + (ob ^ (((ob >> 9) & 1) << 5)); }
__host__ __device__ __forceinline__ void stage_rc(int b, int& R, int& C) { const int st = b / 1024, sb = b % 1024, swz = sb ^ (((sb >> 9) & 1) << 5); R = (st >> 1) * 16 + swz / 64; C = (st & 1) * 32 + (swz % 64) / 2; }
__host__ __device__ __forceinline__ int perm32(int rho) { const int n = rho >> 4, i = rho & 15; return 8 * (i >> 2) + 4 * n + (i & 3); }
struct Unit { int pm, pn; };
struct Gemm { const bf16_t* A; const bf16_t* Bt; int M, N, K; };
struct StaticOrder {
    int nM, nN, nwg, G, c;
    __host__ __device__ void init(int M, int N, int G_, int c_) { nM = M / BM; nN = N / BM; nwg = nM * nN; G = G_; c = c_; }
    __host__ __device__ bool next(int i, Unit& u) const {
        const long L = (long)i * G + c; if (L >= nwg) return false;
        int wgid = (int)L; { const int q = nwg / NXCD, r = nwg % NXCD, xcd = wgid % NXCD, off = wgid / NXCD; wgid = (xcd < r ? xcd * (q + 1) : r * (q + 1) + (xcd - r) * q) + off; }
        const int nig = WGM * nN, gid = wgid / nig, fm = gid * WGM, gsz = (nM - fm) < WGM ? (nM - fm) : WGM;
        u.pm = fm + ((wgid % nig) % gsz); u.pn = (wgid % nig) / gsz; return true;
    }
    __device__ __forceinline__ void a_ready(const Unit&) const {}
    __device__ __forceinline__ void done(const Unit&) const {}
};

template <class Epi, class Sched, bool ALIGN_EPI = false, bool SP2 = false>
__device__ __forceinline__ void gemm_phase(LAS unsigned char* lds, const Gemm g, const Sched& S, const Epi& E) {
    const int tid = threadIdx.x, wid = __builtin_amdgcn_readfirstlane(tid >> 6), lane = tid & 63, wr = wid >> 2, wc = wid & 3, fr = lane & 15, fq = lane >> 4;
    const int K = g.K, nt = K / BK;
    unsigned voffA[2], voffB[2];
#pragma unroll
    for (int i = 0; i < 2; ++i) { int R, C; stage_rc(tid * 16 + i * 8192, R, C); const int Rb = Epi::PERM ? ((R & ~31) + perm32(R & 31)) : R;
        voffA[i] = (unsigned)(R * K + C) * 2u; voffB[i] = (unsigned)(Rb * K + C) * 2u; }
    const size_t kstep = (size_t)(BK * 2);
    const size_t hstep = (size_t)HALF * K * 2;
    const size_t tstep = 2 * hstep;
    const unsigned ldsw = (unsigned)wid * 1024u;
    const int aoff = lds_byte(wr * 64 + fr, fq * 8), boff = lds_byte(wc * 32 + fr, fq * 8);
#define PG8_SA(b, h) (((b) * 2 + (h)) * HTB)
#define PG8_SB(b, h) ((4 + (b) * 2 + (h)) * HTB)
#define PG8_STAGE(bufoff, gbase, voff) do { _Pragma("unroll") for (int _i = 0; _i < 2; ++_i) \
        __builtin_amdgcn_global_load_lds((const unsigned*)((const char*)(gbase) + (voff)[_i]), (LAS unsigned*)(lds + (bufoff) + ldsw + _i * 8192), 16, 0, 0); } while (0)
#define PG8_LDA(dst, b, h) do { _Pragma("unroll") for (int m = 0; m < 4; ++m) _Pragma("unroll") for (int k = 0; k < 2; ++k) dst[m][k] = *(const LAS bf16x8*)(lds + PG8_SA(b, h) + aoff + m * 2048 + k * 1024); } while (0)
#define PG8_LDB(dst, b, h) do { _Pragma("unroll") for (int n = 0; n < 2; ++n) _Pragma("unroll") for (int k = 0; k < 2; ++k) dst[n][k] = *(const LAS bf16x8*)(lds + PG8_SB(b, h) + boff + n * 2048 + k * 1024); } while (0)
#define PG8_MMA(ai, bj, At, Bt) do { __builtin_amdgcn_s_setprio(1); _Pragma("unroll") for (int m = 0; m < 4; ++m) _Pragma("unroll") for (int n = 0; n < 2; ++n) _Pragma("unroll") for (int k = 0; k < 2; ++k) \
        acc[ai][bj][m][n] = __builtin_amdgcn_mfma_f32_16x16x32_bf16(Bt[n][k], At[m][k], acc[ai][bj][m][n], 0, 0, 0); __builtin_amdgcn_s_setprio(0); } while (0)
#define PG8_WAIT_V(n) asm volatile("s_waitcnt vmcnt(" #n ")" ::: "memory")
#define PG8_WAIT_L(n) asm volatile("s_waitcnt lgkmcnt(" #n ")" ::: "memory")
#define PG8_BAR __builtin_amdgcn_s_barrier()
#define PG8_SCHED __builtin_amdgcn_sched_barrier(0)
    Unit cur, nxt; int ui = 0;
    if (!S.next(0, cur)) return;
    f32x4 acc[2][2][4][2];
#pragma unroll
    for (int a = 0; a < 2; ++a)
#pragma unroll
        for (int b = 0; b < 2; ++b)
#pragma unroll
            for (int m = 0; m < 4; ++m)
#pragma unroll
                for (int n = 0; n < 2; ++n) acc[a][b][m][n] = (f32x4){0.f, 0.f, 0.f, 0.f};
    bf16x8 At[4][2], B0[2][2], B1[2][2];
    const char* cA = (const char*)g.A + (size_t)cur.pm * tstep; const char* cB = (const char*)g.Bt + (size_t)cur.pn * tstep;
    S.a_ready(cur);
    if constexpr (SP2) {
        PG8_STAGE(PG8_SB(0, 0), cB, voffB); PG8_STAGE(PG8_SB(0, 1), cB + hstep, voffB); PG8_STAGE(PG8_SA(0, 0), cA, voffA); PG8_STAGE(PG8_SA(0, 1), cA + hstep, voffA);
        if (wr == 1) PG8_BAR;
        PG8_WAIT_V(2); PG8_BAR;
        PG8_STAGE(PG8_SB(1, 0), cB + kstep, voffB); PG8_STAGE(PG8_SA(1, 0), cA + kstep, voffA); PG8_STAGE(PG8_SB(1, 1), cB + hstep + kstep, voffB);
        PG8_WAIT_V(6); PG8_BAR;
    } else {
        PG8_STAGE(PG8_SB(0, 0), cB, voffB); PG8_STAGE(PG8_SA(0, 0), cA, voffA); PG8_STAGE(PG8_SB(0, 1), cB + hstep, voffB); PG8_STAGE(PG8_SA(0, 1), cA + hstep, voffA);
        if (wr == 1) PG8_BAR;
        PG8_WAIT_V(4); PG8_BAR;
        PG8_STAGE(PG8_SB(1, 0), cB + kstep, voffB); PG8_STAGE(PG8_SA(1, 0), cA + kstep, voffA); PG8_STAGE(PG8_SB(1, 1), cB + hstep + kstep, voffB);
        PG8_WAIT_V(6); PG8_BAR;
    }
    for (;;) {
        const bool has_next = S.next(ui + 1, nxt);
        const char* nA = has_next ? (const char*)g.A + (size_t)nxt.pm * tstep : cA; const char* nB = has_next ? (const char*)g.Bt + (size_t)nxt.pn * tstep : cB;
        for (int t = 0; t < nt; t += 2) {
            const bool last = (t == nt - 2);
            const char* a1 = cA + (size_t)(t + 1) * kstep;
            const char* a2 = last ? nA : cA + (size_t)(t + 2) * kstep; const char* b2 = last ? nB : cB + (size_t)(t + 2) * kstep;
            const char* a3 = a2 + kstep; const char* b3 = b2 + kstep;
            if (last && has_next) S.a_ready(nxt);
            if constexpr (SP2) {
            PG8_LDB(B0, 0, 0); PG8_LDB(B1, 0, 1); PG8_SCHED; PG8_LDA(At, 0, 0); PG8_STAGE(PG8_SA(1, 1), a1 + hstep, voffA);
            PG8_WAIT_V(8); PG8_WAIT_L(0); PG8_BAR; PG8_MMA(0, 0, At, B0); PG8_MMA(0, 1, At, B1); PG8_BAR; PG8_SCHED;
            PG8_LDA(At, 0, 1); PG8_STAGE(PG8_SB(0, 0), b2, voffB); PG8_STAGE(PG8_SB(0, 1), b2 + hstep, voffB); PG8_STAGE(PG8_SA(0, 0), a2, voffA);
            PG8_WAIT_V(8); PG8_WAIT_L(0); PG8_BAR; PG8_MMA(1, 0, At, B0); PG8_MMA(1, 1, At, B1); PG8_BAR; PG8_SCHED;
            PG8_LDB(B0, 1, 0); PG8_LDB(B1, 1, 1); PG8_SCHED; PG8_LDA(At, 1, 0); PG8_STAGE(PG8_SA(0, 1), a2 + hstep, voffA);
            PG8_WAIT_V(8); PG8_WAIT_L(0); PG8_BAR; PG8_MMA(0, 0, At, B0); PG8_MMA(0, 1, At, B1); PG8_BAR; PG8_SCHED;
            PG8_LDA(At, 1, 1); PG8_STAGE(PG8_SB(1, 0), b3, voffB); PG8_STAGE(PG8_SB(1, 1), b3 + hstep, voffB); PG8_STAGE(PG8_SA(1, 0), a3, voffA);
            PG8_WAIT_V(8); PG8_WAIT_L(0); PG8_BAR; PG8_MMA(1, 0, At, B0); PG8_MMA(1, 1, At, B1); PG8_BAR; PG8_SCHED;
            } else {
            PG8_LDB(B0, 0, 0); PG8_SCHED; PG8_LDA(At, 0, 0); PG8_STAGE(PG8_SA(1, 1), a1 + hstep, voffA);
            PG8_WAIT_L(8); PG8_BAR; PG8_WAIT_L(0); PG8_MMA(0, 0, At, B0); PG8_BAR; PG8_SCHED;
            PG8_LDB(B1, 0, 1); PG8_STAGE(PG8_SB(0, 0), b2, voffB);
            PG8_BAR; PG8_WAIT_L(0); PG8_MMA(0, 1, At, B1); PG8_BAR;
            PG8_LDA(At, 0, 1); PG8_STAGE(PG8_SA(0, 0), a2, voffA);
            PG8_BAR; PG8_WAIT_L(0); PG8_MMA(1, 0, At, B0); PG8_BAR; PG8_SCHED;
            PG8_STAGE(PG8_SB(0, 1), b2 + hstep, voffB);
            PG8_WAIT_V(6); PG8_BAR; PG8_MMA(1, 1, At, B1); PG8_BAR;
            PG8_LDB(B0, 1, 0); PG8_SCHED; PG8_LDA(At, 1, 0); PG8_STAGE(PG8_SA(0, 1), a2 + hstep, voffA);
            PG8_WAIT_L(8); PG8_BAR; PG8_WAIT_L(0); PG8_MMA(0, 0, At, B0); PG8_BAR; PG8_SCHED;
            PG8_LDB(B1, 1, 1); PG8_STAGE(PG8_SB(1, 0), b3, voffB);
            PG8_BAR; PG8_WAIT_L(0); PG8_MMA(0, 1, At, B1); PG8_BAR;
            PG8_LDA(At, 1, 1); PG8_STAGE(PG8_SA(1, 0), a3, voffA);
            PG8_BAR; PG8_WAIT_L(0); PG8_MMA(1, 0, At, B0); PG8_BAR; PG8_SCHED;
            PG8_STAGE(PG8_SB(1, 1), b3 + hstep, voffB);
            PG8_WAIT_V(6); PG8_BAR; PG8_MMA(1, 1, At, B1); PG8_BAR;
            }
        }
        if constexpr (ALIGN_EPI) { if (wr == 0) PG8_BAR; }
        E(acc, cur, wr, wc, fr, fq); S.done(cur);
        if (!has_next) break;
#pragma unroll
        for (int a = 0; a < 2; ++a)
#pragma unroll
            for (int b = 0; b < 2; ++b)
#pragma unroll
                for (int m = 0; m < 4; ++m)
#pragma unroll
                    for (int n = 0; n < 2; ++n) acc[a][b][m][n] = (f32x4){0.f, 0.f, 0.f, 0.f};
        cur = nxt; cA = nA; cB = nB; ++ui;
        if constexpr (ALIGN_EPI) { if (wr == 1) PG8_BAR; }
    }
    PG8_WAIT_V(0);
    if constexpr (!ALIGN_EPI) { if (wr == 0) PG8_BAR; }
    PG8_BAR;
#undef PG8_SA
#undef PG8_SB
#undef PG8_STAGE
#undef PG8_LDA
#undef PG8_LDB
#undef PG8_MMA
#undef PG8_WAIT_V
#undef PG8_WAIT_L
#undef PG8_BAR
#undef PG8_SCHED
}
}

#ifndef PG8_SP2
#define PG8_SP2 true
#endif
#ifndef PG8_ALIGN
#define PG8_ALIGN true
#endif

struct EpiGateUp {
    static constexpr bool PERM = true;
    bf16_t* H; const float* ss;
    __device__ __forceinline__ void operator()(const f32x4 (&acc)[2][2][4][2], const pg8::Unit& u, int wr, int wc, int fr, int fq) const {
        const int row0 = u.pm * 256 + wr * 64 + fr, col0 = u.pn * 128 + wc * 32 + 8 * fq;
#pragma unroll
        for (int ai = 0; ai < 2; ++ai)
#pragma unroll
            for (int m = 0; m < 4; ++m) {
                const int row = row0 + ai * 128 + m * 16; const float rs = rowscale(ss, row);
                float h[8];
#pragma unroll
                for (int n = 0; n < 2; ++n)
#pragma unroll
                    for (int j = 0; j < 4; ++j) { const float g = acc[ai][0][m][n][j] * rs, up = acc[ai][1][m][n][j] * rs; h[n * 4 + j] = g * sigm(g) * up; }
                u32x4 w; w.x = cvt_pk_bf16(h[0], h[1]); w.y = cvt_pk_bf16(h[2], h[3]); w.z = cvt_pk_bf16(h[4], h[5]); w.w = cvt_pk_bf16(h[6], h[7]);
                *(u32x4*)(H + (size_t)row * DFF + col0) = w;
            }
    }
};
struct EpiResid {
    static constexpr bool PERM = true;
    const float* xin_p; const float* xin_s; float* xout; bf16_t* ax; const float* gnext; float* ssout; float scale;
    __device__ __forceinline__ void operator()(const f32x4 (&acc)[2][2][4][2], const pg8::Unit& u, int wr, int wc, int fr, int fq) const {
        const int row0 = u.pm * 256 + wr * 64 + fr, col0 = u.pn * 256 + wc * 32 + 8 * fq;
        const float* xb = (u.pm < 64) ? xin_p : (xin_s - (size_t)TP * DM);
        f32x4 gn[2][2];
#pragma unroll
        for (int bj = 0; bj < 2; ++bj)
#pragma unroll
            for (int n = 0; n < 2; ++n) gn[bj][n] = ax ? *(const f32x4*)(gnext + col0 + bj * 128 + 4 * n) : (f32x4){1.f, 1.f, 1.f, 1.f};
#pragma unroll
        for (int ai = 0; ai < 2; ++ai)
#pragma unroll
            for (int m = 0; m < 4; ++m) {
                const int row = row0 + ai * 128 + m * 16; const size_t off = (size_t)row * DM + col0; float sq = 0.f;
#pragma unroll
                for (int bj = 0; bj < 2; ++bj) {
                    const f32x4 x0 = *(const f32x4*)(xb + off + bj * 128), x1 = *(const f32x4*)(xb + off + bj * 128 + 4);
                    const f32x4 v0 = x0 + acc[ai][bj][m][0] * scale, v1 = x1 + acc[ai][bj][m][1] * scale;
                    *(f32x4*)(xout + off + bj * 128) = v0; *(f32x4*)(xout + off + bj * 128 + 4) = v1;
                    sq += ((v0[0] * v0[0] + v0[1] * v0[1]) + (v0[2] * v0[2] + v0[3] * v0[3])) + ((v1[0] * v1[0] + v1[1] * v1[1]) + (v1[2] * v1[2] + v1[3] * v1[3]));
                    if (ax) { const f32x4 a0 = v0 * gn[bj][0], a1 = v1 * gn[bj][1];
                        u32x4 w; w.x = cvt_pk_bf16(a0[0], a0[1]); w.y = cvt_pk_bf16(a0[2], a0[3]); w.z = cvt_pk_bf16(a1[0], a1[1]); w.w = cvt_pk_bf16(a1[2], a1[3]);
                        *(u32x4*)(ax + off + bj * 128) = w; }
                }
                sq += __shfl_xor(sq, 16); sq += __shfl_xor(sq, 32);
                if (fq == 0) ssout[(size_t)row * 16 + u.pn * 4 + wc] = sq;
            }
    }
};
struct EpiProj {
    static constexpr bool PERM = true;
    bf16_t *Q, *V, *SG, *GY; float *FZ, *XB; const float* ss;
    __device__ __forceinline__ void operator()(const f32x4 (&acc)[2][2][4][2], const pg8::Unit& u, int wr, int wc, int fr, int fq) const {
        const int seg = u.pn >> 1;
        const int row0 = u.pm * 256 + wr * 64 + fr, col0 = (u.pn & 1) * 256 + wc * 32 + 8 * fq;
        float* fdst = (seg == 1) ? FZ : XB;
        bf16_t* bdst = (seg == 0) ? Q : (seg == 2) ? V : (seg == 3) ? SG : GY;
        const bool isf = (seg == 1) || (seg == 4);
#pragma unroll
        for (int ai = 0; ai < 2; ++ai)
#pragma unroll
            for (int m = 0; m < 4; ++m) {
                const int row = row0 + ai * 128 + m * 16; const float rs = rowscale(ss, row); const size_t off = (size_t)row * DH + col0;
#pragma unroll
                for (int bj = 0; bj < 2; ++bj) {
                    f32x4 v0 = acc[ai][bj][m][0] * rs, v1 = acc[ai][bj][m][1] * rs;
                    if (isf) { *(f32x4*)(fdst + off + bj * 128) = v0; *(f32x4*)(fdst + off + bj * 128 + 4) = v1; }
                    else {
                        float h[8] = {v0[0], v0[1], v0[2], v0[3], v1[0], v1[1], v1[2], v1[3]};
                        if (seg == 0) {
#pragma unroll
                            for (int j = 0; j < 8; ++j) h[j] = h[j] * sigm(h[j]);
                        } else if (seg == 3) {
#pragma unroll
                            for (int j = 0; j < 8; ++j) h[j] = sigm(h[j]);
                        } else if (seg == 5) {
#pragma unroll
                            for (int j = 0; j < 8; ++j) { const float y = h[j]; h[j] = y * sigm(1.5957691216f * (y + 0.044715f * y * y * y)); }
                        }
                        u32x4 w; w.x = cvt_pk_bf16(h[0], h[1]); w.y = cvt_pk_bf16(h[2], h[3]); w.z = cvt_pk_bf16(h[4], h[5]); w.w = cvt_pk_bf16(h[6], h[7]);
                        *(u32x4*)(bdst + off + bj * 128) = w;
                    }
                }
            }
    }
};

struct Params { const float* in[26]; float* out; unsigned char* ws; int ph_lo, ph_hi; };

__device__ __forceinline__ void transpose_item(const float* W, int K, int N, bf16_t* WT, int dst_row0, LAS float* scr, int k0, int n0, int lane) {
#pragma unroll 8
    for (int i = 0; i < 32; ++i) { const int kk = 2 * i + (lane >> 5); scr[kk * 33 + (lane & 31)] = W[(size_t)(k0 + kk) * N + n0 + (lane & 31)]; }
    LDS_WAIT();
    const int c = lane & 7;
#pragma unroll
    for (int j = 0; j < 4; ++j) { const int n = (lane >> 3) + 8 * j; const LAS float* s = scr + (8 * c) * 33 + n;
        u32x4 o; o.x = cvt_pk_bf16(s[0 * 33], s[1 * 33]); o.y = cvt_pk_bf16(s[2 * 33], s[3 * 33]); o.z = cvt_pk_bf16(s[4 * 33], s[5 * 33]); o.w = cvt_pk_bf16(s[6 * 33], s[7 * 33]);
        *(u32x4*)(WT + (size_t)(dst_row0 + n) * K + k0 + 8 * c) = o; }
    LDS_WAIT();
}
__device__ __forceinline__ void transpose_mat(const float* W, int K, int N, bf16_t* WT, int mode, LAS float* scr, int item, int lane) {
    const int nblk = N / 32, kb = item / nblk, nb = item % nblk, n0 = 32 * nb;
    const int dst = (mode == 0) ? n0 : (256 * (n0 >> 7) + (n0 & 127) + (mode == 2 ? 128 : 0));
    transpose_item(W, K, N, WT, dst, scr, 64 * kb, n0, lane);
}

__device__ __forceinline__ void phase0(const Params& p, LAS unsigned char* lds) {
    const int tid = threadIdx.x, lane = tid & 63, wave = tid >> 6;
    const int G = gridDim.x, gw = blockIdx.x * 8 + wave, NGW = G * 8;
    unsigned char* ws = p.ws;
    LAS float* scr = (LAS float*)(lds + wave * 16384);
    constexpr int I_GU = 16 * 88, I_D = 44 * 32, I_IN = 16 * 96, I_O = 16 * 32;
    constexpr int NIT = 4 * I_GU + 2 * I_D + I_IN + I_O;
    for (int it = gw; it < NIT; it += NGW) {
        int r = it;
        if (r < I_GU) { transpose_mat(p.in[6], 1024, 2816, (bf16_t*)(ws + WS_WG1), 1, scr, r, lane); continue; } r -= I_GU;
        if (r < I_GU) { transpose_mat(p.in[7], 1024, 2816, (bf16_t*)(ws + WS_WG1), 2, scr, r, lane); continue; } r -= I_GU;
        if (r < I_D)  { transpose_mat(p.in[8], 2816, 1024, (bf16_t*)(ws + WS_WD1), 0, scr, r, lane); continue; } r -= I_D;
        if (r < I_IN) { transpose_mat(p.in[10], 1024, 3072, (bf16_t*)(ws + WS_WIN), 0, scr, r, lane); continue; } r -= I_IN;
        if (r < I_O)  { transpose_mat(p.in[20], 1024, 1024, (bf16_t*)(ws + WS_WO), 0, scr, r, lane); continue; } r -= I_O;
        if (r < I_GU) { transpose_mat(p.in[22], 1024, 2816, (bf16_t*)(ws + WS_WG2), 1, scr, r, lane); continue; } r -= I_GU;
        if (r < I_GU) { transpose_mat(p.in[23], 1024, 2816, (bf16_t*)(ws + WS_WG2), 2, scr, r, lane); continue; } r -= I_GU;
        transpose_mat(p.in[24], 2816, 1024, (bf16_t*)(ws + WS_WD2), 0, scr, r, lane);
    }
    for (int e = blockIdx.x * 512 + tid; e < 2 * 32768; e += G * 512) {
        const int which = e >> 15, r = e & 32767, n = r >> 12, j = (r >> 6) & 63, i = r & 63;
        const float* W = which ? p.in[17] : p.in[15];
        bf16_t* WT = (bf16_t*)(ws + (which ? WS_WXT : WS_WAT));
        WT[r] = f2bf(W[(n * 64 + i) * 64 + j]);
    }
    bf16_t* A1 = (bf16_t*)(ws + WS_B0); float* SS0 = (float*)(ws + WS_SS0);
    const float* g1 = p.in[5];
    f32x4 gv[4];
#pragma unroll
    for (int j = 0; j < 4; ++j) gv[j] = ((const f32x4*)g1)[lane + 64 * j];
    for (int row = gw; row < T_ALL; row += NGW) {
        const float* xr = (row < TP) ? p.in[0] + (size_t)row * DM : p.in[1] + (size_t)(row - TP) * DM;
        f32x4 v[4]; float s = 0.f;
#pragma unroll
        for (int j = 0; j < 4; ++j) { v[j] = ((const f32x4*)xr)[lane + 64 * j]; s += (v[j].x * v[j].x + v[j].y * v[j].y) + (v[j].z * v[j].z + v[j].w * v[j].w); }
        s = wave_sum(s);
        u32x2* o8 = (u32x2*)(A1 + (size_t)row * DM);
#pragma unroll
        for (int j = 0; j < 4; ++j) { const f32x4 a = v[j] * gv[j]; u32x2 w; w.x = cvt_pk_bf16(a.x, a.y); w.y = cvt_pk_bf16(a.z, a.w); o8[lane + 64 * j] = w; }
        if (lane < 16) SS0[(size_t)row * 16 + lane] = (lane == 0) ? s : 0.f;
    }
}

__device__ __forceinline__ void phase_final(const Params& p) {
    const int tid = threadIdx.x, lane = tid & 63, wave = tid >> 6;
    const int gw = blockIdx.x * 8 + wave, NGW = gridDim.x * 8;
    const float* SS3 = (const float*)(p.ws + WS_SS3); const float* gf = p.in[25];
    f32x4 gv[4];
#pragma unroll
    for (int j = 0; j < 4; ++j) gv[j] = ((const f32x4*)gf)[lane + 64 * j];
    for (int row = gw; row < T_ALL; row += NGW) {
        const float rs = rowscale(SS3, row);
        f32x4* xr = (f32x4*)(p.out + (size_t)row * DM);
#pragma unroll
        for (int j = 0; j < 4; ++j) { f32x4 v = xr[lane + 64 * j]; xr[lane + 64 * j] = v * rs * gv[j]; }
    }
}

struct Mix {
    const bf16_t *Q, *V, *SG, *GY; const float *FZ, *XB; bf16_t* LT; float* DC; float *ACH, *UCH, *HST; bf16_t* O;
    const bf16_t *WAT, *WXT;
    const float *lb, *hnorm, *convw, *convb, *ba, *bx, *lam, *wa, *wx, *st_h, *st_l, *st_c;
    float* out;
};

struct HgrnScan { float cum[16]; float kk[16]; float last; };
__device__ __forceinline__ void hgrn_scan(const Mix& M, int t0, int cb, int k, int seg, LAS float* tot, HgrnScan& hs) {
    const float l0 = M.lb[cb + k], l1 = M.lb[512 + cb + k];
    const float lb = 1.f / (1.f + expf(l1 - l0));
    float run = 0.f;
#pragma unroll
    for (int i = 0; i < 16; ++i) {
        const float fz = M.FZ[(size_t)(t0 + seg * 16 + i) * DH + cb + k];
        const float sg = 1.f / (1.f + expf(-fz)), sn = 1.f / (1.f + expf(fz));
        const float f = lb + (1.f - lb) * sg;
        run += logf(f); hs.cum[i] = run; hs.kk[i] = (1.f - lb) * sn;
    }
    tot[seg * 128 + k] = run;
    __syncthreads();
    float off = 0.f, all = 0.f;
#pragma unroll
    for (int s = 0; s < 4; ++s) { const float v = tot[s * 128 + k]; if (s < seg) off += v; all += v; }
#pragma unroll
    for (int i = 0; i < 16; ++i) hs.cum[i] += off;
    hs.last = all;
}
__device__ __forceinline__ void load_vt(const Mix& M, int t0, int cb, int k, int seg, LAS bf16_t* VT) {
    unsigned pk[8];
#pragma unroll
    for (int i = 0; i < 8; ++i) {
        const unsigned a = M.V[(size_t)(t0 + seg * 16 + 2 * i) * DH + cb + k], b = M.V[(size_t)(t0 + seg * 16 + 2 * i + 1) * DH + cb + k];
        pk[i] = a | (b << 16);
    }
    *(LAS u32x4*)(VT + k * 72 + seg * 16) = (u32x4){pk[0], pk[1], pk[2], pk[3]};
    *(LAS u32x4*)(VT + k * 72 + seg * 16 + 8) = (u32x4){pk[4], pk[5], pk[6], pk[7]};
}

__device__ __forceinline__ void hgrn_local_unit(const Mix& M, int unit, LAS unsigned char* lds) {
    const int tid = threadIdx.x, lane = tid & 63, wave = tid >> 6, fr = lane & 15, fq = lane >> 4;
    const int h = unit & 3, bc = unit >> 2, t0 = bc * 64, cb = h * 128, k = tid & 127, seg = tid >> 7;
    LAS bf16_t* KT = (LAS bf16_t*)lds; LAS bf16_t* VT = (LAS bf16_t*)(lds + 18432); LAS float* tot = (LAS float*)(lds + 36864);
    HgrnScan hs; hgrn_scan(M, t0, cb, k, seg, tot, hs);
    unsigned pk[8];
#pragma unroll
    for (int i = 0; i < 8; ++i) pk[i] = cvt_pk_bf16(hs.kk[2 * i] * expf(hs.last - hs.cum[2 * i]), hs.kk[2 * i + 1] * expf(hs.last - hs.cum[2 * i + 1]));
    *(LAS u32x4*)(KT + k * 72 + seg * 16) = (u32x4){pk[0], pk[1], pk[2], pk[3]};
    *(LAS u32x4*)(KT + k * 72 + seg * 16 + 8) = (u32x4){pk[4], pk[5], pk[6], pk[7]};
    load_vt(M, t0, cb, k, seg, VT);
    if (seg == 0) M.DC[unit * 128 + k] = expf(hs.last);
    __syncthreads();
    const bf16x8 a0 = *(const LAS bf16x8*)(VT + (16 * wave + fr) * 72 + fq * 8), a1 = *(const LAS bf16x8*)(VT + (16 * wave + fr) * 72 + 32 + fq * 8);
#pragma unroll
    for (int ct = 0; ct < 8; ++ct) {
        const bf16x8 b0 = *(const LAS bf16x8*)(KT + (16 * ct + fr) * 72 + fq * 8), b1 = *(const LAS bf16x8*)(KT + (16 * ct + fr) * 72 + 32 + fq * 8);
        f32x4 acc = {0.f, 0.f, 0.f, 0.f};
        acc = __builtin_amdgcn_mfma_f32_16x16x32_bf16(b0, a0, acc, 0, 0, 0);
        acc = __builtin_amdgcn_mfma_f32_16x16x32_bf16(b1, a1, acc, 0, 0, 0);
        u32x2 w; w.x = cvt_pk_bf16(acc[0], acc[1]); w.y = cvt_pk_bf16(acc[2], acc[3]);
        *(u32x2*)(M.LT + ((size_t)unit * 128 + 16 * wave + fr) * 128 + 16 * ct + 4 * fq) = w;
    }
    __syncthreads();
}

__device__ __forceinline__ void hgrn_out_unit(const Mix& M, int unit, LAS unsigned char* lds) {
    const int tid = threadIdx.x, lane = tid & 63, wave = tid >> 6, fr = lane & 15, fq = lane >> 4;
    const int h = unit & 3, bc = unit >> 2, t0 = bc * 64, cb = h * 128, k = tid & 127, seg = tid >> 7;
    LAS bf16_t* QS = (LAS bf16_t*)lds; LAS bf16_t* KS = (LAS bf16_t*)(lds + 17408); LAS bf16_t* VT = (LAS bf16_t*)(lds + 34816);
    LAS bf16_t* PS = (LAS bf16_t*)(lds + 53248); LAS float* tot = (LAS float*)(lds + 62464); LAS float* RS = (LAS float*)(lds + 64512);
    HgrnScan hs; hgrn_scan(M, t0, cb, k, seg, tot, hs);
#pragma unroll
    for (int i = 0; i < 16; ++i) {
        const float q = bf2f(M.Q[(size_t)(t0 + seg * 16 + i) * DH + cb + k]);
        QS[(seg * 16 + i) * 136 + k] = f2bf(q * expf(hs.cum[i]));
        KS[(seg * 16 + i) * 136 + k] = f2bf(hs.kk[i] * expf(-hs.cum[i]));
    }
    load_vt(M, t0, cb, k, seg, VT);
    __syncthreads();
#pragma unroll
    for (int r = 0; r < 2; ++r) {
        const int idx = wave + 8 * r, tr = idx >> 2, tc = idx & 3;
        f32x4 acc = {0.f, 0.f, 0.f, 0.f};
        if (tc <= tr) {
#pragma unroll
            for (int ks = 0; ks < 4; ++ks) {
                const bf16x8 a = *(const LAS bf16x8*)(QS + (16 * tr + fr) * 136 + ks * 32 + fq * 8), b = *(const LAS bf16x8*)(KS + (16 * tc + fr) * 136 + ks * 32 + fq * 8);
                acc = __builtin_amdgcn_mfma_f32_16x16x32_bf16(b, a, acc, 0, 0, 0);
            }
#pragma unroll
            for (int j = 0; j < 4; ++j) if (16 * tc + 4 * fq + j > 16 * tr + fr) acc[j] = 0.f;
        }
        u32x2 w; w.x = cvt_pk_bf16(acc[0], acc[1]); w.y = cvt_pk_bf16(acc[2], acc[3]);
        *(LAS u32x2*)(PS + (16 * tr + fr) * 72 + 16 * tc + 4 * fq) = w;
    }
    __syncthreads();
    bf16x8 bv[2], bs[4];
#pragma unroll
    for (int ks = 0; ks < 2; ++ks) bv[ks] = *(const LAS bf16x8*)(VT + (16 * wave + fr) * 72 + ks * 32 + fq * 8);
#pragma unroll
    for (int ks = 0; ks < 4; ++ks) bs[ks] = *(const bf16x8*)(M.LT + ((size_t)unit * 128 + 16 * wave + fr) * 128 + ks * 32 + fq * 8);
    f32x4 o[4];
#pragma unroll
    for (int tr = 0; tr < 4; ++tr) {
        f32x4 acc = {0.f, 0.f, 0.f, 0.f};
#pragma unroll
        for (int ks = 0; ks < 2; ++ks) { const bf16x8 a = *(const LAS bf16x8*)(PS + (16 * tr + fr) * 72 + ks * 32 + fq * 8); acc = __builtin_amdgcn_mfma_f32_16x16x32_bf16(bv[ks], a, acc, 0, 0, 0); }
#pragma unroll
        for (int ks = 0; ks < 4; ++ks) { const bf16x8 a = *(const LAS bf16x8*)(QS + (16 * tr + fr) * 136 + ks * 32 + fq * 8); acc = __builtin_amdgcn_mfma_f32_16x16x32_bf16(bs[ks], a, acc, 0, 0, 0); }
        o[tr] = acc;
        float ss = (acc[0] * acc[0] + acc[1] * acc[1]) + (acc[2] * acc[2] + acc[3] * acc[3]);
        ss += __shfl_xor(ss, 16); ss += __shfl_xor(ss, 32);
        if (fq == 0) RS[wave * 64 + 16 * tr + fr] = ss;
    }
    __syncthreads();
#pragma unroll
    for (int tr = 0; tr < 4; ++tr) {
        const int tl = 16 * tr + fr; float tt = 0.f;
#pragma unroll
        for (int w = 0; w < 8; ++w) tt += RS[w * 64 + tl];
        const float rinv = rsqrtf(tt * (1.f / 128.f) + EPS);
        const int t = t0 + tl, col = cb + 16 * wave + 4 * fq;
        const f32x4 gn = *(const f32x4*)(M.hnorm + col);
        const u32x2 sg = *(const u32x2*)(M.SG + (size_t)t * DH + col);
        u32x2 w;
        w.x = cvt_pk_bf16(o[tr][0] * rinv * gn[0] * bflo(sg.x), o[tr][1] * rinv * gn[1] * bfhi(sg.x));
        w.y = cvt_pk_bf16(o[tr][2] * rinv * gn[2] * bflo(sg.y), o[tr][3] * rinv * gn[3] * bfhi(sg.y));
        *(u32x2*)(M.O + (size_t)t * DM + col) = w;
    }
    __syncthreads();
}

__device__ __forceinline__ void lru_unit(const Mix& M, int unit, int mode, LAS unsigned char* lds) {
    const int tid = threadIdx.x, lane = tid & 63, wave = tid >> 6, fr = lane & 15, fq = lane >> 4;
    const int n = unit & 7, bc = unit >> 3, c = bc & 31, b = bc >> 5, t0 = bc * 64, ch0 = n * 64;
    const int j = tid & 63, seg = tid >> 6, ch = ch0 + j;
    LAS float* XC32 = (LAS float*)lds; LAS bf16_t* XC16 = (LAS bf16_t*)(lds + 16640); LAS float* GR = (LAS float*)(lds + 25856); LAS float* GI = (LAS float*)(lds + 42496);
    LAS float* SEGA = (LAS float*)(lds + 59136); LAS float* SEGU = (LAS float*)(lds + 61184);
    const float w0 = M.convw[ch], w1 = M.convw[512 + ch], w2 = M.convw[1024 + ch], w3 = M.convw[1536 + ch], cbias = M.convb[ch];
    const int tl0 = seg * 8; const bool first = (c == 0 && seg == 0);
    const float* xp = M.XB + (size_t)(t0 + tl0) * DH + ch;
    float xm3 = first ? 0.f : xp[-3 * DH], xm2 = first ? 0.f : xp[-2 * DH], xm1 = first ? 0.f : xp[-1 * DH];
    float xcv[8];
#pragma unroll
    for (int i = 0; i < 8; ++i) {
        const float x = xp[i * DH];
        const float xc = cbias + w0 * xm3 + w1 * xm2 + w2 * xm1 + w3 * x;
        xcv[i] = xc; XC32[(tl0 + i) * 65 + j] = xc; XC16[(tl0 + i) * 72 + j] = f2bf(xc);
        xm3 = xm2; xm2 = xm1; xm1 = x;
    }
    __syncthreads();
    {
        const int gate = wave >> 2, tr = wave & 3;
        const bf16_t* WT = (gate ? M.WXT : M.WAT) + n * 4096;
        const float* bias = (gate ? M.bx : M.ba) + ch0;
        LAS float* Gd = gate ? GI : GR;
        const bf16x8 a0 = *(const LAS bf16x8*)(XC16 + (16 * tr + fr) * 72 + fq * 8), a1 = *(const LAS bf16x8*)(XC16 + (16 * tr + fr) * 72 + 32 + fq * 8);
#pragma unroll
        for (int ct = 0; ct < 4; ++ct) {
            const bf16x8 b0 = *(const bf16x8*)(WT + (16 * ct + fr) * 64 + fq * 8), b1 = *(const bf16x8*)(WT + (16 * ct + fr) * 64 + 32 + fq * 8);
            f32x4 acc = {0.f, 0.f, 0.f, 0.f};
            acc = __builtin_amdgcn_mfma_f32_16x16x32_bf16(a0, b0, acc, 0, 0, 0);
            acc = __builtin_amdgcn_mfma_f32_16x16x32_bf16(a1, b1, acc, 0, 0, 0);
            const float bb = bias[16 * ct + fr];
#pragma unroll
            for (int jj = 0; jj < 4; ++jj) Gd[(16 * tr + 4 * fq + jj) * 65 + 16 * ct + fr] = 1.f / (1.f + expf(-(acc[jj] + bb)));
        }
    }
    __syncthreads();
    const float sp = log1pf(expf(-M.lam[ch]));
    float av[8], uv[8]; float A = 1.f, U = 0.f;
#pragma unroll
    for (int i = 0; i < 8; ++i) {
        const int tl = tl0 + i; const float r = GR[tl * 65 + j], ig = GI[tl * 65 + j];
        const float la = -8.f * r * sp, a = expf(la); float mult = sqrtf(-expm1f(2.f * la));
        if (c == 0 && tl == 0) mult = 1.f;
        const float u = mult * ig * xcv[i];
        av[i] = a; uv[i] = u; U = a * U + u; A *= a;
    }
    SEGA[seg * 64 + j] = A; SEGU[seg * 64 + j] = U;
    __syncthreads();
    float hin = (mode == 1) ? M.HST[(size_t)bc * 512 + ch] : 0.f;
#pragma unroll
    for (int s = 0; s < 8; ++s) if (s < seg) hin = SEGA[s * 64 + j] * hin + SEGU[s * 64 + j];
    if (mode == 0) {
        if (seg == 7) { float At = 1.f;
#pragma unroll
            for (int s = 0; s < 8; ++s) At *= SEGA[s * 64 + j];
            M.ACH[(size_t)bc * 512 + ch] = At; M.UCH[(size_t)bc * 512 + ch] = A * hin + U; }
    } else {
        float hh = hin;
#pragma unroll
        for (int i = 0; i < 8; ++i) {
            hh = av[i] * hh + uv[i];
            const int t = t0 + tl0 + i;
            M.O[(size_t)t * DM + 512 + ch] = f2bf(hh * bf2f(M.GY[(size_t)t * DH + ch]));
        }
        if (c == 31 && seg == 7) M.out[OUT_LP + b * 512 + ch] = hh;
        if (c == 31 && tid < 192) { const int r = tid >> 6; M.out[OUT_CP + (size_t)(b * 3 + r) * 512 + ch0 + j] = M.XB[(size_t)(b * SEQ + SEQ - 3 + r) * DH + ch0 + j]; }
    }
    __syncthreads();
}

__device__ __forceinline__ void hgrn_sample_unit(const Mix& M, int unit, LAS unsigned char* lds) {
    const int tid = threadIdx.x, lane = tid & 63, wave = tid >> 6;
    const int h = unit & 3, b = unit >> 2, cb = h * 128, tb = TP + b * 4;
    LAS float* SQ = (LAS float*)lds;
    LAS float* SK = SQ + 512;
    LAS float* SD = SK + 512;
    LAS float* SP = SD + 128;
    LAS float* OP = SP + 32;
    LAS float* RS = OP + 2048;
    if (tid < 128) {
        const int k = tid;
        const float l0 = M.lb[cb + k], l1 = M.lb[512 + cb + k];
        const float lb = 1.f / (1.f + expf(l1 - l0));
        float cum[4], kk[4], qv[4]; float run = 0.f;
#pragma unroll
        for (int s = 0; s < 4; ++s) {
            const float fz = M.FZ[(size_t)(tb + s) * DH + cb + k];
            const float sg = 1.f / (1.f + expf(-fz)), sn = 1.f / (1.f + expf(fz));
            run += logf(lb + (1.f - lb) * sg); cum[s] = run; kk[s] = (1.f - lb) * sn;
            qv[s] = bf2f(M.Q[(size_t)(tb + s) * DH + cb + k]);
        }
#pragma unroll
        for (int s = 0; s < 4; ++s) { SQ[s * 128 + k] = qv[s] * expf(cum[s]); SK[s * 128 + k] = kk[s] * expf(cum[3] - cum[s]); }
        SD[k] = expf(cum[3]);
        float pr[10]; int c = 0;
#pragma unroll
        for (int t = 0; t < 4; ++t)
#pragma unroll
            for (int s = 0; s <= t; ++s) { pr[c] = qv[t] * kk[s] * expf(cum[t] - cum[s]); ++c; }
#pragma unroll
        for (int i = 0; i < 10; ++i) { const float v = wave_sum(pr[i]); if (lane == 0) SP[wave * 16 + i] = v; }
    }
    __syncthreads();
    const int v = tid & 127, kq = tid >> 7;
    float vv[4];
#pragma unroll
    for (int s = 0; s < 4; ++s) vv[s] = bf2f(M.V[(size_t)(tb + s) * DH + cb + v]);
    {
        float o[4] = {0.f, 0.f, 0.f, 0.f};
        const size_t sb = ((size_t)(b * 4 + h) * 128) * 128;
#pragma unroll 8
        for (int kx = 0; kx < 32; ++kx) {
            const int k = kq * 32 + kx;
            const float s0 = M.st_h[sb + (size_t)k * 128 + v];
            float sn = SD[k] * s0;
#pragma unroll
            for (int s = 0; s < 4; ++s) { o[s] += SQ[s * 128 + k] * s0; sn += SK[s * 128 + k] * vv[s]; }
            M.out[OUT_HS + sb + (size_t)k * 128 + v] = sn;
        }
#pragma unroll
        for (int s = 0; s < 4; ++s) OP[(kq * 4 + s) * 128 + v] = o[s];
    }
    __syncthreads();
    {
        const int t = kq;
        float ov = (OP[(0 * 4 + t) * 128 + v] + OP[(1 * 4 + t) * 128 + v]) + (OP[(2 * 4 + t) * 128 + v] + OP[(3 * 4 + t) * 128 + v]);
        const int base = t * (t + 1) / 2;
        for (int s = 0; s <= t; ++s) ov += (SP[base + s] + SP[16 + base + s]) * vv[s];
        const float ssq = wave_sum(ov * ov);
        if (lane == 0) RS[wave] = ssq;
        __syncthreads();
        const float tt = RS[2 * t] + RS[2 * t + 1];
        const float rinv = rsqrtf(tt * (1.f / 128.f) + EPS);
        const size_t tok = (size_t)(tb + t);
        M.O[tok * DM + cb + v] = f2bf(ov * rinv * M.hnorm[cb + v] * bf2f(M.SG[tok * DH + cb + v]));
    }
    __syncthreads();
}

__device__ __forceinline__ void lru_sample_unit(const Mix& M, int b, LAS unsigned char* lds) {
    const int tid = threadIdx.x, ch = tid, n = ch >> 6, j = ch & 63, tb = TP + b * 4;
    LAS float* XC = (LAS float*)lds;
    float x[7];
#pragma unroll
    for (int r = 0; r < 3; ++r) x[r] = M.st_c[(size_t)(b * 3 + r) * 512 + ch];
#pragma unroll
    for (int s = 0; s < 4; ++s) x[3 + s] = M.XB[(size_t)(tb + s) * DH + ch];
    const float w0 = M.convw[ch], w1 = M.convw[512 + ch], w2 = M.convw[1024 + ch], w3 = M.convw[1536 + ch], cbias = M.convb[ch];
    float xc[4];
#pragma unroll
    for (int s = 0; s < 4; ++s) { xc[s] = cbias + w0 * x[s] + w1 * x[s + 1] + w2 * x[s + 2] + w3 * x[s + 3]; XC[s * 512 + ch] = xc[s]; }
#pragma unroll
    for (int r = 0; r < 3; ++r) M.out[OUT_CS + (size_t)(b * 3 + r) * 512 + ch] = x[4 + r];
    __syncthreads();
    float ra[4], rx[4];
    const float ba = M.ba[ch], bx = M.bx[ch];
#pragma unroll
    for (int s = 0; s < 4; ++s) { ra[s] = ba; rx[s] = bx; }
    const float* wa = M.wa + (size_t)n * 4096 + j; const float* wx = M.wx + (size_t)n * 4096 + j;
#pragma unroll 4
    for (int i = 0; i < 64; ++i) {
        const float a = wa[i * 64], xw = wx[i * 64];
#pragma unroll
        for (int s = 0; s < 4; ++s) { const float xv = XC[s * 512 + n * 64 + i]; ra[s] += xv * a; rx[s] += xv * xw; }
    }
    const float sp = log1pf(expf(-M.lam[ch]));
    float hh = M.st_l[(size_t)b * 512 + ch];
#pragma unroll
    for (int s = 0; s < 4; ++s) {
        const float r = 1.f / (1.f + expf(-ra[s])), ig = 1.f / (1.f + expf(-rx[s]));
        const float la = -8.f * r * sp, a = expf(la), mult = sqrtf(-expm1f(2.f * la));
        hh = a * hh + mult * ig * xc[s];
        M.O[(size_t)(tb + s) * DM + 512 + ch] = f2bf(hh * bf2f(M.GY[(size_t)(tb + s) * DH + ch]));
    }
    M.out[OUT_LS + (size_t)b * 512 + ch] = hh;
    __syncthreads();
}

__device__ __forceinline__ void scan_item(const Mix& M, int item) {
    const int tid = threadIdx.x;
    if (item < 1024) {
        const int e = item * 512 + tid, bh = e >> 14, vk = e & 16383, b = bh >> 2, h = bh & 3, v = vk >> 7, k = vk & 127;
        float l[32], d[32];
#pragma unroll
        for (int c = 0; c < 32; ++c) { const int unit = (b * 32 + c) * 4 + h; l[c] = bf2f(M.LT[(size_t)unit * 16384 + vk]); d[c] = M.DC[unit * 128 + k]; }
        float S = 0.f;
#pragma unroll
        for (int c = 0; c < 32; ++c) { const int unit = (b * 32 + c) * 4 + h; M.LT[(size_t)unit * 16384 + vk] = f2bf(S); S = d[c] * S + l[c]; }
        M.out[OUT_HP + ((size_t)(b * 4 + h) * 128 + k) * 128 + v] = S;
    } else {
        const int e = (item - 1024) * 512 + tid, b = e >> 9, ch = e & 511;
        float hcar = 0.f;
        for (int c = 0; c < 32; ++c) { const size_t idx = (size_t)(b * 32 + c) * 512 + ch; M.HST[idx] = hcar; hcar = M.ACH[idx] * hcar + M.UCH[idx]; }
    }
}

__global__ void __launch_bounds__(512, 2) mk_fwd(Params p) {
    extern __shared__ __attribute__((aligned(16))) unsigned char lds_raw[];
    LAS unsigned char* lds = (LAS unsigned char*)lds_raw;
    const int lo = p.ph_lo, hi = p.ph_hi, G = gridDim.x;
    unsigned char* ws = p.ws;
#define IN(k) (lo <= (k) && (k) < hi)
#define SEAM(k) do { if (IN(k) && IN((k) + 1)) { asm volatile("s_waitcnt vmcnt(0) lgkmcnt(0)" ::: "memory"); __syncthreads(); cg::this_grid().sync(); \
        __builtin_amdgcn_fence(__ATOMIC_ACQUIRE, "agent"); asm volatile("s_waitcnt vmcnt(0)" ::: "memory"); } } while (0)
    bf16_t* B0 = (bf16_t*)(ws + WS_B0); bf16_t* B1 = (bf16_t*)(ws + WS_B1); bf16_t* H = (bf16_t*)(ws + WS_H);
    float* SS0 = (float*)(ws + WS_SS0); float* SS1 = (float*)(ws + WS_SS1); float* SS2 = (float*)(ws + WS_SS2); float* SS3 = (float*)(ws + WS_SS3);

    if (IN(0)) { phase0(p, lds); __syncthreads(); }
    SEAM(0);
    if (IN(1)) {
        pg8::Gemm g{B0, (const bf16_t*)(ws + WS_WG1), T_ALL, 2 * DFF, DM}; pg8::StaticOrder S; S.init(T_ALL, 2 * DFF, G, (int)blockIdx.x);
        EpiGateUp E{H, SS0};
        pg8::gemm_phase<EpiGateUp, pg8::StaticOrder, PG8_ALIGN, PG8_SP2>(lds, g, S, E);
    }
    SEAM(1);
    if (IN(2)) {
        pg8::Gemm g{H, (const bf16_t*)(ws + WS_WD1), T_ALL, DM, DFF}; pg8::StaticOrder S; S.init(T_ALL, DM, G, (int)blockIdx.x);
        EpiResid E{p.in[0], p.in[1], p.out, B0, p.in[9], SS1, 0.5f};
        pg8::gemm_phase<EpiResid, pg8::StaticOrder, PG8_ALIGN, PG8_SP2>(lds, g, S, E);
    }
    SEAM(2);
    if (IN(3)) {
        pg8::Gemm g{B0, (const bf16_t*)(ws + WS_WIN), T_ALL, DIN, DM}; pg8::StaticOrder S; S.init(T_ALL, DIN, G, (int)blockIdx.x);
        EpiProj E{(bf16_t*)(ws + WS_Q), (bf16_t*)(ws + WS_V), (bf16_t*)(ws + WS_SG), (bf16_t*)(ws + WS_GY), (float*)(ws + WS_FZ), (float*)(ws + WS_XB), SS1};
        pg8::gemm_phase<EpiProj, pg8::StaticOrder, PG8_ALIGN, PG8_SP2>(lds, g, S, E);
    }
    SEAM(3);
    Mix M;
    M.Q = (const bf16_t*)(ws + WS_Q); M.V = (const bf16_t*)(ws + WS_V); M.SG = (const bf16_t*)(ws + WS_SG); M.GY = (const bf16_t*)(ws + WS_GY);
    M.FZ = (const float*)(ws + WS_FZ); M.XB = (const float*)(ws + WS_XB); M.LT = (bf16_t*)(ws + WS_LT); M.DC = (float*)(ws + WS_DC);
    M.ACH = (float*)(ws + WS_ACH); M.UCH = (float*)(ws + WS_UCH); M.HST = (float*)(ws + WS_HST); M.O = B0;
    M.WAT = (const bf16_t*)(ws + WS_WAT); M.WXT = (const bf16_t*)(ws + WS_WXT);
    M.lb = p.in[11]; M.hnorm = p.in[12]; M.convw = p.in[13]; M.convb = p.in[14]; M.wa = p.in[15]; M.ba = p.in[16]; M.wx = p.in[17]; M.bx = p.in[18]; M.lam = p.in[19];
    M.st_h = p.in[2]; M.st_l = p.in[3]; M.st_c = p.in[4]; M.out = p.out;
    if (IN(4)) {
        for (int u = blockIdx.x; u < 3712; u += G) {
            if (u < 512) hgrn_sample_unit(M, u, lds);
            else if (u < 1536) hgrn_local_unit(M, u - 512, lds);
            else if (u < 3584) lru_unit(M, u - 1536, 0, lds);
            else lru_sample_unit(M, u - 3584, lds);
        }
    }
    SEAM(4);
    if (IN(5)) { for (int it = blockIdx.x; it < 1032; it += G) scan_item(M, it); }
    SEAM(5);
    if (IN(6)) {
        for (int u = blockIdx.x; u < 3072; u += G) {
            if (u < 1024) hgrn_out_unit(M, u, lds);
            else lru_unit(M, u - 1024, 1, lds);
        }
    }
    SEAM(6);
    if (IN(7)) {
        pg8::Gemm g{B0, (const bf16_t*)(ws + WS_WO), T_ALL, DM, DM}; pg8::StaticOrder S; S.init(T_ALL, DM, G, (int)blockIdx.x);
        EpiResid E{p.out, p.out + (size_t)TP * DM, p.out, B1, p.in[21], SS2, 1.0f};
        pg8::gemm_phase<EpiResid, pg8::StaticOrder, PG8_ALIGN, PG8_SP2>(lds, g, S, E);
    }
    SEAM(7);
    if (IN(8)) {
        pg8::Gemm g{B1, (const bf16_t*)(ws + WS_WG2), T_ALL, 2 * DFF, DM}; pg8::StaticOrder S; S.init(T_ALL, 2 * DFF, G, (int)blockIdx.x);
        EpiGateUp E{H, SS2};
        pg8::gemm_phase<EpiGateUp, pg8::StaticOrder, PG8_ALIGN, PG8_SP2>(lds, g, S, E);
    }
    SEAM(8);
    if (IN(9)) {
        pg8::Gemm g{H, (const bf16_t*)(ws + WS_WD2), T_ALL, DM, DFF}; pg8::StaticOrder S; S.init(T_ALL, DM, G, (int)blockIdx.x);
        EpiResid E{p.out, p.out + (size_t)TP * DM, p.out, nullptr, nullptr, SS3, 0.5f};
        pg8::gemm_phase<EpiResid, pg8::StaticOrder, PG8_ALIGN, PG8_SP2>(lds, g, S, E);
    }
    SEAM(9);
    if (IN(10)) phase_final(p);
#undef IN
#undef SEAM
}

extern "C" void kernel_launch(void* const* d_in, const int* in_sizes, int n_in, void* d_out, int out_size, void* d_ws, size_t ws_size, hipStream_t stream) {
    static int grid = 0;
    if (grid == 0) {
        if (n_in != 26 || ws_size < WS_END) { fprintf(stderr, "kernel_launch: unexpected n_in %d or ws_size %zu (need %zu)\n", n_in, ws_size, (size_t)WS_END); grid = -1; return; }
        int dev = 0, cus = 0, per_cu = 0;
        hipGetDevice(&dev); hipDeviceGetAttribute(&cus, hipDeviceAttributeMultiprocessorCount, dev);
        if (hipFuncSetAttribute((const void*)mk_fwd, hipFuncAttributeMaxDynamicSharedMemorySize, LDS_BYTES) != hipSuccess) { fprintf(stderr, "kernel_launch: hipFuncSetAttribute failed\n"); grid = -1; return; }
        if (hipOccupancyMaxActiveBlocksPerMultiprocessor(&per_cu, (const void*)mk_fwd, 512, LDS_BYTES) != hipSuccess || per_cu < 1) { fprintf(stderr, "kernel_launch: occupancy query says %d\n", per_cu); per_cu = 1; }
        (void)hipGetLastError();
        grid = cus;
    }
    if (grid < 0) return;
    Params p{};
    for (int i = 0; i < 26; ++i) p.in[i] = (const float*)d_in[i];
    p.out = (float*)d_out; p.ws = (unsigned char*)d_ws;
#if MK_PER_PHASE
    for (int ph = 0; ph < MK_NPH; ++ph) { p.ph_lo = ph; p.ph_hi = ph + 1; hipLaunchKernelGGL(mk_fwd, dim3(grid), dim3(512), LDS_BYTES, stream, p); }
#else
    p.ph_lo = 0; p.ph_hi = MK_NPH;
    void* args[] = {&p};
    hipError_t e = hipLaunchCooperativeKernel((const void*)mk_fwd, dim3(grid), dim3(512), args, LDS_BYTES, stream);
    if (e != hipSuccess) fprintf(stderr, "cooperative launch failed: %s (grid %d)\n", hipGetErrorString(e), grid);
#endif
}
```

```cpp
#include <hip/hip_runtime.h>
#include <hip/hip_cooperative_groups.h>
#include <cstdio>
#include <cstdint>
namespace cg = cooperative_groups;

#ifndef MK_DUP
#define MK_DUP 0
#endif
#ifndef MK_NPH
#define MK_NPH 11
#endif
#ifndef MK_PER_PHASE
#define MK_PER_PHASE 0
#endif

#define LAS __attribute__((address_space(3)))
typedef unsigned short bf16_t;
typedef short bf16x8 __attribute__((ext_vector_type(8)));
typedef float f32x4 __attribute__((ext_vector_type(4)));
typedef unsigned u32x4 __attribute__((ext_vector_type(4)));
typedef unsigned u32x2 __attribute__((ext_vector_type(2)));

constexpr int T_ALL = 16896, TP = 16384, DM = 1024, DFF = 2816, DIN = 3072, DH = 512;
constexpr int SEQ = 2048, NB = 8, NCH = 32, DECB = 128;
constexpr float EPS = 1e-6f;

constexpr size_t OUT_Y = 0, OUT_HP = 17301504, OUT_LP = 17825792, OUT_CP = 17829888, OUT_HS = 17842176, OUT_LS = 26230784, OUT_CS = 26296320;

constexpr size_t WS_WG1 = 0;
constexpr size_t WS_WD1 = WS_WG1 + (size_t)5632 * 1024 * 2;
constexpr size_t WS_WIN = WS_WD1 + (size_t)1024 * 2816 * 2;
constexpr size_t WS_WO  = WS_WIN + (size_t)3072 * 1024 * 2;
constexpr size_t WS_WG2 = WS_WO + (size_t)1024 * 1024 * 2;
constexpr size_t WS_WD2 = WS_WG2 + (size_t)5632 * 1024 * 2;
constexpr size_t WS_WAT = WS_WD2 + (size_t)1024 * 2816 * 2;
constexpr size_t WS_WXT = WS_WAT + 65536;
constexpr size_t WS_SS0 = WS_WXT + 65536;
constexpr size_t SS_BYTES = (size_t)T_ALL * 16 * 4;
constexpr size_t WS_SS1 = WS_SS0 + SS_BYTES, WS_SS2 = WS_SS1 + SS_BYTES, WS_SS3 = WS_SS2 + SS_BYTES;
constexpr size_t WS_DC  = WS_SS3 + SS_BYTES;
constexpr size_t WS_ACH = WS_DC + (size_t)1024 * 128 * 4;
constexpr size_t WS_UCH = WS_ACH + (size_t)NB * NCH * 512 * 4;
constexpr size_t WS_HST = WS_UCH + (size_t)NB * NCH * 512 * 4;
constexpr size_t WS_B0  = WS_HST + (size_t)NB * NCH * 512 * 4;
constexpr size_t WS_R   = WS_B0 + (size_t)T_ALL * 1024 * 2;
constexpr size_t WS_H   = WS_R;
constexpr size_t WS_B1  = WS_H + (size_t)T_ALL * 2816 * 2;
constexpr size_t WS_Q   = WS_R;
constexpr size_t WS_V   = WS_Q + (size_t)T_ALL * 512 * 2;
constexpr size_t WS_SG  = WS_V + (size_t)T_ALL * 512 * 2;
constexpr size_t WS_GY  = WS_SG + (size_t)T_ALL * 512 * 2;
constexpr size_t WS_FZ  = WS_GY + (size_t)T_ALL * 512 * 2;
constexpr size_t WS_XB  = WS_FZ + (size_t)T_ALL * 512 * 4;
constexpr size_t WS_LT  = WS_XB + (size_t)T_ALL * 512 * 4;
constexpr size_t WS_END = WS_LT + (size_t)1024 * 16384 * 2;
constexpr size_t WS_BAR = WS_END;
constexpr size_t WS_END2 = WS_BAR + 16384;
static_assert(WS_END2 <= 268435456, "workspace budget");
static_assert(WS_B1 + (size_t)T_ALL * 1024 * 2 <= WS_END, "B1 inside R");

constexpr int LDS_BYTES = 131072 + 64;

typedef __bf16 nbf16x2 __attribute__((ext_vector_type(2)));
typedef float f32x2 __attribute__((ext_vector_type(2)));
__device__ __forceinline__ unsigned cvt_pk_bf16(float lo, float hi) { const nbf16x2 r = __builtin_convertvector((f32x2){lo, hi}, nbf16x2); return __builtin_bit_cast(unsigned, r); }
__device__ __forceinline__ bf16_t f2bf(float f) { return (bf16_t)(cvt_pk_bf16(f, 0.f) & 0xffffu); }
__device__ __forceinline__ float bf2f(bf16_t b) { return __uint_as_float(((unsigned)b) << 16); }
__device__ __forceinline__ float bflo(unsigned w) { return __uint_as_float(w << 16); }
__device__ __forceinline__ float bfhi(unsigned w) { return __uint_as_float(w & 0xffff0000u); }
__device__ __forceinline__ float sigm(float x) { return __builtin_amdgcn_rcpf(1.f + __expf(-x)); }
__device__ __forceinline__ float rowscale(const float* ss, int row) {
    const f32x4* p = (const f32x4*)(ss + (size_t)row * 16);
    const f32x4 a = p[0], b = p[1], c = p[2], d = p[3];
    const float s = (((a.x + a.y) + (a.z + a.w)) + ((b.x + b.y) + (b.z + b.w))) + (((c.x + c.y) + (c.z + c.w)) + ((d.x + d.y) + (d.z + d.w)));
    return rsqrtf(s * (1.f / 1024.f) + EPS);
}
__device__ __forceinline__ float wave_sum(float v) {
#pragma unroll
    for (int o = 1; o < 64; o <<= 1) v += __shfl_xor(v, o);
    return v;
}
#define LDS_WAIT() asm volatile("s_waitcnt lgkmcnt(0)" ::: "memory")

namespace pg8 {
constexpr int BM = 256, BK = 64, HALF = 128, HTB = HALF * BK * 2, STAGE_BYTES = 8 * HTB, NXCD = 8, WGM = 8;
__host__ __device__ __forceinline__ int lds_byte(int r, int c) { const int st = (r >> 4) * 2 + (c >> 5), rr = r & 15, cc = c & 31, ob = rr * 64 + cc * 2; return st * 1024 + (ob ^ (((ob >> 9) & 1) << 5)); }
__host__ __device__ __forceinline__ void stage_rc(int b, int& R, int& C) { const int st = b / 1024, sb = b % 1024, swz = sb ^ (((sb >> 9) & 1) << 5); R = (st >> 1) * 16 + swz / 64; C = (st & 1) * 32 + (swz % 64) / 2; }
__host__ __device__ __forceinline__ int perm32(int rho) { const int n = rho >> 4, i = rho & 15; return 8 * (i >> 2) + 4 * n + (i & 3); }
struct Unit { int pm, pn; };
struct Gemm { const bf16_t* A; const bf16_t* Bt; int M, N, K; };
struct StaticOrder {
    int nM, nN, nwg, G, c;
    __host__ __device__ void init(int M, int N, int G_, int c_) { nM = M / BM; nN = N / BM; nwg = nM * nN; G = G_; c = c_; }
    __host__ __device__ bool next(int i, Unit& u) const {
        const long L = (long)i * G + c; if (L >= nwg) return false;
        int wgid = (int)L; { const int q = nwg / NXCD, r = nwg % NXCD, xcd = wgid % NXCD, off = wgid / NXCD; wgid = (xcd < r ? xcd * (q + 1) : r * (q + 1) + (xcd - r) * q) + off; }
        const int nig = WGM * nN, gid = wgid / nig, fm = gid * WGM, gsz = (nM - fm) < WGM ? (nM - fm) : WGM;
        u.pm = fm + ((wgid % nig) % gsz); u.pn = (wgid % nig) / gsz; return true;
    }
    __device__ __forceinline__ void a_ready(const Unit&) const {}
    __device__ __forceinline__ void done(const Unit&) const {}
};

template <class Epi, class Sched, bool ALIGN_EPI = false, bool SP2 = false>
__device__ __forceinline__ void gemm_phase(LAS unsigned char* lds, const Gemm g, const Sched& S, const Epi& E) {
    const int tid = threadIdx.x, wid = __builtin_amdgcn_readfirstlane(tid >> 6), lane = tid & 63, wr = wid >> 2, wc = wid & 3, fr = lane & 15, fq = lane >> 4;
    const int K = g.K, nt = K / BK;
    unsigned voffA[2], voffB[2];
#pragma unroll
    for (int i = 0; i < 2; ++i) { int R, C; stage_rc(tid * 16 + i * 8192, R, C); const int Rb = Epi::PERM ? ((R & ~31) + perm32(R & 31)) : R;
        voffA[i] = (unsigned)(R * K + C) * 2u; voffB[i] = (unsigned)(Rb * K + C) * 2u; }
    const size_t kstep = (size_t)(BK * 2);
    const size_t hstep = (size_t)HALF * K * 2;
    const size_t tstep = 2 * hstep;
    const unsigned ldsw = (unsigned)wid * 1024u;
    const int aoff = lds_byte(wr * 64 + fr, fq * 8), boff = lds_byte(wc * 32 + fr, fq * 8);
#define PG8_SA(b, h) (((b) * 2 + (h)) * HTB)
#define PG8_SB(b, h) ((4 + (b) * 2 + (h)) * HTB)
#define PG8_STAGE(bufoff, gbase, voff) do { _Pragma("unroll") for (int _i = 0; _i < 2; ++_i) \
        __builtin_amdgcn_global_load_lds((const unsigned*)((const char*)(gbase) + (voff)[_i]), (LAS unsigned*)(lds + (bufoff) + ldsw + _i * 8192), 16, 0, 0); } while (0)
#define PG8_LDA(dst, b, h) do { _Pragma("unroll") for (int m = 0; m < 4; ++m) _Pragma("unroll") for (int k = 0; k < 2; ++k) dst[m][k] = *(const LAS bf16x8*)(lds + PG8_SA(b, h) + aoff + m * 2048 + k * 1024); } while (0)
#define PG8_LDB(dst, b, h) do { _Pragma("unroll") for (int n = 0; n < 2; ++n) _Pragma("unroll") for (int k = 0; k < 2; ++k) dst[n][k] = *(const LAS bf16x8*)(lds + PG8_SB(b, h) + boff + n * 2048 + k * 1024); } while (0)
#define PG8_MMA(ai, bj, At, Bt) do { __builtin_amdgcn_s_setprio(1); _Pragma("unroll") for (int m = 0; m < 4; ++m) _Pragma("unroll") for (int n = 0; n < 2; ++n) _Pragma("unroll") for (int k = 0; k < 2; ++k) \
        acc[ai][bj][m][n] = __builtin_amdgcn_mfma_f32_16x16x32_bf16(Bt[n][k], At[m][k], acc[ai][bj][m][n], 0, 0, 0); __builtin_amdgcn_s_setprio(0); } while (0)
#define PG8_WAIT_V(n) asm volatile("s_waitcnt vmcnt(" #n ")" ::: "memory")
#define PG8_WAIT_L(n) asm volatile("s_waitcnt lgkmcnt(" #n ")" ::: "memory")
#define PG8_BAR __builtin_amdgcn_s_barrier()
#define PG8_SCHED __builtin_amdgcn_sched_barrier(0)
    Unit cur, nxt; int ui = 0;
    if (!S.next(0, cur)) return;
    f32x4 acc[2][2][4][2];
#pragma unroll
    for (int a = 0; a < 2; ++a)
#pragma unroll
        for (int b = 0; b < 2; ++b)
#pragma unroll
            for (int m = 0; m < 4; ++m)
#pragma unroll
                for (int n = 0; n < 2; ++n) acc[a][b][m][n] = (f32x4){0.f, 0.f, 0.f, 0.f};
    bf16x8 At[4][2], B0[2][2], B1[2][2];
    const char* cA = (const char*)g.A + (size_t)cur.pm * tstep; const char* cB = (const char*)g.Bt + (size_t)cur.pn * tstep;
    S.a_ready(cur);
    if constexpr (SP2) {
        PG8_STAGE(PG8_SB(0, 0), cB, voffB); PG8_STAGE(PG8_SB(0, 1), cB + hstep, voffB); PG8_STAGE(PG8_SA(0, 0), cA, voffA); PG8_STAGE(PG8_SA(0, 1), cA + hstep, voffA);
        if (wr == 1) PG8_BAR;
        PG8_WAIT_V(2); PG8_BAR;
        PG8_STAGE(PG8_SB(1, 0), cB + kstep, voffB); PG8_STAGE(PG8_SA(1, 0), cA + kstep, voffA); PG8_STAGE(PG8_SB(1, 1), cB + hstep + kstep, voffB);
        PG8_WAIT_V(6); PG8_BAR;
    } else {
        PG8_STAGE(PG8_SB(0, 0), cB, voffB); PG8_STAGE(PG8_SA(0, 0), cA, voffA); PG8_STAGE(PG8_SB(0, 1), cB + hstep, voffB); PG8_STAGE(PG8_SA(0, 1), cA + hstep, voffA);
        if (wr == 1) PG8_BAR;
        PG8_WAIT_V(4); PG8_BAR;
        PG8_STAGE(PG8_SB(1, 0), cB + kstep, voffB); PG8_STAGE(PG8_SA(1, 0), cA + kstep, voffA); PG8_STAGE(PG8_SB(1, 1), cB + hstep + kstep, voffB);
        PG8_WAIT_V(6); PG8_BAR;
    }
    for (;;) {
        const bool has_next = S.next(ui + 1, nxt);
        const char* nA = has_next ? (const char*)g.A + (size_t)nxt.pm * tstep : cA; const char* nB = has_next ? (const char*)g.Bt + (size_t)nxt.pn * tstep : cB;
        for (int t = 0; t < nt; t += 2) {
            const bool last = (t == nt - 2);
            const char* a1 = cA + (size_t)(t + 1) * kstep;
            const char* a2 = last ? nA : cA + (size_t)(t + 2) * kstep; const char* b2 = last ? nB : cB + (size_t)(t + 2) * kstep;
            const char* a3 = a2 + kstep; const char* b3 = b2 + kstep;
            if (last && has_next) S.a_ready(nxt);
            if constexpr (SP2) {
            PG8_LDB(B0, 0, 0); PG8_LDB(B1, 0, 1); PG8_SCHED; PG8_LDA(At, 0, 0); PG8_STAGE(PG8_SA(1, 1), a1 + hstep, voffA);
            PG8_WAIT_V(8); PG8_WAIT_L(0); PG8_BAR; PG8_MMA(0, 0, At, B0); PG8_MMA(0, 1, At, B1); PG8_BAR; PG8_SCHED;
            PG8_LDA(At, 0, 1); PG8_STAGE(PG8_SB(0, 0), b2, voffB); PG8_STAGE(PG8_SB(0, 1), b2 + hstep, voffB); PG8_STAGE(PG8_SA(0, 0), a2, voffA);
            PG8_WAIT_V(8); PG8_WAIT_L(0); PG8_BAR; PG8_MMA(1, 0, At, B0); PG8_MMA(1, 1, At, B1); PG8_BAR; PG8_SCHED;
            PG8_LDB(B0, 1, 0); PG8_LDB(B1, 1, 1); PG8_SCHED; PG8_LDA(At, 1, 0); PG8_STAGE(PG8_SA(0, 1), a2 + hstep, voffA);
            PG8_WAIT_V(8); PG8_WAIT_L(0); PG8_BAR; PG8_MMA(0, 0, At, B0); PG8_MMA(0, 1, At, B1); PG8_BAR; PG8_SCHED;
            PG8_LDA(At, 1, 1); PG8_STAGE(PG8_SB(1, 0), b3, voffB); PG8_STAGE(PG8_SB(1, 1), b3 + hstep, voffB); PG8_STAGE(PG8_SA(1, 0), a3, voffA);
            PG8_WAIT_V(8); PG8_WAIT_L(0); PG8_BAR; PG8_MMA(1, 0, At, B0); PG8_MMA(1, 1, At, B1); PG8_BAR; PG8_SCHED;
            } else {
            PG8_LDB(B0, 0, 0); PG8_SCHED; PG8_LDA(At, 0, 0); PG8_STAGE(PG8_SA(1, 1), a1 + hstep, voffA);
            PG8_WAIT_L(8); PG8_BAR; PG8_WAIT_L(0); PG8_MMA(0, 0, At, B0); PG8_BAR; PG8_SCHED;
            PG8_LDB(B1, 0, 1); PG8_STAGE(PG8_SB(0, 0), b2, voffB);
            PG8_BAR; PG8_WAIT_L(0); PG8_MMA(0, 1, At, B1); PG8_BAR;
            PG8_LDA(At, 0, 1); PG8_STAGE(PG8_SA(0, 0), a2, voffA);
            PG8_BAR; PG8_WAIT_L(0); PG8_MMA(1, 0, At, B0); PG8_BAR; PG8_SCHED;
            PG8_STAGE(PG8_SB(0, 1), b2 + hstep, voffB);
            PG8_WAIT_V(6); PG8_BAR; PG8_MMA(1, 1, At, B1); PG8_BAR;
            PG8_LDB(B0, 1, 0); PG8_SCHED; PG8_LDA(At, 1, 0); PG8_STAGE(PG8_SA(0, 1), a2 + hstep, voffA);
            PG8_WAIT_L(8); PG8_BAR; PG8_WAIT_L(0); PG8_MMA(0, 0, At, B0); PG8_BAR; PG8_SCHED;
            PG8_LDB(B1, 1, 1); PG8_STAGE(PG8_SB(1, 0), b3, voffB);
            PG8_BAR; PG8_WAIT_L(0); PG8_MMA(0, 1, At, B1); PG8_BAR;
            PG8_LDA(At, 1, 1); PG8_STAGE(PG8_SA(1, 0), a3, voffA);
            PG8_BAR; PG8_WAIT_L(0); PG8_MMA(1, 0, At, B0); PG8_BAR; PG8_SCHED;
            PG8_STAGE(PG8_SB(1, 1), b3 + hstep, voffB);
            PG8_WAIT_V(6); PG8_BAR; PG8_MMA(1, 1, At, B1); PG8_BAR;
            }
        }
        if constexpr (ALIGN_EPI) { if (wr == 0) PG8_BAR; }
        E(acc, cur, wr, wc, fr, fq); S.done(cur);
        if (!has_next) break;
#pragma unroll
        for (int a = 0; a < 2; ++a)
#pragma unroll
            for (int b = 0; b < 2; ++b)
#pragma unroll
                for (int m = 0; m < 4; ++m)
#pragma unroll
                    for (int n = 0; n < 2; ++n) acc[a][b][m][n] = (f32x4){0.f, 0.f, 0.f, 0.f};
        cur = nxt; cA = nA; cB = nB; ++ui;
        if constexpr (ALIGN_EPI) { if (wr == 1) PG8_BAR; }
    }
    PG8_WAIT_V(0);
    if constexpr (!ALIGN_EPI) { if (wr == 0) PG8_BAR; }
    PG8_BAR;
#undef PG8_SA
#undef PG8_SB
#undef PG8_STAGE
#undef PG8_LDA
#undef PG8_LDB
#undef PG8_MMA
#undef PG8_WAIT_V
#undef PG8_WAIT_L
#undef PG8_BAR
#undef PG8_SCHED
}
}

#ifndef PG8_SP2
#define PG8_SP2 true
#endif
#ifndef PG8_ALIGN
#define PG8_ALIGN true
#endif

struct EpiGateUp {
    static constexpr bool PERM = true;
    bf16_t* H; const float* ss;
    __device__ __forceinline__ void operator()(const f32x4 (&acc)[2][2][4][2], const pg8::Unit& u, int wr, int wc, int fr, int fq) const {
        const int row0 = u.pm * 256 + wr * 64 + fr, col0 = u.pn * 128 + wc * 32 + 8 * fq;
#pragma unroll
        for (int ai = 0; ai < 2; ++ai)
#pragma unroll
            for (int m = 0; m < 4; ++m) {
                const int row = row0 + ai * 128 + m * 16; const float rs = rowscale(ss, row);
                float h[8];
#pragma unroll
                for (int n = 0; n < 2; ++n)
#pragma unroll
                    for (int j = 0; j < 4; ++j) { const float g = acc[ai][0][m][n][j] * rs, up = acc[ai][1][m][n][j] * rs; h[n * 4 + j] = g * sigm(g) * up; }
                u32x4 w; w.x = cvt_pk_bf16(h[0], h[1]); w.y = cvt_pk_bf16(h[2], h[3]); w.z = cvt_pk_bf16(h[4], h[5]); w.w = cvt_pk_bf16(h[6], h[7]);
                *(u32x4*)(H + (size_t)row * DFF + col0) = w;
            }
    }
};
struct EpiResid {
    static constexpr bool PERM = true;
    const float* xin_p; const float* xin_s; float* xout; bf16_t* ax; const float* gnext; float* ssout; float scale;
    __device__ __forceinline__ void operator()(const f32x4 (&acc)[2][2][4][2], const pg8::Unit& u, int wr, int wc, int fr, int fq) const {
        const int row0 = u.pm * 256 + wr * 64 + fr, col0 = u.pn * 256 + wc * 32 + 8 * fq;
        const float* xb = (u.pm < 64) ? xin_p : (xin_s - (size_t)TP * DM);
        f32x4 gn[2][2];
#pragma unroll
        for (int bj = 0; bj < 2; ++bj)
#pragma unroll
            for (int n = 0; n < 2; ++n) gn[bj][n] = ax ? *(const f32x4*)(gnext + col0 + bj * 128 + 4 * n) : (f32x4){1.f, 1.f, 1.f, 1.f};
#pragma unroll
        for (int ai = 0; ai < 2; ++ai)
#pragma unroll
            for (int m = 0; m < 4; ++m) {
                const int row = row0 + ai * 128 + m * 16; const size_t off = (size_t)row * DM + col0; float sq = 0.f;
#pragma unroll
                for (int bj = 0; bj < 2; ++bj) {
                    const f32x4 x0 = *(const f32x4*)(xb + off + bj * 128), x1 = *(const f32x4*)(xb + off + bj * 128 + 4);
                    const f32x4 v0 = x0 + acc[ai][bj][m][0] * scale, v1 = x1 + acc[ai][bj][m][1] * scale;
                    *(f32x4*)(xout + off + bj * 128) = v0; *(f32x4*)(xout + off + bj * 128 + 4) = v1;
                    sq += ((v0[0] * v0[0] + v0[1] * v0[1]) + (v0[2] * v0[2] + v0[3] * v0[3])) + ((v1[0] * v1[0] + v1[1] * v1[1]) + (v1[2] * v1[2] + v1[3] * v1[3]));
                    if (ax) { const f32x4 a0 = v0 * gn[bj][0], a1 = v1 * gn[bj][1];
                        u32x4 w; w.x = cvt_pk_bf16(a0[0], a0[1]); w.y = cvt_pk_bf16(a0[2], a0[3]); w.z = cvt_pk_bf16(a1[0], a1[1]); w.w = cvt_pk_bf16(a1[2], a1[3]);
                        *(u32x4*)(ax + off + bj * 128) = w; }
                }
                sq += __shfl_xor(sq, 16); sq += __shfl_xor(sq, 32);
                if (fq == 0) ssout[(size_t)row * 16 + u.pn * 4 + wc] = sq;
            }
    }
};
struct EpiProj {
    static constexpr bool PERM = true;
    bf16_t *Q, *V, *SG, *GY; float *FZ, *XB; const float* ss;
    __device__ __forceinline__ void operator()(const f32x4 (&acc)[2][2][4][2], const pg8::Unit& u, int wr, int wc, int fr, int fq) const {
        const int seg = u.pn >> 1;
        const int row0 = u.pm * 256 + wr * 64 + fr, col0 = (u.pn & 1) * 256 + wc * 32 + 8 * fq;
        float* fdst = (seg == 1) ? FZ : XB;
        bf16_t* bdst = (seg == 0) ? Q : (seg == 2) ? V : (seg == 3) ? SG : GY;
        const bool isf = (seg == 1) || (seg == 4);
#pragma unroll
        for (int ai = 0; ai < 2; ++ai)
#pragma unroll
            for (int m = 0; m < 4; ++m) {
                const int row = row0 + ai * 128 + m * 16; const float rs = rowscale(ss, row); const size_t off = (size_t)row * DH + col0;
#pragma unroll
                for (int bj = 0; bj < 2; ++bj) {
                    f32x4 v0 = acc[ai][bj][m][0] * rs, v1 = acc[ai][bj][m][1] * rs;
                    if (isf) { *(f32x4*)(fdst + off + bj * 128) = v0; *(f32x4*)(fdst + off + bj * 128 + 4) = v1; }
                    else {
                        float h[8] = {v0[0], v0[1], v0[2], v0[3], v1[0], v1[1], v1[2], v1[3]};
                        if (seg == 0) {
#pragma unroll
                            for (int j = 0; j < 8; ++j) h[j] = h[j] * sigm(h[j]);
                        } else if (seg == 3) {
#pragma unroll
                            for (int j = 0; j < 8; ++j) h[j] = sigm(h[j]);
                        } else if (seg == 5) {
#pragma unroll
                            for (int j = 0; j < 8; ++j) { const float y = h[j]; h[j] = y * sigm(1.5957691216f * (y + 0.044715f * y * y * y)); }
                        }
                        u32x4 w; w.x = cvt_pk_bf16(h[0], h[1]); w.y = cvt_pk_bf16(h[2], h[3]); w.z = cvt_pk_bf16(h[4], h[5]); w.w = cvt_pk_bf16(h[6], h[7]);
                        *(u32x4*)(bdst + off + bj * 128) = w;
                    }
                }
            }
    }
};


#define XB_TMO      128
#define XB_XCNT(j)  (256  + 64 * (j))
#define XB_XSUB(j)  (1280 + 64 * (j))
#define XB_XGEN(j)  (2304 + 64 * (j))
#define XB_TOP      3328
#define XB_TOPGEN   3392
#define XCD_BAR_WORDS 3456
#define XB_SPIN_CAP (1u << 22)
__device__ __forceinline__ unsigned xb_ld(unsigned* p)              { return __hip_atomic_load(p, __ATOMIC_RELAXED, __HIP_MEMORY_SCOPE_AGENT); }
__device__ __forceinline__ unsigned xb_add(unsigned* p, unsigned v) { return __hip_atomic_fetch_add(p, v, __ATOMIC_RELAXED, __HIP_MEMORY_SCOPE_AGENT); }
__device__ __forceinline__ unsigned xb_xcc_id() { return (unsigned)__builtin_amdgcn_s_getreg((3 << 11) | 20) & 0xFu; }
#define XB_SPIN(cond, bar) do { unsigned _sp = 0; while (cond) { __builtin_amdgcn_s_sleep(1); \
    if ((++_sp & 255u) == 0u) { if (xb_ld(&(bar)[XB_TMO])) break; if (_sp > XB_SPIN_CAP) { atomicAdd(&(bar)[XB_TMO], 1u); break; } } } } while (0)
struct XcdBarrier { unsigned* bar; unsigned x; volatile LAS unsigned* st; };
__device__ __forceinline__ XcdBarrier xcd_barrier_post(unsigned* bar, volatile LAS unsigned* st) {
    XcdBarrier b; b.bar = bar; b.x = xb_xcc_id(); b.st = st;
    if (threadIdx.x == 0) (void)xb_add(&bar[XB_XCNT(b.x)], 1u);
    return b;
}
__device__ __forceinline__ void xcd_barrier_complete(unsigned* bar, unsigned x, unsigned& nloc, unsigned& nx) {
    const unsigned G = gridDim.x * gridDim.y * gridDim.z;
    unsigned sum, cnt, mine, sp = 0u;
    for (;;) {
        sum = 0u; cnt = 0u; mine = 0u;
#pragma unroll
        for (unsigned j = 0; j < 16; ++j) { const unsigned c = xb_ld(&bar[XB_XCNT(j)]); sum += c; cnt += (c > 0u) ? 1u : 0u; mine = (j == x) ? c : mine; }
        if (sum == G) break;
        __builtin_amdgcn_s_sleep(1);
        if ((++sp & 255u) == 0u) { if (xb_ld(&bar[XB_TMO])) break; if (sp > XB_SPIN_CAP) { atomicAdd(&bar[XB_TMO], 1u); break; } }
    }
    nloc = mine > 0u ? mine : 1u; nx = cnt > 0u ? cnt : 1u;
}
__device__ __forceinline__ void xcd_barrier(const XcdBarrier& b) {
    asm volatile("s_waitcnt vmcnt(0) lgkmcnt(0)" ::: "memory");
    __syncthreads();
    if (threadIdx.x == 0) {
        unsigned* bar = b.bar;
        __builtin_amdgcn_s_waitcnt(0);
        unsigned nloc = b.st[0], nx = b.st[1];
        if (nloc == 0u) { xcd_barrier_complete(bar, b.x, nloc, nx); b.st[0] = nloc; b.st[1] = nx; }
        const unsigned old = xb_add(&bar[XB_XSUB(b.x)], 1u);
        const unsigned gen = old / nloc;
        if (old + 1u == (gen + 1u) * nloc) {
            __builtin_amdgcn_fence(__ATOMIC_RELEASE, "agent");
            asm volatile("s_waitcnt vmcnt(0)" ::: "memory");
            const unsigned og = xb_add(&bar[XB_TOP], 1u);
            const unsigned tg = og / nx;
            if (og + 1u == (tg + 1u) * nx) xb_add(&bar[XB_TOPGEN], 1u);
            else XB_SPIN(xb_ld(&bar[XB_TOPGEN]) == tg, bar);
            __builtin_amdgcn_fence(__ATOMIC_ACQUIRE, "agent");
            xb_add(&bar[XB_XGEN(b.x)], 1u);
            asm volatile("s_waitcnt vmcnt(0)" ::: "memory");
        } else {
            XB_SPIN(xb_ld(&bar[XB_XGEN(b.x)]) == gen, bar);
            __builtin_amdgcn_fence(__ATOMIC_ACQUIRE, "agent");
            asm volatile("s_waitcnt vmcnt(0)" ::: "memory");
        }
    }
    __syncthreads();
}

struct Params { const float* in[26]; float* out; unsigned char* ws; int ph_lo, ph_hi; };

__device__ __forceinline__ void transpose_item(const float* W, int K, int N, bf16_t* WT, int dst_row0, LAS float* scr, int k0, int n0, int lane) {
#pragma unroll 8
    for (int i = 0; i < 32; ++i) { const int kk = 2 * i + (lane >> 5); scr[kk * 33 + (lane & 31)] = W[(size_t)(k0 + kk) * N + n0 + (lane & 31)]; }
    LDS_WAIT();
    const int c = lane & 7;
#pragma unroll
    for (int j = 0; j < 4; ++j) { const int n = (lane >> 3) + 8 * j; const LAS float* s = scr + (8 * c) * 33 + n;
        u32x4 o; o.x = cvt_pk_bf16(s[0 * 33], s[1 * 33]); o.y = cvt_pk_bf16(s[2 * 33], s[3 * 33]); o.z = cvt_pk_bf16(s[4 * 33], s[5 * 33]); o.w = cvt_pk_bf16(s[6 * 33], s[7 * 33]);
        *(u32x4*)(WT + (size_t)(dst_row0 + n) * K + k0 + 8 * c) = o; }
    LDS_WAIT();
}
__device__ __forceinline__ void transpose_mat(const float* W, int K, int N, bf16_t* WT, int mode, LAS float* scr, int item, int lane) {
    const int nblk = N / 32, kb = item / nblk, nb = item % nblk, n0 = 32 * nb;
    const int dst = (mode == 0) ? n0 : (256 * (n0 >> 7) + (n0 & 127) + (mode == 2 ? 128 : 0));
    transpose_item(W, K, N, WT, dst, scr, 64 * kb, n0, lane);
}

__device__ __forceinline__ void phase0(const Params& p, LAS unsigned char* lds) {
    const int tid = threadIdx.x, lane = tid & 63, wave = tid >> 6;
    const int G = gridDim.x, gw = blockIdx.x * 8 + wave, NGW = G * 8;
    unsigned char* ws = p.ws;
    LAS float* scr = (LAS float*)(lds + wave * 16384);
    constexpr int I_GU = 16 * 88, I_D = 44 * 32, I_IN = 16 * 96, I_O = 16 * 32;
    constexpr int NIT = 4 * I_GU + 2 * I_D + I_IN + I_O;
    for (int it = gw; it < NIT; it += NGW) {
        int r = it;
        if (r < I_GU) { transpose_mat(p.in[6], 1024, 2816, (bf16_t*)(ws + WS_WG1), 1, scr, r, lane); continue; } r -= I_GU;
        if (r < I_GU) { transpose_mat(p.in[7], 1024, 2816, (bf16_t*)(ws + WS_WG1), 2, scr, r, lane); continue; } r -= I_GU;
        if (r < I_D)  { transpose_mat(p.in[8], 2816, 1024, (bf16_t*)(ws + WS_WD1), 0, scr, r, lane); continue; } r -= I_D;
        if (r < I_IN) { transpose_mat(p.in[10], 1024, 3072, (bf16_t*)(ws + WS_WIN), 0, scr, r, lane); continue; } r -= I_IN;
        if (r < I_O)  { transpose_mat(p.in[20], 1024, 1024, (bf16_t*)(ws + WS_WO), 0, scr, r, lane); continue; } r -= I_O;
        if (r < I_GU) { transpose_mat(p.in[22], 1024, 2816, (bf16_t*)(ws + WS_WG2), 1, scr, r, lane); continue; } r -= I_GU;
        if (r < I_GU) { transpose_mat(p.in[23], 1024, 2816, (bf16_t*)(ws + WS_WG2), 2, scr, r, lane); continue; } r -= I_GU;
        transpose_mat(p.in[24], 2816, 1024, (bf16_t*)(ws + WS_WD2), 0, scr, r, lane);
    }
    for (int e = blockIdx.x * 512 + tid; e < 2 * 32768; e += G * 512) {
        const int which = e >> 15, r = e & 32767, n = r >> 12, j = (r >> 6) & 63, i = r & 63;
        const float* W = which ? p.in[17] : p.in[15];
        bf16_t* WT = (bf16_t*)(ws + (which ? WS_WXT : WS_WAT));
        WT[r] = f2bf(W[(n * 64 + i) * 64 + j]);
    }
    bf16_t* A1 = (bf16_t*)(ws + WS_B0); float* SS0 = (float*)(ws + WS_SS0);
    const float* g1 = p.in[5];
    f32x4 gv[4];
#pragma unroll
    for (int j = 0; j < 4; ++j) gv[j] = ((const f32x4*)g1)[lane + 64 * j];
    for (int row = gw; row < T_ALL; row += NGW) {
        const float* xr = (row < TP) ? p.in[0] + (size_t)row * DM : p.in[1] + (size_t)(row - TP) * DM;
        f32x4 v[4]; float s = 0.f;
#pragma unroll
        for (int j = 0; j < 4; ++j) { v[j] = ((const f32x4*)xr)[lane + 64 * j]; s += (v[j].x * v[j].x + v[j].y * v[j].y) + (v[j].z * v[j].z + v[j].w * v[j].w); }
        s = wave_sum(s);
        u32x2* o8 = (u32x2*)(A1 + (size_t)row * DM);
#pragma unroll
        for (int j = 0; j < 4; ++j) { const f32x4 a = v[j] * gv[j]; u32x2 w; w.x = cvt_pk_bf16(a.x, a.y); w.y = cvt_pk_bf16(a.z, a.w); o8[lane + 64 * j] = w; }
        if (lane < 16) SS0[(size_t)row * 16 + lane] = (lane == 0) ? s : 0.f;
    }
}

__device__ __forceinline__ void phase_final(const Params& p) {
    const int tid = threadIdx.x, lane = tid & 63, wave = tid >> 6;
    const int gw = blockIdx.x * 8 + wave, NGW = gridDim.x * 8;
    const float* SS3 = (const float*)(p.ws + WS_SS3); const float* gf = p.in[25];
    f32x4 gv[4];
#pragma unroll
    for (int j = 0; j < 4; ++j) gv[j] = ((const f32x4*)gf)[lane + 64 * j];
    for (int row = gw; row < T_ALL; row += NGW) {
        const float rs = rowscale(SS3, row);
        f32x4* xr = (f32x4*)(p.out + (size_t)row * DM);
#pragma unroll
        for (int j = 0; j < 4; ++j) { f32x4 v = xr[lane + 64 * j]; xr[lane + 64 * j] = v * rs * gv[j]; }
    }
}

struct Mix {
    const bf16_t *Q, *V, *SG, *GY; const float *FZ, *XB; bf16_t* LT; float* DC; float *ACH, *UCH, *HST; bf16_t* O;
    const bf16_t *WAT, *WXT;
    const float *lb, *hnorm, *convw, *convb, *ba, *bx, *lam, *wa, *wx, *st_h, *st_l, *st_c;
    float* out;
};

struct HgrnScan { float cum[16]; float kk[16]; float last; };
__device__ __forceinline__ void hgrn_scan(const Mix& M, int t0, int cb, int k, int seg, LAS float* tot, HgrnScan& hs) {
    const float l0 = M.lb[cb + k], l1 = M.lb[512 + cb + k];
    const float lb = 1.f / (1.f + expf(l1 - l0));
    float run = 0.f;
#pragma unroll
    for (int i = 0; i < 16; ++i) {
        const float fz = M.FZ[(size_t)(t0 + seg * 16 + i) * DH + cb + k];
        const float sg = 1.f / (1.f + expf(-fz)), sn = 1.f / (1.f + expf(fz));
        const float f = lb + (1.f - lb) * sg;
        run += logf(f); hs.cum[i] = run; hs.kk[i] = (1.f - lb) * sn;
    }
    tot[seg * 128 + k] = run;
    __syncthreads();
    float off = 0.f, all = 0.f;
#pragma unroll
    for (int s = 0; s < 4; ++s) { const float v = tot[s * 128 + k]; if (s < seg) off += v; all += v; }
#pragma unroll
    for (int i = 0; i < 16; ++i) hs.cum[i] += off;
    hs.last = all;
}
__device__ __forceinline__ void load_vt(const Mix& M, int t0, int cb, int k, int seg, LAS bf16_t* VT) {
    unsigned pk[8];
#pragma unroll
    for (int i = 0; i < 8; ++i) {
        const unsigned a = M.V[(size_t)(t0 + seg * 16 + 2 * i) * DH + cb + k], b = M.V[(size_t)(t0 + seg * 16 + 2 * i + 1) * DH + cb + k];
        pk[i] = a | (b << 16);
    }
    *(LAS u32x4*)(VT + k * 72 + seg * 16) = (u32x4){pk[0], pk[1], pk[2], pk[3]};
    *(LAS u32x4*)(VT + k * 72 + seg * 16 + 8) = (u32x4){pk[4], pk[5], pk[6], pk[7]};
}

__device__ __forceinline__ void hgrn_local_unit(const Mix& M, int unit, LAS unsigned char* lds) {
    const int tid = threadIdx.x, lane = tid & 63, wave = tid >> 6, fr = lane & 15, fq = lane >> 4;
    const int h = unit & 3, bc = unit >> 2, t0 = bc * 64, cb = h * 128, k = tid & 127, seg = tid >> 7;
    LAS bf16_t* KT = (LAS bf16_t*)lds; LAS bf16_t* VT = (LAS bf16_t*)(lds + 18432); LAS float* tot = (LAS float*)(lds + 36864);
    HgrnScan hs; hgrn_scan(M, t0, cb, k, seg, tot, hs);
    unsigned pk[8];
#pragma unroll
    for (int i = 0; i < 8; ++i) pk[i] = cvt_pk_bf16(hs.kk[2 * i] * expf(hs.last - hs.cum[2 * i]), hs.kk[2 * i + 1] * expf(hs.last - hs.cum[2 * i + 1]));
    *(LAS u32x4*)(KT + k * 72 + seg * 16) = (u32x4){pk[0], pk[1], pk[2], pk[3]};
    *(LAS u32x4*)(KT + k * 72 + seg * 16 + 8) = (u32x4){pk[4], pk[5], pk[6], pk[7]};
    load_vt(M, t0, cb, k, seg, VT);
    if (seg == 0) M.DC[unit * 128 + k] = expf(hs.last);
    __syncthreads();
    const bf16x8 a0 = *(const LAS bf16x8*)(VT + (16 * wave + fr) * 72 + fq * 8), a1 = *(const LAS bf16x8*)(VT + (16 * wave + fr) * 72 + 32 + fq * 8);
#pragma unroll
    for (int ct = 0; ct < 8; ++ct) {
        const bf16x8 b0 = *(const LAS bf16x8*)(KT + (16 * ct + fr) * 72 + fq * 8), b1 = *(const LAS bf16x8*)(KT + (16 * ct + fr) * 72 + 32 + fq * 8);
        f32x4 acc = {0.f, 0.f, 0.f, 0.f};
        acc = __builtin_amdgcn_mfma_f32_16x16x32_bf16(b0, a0, acc, 0, 0, 0);
        acc = __builtin_amdgcn_mfma_f32_16x16x32_bf16(b1, a1, acc, 0, 0, 0);
        u32x2 w; w.x = cvt_pk_bf16(acc[0], acc[1]); w.y = cvt_pk_bf16(acc[2], acc[3]);
        *(u32x2*)(M.LT + ((size_t)unit * 128 + 16 * wave + fr) * 128 + 16 * ct + 4 * fq) = w;
    }
    __syncthreads();
}

__device__ __forceinline__ void hgrn_out_unit(const Mix& M, int unit, LAS unsigned char* lds) {
    const int tid = threadIdx.x, lane = tid & 63, wave = tid >> 6, fr = lane & 15, fq = lane >> 4;
    const int h = unit & 3, bc = unit >> 2, t0 = bc * 64, cb = h * 128, k = tid & 127, seg = tid >> 7;
    LAS bf16_t* QS = (LAS bf16_t*)lds; LAS bf16_t* KS = (LAS bf16_t*)(lds + 17408); LAS bf16_t* VT = (LAS bf16_t*)(lds + 34816);
    LAS bf16_t* PS = (LAS bf16_t*)(lds + 53248); LAS float* tot = (LAS float*)(lds + 62464); LAS float* RS = (LAS float*)(lds + 64512);
    HgrnScan hs; hgrn_scan(M, t0, cb, k, seg, tot, hs);
#pragma unroll
    for (int i = 0; i < 16; ++i) {
        const float q = bf2f(M.Q[(size_t)(t0 + seg * 16 + i) * DH + cb + k]);
        QS[(seg * 16 + i) * 136 + k] = f2bf(q * expf(hs.cum[i]));
        KS[(seg * 16 + i) * 136 + k] = f2bf(hs.kk[i] * expf(-hs.cum[i]));
    }
    load_vt(M, t0, cb, k, seg, VT);
    __syncthreads();
#pragma unroll
    for (int r = 0; r < 2; ++r) {
        const int idx = wave + 8 * r, tr = idx >> 2, tc = idx & 3;
        f32x4 acc = {0.f, 0.f, 0.f, 0.f};
        if (tc <= tr) {
#pragma unroll
            for (int ks = 0; ks < 4; ++ks) {
                const bf16x8 a = *(const LAS bf16x8*)(QS + (16 * tr + fr) * 136 + ks * 32 + fq * 8), b = *(const LAS bf16x8*)(KS + (16 * tc + fr) * 136 + ks * 32 + fq * 8);
                acc = __builtin_amdgcn_mfma_f32_16x16x32_bf16(b, a, acc, 0, 0, 0);
            }
#pragma unroll
            for (int j = 0; j < 4; ++j) if (16 * tc + 4 * fq + j > 16 * tr + fr) acc[j] = 0.f;
        }
        u32x2 w; w.x = cvt_pk_bf16(acc[0], acc[1]); w.y = cvt_pk_bf16(acc[2], acc[3]);
        *(LAS u32x2*)(PS + (16 * tr + fr) * 72 + 16 * tc + 4 * fq) = w;
    }
    __syncthreads();
    bf16x8 bv[2], bs[4];
#pragma unroll
    for (int ks = 0; ks < 2; ++ks) bv[ks] = *(const LAS bf16x8*)(VT + (16 * wave + fr) * 72 + ks * 32 + fq * 8);
#pragma unroll
    for (int ks = 0; ks < 4; ++ks) bs[ks] = *(const bf16x8*)(M.LT + ((size_t)unit * 128 + 16 * wave + fr) * 128 + ks * 32 + fq * 8);
    f32x4 o[4];
#pragma unroll
    for (int tr = 0; tr < 4; ++tr) {
        f32x4 acc = {0.f, 0.f, 0.f, 0.f};
#pragma unroll
        for (int ks = 0; ks < 2; ++ks) { const bf16x8 a = *(const LAS bf16x8*)(PS + (16 * tr + fr) * 72 + ks * 32 + fq * 8); acc = __builtin_amdgcn_mfma_f32_16x16x32_bf16(bv[ks], a, acc, 0, 0, 0); }
#pragma unroll
        for (int ks = 0; ks < 4; ++ks) { const bf16x8 a = *(const LAS bf16x8*)(QS + (16 * tr + fr) * 136 + ks * 32 + fq * 8); acc = __builtin_amdgcn_mfma_f32_16x16x32_bf16(bs[ks], a, acc, 0, 0, 0); }
        o[tr] = acc;
        float ss = (acc[0] * acc[0] + acc[1] * acc[1]) + (acc[2] * acc[2] + acc[3] * acc[3]);
        ss += __shfl_xor(ss, 16); ss += __shfl_xor(ss, 32);
        if (fq == 0) RS[wave * 64 + 16 * tr + fr] = ss;
    }
    __syncthreads();
#pragma unroll
    for (int tr = 0; tr < 4; ++tr) {
        const int tl = 16 * tr + fr; float tt = 0.f;
#pragma unroll
        for (int w = 0; w < 8; ++w) tt += RS[w * 64 + tl];
        const float rinv = rsqrtf(tt * (1.f / 128.f) + EPS);
        const int t = t0 + tl, col = cb + 16 * wave + 4 * fq;
        const f32x4 gn = *(const f32x4*)(M.hnorm + col);
        const u32x2 sg = *(const u32x2*)(M.SG + (size_t)t * DH + col);
        u32x2 w;
        w.x = cvt_pk_bf16(o[tr][0] * rinv * gn[0] * bflo(sg.x), o[tr][1] * rinv * gn[1] * bfhi(sg.x));
        w.y = cvt_pk_bf16(o[tr][2] * rinv * gn[2] * bflo(sg.y), o[tr][3] * rinv * gn[3] * bfhi(sg.y));
        *(u32x2*)(M.O + (size_t)t * DM + col) = w;
    }
    __syncthreads();
}

__device__ __forceinline__ void lru_unit(const Mix& M, int unit, int mode, LAS unsigned char* lds) {
    const int tid = threadIdx.x, lane = tid & 63, wave = tid >> 6, fr = lane & 15, fq = lane >> 4;
    const int n = unit & 7, bc = unit >> 3, c = bc & 31, b = bc >> 5, t0 = bc * 64, ch0 = n * 64;
    const int j = tid & 63, seg = tid >> 6, ch = ch0 + j;
    LAS float* XC32 = (LAS float*)lds; LAS bf16_t* XC16 = (LAS bf16_t*)(lds + 16640); LAS float* GR = (LAS float*)(lds + 25856); LAS float* GI = (LAS float*)(lds + 42496);
    LAS float* SEGA = (LAS float*)(lds + 59136); LAS float* SEGU = (LAS float*)(lds + 61184);
    const float w0 = M.convw[ch], w1 = M.convw[512 + ch], w2 = M.convw[1024 + ch], w3 = M.convw[1536 + ch], cbias = M.convb[ch];
    const int tl0 = seg * 8; const bool first = (c == 0 && seg == 0);
    const float* xp = M.XB + (size_t)(t0 + tl0) * DH + ch;
    float xm3 = first ? 0.f : xp[-3 * DH], xm2 = first ? 0.f : xp[-2 * DH], xm1 = first ? 0.f : xp[-1 * DH];
    float xcv[8];
#pragma unroll
    for (int i = 0; i < 8; ++i) {
        const float x = xp[i * DH];
        const float xc = cbias + w0 * xm3 + w1 * xm2 + w2 * xm1 + w3 * x;
        xcv[i] = xc; XC32[(tl0 + i) * 65 + j] = xc; XC16[(tl0 + i) * 72 + j] = f2bf(xc);
        xm3 = xm2; xm2 = xm1; xm1 = x;
    }
    __syncthreads();
    {
        const int gate = wave >> 2, tr = wave & 3;
        const bf16_t* WT = (gate ? M.WXT : M.WAT) + n * 4096;
        const float* bias = (gate ? M.bx : M.ba) + ch0;
        LAS float* Gd = gate ? GI : GR;
        const bf16x8 a0 = *(const LAS bf16x8*)(XC16 + (16 * tr + fr) * 72 + fq * 8), a1 = *(const LAS bf16x8*)(XC16 + (16 * tr + fr) * 72 + 32 + fq * 8);
#pragma unroll
        for (int ct = 0; ct < 4; ++ct) {
            const bf16x8 b0 = *(const bf16x8*)(WT + (16 * ct + fr) * 64 + fq * 8), b1 = *(const bf16x8*)(WT + (16 * ct + fr) * 64 + 32 + fq * 8);
            f32x4 acc = {0.f, 0.f, 0.f, 0.f};
            acc = __builtin_amdgcn_mfma_f32_16x16x32_bf16(a0, b0, acc, 0, 0, 0);
            acc = __builtin_amdgcn_mfma_f32_16x16x32_bf16(a1, b1, acc, 0, 0, 0);
            const float bb = bias[16 * ct + fr];
#pragma unroll
            for (int jj = 0; jj < 4; ++jj) Gd[(16 * tr + 4 * fq + jj) * 65 + 16 * ct + fr] = 1.f / (1.f + expf(-(acc[jj] + bb)));
        }
    }
    __syncthreads();
    const float sp = log1pf(expf(-M.lam[ch]));
    float av[8], uv[8]; float A = 1.f, U = 0.f;
#pragma unroll
    for (int i = 0; i < 8; ++i) {
        const int tl = tl0 + i; const float r = GR[tl * 65 + j], ig = GI[tl * 65 + j];
        const float la = -8.f * r * sp, a = expf(la); float mult = sqrtf(-expm1f(2.f * la));
        if (c == 0 && tl == 0) mult = 1.f;
        const float u = mult * ig * xcv[i];
        av[i] = a; uv[i] = u; U = a * U + u; A *= a;
    }
    SEGA[seg * 64 + j] = A; SEGU[seg * 64 + j] = U;
    __syncthreads();
    float hin = (mode == 1) ? M.HST[(size_t)bc * 512 + ch] : 0.f;
#pragma unroll
    for (int s = 0; s < 8; ++s) if (s < seg) hin = SEGA[s * 64 + j] * hin + SEGU[s * 64 + j];
    if (mode == 0) {
        if (seg == 7) { float At = 1.f;
#pragma unroll
            for (int s = 0; s < 8; ++s) At *= SEGA[s * 64 + j];
            M.ACH[(size_t)bc * 512 + ch] = At; M.UCH[(size_t)bc * 512 + ch] = A * hin + U; }
    } else {
        float hh = hin;
#pragma unroll
        for (int i = 0; i < 8; ++i) {
            hh = av[i] * hh + uv[i];
            const int t = t0 + tl0 + i;
            M.O[(size_t)t * DM + 512 + ch] = f2bf(hh * bf2f(M.GY[(size_t)t * DH + ch]));
        }
        if (c == 31 && seg == 7) M.out[OUT_LP + b * 512 + ch] = hh;
        if (c == 31 && tid < 192) { const int r = tid >> 6; M.out[OUT_CP + (size_t)(b * 3 + r) * 512 + ch0 + j] = M.XB[(size_t)(b * SEQ + SEQ - 3 + r) * DH + ch0 + j]; }
    }
    __syncthreads();
}

__device__ __forceinline__ void hgrn_sample_unit(const Mix& M, int unit, LAS unsigned char* lds) {
    const int tid = threadIdx.x, lane = tid & 63, wave = tid >> 6;
    const int h = unit & 3, b = unit >> 2, cb = h * 128, tb = TP + b * 4;
    LAS float* SQ = (LAS float*)lds;
    LAS float* SK = SQ + 512;
    LAS float* SD = SK + 512;
    LAS float* SP = SD + 128;
    LAS float* OP = SP + 32;
    LAS float* RS = OP + 2048;
    if (tid < 128) {
        const int k = tid;
        const float l0 = M.lb[cb + k], l1 = M.lb[512 + cb + k];
        const float lb = 1.f / (1.f + expf(l1 - l0));
        float cum[4], kk[4], qv[4]; float run = 0.f;
#pragma unroll
        for (int s = 0; s < 4; ++s) {
            const float fz = M.FZ[(size_t)(tb + s) * DH + cb + k];
            const float sg = 1.f / (1.f + expf(-fz)), sn = 1.f / (1.f + expf(fz));
            run += logf(lb + (1.f - lb) * sg); cum[s] = run; kk[s] = (1.f - lb) * sn;
            qv[s] = bf2f(M.Q[(size_t)(tb + s) * DH + cb + k]);
        }
#pragma unroll
        for (int s = 0; s < 4; ++s) { SQ[s * 128 + k] = qv[s] * expf(cum[s]); SK[s * 128 + k] = kk[s] * expf(cum[3] - cum[s]); }
        SD[k] = expf(cum[3]);
        float pr[10]; int c = 0;
#pragma unroll
        for (int t = 0; t < 4; ++t)
#pragma unroll
            for (int s = 0; s <= t; ++s) { pr[c] = qv[t] * kk[s] * expf(cum[t] - cum[s]); ++c; }
#pragma unroll
        for (int i = 0; i < 10; ++i) { const float v = wave_sum(pr[i]); if (lane == 0) SP[wave * 16 + i] = v; }
    }
    __syncthreads();
    const int v = tid & 127, kq = tid >> 7;
    float vv[4];
#pragma unroll
    for (int s = 0; s < 4; ++s) vv[s] = bf2f(M.V[(size_t)(tb + s) * DH + cb + v]);
    {
        float o[4] = {0.f, 0.f, 0.f, 0.f};
        const size_t sb = ((size_t)(b * 4 + h) * 128) * 128;
#pragma unroll 8
        for (int kx = 0; kx < 32; ++kx) {
            const int k = kq * 32 + kx;
            const float s0 = M.st_h[sb + (size_t)k * 128 + v];
            float sn = SD[k] * s0;
#pragma unroll
            for (int s = 0; s < 4; ++s) { o[s] += SQ[s * 128 + k] * s0; sn += SK[s * 128 + k] * vv[s]; }
            M.out[OUT_HS + sb + (size_t)k * 128 + v] = sn;
        }
#pragma unroll
        for (int s = 0; s < 4; ++s) OP[(kq * 4 + s) * 128 + v] = o[s];
    }
    __syncthreads();
    {
        const int t = kq;
        float ov = (OP[(0 * 4 + t) * 128 + v] + OP[(1 * 4 + t) * 128 + v]) + (OP[(2 * 4 + t) * 128 + v] + OP[(3 * 4 + t) * 128 + v]);
        const int base = t * (t + 1) / 2;
        for (int s = 0; s <= t; ++s) ov += (SP[base + s] + SP[16 + base + s]) * vv[s];
        const float ssq = wave_sum(ov * ov);
        if (lane == 0) RS[wave] = ssq;
        __syncthreads();
        const float tt = RS[2 * t] + RS[2 * t + 1];
        const float rinv = rsqrtf(tt * (1.f / 128.f) + EPS);
        const size_t tok = (size_t)(tb + t);
        M.O[tok * DM + cb + v] = f2bf(ov * rinv * M.hnorm[cb + v] * bf2f(M.SG[tok * DH + cb + v]));
    }
    __syncthreads();
}

__device__ __forceinline__ void lru_sample_unit(const Mix& M, int b, LAS unsigned char* lds) {
    const int tid = threadIdx.x, ch = tid, n = ch >> 6, j = ch & 63, tb = TP + b * 4;
    LAS float* XC = (LAS float*)lds;
    float x[7];
#pragma unroll
    for (int r = 0; r < 3; ++r) x[r] = M.st_c[(size_t)(b * 3 + r) * 512 + ch];
#pragma unroll
    for (int s = 0; s < 4; ++s) x[3 + s] = M.XB[(size_t)(tb + s) * DH + ch];
    const float w0 = M.convw[ch], w1 = M.convw[512 + ch], w2 = M.convw[1024 + ch], w3 = M.convw[1536 + ch], cbias = M.convb[ch];
    float xc[4];
#pragma unroll
    for (int s = 0; s < 4; ++s) { xc[s] = cbias + w0 * x[s] + w1 * x[s + 1] + w2 * x[s + 2] + w3 * x[s + 3]; XC[s * 512 + ch] = xc[s]; }
#pragma unroll
    for (int r = 0; r < 3; ++r) M.out[OUT_CS + (size_t)(b * 3 + r) * 512 + ch] = x[4 + r];
    __syncthreads();
    float ra[4], rx[4];
    const float ba = M.ba[ch], bx = M.bx[ch];
#pragma unroll
    for (int s = 0; s < 4; ++s) { ra[s] = ba; rx[s] = bx; }
    const float* wa = M.wa + (size_t)n * 4096 + j; const float* wx = M.wx + (size_t)n * 4096 + j;
#pragma unroll 4
    for (int i = 0; i < 64; ++i) {
        const float a = wa[i * 64], xw = wx[i * 64];
#pragma unroll
        for (int s = 0; s < 4; ++s) { const float xv = XC[s * 512 + n * 64 + i]; ra[s] += xv * a; rx[s] += xv * xw; }
    }
    const float sp = log1pf(expf(-M.lam[ch]));
    float hh = M.st_l[(size_t)b * 512 + ch];
#pragma unroll
    for (int s = 0; s < 4; ++s) {
        const float r = 1.f / (1.f + expf(-ra[s])), ig = 1.f / (1.f + expf(-rx[s]));
        const float la = -8.f * r * sp, a = expf(la), mult = sqrtf(-expm1f(2.f * la));
        hh = a * hh + mult * ig * xc[s];
        M.O[(size_t)(tb + s) * DM + 512 + ch] = f2bf(hh * bf2f(M.GY[(size_t)(tb + s) * DH + ch]));
    }
    M.out[OUT_LS + (size_t)b * 512 + ch] = hh;
    __syncthreads();
}

__device__ __forceinline__ void scan_item(const Mix& M, int item) {
    const int tid = threadIdx.x;
    if (item < 1024) {
        const int e = item * 512 + tid, bh = e >> 14, vk = e & 16383, b = bh >> 2, h = bh & 3, v = vk >> 7, k = vk & 127;
        float l[32], d[32];
#pragma unroll
        for (int c = 0; c < 32; ++c) { const int unit = (b * 32 + c) * 4 + h; l[c] = bf2f(M.LT[(size_t)unit * 16384 + vk]); d[c] = M.DC[unit * 128 + k]; }
        float S = 0.f;
#pragma unroll
        for (int c = 0; c < 32; ++c) { const int unit = (b * 32 + c) * 4 + h; M.LT[(size_t)unit * 16384 + vk] = f2bf(S); S = d[c] * S + l[c]; }
        M.out[OUT_HP + ((size_t)(b * 4 + h) * 128 + k) * 128 + v] = S;
    } else {
        const int e = (item - 1024) * 512 + tid, b = e >> 9, ch = e & 511;
        float hcar = 0.f;
        for (int c = 0; c < 32; ++c) { const size_t idx = (size_t)(b * 32 + c) * 512 + ch; M.HST[idx] = hcar; hcar = M.ACH[idx] * hcar + M.UCH[idx]; }
    }
}

__global__ void __launch_bounds__(512, 2) mk_fwd(Params p) {
    extern __shared__ __attribute__((aligned(16))) unsigned char lds_raw[];
    LAS unsigned char* lds = (LAS unsigned char*)lds_raw;
    const int lo = p.ph_lo, hi = p.ph_hi, G = gridDim.x;
    unsigned char* ws = p.ws;
#define IN(k) (lo <= (k) && (k) < hi)
    volatile LAS unsigned* xst = (volatile LAS unsigned*)(lds + 131072);
    if (threadIdx.x < 16) xst[threadIdx.x] = 0u;
    __syncthreads();
    XcdBarrier xbar; xbar.bar = (unsigned*)(ws + WS_BAR); xbar.x = 0; xbar.st = xst;
    if (hi - lo > 1) xbar = xcd_barrier_post((unsigned*)(ws + WS_BAR), xst);
    if (hi == 0x7fffffff) cg::this_grid().sync();
#define SEAM(k) do { if (IN(k) && IN((k) + 1)) { xcd_barrier(xbar); } } while (0)
    bf16_t* B0 = (bf16_t*)(ws + WS_B0); bf16_t* B1 = (bf16_t*)(ws + WS_B1); bf16_t* H = (bf16_t*)(ws + WS_H);
    float* SS0 = (float*)(ws + WS_SS0); float* SS1 = (float*)(ws + WS_SS1); float* SS2 = (float*)(ws + WS_SS2); float* SS3 = (float*)(ws + WS_SS3);

    if (IN(0)) { phase0(p, lds); __syncthreads(); }
    SEAM(0);
    if (IN(1)) {
        pg8::Gemm g{B0, (const bf16_t*)(ws + WS_WG1), T_ALL, 2 * DFF, DM}; pg8::StaticOrder S; S.init(T_ALL, 2 * DFF, G, (int)blockIdx.x);
        EpiGateUp E{H, SS0};
        pg8::gemm_phase<EpiGateUp, pg8::StaticOrder, PG8_ALIGN, PG8_SP2>(lds, g, S, E);
    }
    SEAM(1);
    if (IN(2)) {
        pg8::Gemm g{H, (const bf16_t*)(ws + WS_WD1), T_ALL, DM, DFF}; pg8::StaticOrder S; S.init(T_ALL, DM, G, (int)blockIdx.x);
        EpiResid E{p.in[0], p.in[1], p.out, B0, p.in[9], SS1, 0.5f};
        pg8::gemm_phase<EpiResid, pg8::StaticOrder, PG8_ALIGN, PG8_SP2>(lds, g, S, E);
    }
    SEAM(2);
    if (IN(3)) {
        pg8::Gemm g{B0, (const bf16_t*)(ws + WS_WIN), T_ALL, DIN, DM}; pg8::StaticOrder S; S.init(T_ALL, DIN, G, (int)blockIdx.x);
        EpiProj E{(bf16_t*)(ws + WS_Q), (bf16_t*)(ws + WS_V), (bf16_t*)(ws + WS_SG), (bf16_t*)(ws + WS_GY), (float*)(ws + WS_FZ), (float*)(ws + WS_XB), SS1};
        pg8::gemm_phase<EpiProj, pg8::StaticOrder, PG8_ALIGN, PG8_SP2>(lds, g, S, E);
    }
    SEAM(3);
    Mix M;
    M.Q = (const bf16_t*)(ws + WS_Q); M.V = (const bf16_t*)(ws + WS_V); M.SG = (const bf16_t*)(ws + WS_SG); M.GY = (const bf16_t*)(ws + WS_GY);
    M.FZ = (const float*)(ws + WS_FZ); M.XB = (const float*)(ws + WS_XB); M.LT = (bf16_t*)(ws + WS_LT); M.DC = (float*)(ws + WS_DC);
    M.ACH = (float*)(ws + WS_ACH); M.UCH = (float*)(ws + WS_UCH); M.HST = (float*)(ws + WS_HST); M.O = B0;
    M.WAT = (const bf16_t*)(ws + WS_WAT); M.WXT = (const bf16_t*)(ws + WS_WXT);
    M.lb = p.in[11]; M.hnorm = p.in[12]; M.convw = p.in[13]; M.convb = p.in[14]; M.wa = p.in[15]; M.ba = p.in[16]; M.wx = p.in[17]; M.bx = p.in[18]; M.lam = p.in[19];
    M.st_h = p.in[2]; M.st_l = p.in[3]; M.st_c = p.in[4]; M.out = p.out;
    if (IN(4)) {
        for (int u = blockIdx.x; u < 3712; u += G) {
            if (u < 512) hgrn_sample_unit(M, u, lds);
            else if (u < 1536) hgrn_local_unit(M, u - 512, lds);
            else if (u < 3584) lru_unit(M, u - 1536, 0, lds);
            else lru_sample_unit(M, u - 3584, lds);
        }
    }
    SEAM(4);
    if (IN(5)) { for (int it = blockIdx.x; it < 1032; it += G) scan_item(M, it); }
    SEAM(5);
    if (IN(6)) {
        for (int u = blockIdx.x; u < 3072; u += G) {
            if (u < 1024) hgrn_out_unit(M, u, lds);
            else lru_unit(M, u - 1024, 1, lds);
        }
    }
    SEAM(6);
    if (IN(7)) {
        pg8::Gemm g{B0, (const bf16_t*)(ws + WS_WO), T_ALL, DM, DM}; pg8::StaticOrder S; S.init(T_ALL, DM, G, (int)blockIdx.x);
        EpiResid E{p.out, p.out + (size_t)TP * DM, p.out, B1, p.in[21], SS2, 1.0f};
        pg8::gemm_phase<EpiResid, pg8::StaticOrder, PG8_ALIGN, PG8_SP2>(lds, g, S, E);
    }
    SEAM(7);
    if (IN(8)) {
        pg8::Gemm g{B1, (const bf16_t*)(ws + WS_WG2), T_ALL, 2 * DFF, DM}; pg8::StaticOrder S; S.init(T_ALL, 2 * DFF, G, (int)blockIdx.x);
        EpiGateUp E{H, SS2};
        pg8::gemm_phase<EpiGateUp, pg8::StaticOrder, PG8_ALIGN, PG8_SP2>(lds, g, S, E);
    }
    SEAM(8);
    if (IN(9)) {
        pg8::Gemm g{H, (const bf16_t*)(ws + WS_WD2), T_ALL, DM, DFF}; pg8::StaticOrder S; S.init(T_ALL, DM, G, (int)blockIdx.x);
        EpiResid E{p.out, p.out + (size_t)TP * DM, p.out, nullptr, nullptr, SS3, 0.5f};
        pg8::gemm_phase<EpiResid, pg8::StaticOrder, PG8_ALIGN, PG8_SP2>(lds, g, S, E);
    }
    SEAM(9);
    if (IN(10)) phase_final(p);
#undef IN
#undef SEAM
}

extern "C" void kernel_launch(void* const* d_in, const int* in_sizes, int n_in, void* d_out, int out_size, void* d_ws, size_t ws_size, hipStream_t stream) {
    static int grid = 0;
    if (grid == 0) {
        if (n_in != 26 || ws_size < WS_END2) { fprintf(stderr, "kernel_launch: unexpected n_in %d or ws_size %zu (need %zu)\n", n_in, ws_size, (size_t)WS_END2); grid = -1; return; }
        int dev = 0, cus = 0, per_cu = 0;
        hipGetDevice(&dev); hipDeviceGetAttribute(&cus, hipDeviceAttributeMultiprocessorCount, dev);
        if (hipFuncSetAttribute((const void*)mk_fwd, hipFuncAttributeMaxDynamicSharedMemorySize, LDS_BYTES) != hipSuccess) { fprintf(stderr, "kernel_launch: hipFuncSetAttribute failed\n"); grid = -1; return; }
        if (hipOccupancyMaxActiveBlocksPerMultiprocessor(&per_cu, (const void*)mk_fwd, 512, LDS_BYTES) != hipSuccess || per_cu < 1) { fprintf(stderr, "kernel_launch: occupancy query says %d\n", per_cu); per_cu = 1; }
        (void)hipGetLastError();
        grid = cus;
    }
    if (grid < 0) return;
    Params p{};
    for (int i = 0; i < 26; ++i) p.in[i] = (const float*)d_in[i];
    p.out = (float*)d_out; p.ws = (unsigned char*)d_ws;
#if MK_PER_PHASE
    for (int ph = 0; ph < MK_NPH; ++ph) { p.ph_lo = ph; p.ph_hi = ph + 1; hipLaunchKernelGGL(mk_fwd, dim3(grid), dim3(512), LDS_BYTES, stream, p); if ((MK_DUP >> ph) & 1) hipLaunchKernelGGL(mk_fwd, dim3(grid), dim3(512), LDS_BYTES, stream, p); }
#else
    p.ph_lo = 0; p.ph_hi = MK_NPH;
    if (hipMemsetAsync((char*)d_ws + WS_BAR, 0, 16384, stream) != hipSuccess) { fprintf(stderr, "memset failed\n"); return; }
    void* args[] = {&p};
    hipError_t e = hipLaunchCooperativeKernel((const void*)mk_fwd, dim3(grid), dim3(512), args, LDS_BYTES, stream);
    if (e != hipSuccess) fprintf(stderr, "cooperative launch failed: %s (grid %d)\n", hipGetErrorString(e), grid);
#endif
}
```

```cpp
#include <hip/hip_runtime.h>
#include <hip/hip_cooperative_groups.h>
#include <cstdio>
#include <cstdint>
namespace cg = cooperative_groups;

#ifndef MK_DUP
#define MK_DUP 0
#endif
#ifndef MK_NPH
#define MK_NPH 11
#endif
#ifndef MK_PER_PHASE
#define MK_PER_PHASE 0
#endif

#define LAS __attribute__((address_space(3)))
typedef unsigned short bf16_t;
typedef short bf16x8 __attribute__((ext_vector_type(8)));
typedef float f32x4 __attribute__((ext_vector_type(4)));
typedef unsigned u32x4 __attribute__((ext_vector_type(4)));
typedef unsigned u32x2 __attribute__((ext_vector_type(2)));

constexpr int T_ALL = 16896, TP = 16384, DM = 1024, DFF = 2816, DIN = 3072, DH = 512;
constexpr int SEQ = 2048, NB = 8, NCH = 32, DECB = 128;
constexpr float EPS = 1e-6f;

constexpr size_t OUT_Y = 0, OUT_HP = 17301504, OUT_LP = 17825792, OUT_CP = 17829888, OUT_HS = 17842176, OUT_LS = 26230784, OUT_CS = 26296320;

constexpr size_t WS_WG1 = 0;
constexpr size_t WS_WD1 = WS_WG1 + (size_t)5632 * 1024 * 2;
constexpr size_t WS_WIN = WS_WD1 + (size_t)1024 * 2816 * 2;
constexpr size_t WS_WO  = WS_WIN + (size_t)3072 * 1024 * 2;
constexpr size_t WS_WG2 = WS_WO + (size_t)1024 * 1024 * 2;
constexpr size_t WS_WD2 = WS_WG2 + (size_t)5632 * 1024 * 2;
constexpr size_t WS_WAT = WS_WD2 + (size_t)1024 * 2816 * 2;
constexpr size_t WS_WXT = WS_WAT + 65536;
constexpr size_t WS_SS0 = WS_WXT + 65536;
constexpr size_t SS_BYTES = (size_t)T_ALL * 16 * 4;
constexpr size_t WS_SS1 = WS_SS0 + SS_BYTES, WS_SS2 = WS_SS1 + SS_BYTES, WS_SS3 = WS_SS2 + SS_BYTES;
constexpr size_t WS_DC  = WS_SS3 + SS_BYTES;
constexpr size_t WS_ACH = WS_DC + (size_t)1024 * 128 * 4;
constexpr size_t WS_UCH = WS_ACH + (size_t)NB * NCH * 512 * 4;
constexpr size_t WS_HST = WS_UCH + (size_t)NB * NCH * 512 * 4;
constexpr size_t WS_B0  = WS_HST + (size_t)NB * NCH * 512 * 4;
constexpr size_t WS_R   = WS_B0 + (size_t)T_ALL * 1024 * 2;
constexpr size_t WS_H   = WS_R;
constexpr size_t WS_B1  = WS_H + (size_t)T_ALL * 2816 * 2;
constexpr size_t WS_Q   = WS_R;
constexpr size_t WS_V   = WS_Q + (size_t)T_ALL * 512 * 2;
constexpr size_t WS_SG  = WS_V + (size_t)T_ALL * 512 * 2;
constexpr size_t WS_GY  = WS_SG + (size_t)T_ALL * 512 * 2;
constexpr size_t WS_FZ  = WS_GY + (size_t)T_ALL * 512 * 2;
constexpr size_t WS_XB  = WS_FZ + (size_t)T_ALL * 512 * 4;
constexpr size_t WS_LT  = WS_XB + (size_t)T_ALL * 512 * 4;
constexpr size_t WS_END = WS_LT + (size_t)1024 * 16384 * 2;
constexpr size_t WS_BAR = WS_END;
constexpr size_t WS_END2 = WS_BAR + 16384;
static_assert(WS_END2 <= 268435456, "workspace budget");
static_assert(WS_B1 + (size_t)T_ALL * 1024 * 2 <= WS_END, "B1 inside R");

constexpr int LDS_BYTES = 131072 + 64;

typedef __bf16 nbf16x2 __attribute__((ext_vector_type(2)));
typedef float f32x2 __attribute__((ext_vector_type(2)));
__device__ __forceinline__ unsigned cvt_pk_bf16(float lo, float hi) { const nbf16x2 r = __builtin_convertvector((f32x2){lo, hi}, nbf16x2); return __builtin_bit_cast(unsigned, r); }
__device__ __forceinline__ bf16_t f2bf(float f) { return (bf16_t)(cvt_pk_bf16(f, 0.f) & 0xffffu); }
__device__ __forceinline__ float bf2f(bf16_t b) { return __uint_as_float(((unsigned)b) << 16); }
__device__ __forceinline__ float bflo(unsigned w) { return __uint_as_float(w << 16); }
__device__ __forceinline__ float bfhi(unsigned w) { return __uint_as_float(w & 0xffff0000u); }
__device__ __forceinline__ float sigm(float x) { return __builtin_amdgcn_rcpf(1.f + __expf(-x)); }
__device__ __forceinline__ float rowscale(const float* ss, int row) {
    const f32x4* p = (const f32x4*)(ss + (size_t)row * 16);
    const f32x4 a = p[0], b = p[1], c = p[2], d = p[3];
    const float s = (((a.x + a.y) + (a.z + a.w)) + ((b.x + b.y) + (b.z + b.w))) + (((c.x + c.y) + (c.z + c.w)) + ((d.x + d.y) + (d.z + d.w)));
    return rsqrtf(s * (1.f / 1024.f) + EPS);
}
__device__ __forceinline__ float wave_sum(float v) {
#pragma unroll
    for (int o = 1; o < 64; o <<= 1) v += __shfl_xor(v, o);
    return v;
}
#define LDS_WAIT() asm volatile("s_waitcnt lgkmcnt(0)" ::: "memory")

namespace pg8 {
constexpr int BM = 256, BK = 64, HALF = 128, HTB = HALF * BK * 2, STAGE_BYTES = 8 * HTB, NXCD = 8, WGM = 8;
__host__ __device__ __forceinline__ int lds_byte(int r, int c) { const int st = (r >> 4) * 2 + (c >> 5), rr = r & 15, cc = c & 31, ob = rr * 64 + cc * 2; return st * 1024 + (ob ^ (((ob >> 9) & 1) << 5)); }
__host__ __device__ __forceinline__ void stage_rc(int b, int& R, int& C) { const int st = b / 1024, sb = b % 1024, swz = sb ^ (((sb >> 9) & 1) << 5); R = (st >> 1) * 16 + swz / 64; C = (st & 1) * 32 + (swz % 64) / 2; }
__host__ __device__ __forceinline__ int perm32(int rho) { const int n = rho >> 4, i = rho & 15; return 8 * (i >> 2) + 4 * n + (i & 3); }
struct Unit { int pm, pn; };
struct Gemm { const bf16_t* A; const bf16_t* Bt; int M, N, K; };
struct StaticOrder {
    int nM, nN, nwg, G, c;
    __host__ __device__ void init(int M, int N, int G_, int c_) { nM = M / BM; nN = N / BM; nwg = nM * nN; G = G_; c = c_; }
    __host__ __device__ bool next(int i, Unit& u) const {
        const long L = (long)i * G + c; if (L >= nwg) return false;
        int wgid = (int)L; { const int q = nwg / NXCD, r = nwg % NXCD, xcd = wgid % NXCD, off = wgid / NXCD; wgid = (xcd < r ? xcd * (q + 1) : r * (q + 1) + (xcd - r) * q) + off; }
        const int nig = WGM * nN, gid = wgid / nig, fm = gid * WGM, gsz = (nM - fm) < WGM ? (nM - fm) : WGM;
        u.pm = fm + ((wgid % nig) % gsz); u.pn = (wgid % nig) / gsz; return true;
    }
    __device__ __forceinline__ void a_ready(const Unit&) const {}
    __device__ __forceinline__ void done(const Unit&) const {}
};

template <class Epi, class Sched, bool ALIGN_EPI = false, bool SP2 = false>
__device__ __forceinline__ void gemm_phase(LAS unsigned char* lds, const Gemm g, const Sched& S, const Epi& E) {
    const int tid = threadIdx.x, wid = __builtin_amdgcn_readfirstlane(tid >> 6), lane = tid & 63, wr = wid >> 2, wc = wid & 3, fr = lane & 15, fq = lane >> 4;
    const int K = g.K, nt = K / BK;
    unsigned voffA[2], voffB[2];
#pragma unroll
    for (int i = 0; i < 2; ++i) { int R, C; stage_rc(tid * 16 + i * 8192, R, C); const int Rb = Epi::PERM ? ((R & ~31) + perm32(R & 31)) : R;
        voffA[i] = (unsigned)(R * K + C) * 2u; voffB[i] = (unsigned)(Rb * K + C) * 2u; }
    const size_t kstep = (size_t)(BK * 2);
    const size_t hstep = (size_t)HALF * K * 2;
    const size_t tstep = 2 * hstep;
    const unsigned ldsw = (unsigned)wid * 1024u;
    const int aoff = lds_byte(wr * 64 + fr, fq * 8), boff = lds_byte(wc * 32 + fr, fq * 8);
#define PG8_SA(b, h) (((b) * 2 + (h)) * HTB)
#define PG8_SB(b, h) ((4 + (b) * 2 + (h)) * HTB)
#define PG8_STAGE(bufoff, gbase, voff) do { _Pragma("unroll") for (int _i = 0; _i < 2; ++_i) \
        __builtin_amdgcn_global_load_lds((const unsigned*)((const char*)(gbase) + (voff)[_i]), (LAS unsigned*)(lds + (bufoff) + ldsw + _i * 8192), 16, 0, 0); } while (0)
#define PG8_LDA(dst, b, h) do { _Pragma("unroll") for (int m = 0; m < 4; ++m) _Pragma("unroll") for (int k = 0; k < 2; ++k) dst[m][k] = *(const LAS bf16x8*)(lds + PG8_SA(b, h) + aoff + m * 2048 + k * 1024); } while (0)
#define PG8_LDB(dst, b, h) do { _Pragma("unroll") for (int n = 0; n < 2; ++n) _Pragma("unroll") for (int k = 0; k < 2; ++k) dst[n][k] = *(const LAS bf16x8*)(lds + PG8_SB(b, h) + boff + n * 2048 + k * 1024); } while (0)
#define PG8_MMA(ai, bj, At, Bt) do { __builtin_amdgcn_s_setprio(1); _Pragma("unroll") for (int m = 0; m < 4; ++m) _Pragma("unroll") for (int n = 0; n < 2; ++n) _Pragma("unroll") for (int k = 0; k < 2; ++k) \
        acc[ai][bj][m][n] = __builtin_amdgcn_mfma_f32_16x16x32_bf16(Bt[n][k], At[m][k], acc[ai][bj][m][n], 0, 0, 0); __builtin_amdgcn_s_setprio(0); } while (0)
#define PG8_WAIT_V(n) asm volatile("s_waitcnt vmcnt(" #n ")" ::: "memory")
#define PG8_WAIT_L(n) asm volatile("s_waitcnt lgkmcnt(" #n ")" ::: "memory")
#define PG8_BAR __builtin_amdgcn_s_barrier()
#define PG8_SCHED __builtin_amdgcn_sched_barrier(0)
    Unit cur, nxt; int ui = 0;
    if (!S.next(0, cur)) return;
    f32x4 acc[2][2][4][2];
#pragma unroll
    for (int a = 0; a < 2; ++a)
#pragma unroll
        for (int b = 0; b < 2; ++b)
#pragma unroll
            for (int m = 0; m < 4; ++m)
#pragma unroll
                for (int n = 0; n < 2; ++n) acc[a][b][m][n] = (f32x4){0.f, 0.f, 0.f, 0.f};
    bf16x8 At[4][2], B0[2][2], B1[2][2];
    const char* cA = (const char*)g.A + (size_t)cur.pm * tstep; const char* cB = (const char*)g.Bt + (size_t)cur.pn * tstep;
    S.a_ready(cur);
    if constexpr (SP2) {
        PG8_STAGE(PG8_SB(0, 0), cB, voffB); PG8_STAGE(PG8_SB(0, 1), cB + hstep, voffB); PG8_STAGE(PG8_SA(0, 0), cA, voffA); PG8_STAGE(PG8_SA(0, 1), cA + hstep, voffA);
        if (wr == 1) PG8_BAR;
        PG8_WAIT_V(2); PG8_BAR;
        PG8_STAGE(PG8_SB(1, 0), cB + kstep, voffB); PG8_STAGE(PG8_SA(1, 0), cA + kstep, voffA); PG8_STAGE(PG8_SB(1, 1), cB + hstep + kstep, voffB);
        PG8_WAIT_V(6); PG8_BAR;
    } else {
        PG8_STAGE(PG8_SB(0, 0), cB, voffB); PG8_STAGE(PG8_SA(0, 0), cA, voffA); PG8_STAGE(PG8_SB(0, 1), cB + hstep, voffB); PG8_STAGE(PG8_SA(0, 1), cA + hstep, voffA);
        if (wr == 1) PG8_BAR;
        PG8_WAIT_V(4); PG8_BAR;
        PG8_STAGE(PG8_SB(1, 0), cB + kstep, voffB); PG8_STAGE(PG8_SA(1, 0), cA + kstep, voffA); PG8_STAGE(PG8_SB(1, 1), cB + hstep + kstep, voffB);
        PG8_WAIT_V(6); PG8_BAR;
    }
    for (;;) {
        const bool has_next = S.next(ui + 1, nxt);
        const char* nA = has_next ? (const char*)g.A + (size_t)nxt.pm * tstep : cA; const char* nB = has_next ? (const char*)g.Bt + (size_t)nxt.pn * tstep : cB;
        for (int t = 0; t < nt; t += 2) {
            const bool last = (t == nt - 2);
            const char* a1 = cA + (size_t)(t + 1) * kstep;
            const char* a2 = last ? nA : cA + (size_t)(t + 2) * kstep; const char* b2 = last ? nB : cB + (size_t)(t + 2) * kstep;
            const char* a3 = a2 + kstep; const char* b3 = b2 + kstep;
            if (last && has_next) S.a_ready(nxt);
            if constexpr (SP2) {
            PG8_LDB(B0, 0, 0); PG8_LDB(B1, 0, 1); PG8_SCHED; PG8_LDA(At, 0, 0); PG8_STAGE(PG8_SA(1, 1), a1 + hstep, voffA);
            PG8_WAIT_V(8); PG8_WAIT_L(0); PG8_BAR; PG8_MMA(0, 0, At, B0); PG8_MMA(0, 1, At, B1); PG8_BAR; PG8_SCHED;
            PG8_LDA(At, 0, 1); PG8_STAGE(PG8_SB(0, 0), b2, voffB); PG8_STAGE(PG8_SB(0, 1), b2 + hstep, voffB); PG8_STAGE(PG8_SA(0, 0), a2, voffA);
            PG8_WAIT_V(8); PG8_WAIT_L(0); PG8_BAR; PG8_MMA(1, 0, At, B0); PG8_MMA(1, 1, At, B1); PG8_BAR; PG8_SCHED;
            PG8_LDB(B0, 1, 0); PG8_LDB(B1, 1, 1); PG8_SCHED; PG8_LDA(At, 1, 0); PG8_STAGE(PG8_SA(0, 1), a2 + hstep, voffA);
            PG8_WAIT_V(8); PG8_WAIT_L(0); PG8_BAR; PG8_MMA(0, 0, At, B0); PG8_MMA(0, 1, At, B1); PG8_BAR; PG8_SCHED;
            PG8_LDA(At, 1, 1); PG8_STAGE(PG8_SB(1, 0), b3, voffB); PG8_STAGE(PG8_SB(1, 1), b3 + hstep, voffB); PG8_STAGE(PG8_SA(1, 0), a3, voffA);
            PG8_WAIT_V(8); PG8_WAIT_L(0); PG8_BAR; PG8_MMA(1, 0, At, B0); PG8_MMA(1, 1, At, B1); PG8_BAR; PG8_SCHED;
            } else {
            PG8_LDB(B0, 0, 0); PG8_SCHED; PG8_LDA(At, 0, 0); PG8_STAGE(PG8_SA(1, 1), a1 + hstep, voffA);
            PG8_WAIT_L(8); PG8_BAR; PG8_WAIT_L(0); PG8_MMA(0, 0, At, B0); PG8_BAR; PG8_SCHED;
            PG8_LDB(B1, 0, 1); PG8_STAGE(PG8_SB(0, 0), b2, voffB);
            PG8_BAR; PG8_WAIT_L(0); PG8_MMA(0, 1, At, B1); PG8_BAR;
            PG8_LDA(At, 0, 1); PG8_STAGE(PG8_SA(0, 0), a2, voffA);
            PG8_BAR; PG8_WAIT_L(0); PG8_MMA(1, 0, At, B0); PG8_BAR; PG8_SCHED;
            PG8_STAGE(PG8_SB(0, 1), b2 + hstep, voffB);
            PG8_WAIT_V(6); PG8_BAR; PG8_MMA(1, 1, At, B1); PG8_BAR;
            PG8_LDB(B0, 1, 0); PG8_SCHED; PG8_LDA(At, 1, 0); PG8_STAGE(PG8_SA(0, 1), a2 + hstep, voffA);
            PG8_WAIT_L(8); PG8_BAR; PG8_WAIT_L(0); PG8_MMA(0, 0, At, B0); PG8_BAR; PG8_SCHED;
            PG8_LDB(B1, 1, 1); PG8_STAGE(PG8_SB(1, 0), b3, voffB);
            PG8_BAR; PG8_WAIT_L(0); PG8_MMA(0, 1, At, B1); PG8_BAR;
            PG8_LDA(At, 1, 1); PG8_STAGE(PG8_SA(1, 0), a3, voffA);
            PG8_BAR; PG8_WAIT_L(0); PG8_MMA(1, 0, At, B0); PG8_BAR; PG8_SCHED;
            PG8_STAGE(PG8_SB(1, 1), b3 + hstep, voffB);
            PG8_WAIT_V(6); PG8_BAR; PG8_MMA(1, 1, At, B1); PG8_BAR;
            }
        }
        if constexpr (ALIGN_EPI) { if (wr == 0) PG8_BAR; }
        E(acc, cur, wr, wc, fr, fq); S.done(cur);
        if (!has_next) break;
#pragma unroll
        for (int a = 0; a < 2; ++a)
#pragma unroll
            for (int b = 0; b < 2; ++b)
#pragma unroll
                for (int m = 0; m < 4; ++m)
#pragma unroll
                    for (int n = 0; n < 2; ++n) acc[a][b][m][n] = (f32x4){0.f, 0.f, 0.f, 0.f};
        cur = nxt; cA = nA; cB = nB; ++ui;
        if constexpr (ALIGN_EPI) { if (wr == 1) PG8_BAR; }
    }
    PG8_WAIT_V(0);
    if constexpr (!ALIGN_EPI) { if (wr == 0) PG8_BAR; }
    PG8_BAR;
#undef PG8_SA
#undef PG8_SB
#undef PG8_STAGE
#undef PG8_LDA
#undef PG8_LDB
#undef PG8_MMA
#undef PG8_WAIT_V
#undef PG8_WAIT_L
#undef PG8_BAR
#undef PG8_SCHED
}
}

#ifndef PG8_SP2
#define PG8_SP2 true
#endif
#ifndef PG8_ALIGN
#define PG8_ALIGN true
#endif

struct EpiGateUp {
    static constexpr bool PERM = true;
    bf16_t* H; const float* ss;
    __device__ __forceinline__ void operator()(const f32x4 (&acc)[2][2][4][2], const pg8::Unit& u, int wr, int wc, int fr, int fq) const {
        const int row0 = u.pm * 256 + wr * 64 + fr, col0 = u.pn * 128 + wc * 32 + 8 * fq;
#pragma unroll
        for (int ai = 0; ai < 2; ++ai)
#pragma unroll
            for (int m = 0; m < 4; ++m) {
                const int row = row0 + ai * 128 + m * 16; const float rs = rowscale(ss, row);
                float h[8];
#pragma unroll
                for (int n = 0; n < 2; ++n)
#pragma unroll
                    for (int j = 0; j < 4; ++j) { const float g = acc[ai][0][m][n][j] * rs, up = acc[ai][1][m][n][j] * rs; h[n * 4 + j] = g * sigm(g) * up; }
                u32x4 w; w.x = cvt_pk_bf16(h[0], h[1]); w.y = cvt_pk_bf16(h[2], h[3]); w.z = cvt_pk_bf16(h[4], h[5]); w.w = cvt_pk_bf16(h[6], h[7]);
                *(u32x4*)(H + (size_t)row * DFF + col0) = w;
            }
    }
};
struct EpiResid {
    static constexpr bool PERM = true;
    const float* xin_p; const float* xin_s; float* xout; bf16_t* ax; const float* gnext; float* ssout; float scale;
    __device__ __forceinline__ void operator()(const f32x4 (&acc)[2][2][4][2], const pg8::Unit& u, int wr, int wc, int fr, int fq) const {
        const int row0 = u.pm * 256 + wr * 64 + fr, col0 = u.pn * 256 + wc * 32 + 8 * fq;
        const float* xb = (u.pm < 64) ? xin_p : (xin_s - (size_t)TP * DM);
        f32x4 gn[2][2];
#pragma unroll
        for (int bj = 0; bj < 2; ++bj)
#pragma unroll
            for (int n = 0; n < 2; ++n) gn[bj][n] = ax ? *(const f32x4*)(gnext + col0 + bj * 128 + 4 * n) : (f32x4){1.f, 1.f, 1.f, 1.f};
#pragma unroll
        for (int ai = 0; ai < 2; ++ai)
#pragma unroll
            for (int m = 0; m < 4; ++m) {
                const int row = row0 + ai * 128 + m * 16; const size_t off = (size_t)row * DM + col0; float sq = 0.f;
#pragma unroll
                for (int bj = 0; bj < 2; ++bj) {
                    const f32x4 x0 = *(const f32x4*)(xb + off + bj * 128), x1 = *(const f32x4*)(xb + off + bj * 128 + 4);
                    const f32x4 v0 = x0 + acc[ai][bj][m][0] * scale, v1 = x1 + acc[ai][bj][m][1] * scale;
                    *(f32x4*)(xout + off + bj * 128) = v0; *(f32x4*)(xout + off + bj * 128 + 4) = v1;
                    sq += ((v0[0] * v0[0] + v0[1] * v0[1]) + (v0[2] * v0[2] + v0[3] * v0[3])) + ((v1[0] * v1[0] + v1[1] * v1[1]) + (v1[2] * v1[2] + v1[3] * v1[3]));
                    if (ax) { const f32x4 a0 = v0 * gn[bj][0], a1 = v1 * gn[bj][1];
                        u32x4 w; w.x = cvt_pk_bf16(a0[0], a0[1]); w.y = cvt_pk_bf16(a0[2], a0[3]); w.z = cvt_pk_bf16(a1[0], a1[1]); w.w = cvt_pk_bf16(a1[2], a1[3]);
                        *(u32x4*)(ax + off + bj * 128) = w; }
                }
                sq += __shfl_xor(sq, 16); sq += __shfl_xor(sq, 32);
                if (fq == 0) ssout[(size_t)row * 16 + u.pn * 4 + wc] = sq;
            }
    }
};
struct EpiProj {
    static constexpr bool PERM = true;
    bf16_t *Q, *V, *SG, *GY; float *FZ, *XB; const float* ss;
    __device__ __forceinline__ void operator()(const f32x4 (&acc)[2][2][4][2], const pg8::Unit& u, int wr, int wc, int fr, int fq) const {
        const int seg = u.pn >> 1;
        const int row0 = u.pm * 256 + wr * 64 + fr, col0 = (u.pn & 1) * 256 + wc * 32 + 8 * fq;
        float* fdst = (seg == 1) ? FZ : XB;
        bf16_t* bdst = (seg == 0) ? Q : (seg == 2) ? V : (seg == 3) ? SG : GY;
        const bool isf = (seg == 1) || (seg == 4);
#pragma unroll
        for (int ai = 0; ai < 2; ++ai)
#pragma unroll
            for (int m = 0; m < 4; ++m) {
                const int row = row0 + ai * 128 + m * 16; const float rs = rowscale(ss, row); const size_t off = (size_t)row * DH + col0;
#pragma unroll
                for (int bj = 0; bj < 2; ++bj) {
                    f32x4 v0 = acc[ai][bj][m][0] * rs, v1 = acc[ai][bj][m][1] * rs;
                    if (isf) { *(f32x4*)(fdst + off + bj * 128) = v0; *(f32x4*)(fdst + off + bj * 128 + 4) = v1; }
                    else {
                        float h[8] = {v0[0], v0[1], v0[2], v0[3], v1[0], v1[1], v1[2], v1[3]};
                        if (seg == 0) {
#pragma unroll
                            for (int j = 0; j < 8; ++j) h[j] = h[j] * sigm(h[j]);
                        } else if (seg == 3) {
#pragma unroll
                            for (int j = 0; j < 8; ++j) h[j] = sigm(h[j]);
                        } else if (seg == 5) {
#pragma unroll
                            for (int j = 0; j < 8; ++j) { const float y = h[j]; h[j] = y * sigm(1.5957691216f * (y + 0.044715f * y * y * y)); }
                        }
                        u32x4 w; w.x = cvt_pk_bf16(h[0], h[1]); w.y = cvt_pk_bf16(h[2], h[3]); w.z = cvt_pk_bf16(h[4], h[5]); w.w = cvt_pk_bf16(h[6], h[7]);
                        *(u32x4*)(bdst + off + bj * 128) = w;
                    }
                }
            }
    }
};


struct SmallResid {
    const float* xin; float* xout; bf16_t* ax; const float* gnext; float* ssout; float scale;
    __device__ __forceinline__ void apply(const f32x4& acc, int grow, int c, int cn, int c16, int r16, int fr, int fq, LAS unsigned char* lds) const {
        const size_t off = (size_t)grow * DM + c;
        const f32x4 x = *(const f32x4*)(xin + off);
        const f32x4 v = x + acc * scale;
        *(f32x4*)(xout + off) = v;
        float sq = (v[0] * v[0] + v[1] * v[1]) + (v[2] * v[2] + v[3] * v[3]);
        if (ax) { const f32x4 g = *(const f32x4*)(gnext + c); const f32x4 a = v * g; u32x2 w; w.x = cvt_pk_bf16(a[0], a[1]); w.y = cvt_pk_bf16(a[2], a[3]); *(u32x2*)(ax + off) = w; }
        sq += __shfl_xor(sq, 16); sq += __shfl_xor(sq, 32);
        LAS float* P = (LAS float*)lds;
        if (fq == 0) P[(r16 * 16 + fr) * 4 + c16] = sq;
        __syncthreads();
        if (c16 == 0 && fq == 0) { const LAS float* q = P + (r16 * 16 + fr) * 4; ssout[(size_t)grow * 16 + cn] = (q[0] + q[1]) + (q[2] + q[3]); }
        __syncthreads();
    }
};
struct SmallProj {
    bf16_t *Q, *V, *SG, *GY; float *FZ, *XB; const float* ss;
    __device__ __forceinline__ void apply(const f32x4& acc, int grow, int c, int cn, int c16, int r16, int fr, int fq, LAS unsigned char* lds) const {
        const int seg = cn >> 3, cs = c & 511;
        const float rs = rowscale(ss, grow);
        const f32x4 v = acc * rs;
        const size_t off = (size_t)grow * DH + cs;
        if (seg == 1 || seg == 4) { *(f32x4*)(((seg == 1) ? FZ : XB) + off) = v; }
        else {
            float h[4] = {v[0], v[1], v[2], v[3]};
            if (seg == 0) {
#pragma unroll
                for (int j = 0; j < 4; ++j) h[j] = h[j] * sigm(h[j]);
            } else if (seg == 3) {
#pragma unroll
                for (int j = 0; j < 4; ++j) h[j] = sigm(h[j]);
            } else if (seg == 5) {
#pragma unroll
                for (int j = 0; j < 4; ++j) { const float y = h[j]; h[j] = y * sigm(1.5957691216f * (y + 0.044715f * y * y * y)); }
            }
            bf16_t* bdst = (seg == 0) ? Q : (seg == 2) ? V : (seg == 3) ? SG : GY;
            u32x2 w; w.x = cvt_pk_bf16(h[0], h[1]); w.y = cvt_pk_bf16(h[2], h[3]);
            *(u32x2*)(bdst + off) = w;
        }
    }
};
template <class Epi>
__device__ __forceinline__ void small_gemm(const bf16_t* A, const bf16_t* Bt, int N, int K, const Epi& E, LAS unsigned char* lds) {
    const int tid = threadIdx.x, lane = tid & 63, wave = tid >> 6, fr = lane & 15, fq = lane >> 4, r16 = wave >> 2, c16 = wave & 3;
    const int nunits = 16 * (N / 64), G = gridDim.x;
    for (int u = G - 1 - (int)blockIdx.x; u < nunits; u += G) {
        const int rm = u & 15, cn = u >> 4;
        const int lrow = rm * 32 + r16 * 16 + fr, col = cn * 64 + c16 * 16;
        const bf16_t* ap = A + (size_t)(TP + lrow) * K + fq * 8;
        const bf16_t* bp = Bt + (size_t)(col + fr) * K + fq * 8;
        f32x4 acc = {0.f, 0.f, 0.f, 0.f};
        for (int k0 = 0; k0 < K; k0 += 256) {
            bf16x8 a[8], b[8];
#pragma unroll
            for (int i = 0; i < 8; ++i) { a[i] = *(const bf16x8*)(ap + k0 + i * 32); b[i] = *(const bf16x8*)(bp + k0 + i * 32); }
#pragma unroll
            for (int i = 0; i < 8; ++i) acc = __builtin_amdgcn_mfma_f32_16x16x32_bf16(b[i], a[i], acc, 0, 0, 0);
        }
        E.apply(acc, TP + lrow, col + 4 * fq, cn, c16, r16, fr, fq, lds);
    }
}

#define XB_TMO      128
#define XB_XCNT(j)  (256  + 64 * (j))
#define XB_XSUB(j)  (1280 + 64 * (j))
#define XB_XGEN(j)  (2304 + 64 * (j))
#define XB_TOP      3328
#define XB_TOPGEN   3392
#define XCD_BAR_WORDS 3456
#define XB_SPIN_CAP (1u << 22)
__device__ __forceinline__ unsigned xb_ld(unsigned* p)              { return __hip_atomic_load(p, __ATOMIC_RELAXED, __HIP_MEMORY_SCOPE_AGENT); }
__device__ __forceinline__ unsigned xb_add(unsigned* p, unsigned v) { return __hip_atomic_fetch_add(p, v, __ATOMIC_RELAXED, __HIP_MEMORY_SCOPE_AGENT); }
__device__ __forceinline__ unsigned xb_xcc_id() { return (unsigned)__builtin_amdgcn_s_getreg((3 << 11) | 20) & 0xFu; }
#define XB_SPIN(cond, bar) do { unsigned _sp = 0; while (cond) { __builtin_amdgcn_s_sleep(1); \
    if ((++_sp & 255u) == 0u) { if (xb_ld(&(bar)[XB_TMO])) break; if (_sp > XB_SPIN_CAP) { atomicAdd(&(bar)[XB_TMO], 1u); break; } } } } while (0)
struct XcdBarrier { unsigned* bar; unsigned x; volatile LAS unsigned* st; };
__device__ __forceinline__ XcdBarrier xcd_barrier_post(unsigned* bar, volatile LAS unsigned* st) {
    XcdBarrier b; b.bar = bar; b.x = xb_xcc_id(); b.st = st;
    if (threadIdx.x == 0) (void)xb_add(&bar[XB_XCNT(b.x)], 1u);
    return b;
}
__device__ __forceinline__ void xcd_barrier_complete(unsigned* bar, unsigned x, unsigned& nloc, unsigned& nx) {
    const unsigned G = gridDim.x * gridDim.y * gridDim.z;
    unsigned sum, cnt, mine, sp = 0u;
    for (;;) {
        sum = 0u; cnt = 0u; mine = 0u;
#pragma unroll
        for (unsigned j = 0; j < 16; ++j) { const unsigned c = xb_ld(&bar[XB_XCNT(j)]); sum += c; cnt += (c > 0u) ? 1u : 0u; mine = (j == x) ? c : mine; }
        if (sum == G) break;
        __builtin_amdgcn_s_sleep(1);
        if ((++sp & 255u) == 0u) { if (xb_ld(&bar[XB_TMO])) break; if (sp > XB_SPIN_CAP) { atomicAdd(&bar[XB_TMO], 1u); break; } }
    }
    nloc = mine > 0u ? mine : 1u; nx = cnt > 0u ? cnt : 1u;
}
__device__ __forceinline__ void xcd_barrier(const XcdBarrier& b) {
    asm volatile("s_waitcnt vmcnt(0) lgkmcnt(0)" ::: "memory");
    __syncthreads();
    if (threadIdx.x == 0) {
        unsigned* bar = b.bar;
        __builtin_amdgcn_s_waitcnt(0);
        unsigned nloc = b.st[0], nx = b.st[1];
        if (nloc == 0u) { xcd_barrier_complete(bar, b.x, nloc, nx); b.st[0] = nloc; b.st[1] = nx; }
        const unsigned old = xb_add(&bar[XB_XSUB(b.x)], 1u);
        const unsigned gen = old / nloc;
        if (old + 1u == (gen + 1u) * nloc) {
            __builtin_amdgcn_fence(__ATOMIC_RELEASE, "agent");
            asm volatile("s_waitcnt vmcnt(0)" ::: "memory");
            const unsigned og = xb_add(&bar[XB_TOP], 1u);
            const unsigned tg = og / nx;
            if (og + 1u == (tg + 1u) * nx) xb_add(&bar[XB_TOPGEN], 1u);
            else XB_SPIN(xb_ld(&bar[XB_TOPGEN]) == tg, bar);
            __builtin_amdgcn_fence(__ATOMIC_ACQUIRE, "agent");
            xb_add(&bar[XB_XGEN(b.x)], 1u);
            asm volatile("s_waitcnt vmcnt(0)" ::: "memory");
        } else {
            XB_SPIN(xb_ld(&bar[XB_XGEN(b.x)]) == gen, bar);
            __builtin_amdgcn_fence(__ATOMIC_ACQUIRE, "agent");
            asm volatile("s_waitcnt vmcnt(0)" ::: "memory");
        }
    }
    __syncthreads();
}

struct Params { const float* in[26]; float* out; unsigned char* ws; int ph_lo, ph_hi; };

__device__ __forceinline__ void transpose_item(const float* W, int K, int N, bf16_t* WT, int dst_row0, LAS float* scr, int k0, int n0, int lane) {
#pragma unroll 8
    for (int i = 0; i < 32; ++i) { const int kk = 2 * i + (lane >> 5); scr[kk * 33 + (lane & 31)] = W[(size_t)(k0 + kk) * N + n0 + (lane & 31)]; }
    LDS_WAIT();
    const int c = lane & 7;
#pragma unroll
    for (int j = 0; j < 4; ++j) { const int n = (lane >> 3) + 8 * j; const LAS float* s = scr + (8 * c) * 33 + n;
        u32x4 o; o.x = cvt_pk_bf16(s[0 * 33], s[1 * 33]); o.y = cvt_pk_bf16(s[2 * 33], s[3 * 33]); o.z = cvt_pk_bf16(s[4 * 33], s[5 * 33]); o.w = cvt_pk_bf16(s[6 * 33], s[7 * 33]);
        *(u32x4*)(WT + (size_t)(dst_row0 + n) * K + k0 + 8 * c) = o; }
    LDS_WAIT();
}
__device__ __forceinline__ void transpose_mat(const float* W, int K, int N, bf16_t* WT, int mode, LAS float* scr, int item, int lane) {
    const int nblk = N / 32, kb = item / nblk, nb = item % nblk, n0 = 32 * nb;
    const int dst = (mode == 0) ? n0 : (256 * (n0 >> 7) + (n0 & 127) + (mode == 2 ? 128 : 0));
    transpose_item(W, K, N, WT, dst, scr, 64 * kb, n0, lane);
}

__device__ __forceinline__ void phase0(const Params& p, LAS unsigned char* lds) {
    const int tid = threadIdx.x, lane = tid & 63, wave = tid >> 6;
    const int G = gridDim.x, gw = blockIdx.x * 8 + wave, NGW = G * 8;
    unsigned char* ws = p.ws;
    LAS float* scr = (LAS float*)(lds + wave * 16384);
    constexpr int I_GU = 16 * 88, I_D = 44 * 32, I_IN = 16 * 96, I_O = 16 * 32;
    constexpr int NIT = 4 * I_GU + 2 * I_D + I_IN + I_O;
    for (int it = gw; it < NIT; it += NGW) {
        int r = it;
        if (r < I_GU) { transpose_mat(p.in[6], 1024, 2816, (bf16_t*)(ws + WS_WG1), 1, scr, r, lane); continue; } r -= I_GU;
        if (r < I_GU) { transpose_mat(p.in[7], 1024, 2816, (bf16_t*)(ws + WS_WG1), 2, scr, r, lane); continue; } r -= I_GU;
        if (r < I_D)  { transpose_mat(p.in[8], 2816, 1024, (bf16_t*)(ws + WS_WD1), 0, scr, r, lane); continue; } r -= I_D;
        if (r < I_IN) { transpose_mat(p.in[10], 1024, 3072, (bf16_t*)(ws + WS_WIN), 0, scr, r, lane); continue; } r -= I_IN;
        if (r < I_O)  { transpose_mat(p.in[20], 1024, 1024, (bf16_t*)(ws + WS_WO), 0, scr, r, lane); continue; } r -= I_O;
        if (r < I_GU) { transpose_mat(p.in[22], 1024, 2816, (bf16_t*)(ws + WS_WG2), 1, scr, r, lane); continue; } r -= I_GU;
        if (r < I_GU) { transpose_mat(p.in[23], 1024, 2816, (bf16_t*)(ws + WS_WG2), 2, scr, r, lane); continue; } r -= I_GU;
        transpose_mat(p.in[24], 2816, 1024, (bf16_t*)(ws + WS_WD2), 0, scr, r, lane);
    }
    for (int e = blockIdx.x * 512 + tid; e < 2 * 32768; e += G * 512) {
        const int which = e >> 15, r = e & 32767, n = r >> 12, j = (r >> 6) & 63, i = r & 63;
        const float* W = which ? p.in[17] : p.in[15];
        bf16_t* WT = (bf16_t*)(ws + (which ? WS_WXT : WS_WAT));
        WT[r] = f2bf(W[(n * 64 + i) * 64 + j]);
    }
    bf16_t* A1 = (bf16_t*)(ws + WS_B0); float* SS0 = (float*)(ws + WS_SS0);
    const float* g1 = p.in[5];
    f32x4 gv[4];
#pragma unroll
    for (int j = 0; j < 4; ++j) gv[j] = ((const f32x4*)g1)[lane + 64 * j];
    for (int row = gw; row < T_ALL; row += NGW) {
        const float* xr = (row < TP) ? p.in[0] + (size_t)row * DM : p.in[1] + (size_t)(row - TP) * DM;
        f32x4 v[4]; float s = 0.f;
#pragma unroll
        for (int j = 0; j < 4; ++j) { v[j] = ((const f32x4*)xr)[lane + 64 * j]; s += (v[j].x * v[j].x + v[j].y * v[j].y) + (v[j].z * v[j].z + v[j].w * v[j].w); }
        s = wave_sum(s);
        u32x2* o8 = (u32x2*)(A1 + (size_t)row * DM);
#pragma unroll
        for (int j = 0; j < 4; ++j) { const f32x4 a = v[j] * gv[j]; u32x2 w; w.x = cvt_pk_bf16(a.x, a.y); w.y = cvt_pk_bf16(a.z, a.w); o8[lane + 64 * j] = w; }
        if (lane < 16) SS0[(size_t)row * 16 + lane] = (lane == 0) ? s : 0.f;
    }
}

__device__ __forceinline__ void phase_final(const Params& p) {
    const int tid = threadIdx.x, lane = tid & 63, wave = tid >> 6;
    const int gw = blockIdx.x * 8 + wave, NGW = gridDim.x * 8;
    const float* SS3 = (const float*)(p.ws + WS_SS3); const float* gf = p.in[25];
    f32x4 gv[4];
#pragma unroll
    for (int j = 0; j < 4; ++j) gv[j] = ((const f32x4*)gf)[lane + 64 * j];
    for (int row = gw; row < T_ALL; row += NGW) {
        const float rs = rowscale(SS3, row);
        f32x4* xr = (f32x4*)(p.out + (size_t)row * DM);
#pragma unroll
        for (int j = 0; j < 4; ++j) { f32x4 v = xr[lane + 64 * j]; xr[lane + 64 * j] = v * rs * gv[j]; }
    }
}

struct Mix {
    const bf16_t *Q, *V, *SG, *GY; const float *FZ, *XB; bf16_t* LT; float* DC; float *ACH, *UCH, *HST; bf16_t* O;
    const bf16_t *WAT, *WXT;
    const float *lb, *hnorm, *convw, *convb, *ba, *bx, *lam, *wa, *wx, *st_h, *st_l, *st_c;
    float* out;
};

struct HgrnScan { float cum[16]; float kk[16]; float last; };
__device__ __forceinline__ void hgrn_scan(const float (&fzv)[16], float lb, int k, int seg, LAS float* tot, HgrnScan& hs) {
    float run = 0.f;
#pragma unroll
    for (int i = 0; i < 16; ++i) {
        const float e = __expf(-fmaxf(fzv[i], -80.f));
        const float sg = __builtin_amdgcn_rcpf(1.f + e), sn = e * sg;
        const float f = lb + (1.f - lb) * sg;
        run += __logf(f); hs.cum[i] = run; hs.kk[i] = (1.f - lb) * sn;
    }
    tot[seg * 128 + k] = run;
    __syncthreads();
    float off = 0.f, all = 0.f;
#pragma unroll
    for (int s = 0; s < 4; ++s) { const float v = tot[s * 128 + k]; if (s < seg) off += v; all += v; }
#pragma unroll
    for (int i = 0; i < 16; ++i) hs.cum[i] += off;
    hs.last = all;
}

__device__ __forceinline__ void hgrn_local_unit(const Mix& M, int unit, LAS unsigned char* lds) {
    const int tid = threadIdx.x, lane = tid & 63, wave = tid >> 6, fr = lane & 15, fq = lane >> 4;
    const int h = unit & 3, bc = unit >> 2, t0 = bc * 64, cb = h * 128, k = tid & 127, seg = tid >> 7;
    LAS bf16_t* KT = (LAS bf16_t*)lds; LAS bf16_t* VT = (LAS bf16_t*)(lds + 18432); LAS float* tot = (LAS float*)(lds + 36864);
    float fzv[16]; unsigned vv[16];
    const size_t rb = (size_t)(t0 + seg * 16) * DH + cb + k;
#pragma unroll
    for (int i = 0; i < 16; ++i) { fzv[i] = M.FZ[rb + (size_t)i * DH]; vv[i] = M.V[rb + (size_t)i * DH]; }
    const float l0 = M.lb[cb + k], l1 = M.lb[512 + cb + k];
    const float lb = __builtin_amdgcn_rcpf(1.f + __expf(l1 - l0));
    HgrnScan hs; hgrn_scan(fzv, lb, k, seg, tot, hs);
    unsigned pk[8];
#pragma unroll
    for (int i = 0; i < 8; ++i) pk[i] = cvt_pk_bf16(hs.kk[2 * i] * __expf(hs.last - hs.cum[2 * i]), hs.kk[2 * i + 1] * __expf(hs.last - hs.cum[2 * i + 1]));
    *(LAS u32x4*)(KT + k * 72 + seg * 16) = (u32x4){pk[0], pk[1], pk[2], pk[3]};
    *(LAS u32x4*)(KT + k * 72 + seg * 16 + 8) = (u32x4){pk[4], pk[5], pk[6], pk[7]};
    *(LAS u32x4*)(VT + k * 72 + seg * 16) = (u32x4){vv[0] | (vv[1] << 16), vv[2] | (vv[3] << 16), vv[4] | (vv[5] << 16), vv[6] | (vv[7] << 16)};
    *(LAS u32x4*)(VT + k * 72 + seg * 16 + 8) = (u32x4){vv[8] | (vv[9] << 16), vv[10] | (vv[11] << 16), vv[12] | (vv[13] << 16), vv[14] | (vv[15] << 16)};
    if (seg == 0) M.DC[unit * 128 + k] = __expf(hs.last);
    __syncthreads();
    const bf16x8 a0 = *(const LAS bf16x8*)(VT + (16 * wave + fr) * 72 + fq * 8), a1 = *(const LAS bf16x8*)(VT + (16 * wave + fr) * 72 + 32 + fq * 8);
#pragma unroll
    for (int ct = 0; ct < 8; ++ct) {
        const bf16x8 b0 = *(const LAS bf16x8*)(KT + (16 * ct + fr) * 72 + fq * 8), b1 = *(const LAS bf16x8*)(KT + (16 * ct + fr) * 72 + 32 + fq * 8);
        f32x4 acc = {0.f, 0.f, 0.f, 0.f};
        acc = __builtin_amdgcn_mfma_f32_16x16x32_bf16(b0, a0, acc, 0, 0, 0);
        acc = __builtin_amdgcn_mfma_f32_16x16x32_bf16(b1, a1, acc, 0, 0, 0);
        u32x2 w; w.x = cvt_pk_bf16(acc[0], acc[1]); w.y = cvt_pk_bf16(acc[2], acc[3]);
        *(u32x2*)(M.LT + ((size_t)unit * 128 + 16 * wave + fr) * 128 + 16 * ct + 4 * fq) = w;
    }
    __syncthreads();
}

__device__ __forceinline__ void hgrn_out_unit(const Mix& M, int unit, LAS unsigned char* lds) {
    const int tid = threadIdx.x, lane = tid & 63, wave = tid >> 6, fr = lane & 15, fq = lane >> 4;
    const int h = unit & 3, bc = unit >> 2, t0 = bc * 64, cb = h * 128, k = tid & 127, seg = tid >> 7;
    LAS bf16_t* QS = (LAS bf16_t*)lds; LAS bf16_t* KS = (LAS bf16_t*)(lds + 17408); LAS bf16_t* VT = (LAS bf16_t*)(lds + 34816);
    LAS bf16_t* PS = (LAS bf16_t*)(lds + 53248); LAS float* tot = (LAS float*)(lds + 62464); LAS float* RS = (LAS float*)(lds + 64512);
    float fzv[16]; unsigned vv[16], qv[16];
    const size_t rb = (size_t)(t0 + seg * 16) * DH + cb + k;
#pragma unroll
    for (int i = 0; i < 16; ++i) { fzv[i] = M.FZ[rb + (size_t)i * DH]; vv[i] = M.V[rb + (size_t)i * DH]; qv[i] = M.Q[rb + (size_t)i * DH]; }
    bf16x8 bs[4];
#pragma unroll
    for (int ks = 0; ks < 4; ++ks) bs[ks] = *(const bf16x8*)(M.LT + ((size_t)unit * 128 + 16 * wave + fr) * 128 + ks * 32 + fq * 8);
    const int ocol = cb + 16 * wave + 4 * fq;
    u32x2 sgv[4];
#pragma unroll
    for (int tr = 0; tr < 4; ++tr) sgv[tr] = *(const u32x2*)(M.SG + (size_t)(t0 + 16 * tr + fr) * DH + ocol);
    const f32x4 gn = *(const f32x4*)(M.hnorm + ocol);
    const float l0 = M.lb[cb + k], l1 = M.lb[512 + cb + k];
    const float lb = __builtin_amdgcn_rcpf(1.f + __expf(l1 - l0));
    HgrnScan hs; hgrn_scan(fzv, lb, k, seg, tot, hs);
#pragma unroll
    for (int i = 0; i < 16; ++i) {
        const float q = __uint_as_float(qv[i] << 16);
        QS[(seg * 16 + i) * 136 + k] = f2bf(q * __expf(hs.cum[i]));
        KS[(seg * 16 + i) * 136 + k] = f2bf(hs.kk[i] * __expf(-hs.cum[i]));
    }
    *(LAS u32x4*)(VT + k * 72 + seg * 16) = (u32x4){vv[0] | (vv[1] << 16), vv[2] | (vv[3] << 16), vv[4] | (vv[5] << 16), vv[6] | (vv[7] << 16)};
    *(LAS u32x4*)(VT + k * 72 + seg * 16 + 8) = (u32x4){vv[8] | (vv[9] << 16), vv[10] | (vv[11] << 16), vv[12] | (vv[13] << 16), vv[14] | (vv[15] << 16)};
    __syncthreads();
#pragma unroll
    for (int r = 0; r < 2; ++r) {
        const int idx = wave + 8 * r, tr = idx >> 2, tc = idx & 3;
        f32x4 acc = {0.f, 0.f, 0.f, 0.f};
        if (tc <= tr) {
#pragma unroll
            for (int ks = 0; ks < 4; ++ks) {
                const bf16x8 a = *(const LAS bf16x8*)(QS + (16 * tr + fr) * 136 + ks * 32 + fq * 8), b = *(const LAS bf16x8*)(KS + (16 * tc + fr) * 136 + ks * 32 + fq * 8);
                acc = __builtin_amdgcn_mfma_f32_16x16x32_bf16(b, a, acc, 0, 0, 0);
            }
#pragma unroll
            for (int j = 0; j < 4; ++j) if (16 * tc + 4 * fq + j > 16 * tr + fr) acc[j] = 0.f;
        }
        u32x2 w; w.x = cvt_pk_bf16(acc[0], acc[1]); w.y = cvt_pk_bf16(acc[2], acc[3]);
        *(LAS u32x2*)(PS + (16 * tr + fr) * 72 + 16 * tc + 4 * fq) = w;
    }
    __syncthreads();
    bf16x8 bv[2];
#pragma unroll
    for (int ks = 0; ks < 2; ++ks) bv[ks] = *(const LAS bf16x8*)(VT + (16 * wave + fr) * 72 + ks * 32 + fq * 8);
    f32x4 o[4];
#pragma unroll
    for (int tr = 0; tr < 4; ++tr) {
        f32x4 acc = {0.f, 0.f, 0.f, 0.f};
#pragma unroll
        for (int ks = 0; ks < 2; ++ks) { const bf16x8 a = *(const LAS bf16x8*)(PS + (16 * tr + fr) * 72 + ks * 32 + fq * 8); acc = __builtin_amdgcn_mfma_f32_16x16x32_bf16(bv[ks], a, acc, 0, 0, 0); }
#pragma unroll
        for (int ks = 0; ks < 4; ++ks) { const bf16x8 a = *(const LAS bf16x8*)(QS + (16 * tr + fr) * 136 + ks * 32 + fq * 8); acc = __builtin_amdgcn_mfma_f32_16x16x32_bf16(bs[ks], a, acc, 0, 0, 0); }
        o[tr] = acc;
        float ss = (acc[0] * acc[0] + acc[1] * acc[1]) + (acc[2] * acc[2] + acc[3] * acc[3]);
        ss += __shfl_xor(ss, 16); ss += __shfl_xor(ss, 32);
        if (fq == 0) RS[wave * 64 + 16 * tr + fr] = ss;
    }
    __syncthreads();
#pragma unroll
    for (int tr = 0; tr < 4; ++tr) {
        const int tl = 16 * tr + fr; float tt = 0.f;
#pragma unroll
        for (int w = 0; w < 8; ++w) tt += RS[w * 64 + tl];
        const float rinv = rsqrtf(tt * (1.f / 128.f) + EPS);
        const u32x2 sg = sgv[tr];
        u32x2 w;
        w.x = cvt_pk_bf16(o[tr][0] * rinv * gn[0] * bflo(sg.x), o[tr][1] * rinv * gn[1] * bfhi(sg.x));
        w.y = cvt_pk_bf16(o[tr][2] * rinv * gn[2] * bflo(sg.y), o[tr][3] * rinv * gn[3] * bfhi(sg.y));
        *(u32x2*)(M.O + (size_t)(t0 + tl) * DM + ocol) = w;
    }
    __syncthreads();
}

__device__ __forceinline__ void lru_unit(const Mix& M, int unit, int mode, LAS unsigned char* lds) {
    const int tid = threadIdx.x, lane = tid & 63, wave = tid >> 6, fr = lane & 15, fq = lane >> 4;
    const int n = unit & 7, bc = unit >> 3, c = bc & 31, b = bc >> 5, t0 = bc * 64, ch0 = n * 64;
    const int j = tid & 63, seg = tid >> 6, ch = ch0 + j;
    LAS float* XC32 = (LAS float*)lds; LAS bf16_t* XC16 = (LAS bf16_t*)(lds + 16640); LAS float* GR = (LAS float*)(lds + 25856); LAS float* GI = (LAS float*)(lds + 42496);
    LAS float* SEGA = (LAS float*)(lds + 59136); LAS float* SEGU = (LAS float*)(lds + 61184);
    const int tl0 = seg * 8; const bool first = (c == 0 && seg == 0);
    const float* xp = M.XB + (size_t)(t0 + tl0) * DH + ch;
    float xm3 = first ? 0.f : xp[-3 * DH], xm2 = first ? 0.f : xp[-2 * DH], xm1 = first ? 0.f : xp[-1 * DH];
    float xr[8];
#pragma unroll
    for (int i = 0; i < 8; ++i) xr[i] = xp[i * DH];
    const float w0 = M.convw[ch], w1 = M.convw[512 + ch], w2 = M.convw[1024 + ch], w3 = M.convw[1536 + ch], cbias = M.convb[ch];
    const int gate = wave >> 2, tr = wave & 3;
    const bf16_t* WT = (gate ? M.WXT : M.WAT) + n * 4096;
    const float* bias = (gate ? M.bx : M.ba) + ch0;
    bf16x8 wb[4][2]; float bbv[4];
#pragma unroll
    for (int ct = 0; ct < 4; ++ct) { wb[ct][0] = *(const bf16x8*)(WT + (16 * ct + fr) * 64 + fq * 8); wb[ct][1] = *(const bf16x8*)(WT + (16 * ct + fr) * 64 + 32 + fq * 8); bbv[ct] = bias[16 * ct + fr]; }
    const float lamv = M.lam[ch];
    float hin = (mode == 1) ? M.HST[(size_t)bc * 512 + ch] : 0.f;
    unsigned gyv[8];
    if (mode == 1) {
#pragma unroll
        for (int i = 0; i < 8; ++i) gyv[i] = M.GY[(size_t)(t0 + tl0 + i) * DH + ch];
    }
    float cpv = 0.f;
    if (mode == 1 && c == 31 && tid < 192) cpv = M.XB[(size_t)(b * SEQ + SEQ - 3 + (tid >> 6)) * DH + ch0 + j];
    float xcv[8];
#pragma unroll
    for (int i = 0; i < 8; ++i) {
        const float x = xr[i];
        const float xc = cbias + w0 * xm3 + w1 * xm2 + w2 * xm1 + w3 * x;
        xcv[i] = xc; XC16[(tl0 + i) * 72 + j] = f2bf(xc);
        xm3 = xm2; xm2 = xm1; xm1 = x;
    }
    __syncthreads();
    {
        LAS float* Gd = gate ? GI : GR;
        const bf16x8 a0 = *(const LAS bf16x8*)(XC16 + (16 * tr + fr) * 72 + fq * 8), a1 = *(const LAS bf16x8*)(XC16 + (16 * tr + fr) * 72 + 32 + fq * 8);
#pragma unroll
        for (int ct = 0; ct < 4; ++ct) {
            f32x4 acc = {0.f, 0.f, 0.f, 0.f};
            acc = __builtin_amdgcn_mfma_f32_16x16x32_bf16(a0, wb[ct][0], acc, 0, 0, 0);
            acc = __builtin_amdgcn_mfma_f32_16x16x32_bf16(a1, wb[ct][1], acc, 0, 0, 0);
#pragma unroll
            for (int jj = 0; jj < 4; ++jj) Gd[(16 * tr + 4 * fq + jj) * 65 + 16 * ct + fr] = sigm(acc[jj] + bbv[ct]);
        }
    }
    __syncthreads();
    const float sp = log1pf(__expf(-lamv));
    float av[8], uv[8]; float A = 1.f, U = 0.f;
#pragma unroll
    for (int i = 0; i < 8; ++i) {
        const int tl = tl0 + i; const float r = GR[tl * 65 + j], ig = GI[tl * 65 + j];
        const float la = -8.f * r * sp, a = __expf(la); float mult = sqrtf(fmaxf(1.f - a * a, 0.f));
        if (la > -0.05f) mult = sqrtf(-expm1f(2.f * la));
        if (c == 0 && tl == 0) mult = 1.f;
        const float u = mult * ig * xcv[i];
        av[i] = a; uv[i] = u; U = a * U + u; A *= a;
    }
    SEGA[seg * 64 + j] = A; SEGU[seg * 64 + j] = U;
    __syncthreads();
#pragma unroll
    for (int s = 0; s < 8; ++s) if (s < seg) hin = SEGA[s * 64 + j] * hin + SEGU[s * 64 + j];
    if (mode == 0) {
        if (seg == 7) { float At = 1.f;
#pragma unroll
            for (int s = 0; s < 8; ++s) At *= SEGA[s * 64 + j];
            M.ACH[(size_t)bc * 512 + ch] = At; M.UCH[(size_t)bc * 512 + ch] = A * hin + U; }
    } else {
        float hh = hin;
#pragma unroll
        for (int i = 0; i < 8; ++i) {
            hh = av[i] * hh + uv[i];
            M.O[(size_t)(t0 + tl0 + i) * DM + 512 + ch] = f2bf(hh * __uint_as_float(gyv[i] << 16));
        }
        if (c == 31 && seg == 7) M.out[OUT_LP + b * 512 + ch] = hh;
        if (c == 31 && tid < 192) M.out[OUT_CP + (size_t)(b * 3 + (tid >> 6)) * 512 + ch0 + j] = cpv;
    }
    __syncthreads();
}

__device__ __forceinline__ void hgrn_sample_unit(const Mix& M, int unit, LAS unsigned char* lds) {
    const int tid = threadIdx.x, lane = tid & 63, wave = tid >> 6;
    const int h = unit & 3, b = unit >> 2, cb = h * 128, tb = TP + b * 4;
    LAS float* SQ = (LAS float*)lds;
    LAS float* SK = SQ + 512;
    LAS float* SD = SK + 512;
    LAS float* SP = SD + 128;
    LAS float* OP = SP + 32;
    LAS float* RS = OP + 2048;
    if (tid < 128) {
        const int k = tid;
        const float l0 = M.lb[cb + k], l1 = M.lb[512 + cb + k];
        const float lb = 1.f / (1.f + expf(l1 - l0));
        float cum[4], kk[4], qv[4]; float run = 0.f;
#pragma unroll
        for (int s = 0; s < 4; ++s) {
            const float fz = M.FZ[(size_t)(tb + s) * DH + cb + k];
            const float sg = 1.f / (1.f + expf(-fz)), sn = 1.f / (1.f + expf(fz));
            run += logf(lb + (1.f - lb) * sg); cum[s] = run; kk[s] = (1.f - lb) * sn;
            qv[s] = bf2f(M.Q[(size_t)(tb + s) * DH + cb + k]);
        }
#pragma unroll
        for (int s = 0; s < 4; ++s) { SQ[s * 128 + k] = qv[s] * expf(cum[s]); SK[s * 128 + k] = kk[s] * expf(cum[3] - cum[s]); }
        SD[k] = expf(cum[3]);
        float pr[10]; int c = 0;
#pragma unroll
        for (int t = 0; t < 4; ++t)
#pragma unroll
            for (int s = 0; s <= t; ++s) { pr[c] = qv[t] * kk[s] * expf(cum[t] - cum[s]); ++c; }
#pragma unroll
        for (int i = 0; i < 10; ++i) { const float v = wave_sum(pr[i]); if (lane == 0) SP[wave * 16 + i] = v; }
    }
    __syncthreads();
    const int v = tid & 127, kq = tid >> 7;
    float vv[4];
#pragma unroll
    for (int s = 0; s < 4; ++s) vv[s] = bf2f(M.V[(size_t)(tb + s) * DH + cb + v]);
    {
        float o[4] = {0.f, 0.f, 0.f, 0.f};
        const size_t sb = ((size_t)(b * 4 + h) * 128) * 128;
#pragma unroll 8
        for (int kx = 0; kx < 32; ++kx) {
            const int k = kq * 32 + kx;
            const float s0 = M.st_h[sb + (size_t)k * 128 + v];
            float sn = SD[k] * s0;
#pragma unroll
            for (int s = 0; s < 4; ++s) { o[s] += SQ[s * 128 + k] * s0; sn += SK[s * 128 + k] * vv[s]; }
            M.out[OUT_HS + sb + (size_t)k * 128 + v] = sn;
        }
#pragma unroll
        for (int s = 0; s < 4; ++s) OP[(kq * 4 + s) * 128 + v] = o[s];
    }
    __syncthreads();
    {
        const int t = kq;
        float ov = (OP[(0 * 4 + t) * 128 + v] + OP[(1 * 4 + t) * 128 + v]) + (OP[(2 * 4 + t) * 128 + v] + OP[(3 * 4 + t) * 128 + v]);
        const int base = t * (t + 1) / 2;
        for (int s = 0; s <= t; ++s) ov += (SP[base + s] + SP[16 + base + s]) * vv[s];
        const float ssq = wave_sum(ov * ov);
        if (lane == 0) RS[wave] = ssq;
        __syncthreads();
        const float tt = RS[2 * t] + RS[2 * t + 1];
        const float rinv = rsqrtf(tt * (1.f / 128.f) + EPS);
        const size_t tok = (size_t)(tb + t);
        M.O[tok * DM + cb + v] = f2bf(ov * rinv * M.hnorm[cb + v] * bf2f(M.SG[tok * DH + cb + v]));
    }
    __syncthreads();
}

__device__ __forceinline__ void lru_sample_unit(const Mix& M, int b, LAS unsigned char* lds) {
    const int tid = threadIdx.x, ch = tid, n = ch >> 6, j = ch & 63, tb = TP + b * 4;
    LAS float* XC = (LAS float*)lds;
    float x[7];
#pragma unroll
    for (int r = 0; r < 3; ++r) x[r] = M.st_c[(size_t)(b * 3 + r) * 512 + ch];
#pragma unroll
    for (int s = 0; s < 4; ++s) x[3 + s] = M.XB[(size_t)(tb + s) * DH + ch];
    const float w0 = M.convw[ch], w1 = M.convw[512 + ch], w2 = M.convw[1024 + ch], w3 = M.convw[1536 + ch], cbias = M.convb[ch];
    float xc[4];
#pragma unroll
    for (int s = 0; s < 4; ++s) { xc[s] = cbias + w0 * x[s] + w1 * x[s + 1] + w2 * x[s + 2] + w3 * x[s + 3]; XC[s * 512 + ch] = xc[s]; }
#pragma unroll
    for (int r = 0; r < 3; ++r) M.out[OUT_CS + (size_t)(b * 3 + r) * 512 + ch] = x[4 + r];
    __syncthreads();
    float ra[4], rx[4];
    const float ba = M.ba[ch], bx = M.bx[ch];
#pragma unroll
    for (int s = 0; s < 4; ++s) { ra[s] = ba; rx[s] = bx; }
    const float* wa = M.wa + (size_t)n * 4096 + j; const float* wx = M.wx + (size_t)n * 4096 + j;
#pragma unroll 4
    for (int i = 0; i < 64; ++i) {
        const float a = wa[i * 64], xw = wx[i * 64];
#pragma unroll
        for (int s = 0; s < 4; ++s) { const float xv = XC[s * 512 + n * 64 + i]; ra[s] += xv * a; rx[s] += xv * xw; }
    }
    const float sp = log1pf(expf(-M.lam[ch]));
    float hh = M.st_l[(size_t)b * 512 + ch];
#pragma unroll
    for (int s = 0; s < 4; ++s) {
        const float r = 1.f / (1.f + expf(-ra[s])), ig = 1.f / (1.f + expf(-rx[s]));
        const float la = -8.f * r * sp, a = expf(la), mult = sqrtf(-expm1f(2.f * la));
        hh = a * hh + mult * ig * xc[s];
        M.O[(size_t)(tb + s) * DM + 512 + ch] = f2bf(hh * bf2f(M.GY[(size_t)(tb + s) * DH + ch]));
    }
    M.out[OUT_LS + (size_t)b * 512 + ch] = hh;
    __syncthreads();
}

__device__ __forceinline__ void scan_item(const Mix& M, int item) {
    const int tid = threadIdx.x;
    if (item < 1024) {
        const int e = item * 512 + tid, bh = e >> 14, vk = e & 16383, b = bh >> 2, h = bh & 3, v = vk >> 7, k = vk & 127;
        float l[32], d[32];
#pragma unroll
        for (int c = 0; c < 32; ++c) { const int unit = (b * 32 + c) * 4 + h; l[c] = bf2f(M.LT[(size_t)unit * 16384 + vk]); d[c] = M.DC[unit * 128 + k]; }
        float S = 0.f;
#pragma unroll
        for (int c = 0; c < 32; ++c) { const int unit = (b * 32 + c) * 4 + h; M.LT[(size_t)unit * 16384 + vk] = f2bf(S); S = d[c] * S + l[c]; }
        M.out[OUT_HP + ((size_t)(b * 4 + h) * 128 + k) * 128 + v] = S;
    } else {
        const int e = (item - 1024) * 512 + tid, b = e >> 9, ch = e & 511;
        float hcar = 0.f;
        for (int c = 0; c < 32; ++c) { const size_t idx = (size_t)(b * 32 + c) * 512 + ch; M.HST[idx] = hcar; hcar = M.ACH[idx] * hcar + M.UCH[idx]; }
    }
}

__global__ void __launch_bounds__(512, 2) mk_fwd(Params p) {
    extern __shared__ __attribute__((aligned(16))) unsigned char lds_raw[];
    LAS unsigned char* lds = (LAS unsigned char*)lds_raw;
    const int lo = p.ph_lo, hi = p.ph_hi, G = gridDim.x;
    unsigned char* ws = p.ws;
#define IN(k) (lo <= (k) && (k) < hi)
    volatile LAS unsigned* xst = (volatile LAS unsigned*)(lds + 131072);
    if (threadIdx.x < 16) xst[threadIdx.x] = 0u;
    __syncthreads();
    XcdBarrier xbar; xbar.bar = (unsigned*)(ws + WS_BAR); xbar.x = 0; xbar.st = xst;
    if (hi - lo > 1) xbar = xcd_barrier_post((unsigned*)(ws + WS_BAR), xst);
    if (hi == 0x7fffffff) cg::this_grid().sync();
#define SEAM(k) do { if (IN(k) && IN((k) + 1)) { xcd_barrier(xbar); } } while (0)
    bf16_t* B0 = (bf16_t*)(ws + WS_B0); bf16_t* B1 = (bf16_t*)(ws + WS_B1); bf16_t* H = (bf16_t*)(ws + WS_H);
    float* SS0 = (float*)(ws + WS_SS0); float* SS1 = (float*)(ws + WS_SS1); float* SS2 = (float*)(ws + WS_SS2); float* SS3 = (float*)(ws + WS_SS3);

    if (IN(0)) { phase0(p, lds); __syncthreads(); }
    SEAM(0);
    if (IN(1)) {
        pg8::Gemm g{B0, (const bf16_t*)(ws + WS_WG1), T_ALL, 2 * DFF, DM}; pg8::StaticOrder S; S.init(T_ALL, 2 * DFF, G, (int)blockIdx.x);
        EpiGateUp E{H, SS0};
        pg8::gemm_phase<EpiGateUp, pg8::StaticOrder, PG8_ALIGN, PG8_SP2>(lds, g, S, E);
    }
    SEAM(1);
    if (IN(2)) {
        pg8::Gemm g{H, (const bf16_t*)(ws + WS_WD1), TP, DM, DFF}; pg8::StaticOrder S; S.init(TP, DM, G, (int)blockIdx.x);
        EpiResid E{p.in[0], p.in[1], p.out, B0, p.in[9], SS1, 0.5f};
        pg8::gemm_phase<EpiResid, pg8::StaticOrder, PG8_ALIGN, PG8_SP2>(lds, g, S, E);
        SmallResid Es{p.in[1] - (size_t)TP * DM, p.out, B0, p.in[9], SS1, 0.5f};
        small_gemm<SmallResid>(H, (const bf16_t*)(ws + WS_WD1), DM, DFF, Es, lds);
    }
    SEAM(2);
    if (IN(3)) {
        pg8::Gemm g{B0, (const bf16_t*)(ws + WS_WIN), TP, DIN, DM}; pg8::StaticOrder S; S.init(TP, DIN, G, (int)blockIdx.x);
        EpiProj E{(bf16_t*)(ws + WS_Q), (bf16_t*)(ws + WS_V), (bf16_t*)(ws + WS_SG), (bf16_t*)(ws + WS_GY), (float*)(ws + WS_FZ), (float*)(ws + WS_XB), SS1};
        pg8::gemm_phase<EpiProj, pg8::StaticOrder, PG8_ALIGN, PG8_SP2>(lds, g, S, E);
        SmallProj Es{(bf16_t*)(ws + WS_Q), (bf16_t*)(ws + WS_V), (bf16_t*)(ws + WS_SG), (bf16_t*)(ws + WS_GY), (float*)(ws + WS_FZ), (float*)(ws + WS_XB), SS1};
        small_gemm<SmallProj>(B0, (const bf16_t*)(ws + WS_WIN), DIN, DM, Es, lds);
    }
    SEAM(3);
    Mix M;
    M.Q = (const bf16_t*)(ws + WS_Q); M.V = (const bf16_t*)(ws + WS_V); M.SG = (const bf16_t*)(ws + WS_SG); M.GY = (const bf16_t*)(ws + WS_GY);
    M.FZ = (const float*)(ws + WS_FZ); M.XB = (const float*)(ws + WS_XB); M.LT = (bf16_t*)(ws + WS_LT); M.DC = (float*)(ws + WS_DC);
    M.ACH = (float*)(ws + WS_ACH); M.UCH = (float*)(ws + WS_UCH); M.HST = (float*)(ws + WS_HST); M.O = B0;
    M.WAT = (const bf16_t*)(ws + WS_WAT); M.WXT = (const bf16_t*)(ws + WS_WXT);
    M.lb = p.in[11]; M.hnorm = p.in[12]; M.convw = p.in[13]; M.convb = p.in[14]; M.wa = p.in[15]; M.ba = p.in[16]; M.wx = p.in[17]; M.bx = p.in[18]; M.lam = p.in[19];
    M.st_h = p.in[2]; M.st_l = p.in[3]; M.st_c = p.in[4]; M.out = p.out;
    if (IN(4)) {
        for (int u = blockIdx.x; u < 3712; u += G) {
            if (u < 512) hgrn_sample_unit(M, u, lds);
            else if (u < 1536) hgrn_local_unit(M, u - 512, lds);
            else if (u < 3584) lru_unit(M, u - 1536, 0, lds);
            else lru_sample_unit(M, u - 3584, lds);
        }
    }
    SEAM(4);
    if (IN(5)) { for (int it = blockIdx.x; it < 1032; it += G) scan_item(M, it); }
    SEAM(5);
    if (IN(6)) {
        for (int u = blockIdx.x; u < 3072; u += G) {
            if (u < 1024) hgrn_out_unit(M, u, lds);
            else lru_unit(M, u - 1024, 1, lds);
        }
    }
    SEAM(6);
    if (IN(7)) {
        pg8::Gemm g{B0, (const bf16_t*)(ws + WS_WO), TP, DM, DM}; pg8::StaticOrder S; S.init(TP, DM, G, (int)blockIdx.x);
        EpiResid E{p.out, p.out + (size_t)TP * DM, p.out, B1, p.in[21], SS2, 1.0f};
        pg8::gemm_phase<EpiResid, pg8::StaticOrder, PG8_ALIGN, PG8_SP2>(lds, g, S, E);
        SmallResid Es{p.out, p.out, B1, p.in[21], SS2, 1.0f};
        small_gemm<SmallResid>(B0, (const bf16_t*)(ws + WS_WO), DM, DM, Es, lds);
    }
    SEAM(7);
    if (IN(8)) {
        pg8::Gemm g{B1, (const bf16_t*)(ws + WS_WG2), T_ALL, 2 * DFF, DM}; pg8::StaticOrder S; S.init(T_ALL, 2 * DFF, G, (int)blockIdx.x);
        EpiGateUp E{H, SS2};
        pg8::gemm_phase<EpiGateUp, pg8::StaticOrder, PG8_ALIGN, PG8_SP2>(lds, g, S, E);
    }
    SEAM(8);
    if (IN(9)) {
        pg8::Gemm g{H, (const bf16_t*)(ws + WS_WD2), TP, DM, DFF}; pg8::StaticOrder S; S.init(TP, DM, G, (int)blockIdx.x);
        EpiResid E{p.out, p.out + (size_t)TP * DM, p.out, nullptr, nullptr, SS3, 0.5f};
        pg8::gemm_phase<EpiResid, pg8::StaticOrder, PG8_ALIGN, PG8_SP2>(lds, g, S, E);
        SmallResid Es{p.out, p.out, nullptr, nullptr, SS3, 0.5f};
        small_gemm<SmallResid>(H, (const bf16_t*)(ws + WS_WD2), DM, DFF, Es, lds);
    }
    SEAM(9);
    if (IN(10)) phase_final(p);
#undef IN
#undef SEAM
}

extern "C" void kernel_launch(void* const* d_in, const int* in_sizes, int n_in, void* d_out, int out_size, void* d_ws, size_t ws_size, hipStream_t stream) {
    static int grid = 0;
    if (grid == 0) {
        if (n_in != 26 || ws_size < WS_END2) { fprintf(stderr, "kernel_launch: unexpected n_in %d or ws_size %zu (need %zu)\n", n_in, ws_size, (size_t)WS_END2); grid = -1; return; }
        int dev = 0, cus = 0, per_cu = 0;
        hipGetDevice(&dev); hipDeviceGetAttribute(&cus, hipDeviceAttributeMultiprocessorCount, dev);
        if (hipFuncSetAttribute((const void*)mk_fwd, hipFuncAttributeMaxDynamicSharedMemorySize, LDS_BYTES) != hipSuccess) { fprintf(stderr, "kernel_launch: hipFuncSetAttribute failed\n"); grid = -1; return; }
        if (hipOccupancyMaxActiveBlocksPerMultiprocessor(&per_cu, (const void*)mk_fwd, 512, LDS_BYTES) != hipSuccess || per_cu < 1) { fprintf(stderr, "kernel_launch: occupancy query says %d\n", per_cu); per_cu = 1; }
        (void)hipGetLastError();
        grid = cus;
    }
    if (grid < 0) return;
    Params p{};
    for (int i = 0; i < 26; ++i) p.in[i] = (const float*)d_in[i];
    p.out = (float*)d_out; p.ws = (unsigned char*)d_ws;
#if MK_PER_PHASE
    for (int ph = 0; ph < MK_NPH; ++ph) { p.ph_lo = ph; p.ph_hi = ph + 1; hipLaunchKernelGGL(mk_fwd, dim3(grid), dim3(512), LDS_BYTES, stream, p); if ((MK_DUP >> ph) & 1) hipLaunchKernelGGL(mk_fwd, dim3(grid), dim3(512), LDS_BYTES, stream, p); }
#else
    p.ph_lo = 0; p.ph_hi = MK_NPH;
    if (hipMemsetAsync((char*)d_ws + WS_BAR, 0, 16384, stream) != hipSuccess) { fprintf(stderr, "memset failed\n"); return; }
    void* args[] = {&p};
    hipError_t e = hipLaunchCooperativeKernel((const void*)mk_fwd, dim3(grid), dim3(512), args, LDS_BYTES, stream);
    if (e != hipSuccess) fprintf(stderr, "cooperative launch failed: %s (grid %d)\n", hipGetErrorString(e), grid);
#endif
}
```

```cpp
#include <hip/hip_runtime.h>
#include <hip/hip_cooperative_groups.h>
#include <cstdio>
#include <cstdint>
namespace cg = cooperative_groups;

#ifndef MK_DUP
#define MK_DUP 0
#endif
#ifndef MK_NPH
#define MK_NPH 11
#endif
#ifndef MK_PER_PHASE
#define MK_PER_PHASE 0
#endif

#define LAS __attribute__((address_space(3)))
typedef unsigned short bf16_t;
typedef short bf16x8 __attribute__((ext_vector_type(8)));
typedef float f32x4 __attribute__((ext_vector_type(4)));
typedef unsigned u32x4 __attribute__((ext_vector_type(4)));
typedef unsigned u32x2 __attribute__((ext_vector_type(2)));

constexpr int T_ALL = 16896, TP = 16384, DM = 1024, DFF = 2816, DIN = 3072, DH = 512;
constexpr int SEQ = 2048, NB = 8, NCH = 32, DECB = 128;
constexpr float EPS = 1e-6f;

constexpr size_t OUT_Y = 0, OUT_HP = 17301504, OUT_LP = 17825792, OUT_CP = 17829888, OUT_HS = 17842176, OUT_LS = 26230784, OUT_CS = 26296320;

constexpr size_t WS_WG1 = 0;
constexpr size_t WS_WD1 = WS_WG1 + (size_t)5632 * 1024 * 2;
constexpr size_t WS_WIN = WS_WD1 + (size_t)1024 * 2816 * 2;
constexpr size_t WS_WO  = WS_WIN + (size_t)3072 * 1024 * 2;
constexpr size_t WS_WG2 = WS_WO + (size_t)1024 * 1024 * 2;
constexpr size_t WS_WD2 = WS_WG2 + (size_t)5632 * 1024 * 2;
constexpr size_t WS_WAT = WS_WD2 + (size_t)1024 * 2816 * 2;
constexpr size_t WS_WXT = WS_WAT + 65536;
constexpr size_t WS_SS0 = WS_WXT + 65536;
constexpr size_t SS_BYTES = (size_t)T_ALL * 16 * 4;
constexpr size_t WS_SS1 = WS_SS0 + SS_BYTES, WS_SS2 = WS_SS1 + SS_BYTES, WS_SS3 = WS_SS2 + SS_BYTES;
constexpr size_t WS_DC  = WS_SS3 + SS_BYTES;
constexpr size_t WS_ACH = WS_DC + (size_t)1024 * 128 * 4;
constexpr size_t WS_UCH = WS_ACH + (size_t)NB * NCH * 512 * 4;
constexpr size_t WS_HST = WS_UCH + (size_t)NB * NCH * 512 * 4;
constexpr size_t WS_B0  = WS_HST + (size_t)NB * NCH * 512 * 4;
constexpr size_t WS_R   = WS_B0 + (size_t)T_ALL * 1024 * 2;
constexpr size_t WS_H   = WS_R;
constexpr size_t WS_B1  = WS_H + (size_t)T_ALL * 2816 * 2;
constexpr size_t WS_Q   = WS_R;
constexpr size_t WS_V   = WS_Q + (size_t)T_ALL * 512 * 2;
constexpr size_t WS_SG  = WS_V + (size_t)T_ALL * 512 * 2;
constexpr size_t WS_GY  = WS_SG + (size_t)T_ALL * 512 * 2;
constexpr size_t WS_FZ  = WS_GY + (size_t)T_ALL * 512 * 2;
constexpr size_t WS_XB  = WS_FZ + (size_t)T_ALL * 512 * 4;
constexpr size_t WS_LT  = WS_XB + (size_t)T_ALL * 512 * 4;
constexpr size_t WS_END = WS_LT + (size_t)1024 * 16384 * 2;
constexpr size_t WS_BAR = WS_END;
constexpr size_t WS_END2 = WS_BAR + 16384;
static_assert(WS_END2 <= 268435456, "workspace budget");
static_assert(WS_B1 + (size_t)T_ALL * 1024 * 2 <= WS_END, "B1 inside R");

constexpr int LDS_BYTES = 131072 + 64;

typedef __bf16 nbf16x2 __attribute__((ext_vector_type(2)));
typedef float f32x2 __attribute__((ext_vector_type(2)));
__device__ __forceinline__ unsigned cvt_pk_bf16(float lo, float hi) { const nbf16x2 r = __builtin_convertvector((f32x2){lo, hi}, nbf16x2); return __builtin_bit_cast(unsigned, r); }
__device__ __forceinline__ bf16_t f2bf(float f) { return (bf16_t)(cvt_pk_bf16(f, 0.f) & 0xffffu); }
__device__ __forceinline__ float bf2f(bf16_t b) { return __uint_as_float(((unsigned)b) << 16); }
__device__ __forceinline__ float bflo(unsigned w) { return __uint_as_float(w << 16); }
__device__ __forceinline__ float bfhi(unsigned w) { return __uint_as_float(w & 0xffff0000u); }
__device__ __forceinline__ float sigm(float x) { return __builtin_amdgcn_rcpf(1.f + __expf(-x)); }
__device__ __forceinline__ float rowscale(const float* ss, int row) {
    const f32x4* p = (const f32x4*)(ss + (size_t)row * 16);
    const f32x4 a = p[0], b = p[1], c = p[2], d = p[3];
    const float s = (((a.x + a.y) + (a.z + a.w)) + ((b.x + b.y) + (b.z + b.w))) + (((c.x + c.y) + (c.z + c.w)) + ((d.x + d.y) + (d.z + d.w)));
    return rsqrtf(s * (1.f / 1024.f) + EPS);
}
__device__ __forceinline__ float wave_sum(float v) {
#pragma unroll
    for (int o = 1; o < 64; o <<= 1) v += __shfl_xor(v, o);
    return v;
}
#define LDS_WAIT() asm volatile("s_waitcnt lgkmcnt(0)" ::: "memory")

namespace pg8 {
constexpr int BM = 256, BK = 64, HALF = 128, HTB = HALF * BK * 2, STAGE_BYTES = 8 * HTB, NXCD = 8, WGM = 8;
__host__ __device__ __forceinline__ int lds_byte(int r, int c) { const int st = (r >> 4) * 2 + (c >> 5), rr = r & 15, cc = c & 31, ob = rr * 64 + cc * 2; return st * 1024 + (ob ^ (((ob >> 9) & 1) << 5)); }
__host__ __device__ __forceinline__ void stage_rc(int b, int& R, int& C) { const int st = b / 1024, sb = b % 1024, swz = sb ^ (((sb >> 9) & 1) << 5); R = (st >> 1) * 16 + swz / 64; C = (st & 1) * 32 + (swz % 64) / 2; }
__host__ __device__ __forceinline__ int perm32(int rho) { const int n = rho >> 4, i = rho & 15; return 8 * (i >> 2) + 4 * n + (i & 3); }
struct Unit { int pm, pn; };
struct Gemm { const bf16_t* A; const bf16_t* Bt; int M, N, K; };
struct StaticOrder {
    int nM, nN, nwg, G, c;
    __host__ __device__ void init(int M, int N, int G_, int c_) { nM = M / BM; nN = N / BM; nwg = nM * nN; G = G_; c = c_; }
    __host__ __device__ bool next(int i, Unit& u) const {
        const long L = (long)i * G + c; if (L >= nwg) return false;
        int wgid = (int)L; { const int q = nwg / NXCD, r = nwg % NXCD, xcd = wgid % NXCD, off = wgid / NXCD; wgid = (xcd < r ? xcd * (q + 1) : r * (q + 1) + (xcd - r) * q) + off; }
        const int nig = WGM * nN, gid = wgid / nig, fm = gid * WGM, gsz = (nM - fm) < WGM ? (nM - fm) : WGM;
        u.pm = fm + ((wgid % nig) % gsz); u.pn = (wgid % nig) / gsz; return true;
    }
    __device__ __forceinline__ void a_ready(const Unit&) const {}
    __device__ __forceinline__ void done(const Unit&) const {}
};

template <class Epi, class Sched, bool ALIGN_EPI = false, bool SP2 = false>
__device__ __forceinline__ void gemm_phase(LAS unsigned char* lds, const Gemm g, const Sched& S, const Epi& E) {
    const int tid = threadIdx.x, wid = __builtin_amdgcn_readfirstlane(tid >> 6), lane = tid & 63, wr = wid >> 2, wc = wid & 3, fr = lane & 15, fq = lane >> 4;
    const int K = g.K, nt = K / BK;
    unsigned voffA[2], voffB[2];
#pragma unroll
    for (int i = 0; i < 2; ++i) { int R, C; stage_rc(tid * 16 + i * 8192, R, C); const int Rb = Epi::PERM ? ((R & ~31) + perm32(R & 31)) : R;
        voffA[i] = (unsigned)(R * K + C) * 2u; voffB[i] = (unsigned)(Rb * K + C) * 2u; }
    const size_t kstep = (size_t)(BK * 2);
    const size_t hstep = (size_t)HALF * K * 2;
    const size_t tstep = 2 * hstep;
    const unsigned ldsw = (unsigned)wid * 1024u;
    const int aoff = lds_byte(wr * 64 + fr, fq * 8), boff = lds_byte(wc * 32 + fr, fq * 8);
#define PG8_SA(b, h) (((b) * 2 + (h)) * HTB)
#define PG8_SB(b, h) ((4 + (b) * 2 + (h)) * HTB)
#define PG8_STAGE(bufoff, gbase, voff) do { _Pragma("unroll") for (int _i = 0; _i < 2; ++_i) \
        __builtin_amdgcn_global_load_lds((const unsigned*)((const char*)(gbase) + (voff)[_i]), (LAS unsigned*)(lds + (bufoff) + ldsw + _i * 8192), 16, 0, 0); } while (0)
#define PG8_LDA(dst, b, h) do { _Pragma("unroll") for (int m = 0; m < 4; ++m) _Pragma("unroll") for (int k = 0; k < 2; ++k) dst[m][k] = *(const LAS bf16x8*)(lds + PG8_SA(b, h) + aoff + m * 2048 + k * 1024); } while (0)
#define PG8_LDB(dst, b, h) do { _Pragma("unroll") for (int n = 0; n < 2; ++n) _Pragma("unroll") for (int k = 0; k < 2; ++k) dst[n][k] = *(const LAS bf16x8*)(lds + PG8_SB(b, h) + boff + n * 2048 + k * 1024); } while (0)
#define PG8_MMA(ai, bj, At, Bt) do { __builtin_amdgcn_s_setprio(1); _Pragma("unroll") for (int m = 0; m < 4; ++m) _Pragma("unroll") for (int n = 0; n < 2; ++n) _Pragma("unroll") for (int k = 0; k < 2; ++k) \
        acc[ai][bj][m][n] = __builtin_amdgcn_mfma_f32_16x16x32_bf16(Bt[n][k], At[m][k], acc[ai][bj][m][n], 0, 0, 0); __builtin_amdgcn_s_setprio(0); } while (0)
#define PG8_WAIT_V(n) asm volatile("s_waitcnt vmcnt(" #n ")" ::: "memory")
#define PG8_WAIT_L(n) asm volatile("s_waitcnt lgkmcnt(" #n ")" ::: "memory")
#define PG8_BAR __builtin_amdgcn_s_barrier()
#define PG8_SCHED __builtin_amdgcn_sched_barrier(0)
    Unit cur, nxt; int ui = 0;
    if (!S.next(0, cur)) return;
    f32x4 acc[2][2][4][2];
#pragma unroll
    for (int a = 0; a < 2; ++a)
#pragma unroll
        for (int b = 0; b < 2; ++b)
#pragma unroll
            for (int m = 0; m < 4; ++m)
#pragma unroll
                for (int n = 0; n < 2; ++n) acc[a][b][m][n] = (f32x4){0.f, 0.f, 0.f, 0.f};
    bf16x8 At[4][2], B0[2][2], B1[2][2];
    const char* cA = (const char*)g.A + (size_t)cur.pm * tstep; const char* cB = (const char*)g.Bt + (size_t)cur.pn * tstep;
    S.a_ready(cur);
    if constexpr (SP2) {
        PG8_STAGE(PG8_SB(0, 0), cB, voffB); PG8_STAGE(PG8_SB(0, 1), cB + hstep, voffB); PG8_STAGE(PG8_SA(0, 0), cA, voffA); PG8_STAGE(PG8_SA(0, 1), cA + hstep, voffA);
        if (wr == 1) PG8_BAR;
        PG8_WAIT_V(2); PG8_BAR;
        PG8_STAGE(PG8_SB(1, 0), cB + kstep, voffB); PG8_STAGE(PG8_SA(1, 0), cA + kstep, voffA); PG8_STAGE(PG8_SB(1, 1), cB + hstep + kstep, voffB);
        PG8_WAIT_V(6); PG8_BAR;
    } else {
        PG8_STAGE(PG8_SB(0, 0), cB, voffB); PG8_STAGE(PG8_SA(0, 0), cA, voffA); PG8_STAGE(PG8_SB(0, 1), cB + hstep, voffB); PG8_STAGE(PG8_SA(0, 1), cA + hstep, voffA);
        if (wr == 1) PG8_BAR;
        PG8_WAIT_V(4); PG8_BAR;
        PG8_STAGE(PG8_SB(1, 0), cB + kstep, voffB); PG8_STAGE(PG8_SA(1, 0), cA + kstep, voffA); PG8_STAGE(PG8_SB(1, 1), cB + hstep + kstep, voffB);
        PG8_WAIT_V(6); PG8_BAR;
    }
    for (;;) {
        const bool has_next = S.next(ui + 1, nxt);
        const char* nA = has_next ? (const char*)g.A + (size_t)nxt.pm * tstep : cA; const char* nB = has_next ? (const char*)g.Bt + (size_t)nxt.pn * tstep : cB;
        for (int t = 0; t < nt; t += 2) {
            const bool last = (t == nt - 2);
            const char* a1 = cA + (size_t)(t + 1) * kstep;
            const char* a2 = last ? nA : cA + (size_t)(t + 2) * kstep; const char* b2 = last ? nB : cB + (size_t)(t + 2) * kstep;
            const char* a3 = a2 + kstep; const char* b3 = b2 + kstep;
            if (last && has_next) S.a_ready(nxt);
            if constexpr (SP2) {
            PG8_LDB(B0, 0, 0); PG8_LDB(B1, 0, 1); PG8_SCHED; PG8_LDA(At, 0, 0); PG8_STAGE(PG8_SA(1, 1), a1 + hstep, voffA);
            PG8_WAIT_V(8); PG8_WAIT_L(0); PG8_BAR; PG8_MMA(0, 0, At, B0); PG8_MMA(0, 1, At, B1); PG8_BAR; PG8_SCHED;
            PG8_LDA(At, 0, 1); PG8_STAGE(PG8_SB(0, 0), b2, voffB); PG8_STAGE(PG8_SB(0, 1), b2 + hstep, voffB); PG8_STAGE(PG8_SA(0, 0), a2, voffA);
            PG8_WAIT_V(8); PG8_WAIT_L(0); PG8_BAR; PG8_MMA(1, 0, At, B0); PG8_MMA(1, 1, At, B1); PG8_BAR; PG8_SCHED;
            PG8_LDB(B0, 1, 0); PG8_LDB(B1, 1, 1); PG8_SCHED; PG8_LDA(At, 1, 0); PG8_STAGE(PG8_SA(0, 1), a2 + hstep, voffA);
            PG8_WAIT_V(8); PG8_WAIT_L(0); PG8_BAR; PG8_MMA(0, 0, At, B0); PG8_MMA(0, 1, At, B1); PG8_BAR; PG8_SCHED;
            PG8_LDA(At, 1, 1); PG8_STAGE(PG8_SB(1, 0), b3, voffB); PG8_STAGE(PG8_SB(1, 1), b3 + hstep, voffB); PG8_STAGE(PG8_SA(1, 0), a3, voffA);
            PG8_WAIT_V(8); PG8_WAIT_L(0); PG8_BAR; PG8_MMA(1, 0, At, B0); PG8_MMA(1, 1, At, B1); PG8_BAR; PG8_SCHED;
            } else {
            PG8_LDB(B0, 0, 0); PG8_SCHED; PG8_LDA(At, 0, 0); PG8_STAGE(PG8_SA(1, 1), a1 + hstep, voffA);
            PG8_WAIT_L(8); PG8_BAR; PG8_WAIT_L(0); PG8_MMA(0, 0, At, B0); PG8_BAR; PG8_SCHED;
            PG8_LDB(B1, 0, 1); PG8_STAGE(PG8_SB(0, 0), b2, voffB);
            PG8_BAR; PG8_WAIT_L(0); PG8_MMA(0, 1, At, B1); PG8_BAR;
            PG8_LDA(At, 0, 1); PG8_STAGE(PG8_SA(0, 0), a2, voffA);
            PG8_BAR; PG8_WAIT_L(0); PG8_MMA(1, 0, At, B0); PG8_BAR; PG8_SCHED;
            PG8_STAGE(PG8_SB(0, 1), b2 + hstep, voffB);
            PG8_WAIT_V(6); PG8_BAR; PG8_MMA(1, 1, At, B1); PG8_BAR;
            PG8_LDB(B0, 1, 0); PG8_SCHED; PG8_LDA(At, 1, 0); PG8_STAGE(PG8_SA(0, 1), a2 + hstep, voffA);
            PG8_WAIT_L(8); PG8_BAR; PG8_WAIT_L(0); PG8_MMA(0, 0, At, B0); PG8_BAR; PG8_SCHED;
            PG8_LDB(B1, 1, 1); PG8_STAGE(PG8_SB(1, 0), b3, voffB);
            PG8_BAR; PG8_WAIT_L(0); PG8_MMA(0, 1, At, B1); PG8_BAR;
            PG8_LDA(At, 1, 1); PG8_STAGE(PG8_SA(1, 0), a3, voffA);
            PG8_BAR; PG8_WAIT_L(0); PG8_MMA(1, 0, At, B0); PG8_BAR; PG8_SCHED;
            PG8_STAGE(PG8_SB(1, 1), b3 + hstep, voffB);
            PG8_WAIT_V(6); PG8_BAR; PG8_MMA(1, 1, At, B1); PG8_BAR;
            }
        }
        if constexpr (ALIGN_EPI) { if (wr == 0) PG8_BAR; }
        E(acc, cur, wr, wc, fr, fq); S.done(cur);
        if (!has_next) break;
#pragma unroll
        for (int a = 0; a < 2; ++a)
#pragma unroll
            for (int b = 0; b < 2; ++b)
#pragma unroll
                for (int m = 0; m < 4; ++m)
#pragma unroll
                    for (int n = 0; n < 2; ++n) acc[a][b][m][n] = (f32x4){0.f, 0.f, 0.f, 0.f};
        cur = nxt; cA = nA; cB = nB; ++ui;
        if constexpr (ALIGN_EPI) { if (wr == 1) PG8_BAR; }
    }
    PG8_WAIT_V(0);
    if constexpr (!ALIGN_EPI) { if (wr == 0) PG8_BAR; }
    PG8_BAR;
#undef PG8_SA
#undef PG8_SB
#undef PG8_STAGE
#undef PG8_LDA
#undef PG8_LDB
#undef PG8_MMA
#undef PG8_WAIT_V
#undef PG8_WAIT_L
#undef PG8_BAR
#undef PG8_SCHED
}
}

#ifndef PG8_SP2
#define PG8_SP2 true
#endif
#ifndef PG8_ALIGN
#define PG8_ALIGN true
#endif

struct EpiGateUp {
    static constexpr bool PERM = true;
    bf16_t* H; const float* ss;
    __device__ __forceinline__ void operator()(const f32x4 (&acc)[2][2][4][2], const pg8::Unit& u, int wr, int wc, int fr, int fq) const {
        const int row0 = u.pm * 256 + wr * 64 + fr, col0 = u.pn * 128 + wc * 32 + 8 * fq;
#pragma unroll
        for (int ai = 0; ai < 2; ++ai)
#pragma unroll
            for (int m = 0; m < 4; ++m) {
                const int row = row0 + ai * 128 + m * 16; const float rs = rowscale(ss, row);
                float h[8];
#pragma unroll
                for (int n = 0; n < 2; ++n)
#pragma unroll
                    for (int j = 0; j < 4; ++j) { const float g = acc[ai][0][m][n][j] * rs, up = acc[ai][1][m][n][j] * rs; h[n * 4 + j] = g * sigm(g) * up; }
                u32x4 w; w.x = cvt_pk_bf16(h[0], h[1]); w.y = cvt_pk_bf16(h[2], h[3]); w.z = cvt_pk_bf16(h[4], h[5]); w.w = cvt_pk_bf16(h[6], h[7]);
                *(u32x4*)(H + (size_t)row * DFF + col0) = w;
            }
    }
};
struct EpiResid {
    static constexpr bool PERM = true;
    const float* xin_p; const float* xin_s; float* xout; bf16_t* ax; const float* gnext; float* ssout; float scale;
    __device__ __forceinline__ void operator()(const f32x4 (&acc)[2][2][4][2], const pg8::Unit& u, int wr, int wc, int fr, int fq) const {
        const int row0 = u.pm * 256 + wr * 64 + fr, col0 = u.pn * 256 + wc * 32 + 8 * fq;
        const float* xb = (u.pm < 64) ? xin_p : (xin_s - (size_t)TP * DM);
        f32x4 gn[2][2];
#pragma unroll
        for (int bj = 0; bj < 2; ++bj)
#pragma unroll
            for (int n = 0; n < 2; ++n) gn[bj][n] = ax ? *(const f32x4*)(gnext + col0 + bj * 128 + 4 * n) : (f32x4){1.f, 1.f, 1.f, 1.f};
#pragma unroll
        for (int ai = 0; ai < 2; ++ai)
#pragma unroll
            for (int m = 0; m < 4; ++m) {
                const int row = row0 + ai * 128 + m * 16; const size_t off = (size_t)row * DM + col0; float sq = 0.f;
#pragma unroll
                for (int bj = 0; bj < 2; ++bj) {
                    const f32x4 x0 = *(const f32x4*)(xb + off + bj * 128), x1 = *(const f32x4*)(xb + off + bj * 128 + 4);
                    const f32x4 v0 = x0 + acc[ai][bj][m][0] * scale, v1 = x1 + acc[ai][bj][m][1] * scale;
                    *(f32x4*)(xout + off + bj * 128) = v0; *(f32x4*)(xout + off + bj * 128 + 4) = v1;
                    sq += ((v0[0] * v0[0] + v0[1] * v0[1]) + (v0[2] * v0[2] + v0[3] * v0[3])) + ((v1[0] * v1[0] + v1[1] * v1[1]) + (v1[2] * v1[2] + v1[3] * v1[3]));
                    if (ax) { const f32x4 a0 = v0 * gn[bj][0], a1 = v1 * gn[bj][1];
                        u32x4 w; w.x = cvt_pk_bf16(a0[0], a0[1]); w.y = cvt_pk_bf16(a0[2], a0[3]); w.z = cvt_pk_bf16(a1[0], a1[1]); w.w = cvt_pk_bf16(a1[2], a1[3]);
                        *(u32x4*)(ax + off + bj * 128) = w; }
                }
                sq += __shfl_xor(sq, 16); sq += __shfl_xor(sq, 32);
                if (fq == 0) ssout[(size_t)row * 16 + u.pn * 4 + wc] = sq;
            }
    }
};
struct EpiProj {
    static constexpr bool PERM = true;
    bf16_t *Q, *V, *SG, *GY; float *FZ, *XB; const float* ss;
    __device__ __forceinline__ void operator()(const f32x4 (&acc)[2][2][4][2], const pg8::Unit& u, int wr, int wc, int fr, int fq) const {
        const int seg = u.pn >> 1;
        const int row0 = u.pm * 256 + wr * 64 + fr, col0 = (u.pn & 1) * 256 + wc * 32 + 8 * fq;
        float* fdst = (seg == 1) ? FZ : XB;
        bf16_t* bdst = (seg == 0) ? Q : (seg == 2) ? V : (seg == 3) ? SG : GY;
        const bool isf = (seg == 1) || (seg == 4);
#pragma unroll
        for (int ai = 0; ai < 2; ++ai)
#pragma unroll
            for (int m = 0; m < 4; ++m) {
                const int row = row0 + ai * 128 + m * 16; const float rs = rowscale(ss, row); const size_t off = (size_t)row * DH + col0;
#pragma unroll
                for (int bj = 0; bj < 2; ++bj) {
                    f32x4 v0 = acc[ai][bj][m][0] * rs, v1 = acc[ai][bj][m][1] * rs;
                    if (isf) { *(f32x4*)(fdst + off + bj * 128) = v0; *(f32x4*)(fdst + off + bj * 128 + 4) = v1; }
                    else {
                        float h[8] = {v0[0], v0[1], v0[2], v0[3], v1[0], v1[1], v1[2], v1[3]};
                        if (seg == 0) {
#pragma unroll
                            for (int j = 0; j < 8; ++j) h[j] = h[j] * sigm(h[j]);
                        } else if (seg == 3) {
#pragma unroll
                            for (int j = 0; j < 8; ++j) h[j] = sigm(h[j]);
                        } else if (seg == 5) {
#pragma unroll
                            for (int j = 0; j < 8; ++j) { const float y = h[j]; h[j] = y * sigm(1.5957691216f * (y + 0.044715f * y * y * y)); }
                        }
                        u32x4 w; w.x = cvt_pk_bf16(h[0], h[1]); w.y = cvt_pk_bf16(h[2], h[3]); w.z = cvt_pk_bf16(h[4], h[5]); w.w = cvt_pk_bf16(h[6], h[7]);
                        *(u32x4*)(bdst + off + bj * 128) = w;
                    }
                }
            }
    }
};


struct SmallResid {
    const float* xin; float* xout; bf16_t* ax; const float* gnext; float* ssout; float scale;
    __device__ __forceinline__ void apply(const f32x4& acc, int grow, int c, int cn, int c16, int r16, int fr, int fq, LAS unsigned char* lds) const {
        const size_t off = (size_t)grow * DM + c;
        const f32x4 x = *(const f32x4*)(xin + off);
        const f32x4 v = x + acc * scale;
        *(f32x4*)(xout + off) = v;
        float sq = (v[0] * v[0] + v[1] * v[1]) + (v[2] * v[2] + v[3] * v[3]);
        if (ax) { const f32x4 g = *(const f32x4*)(gnext + c); const f32x4 a = v * g; u32x2 w; w.x = cvt_pk_bf16(a[0], a[1]); w.y = cvt_pk_bf16(a[2], a[3]); *(u32x2*)(ax + off) = w; }
        sq += __shfl_xor(sq, 16); sq += __shfl_xor(sq, 32);
        LAS float* P = (LAS float*)lds;
        if (fq == 0) P[(r16 * 16 + fr) * 4 + c16] = sq;
        __syncthreads();
        if (c16 == 0 && fq == 0) { const LAS float* q = P + (r16 * 16 + fr) * 4; ssout[(size_t)grow * 16 + cn] = (q[0] + q[1]) + (q[2] + q[3]); }
        __syncthreads();
    }
};
struct SmallProj {
    bf16_t *Q, *V, *SG, *GY; float *FZ, *XB; const float* ss;
    __device__ __forceinline__ void apply(const f32x4& acc, int grow, int c, int cn, int c16, int r16, int fr, int fq, LAS unsigned char* lds) const {
        const int seg = cn >> 3, cs = c & 511;
        const float rs = rowscale(ss, grow);
        const f32x4 v = acc * rs;
        const size_t off = (size_t)grow * DH + cs;
        if (seg == 1 || seg == 4) { *(f32x4*)(((seg == 1) ? FZ : XB) + off) = v; }
        else {
            float h[4] = {v[0], v[1], v[2], v[3]};
            if (seg == 0) {
#pragma unroll
                for (int j = 0; j < 4; ++j) h[j] = h[j] * sigm(h[j]);
            } else if (seg == 3) {
#pragma unroll
                for (int j = 0; j < 4; ++j) h[j] = sigm(h[j]);
            } else if (seg == 5) {
#pragma unroll
                for (int j = 0; j < 4; ++j) { const float y = h[j]; h[j] = y * sigm(1.5957691216f * (y + 0.044715f * y * y * y)); }
            }
            bf16_t* bdst = (seg == 0) ? Q : (seg == 2) ? V : (seg == 3) ? SG : GY;
            u32x2 w; w.x = cvt_pk_bf16(h[0], h[1]); w.y = cvt_pk_bf16(h[2], h[3]);
            *(u32x2*)(bdst + off) = w;
        }
    }
};
template <class Epi>
__device__ __forceinline__ void small_gemm(const bf16_t* A, const bf16_t* Bt, int N, int K, const Epi& E, LAS unsigned char* lds) {
    const int tid = threadIdx.x, lane = tid & 63, wave = tid >> 6, fr = lane & 15, fq = lane >> 4, r16 = wave >> 2, c16 = wave & 3;
    const int nunits = 16 * (N / 64), G = gridDim.x;
    for (int u = G - 1 - (int)blockIdx.x; u < nunits; u += G) {
        const int rm = u & 15, cn = u >> 4;
        const int lrow = rm * 32 + r16 * 16 + fr, col = cn * 64 + c16 * 16;
        const bf16_t* ap = A + (size_t)(TP + lrow) * K + fq * 8;
        const bf16_t* bp = Bt + (size_t)(col + fr) * K + fq * 8;
        f32x4 acc = {0.f, 0.f, 0.f, 0.f};
        for (int k0 = 0; k0 < K; k0 += 256) {
            bf16x8 a[8], b[8];
#pragma unroll
            for (int i = 0; i < 8; ++i) { a[i] = *(const bf16x8*)(ap + k0 + i * 32); b[i] = *(const bf16x8*)(bp + k0 + i * 32); }
#pragma unroll
            for (int i = 0; i < 8; ++i) acc = __builtin_amdgcn_mfma_f32_16x16x32_bf16(b[i], a[i], acc, 0, 0, 0);
        }
        E.apply(acc, TP + lrow, col + 4 * fq, cn, c16, r16, fr, fq, lds);
    }
}

#define XB_TMO      128
#define XB_XCNT(j)  (256  + 64 * (j))
#define XB_XSUB(j)  (1280 + 64 * (j))
#define XB_XGEN(j)  (2304 + 64 * (j))
#define XB_TOP      3328
#define XB_TOPGEN   3392
#define XCD_BAR_WORDS 3456
#define XB_SPIN_CAP (1u << 22)
__device__ __forceinline__ unsigned xb_ld(unsigned* p)              { return __hip_atomic_load(p, __ATOMIC_RELAXED, __HIP_MEMORY_SCOPE_AGENT); }
__device__ __forceinline__ unsigned xb_add(unsigned* p, unsigned v) { return __hip_atomic_fetch_add(p, v, __ATOMIC_RELAXED, __HIP_MEMORY_SCOPE_AGENT); }
__device__ __forceinline__ unsigned xb_xcc_id() { return (unsigned)__builtin_amdgcn_s_getreg((3 << 11) | 20) & 0xFu; }
#define XB_SPIN(cond, bar) do { unsigned _sp = 0; while (cond) { __builtin_amdgcn_s_sleep(1); \
    if ((++_sp & 255u) == 0u) { if (xb_ld(&(bar)[XB_TMO])) break; if (_sp > XB_SPIN_CAP) { atomicAdd(&(bar)[XB_TMO], 1u); break; } } } } while (0)
struct XcdBarrier { unsigned* bar; unsigned x; volatile LAS unsigned* st; };
__device__ __forceinline__ XcdBarrier xcd_barrier_post(unsigned* bar, volatile LAS unsigned* st) {
    XcdBarrier b; b.bar = bar; b.x = xb_xcc_id(); b.st = st;
    if (threadIdx.x == 0) (void)xb_add(&bar[XB_XCNT(b.x)], 1u);
    return b;
}
__device__ __forceinline__ void xcd_barrier_complete(unsigned* bar, unsigned x, unsigned& nloc, unsigned& nx) {
    const unsigned G = gridDim.x * gridDim.y * gridDim.z;
    unsigned sum, cnt, mine, sp = 0u;
    for (;;) {
        sum = 0u; cnt = 0u; mine = 0u;
#pragma unroll
        for (unsigned j = 0; j < 16; ++j) { const unsigned c = xb_ld(&bar[XB_XCNT(j)]); sum += c; cnt += (c > 0u) ? 1u : 0u; mine = (j == x) ? c : mine; }
        if (sum == G) break;
        __builtin_amdgcn_s_sleep(1);
        if ((++sp & 255u) == 0u) { if (xb_ld(&bar[XB_TMO])) break; if (sp > XB_SPIN_CAP) { atomicAdd(&bar[XB_TMO], 1u); break; } }
    }
    nloc = mine > 0u ? mine : 1u; nx = cnt > 0u ? cnt : 1u;
}
__device__ __forceinline__ void xcd_barrier(const XcdBarrier& b) {
    asm volatile("s_waitcnt vmcnt(0) lgkmcnt(0)" ::: "memory");
    __syncthreads();
    if (threadIdx.x == 0) {
        unsigned* bar = b.bar;
        __builtin_amdgcn_s_waitcnt(0);
        unsigned nloc = b.st[0], nx = b.st[1];
        if (nloc == 0u) { xcd_barrier_complete(bar, b.x, nloc, nx); b.st[0] = nloc; b.st[1] = nx; }
        const unsigned old = xb_add(&bar[XB_XSUB(b.x)], 1u);
        const unsigned gen = old / nloc;
        if (old + 1u == (gen + 1u) * nloc) {
            __builtin_amdgcn_fence(__ATOMIC_RELEASE, "agent");
            asm volatile("s_waitcnt vmcnt(0)" ::: "memory");
            const unsigned og = xb_add(&bar[XB_TOP], 1u);
            const unsigned tg = og / nx;
            if (og + 1u == (tg + 1u) * nx) xb_add(&bar[XB_TOPGEN], 1u);
            else XB_SPIN(xb_ld(&bar[XB_TOPGEN]) == tg, bar);
            __builtin_amdgcn_fence(__ATOMIC_ACQUIRE, "agent");
            xb_add(&bar[XB_XGEN(b.x)], 1u);
            asm volatile("s_waitcnt vmcnt(0)" ::: "memory");
        } else {
            XB_SPIN(xb_ld(&bar[XB_XGEN(b.x)]) == gen, bar);
            __builtin_amdgcn_fence(__ATOMIC_ACQUIRE, "agent");
            asm volatile("s_waitcnt vmcnt(0)" ::: "memory");
        }
    }
    __syncthreads();
}

struct Params { const float* in[26]; float* out; unsigned char* ws; int ph_lo, ph_hi; };

__device__ __forceinline__ void transpose_item(const float* W, int K, int N, bf16_t* WT, int dst_row0, LAS float* scr, int k0, int n0, int lane) {
    float wv[32];
#pragma unroll
    for (int i = 0; i < 32; ++i) wv[i] = W[(size_t)(k0 + 2 * i + (lane >> 5)) * N + n0 + (lane & 31)];
#pragma unroll
    for (int i = 0; i < 32; ++i) scr[(2 * i + (lane >> 5)) * 33 + (lane & 31)] = wv[i];
    LDS_WAIT();
    const int c = lane & 7;
#pragma unroll
    for (int j = 0; j < 4; ++j) { const int n = (lane >> 3) + 8 * j; const LAS float* s = scr + (8 * c) * 33 + n;
        u32x4 o; o.x = cvt_pk_bf16(s[0 * 33], s[1 * 33]); o.y = cvt_pk_bf16(s[2 * 33], s[3 * 33]); o.z = cvt_pk_bf16(s[4 * 33], s[5 * 33]); o.w = cvt_pk_bf16(s[6 * 33], s[7 * 33]);
        *(u32x4*)(WT + (size_t)(dst_row0 + n) * K + k0 + 8 * c) = o; }
    LDS_WAIT();
}
__device__ __forceinline__ void transpose_mat(const float* W, int K, int N, bf16_t* WT, int mode, LAS float* scr, int item, int lane) {
    const int nblk = N / 32, kb = item / nblk, nb = item % nblk, n0 = 32 * nb;
    const int dst = (mode == 0) ? n0 : (256 * (n0 >> 7) + (n0 & 127) + (mode == 2 ? 128 : 0));
    transpose_item(W, K, N, WT, dst, scr, 64 * kb, n0, lane);
}

__device__ __forceinline__ void phase0(const Params& p, LAS unsigned char* lds) {
    const int tid = threadIdx.x, lane = tid & 63, wave = tid >> 6;
    const int G = gridDim.x, gw = blockIdx.x * 8 + wave, NGW = G * 8;
    unsigned char* ws = p.ws;
    LAS float* scr = (LAS float*)(lds + wave * 16384);
    constexpr int I_GU = 16 * 88, I_D = 44 * 32, I_IN = 16 * 96, I_O = 16 * 32;
    constexpr int NIT = 4 * I_GU + 2 * I_D + I_IN + I_O;
    for (int it = gw; it < NIT; it += NGW) {
        int r = it;
        if (r < I_GU) { transpose_mat(p.in[6], 1024, 2816, (bf16_t*)(ws + WS_WG1), 1, scr, r, lane); continue; } r -= I_GU;
        if (r < I_GU) { transpose_mat(p.in[7], 1024, 2816, (bf16_t*)(ws + WS_WG1), 2, scr, r, lane); continue; } r -= I_GU;
        if (r < I_D)  { transpose_mat(p.in[8], 2816, 1024, (bf16_t*)(ws + WS_WD1), 0, scr, r, lane); continue; } r -= I_D;
        if (r < I_IN) { transpose_mat(p.in[10], 1024, 3072, (bf16_t*)(ws + WS_WIN), 0, scr, r, lane); continue; } r -= I_IN;
        if (r < I_O)  { transpose_mat(p.in[20], 1024, 1024, (bf16_t*)(ws + WS_WO), 0, scr, r, lane); continue; } r -= I_O;
        if (r < I_GU) { transpose_mat(p.in[22], 1024, 2816, (bf16_t*)(ws + WS_WG2), 1, scr, r, lane); continue; } r -= I_GU;
        if (r < I_GU) { transpose_mat(p.in[23], 1024, 2816, (bf16_t*)(ws + WS_WG2), 2, scr, r, lane); continue; } r -= I_GU;
        transpose_mat(p.in[24], 2816, 1024, (bf16_t*)(ws + WS_WD2), 0, scr, r, lane);
    }
    for (int e = blockIdx.x * 512 + tid; e < 2 * 32768; e += G * 512) {
        const int which = e >> 15, r = e & 32767, n = r >> 12, j = (r >> 6) & 63, i = r & 63;
        const float* W = which ? p.in[17] : p.in[15];
        bf16_t* WT = (bf16_t*)(ws + (which ? WS_WXT : WS_WAT));
        WT[r] = f2bf(W[(n * 64 + i) * 64 + j]);
    }
    bf16_t* A1 = (bf16_t*)(ws + WS_B0); float* SS0 = (float*)(ws + WS_SS0);
    const float* g1 = p.in[5];
    f32x4 gv[4];
#pragma unroll
    for (int j = 0; j < 4; ++j) gv[j] = ((const f32x4*)g1)[lane + 64 * j];
    for (int row0 = gw; row0 < T_ALL; row0 += 3 * NGW) {
        f32x4 v[3][4];
#pragma unroll
        for (int r = 0; r < 3; ++r) { const int row = row0 + r * NGW; if (row < T_ALL) {
            const float* xr = (row < TP) ? p.in[0] + (size_t)row * DM : p.in[1] + (size_t)(row - TP) * DM;
#pragma unroll
            for (int j = 0; j < 4; ++j) v[r][j] = ((const f32x4*)xr)[lane + 64 * j]; } }
#pragma unroll
        for (int r = 0; r < 3; ++r) { const int row = row0 + r * NGW; if (row < T_ALL) {
            float s = 0.f;
#pragma unroll
            for (int j = 0; j < 4; ++j) s += (v[r][j].x * v[r][j].x + v[r][j].y * v[r][j].y) + (v[r][j].z * v[r][j].z + v[r][j].w * v[r][j].w);
            s = wave_sum(s);
            u32x2* o8 = (u32x2*)(A1 + (size_t)row * DM);
#pragma unroll
            for (int j = 0; j < 4; ++j) { const f32x4 a = v[r][j] * gv[j]; u32x2 w; w.x = cvt_pk_bf16(a.x, a.y); w.y = cvt_pk_bf16(a.z, a.w); o8[lane + 64 * j] = w; }
            if (lane < 16) SS0[(size_t)row * 16 + lane] = (lane == 0) ? s : 0.f; } }
    }
}

__device__ __forceinline__ void phase_final(const Params& p) {
    const int tid = threadIdx.x, lane = tid & 63, wave = tid >> 6;
    const int gw = blockIdx.x * 8 + wave, NGW = gridDim.x * 8;
    const float* SS3 = (const float*)(p.ws + WS_SS3); const float* gf = p.in[25];
    f32x4 gv[4];
#pragma unroll
    for (int j = 0; j < 4; ++j) gv[j] = ((const f32x4*)gf)[lane + 64 * j];
    for (int row0 = gw; row0 < T_ALL; row0 += 3 * NGW) {
        f32x4 v[3][4]; float rs[3];
#pragma unroll
        for (int r = 0; r < 3; ++r) { const int row = row0 + r * NGW; if (row < T_ALL) {
            rs[r] = rowscale(SS3, row);
            const f32x4* xr = (const f32x4*)(p.out + (size_t)row * DM);
#pragma unroll
            for (int j = 0; j < 4; ++j) v[r][j] = xr[lane + 64 * j]; } }
#pragma unroll
        for (int r = 0; r < 3; ++r) { const int row = row0 + r * NGW; if (row < T_ALL) {
            f32x4* xr = (f32x4*)(p.out + (size_t)row * DM);
#pragma unroll
            for (int j = 0; j < 4; ++j) xr[lane + 64 * j] = v[r][j] * rs[r] * gv[j]; } }
    }
}

struct Mix {
    const bf16_t *Q, *V, *SG, *GY; const float *FZ, *XB; bf16_t* LT; float* DC; float *ACH, *UCH, *HST; bf16_t* O;
    const bf16_t *WAT, *WXT;
    const float *lb, *hnorm, *convw, *convb, *ba, *bx, *lam, *wa, *wx, *st_h, *st_l, *st_c;
    float* out;
};

struct HgrnScan { float cum[16]; float kk[16]; float last; };
__device__ __forceinline__ void hgrn_scan(const float (&fzv)[16], float lb, int k, int seg, LAS float* tot, HgrnScan& hs) {
    float run = 0.f;
#pragma unroll
    for (int i = 0; i < 16; ++i) {
        const float e = __expf(-fmaxf(fzv[i], -80.f));
        const float sg = __builtin_amdgcn_rcpf(1.f + e), sn = e * sg;
        const float f = lb + (1.f - lb) * sg;
        run += __logf(f); hs.cum[i] = run; hs.kk[i] = (1.f - lb) * sn;
    }
    tot[seg * 128 + k] = run;
    __syncthreads();
    float off = 0.f, all = 0.f;
#pragma unroll
    for (int s = 0; s < 4; ++s) { const float v = tot[s * 128 + k]; if (s < seg) off += v; all += v; }
#pragma unroll
    for (int i = 0; i < 16; ++i) hs.cum[i] += off;
    hs.last = all;
}

__device__ __forceinline__ void hgrn_local_unit(const Mix& M, int unit, LAS unsigned char* lds) {
    const int tid = threadIdx.x, lane = tid & 63, wave = tid >> 6, fr = lane & 15, fq = lane >> 4;
    const int h = unit & 3, bc = unit >> 2, t0 = bc * 64, cb = h * 128, k = tid & 127, seg = tid >> 7;
    LAS bf16_t* KT = (LAS bf16_t*)lds; LAS bf16_t* VT = (LAS bf16_t*)(lds + 18432); LAS float* tot = (LAS float*)(lds + 36864);
    float fzv[16]; unsigned vv[16];
    const size_t rb = (size_t)(t0 + seg * 16) * DH + cb + k;
#pragma unroll
    for (int i = 0; i < 16; ++i) { fzv[i] = M.FZ[rb + (size_t)i * DH]; vv[i] = M.V[rb + (size_t)i * DH]; }
    const float l0 = M.lb[cb + k], l1 = M.lb[512 + cb + k];
    const float lb = __builtin_amdgcn_rcpf(1.f + __expf(l1 - l0));
    HgrnScan hs; hgrn_scan(fzv, lb, k, seg, tot, hs);
    unsigned pk[8];
#pragma unroll
    for (int i = 0; i < 8; ++i) pk[i] = cvt_pk_bf16(hs.kk[2 * i] * __expf(hs.last - hs.cum[2 * i]), hs.kk[2 * i + 1] * __expf(hs.last - hs.cum[2 * i + 1]));
    *(LAS u32x4*)(KT + k * 72 + seg * 16) = (u32x4){pk[0], pk[1], pk[2], pk[3]};
    *(LAS u32x4*)(KT + k * 72 + seg * 16 + 8) = (u32x4){pk[4], pk[5], pk[6], pk[7]};
    *(LAS u32x4*)(VT + k * 72 + seg * 16) = (u32x4){vv[0] | (vv[1] << 16), vv[2] | (vv[3] << 16), vv[4] | (vv[5] << 16), vv[6] | (vv[7] << 16)};
    *(LAS u32x4*)(VT + k * 72 + seg * 16 + 8) = (u32x4){vv[8] | (vv[9] << 16), vv[10] | (vv[11] << 16), vv[12] | (vv[13] << 16), vv[14] | (vv[15] << 16)};
    if (seg == 0) M.DC[unit * 128 + k] = __expf(hs.last);
    __syncthreads();
    const bf16x8 a0 = *(const LAS bf16x8*)(VT + (16 * wave + fr) * 72 + fq * 8), a1 = *(const LAS bf16x8*)(VT + (16 * wave + fr) * 72 + 32 + fq * 8);
#pragma unroll
    for (int ct = 0; ct < 8; ++ct) {
        const bf16x8 b0 = *(const LAS bf16x8*)(KT + (16 * ct + fr) * 72 + fq * 8), b1 = *(const LAS bf16x8*)(KT + (16 * ct + fr) * 72 + 32 + fq * 8);
        f32x4 acc = {0.f, 0.f, 0.f, 0.f};
        acc = __builtin_amdgcn_mfma_f32_16x16x32_bf16(b0, a0, acc, 0, 0, 0);
        acc = __builtin_amdgcn_mfma_f32_16x16x32_bf16(b1, a1, acc, 0, 0, 0);
        u32x2 w; w.x = cvt_pk_bf16(acc[0], acc[1]); w.y = cvt_pk_bf16(acc[2], acc[3]);
        *(u32x2*)(M.LT + ((size_t)unit * 128 + 16 * wave + fr) * 128 + 16 * ct + 4 * fq) = w;
    }
    __syncthreads();
}

__device__ __forceinline__ void hgrn_out_unit(const Mix& M, int unit, LAS unsigned char* lds) {
    const int tid = threadIdx.x, lane = tid & 63, wave = tid >> 6, fr = lane & 15, fq = lane >> 4;
    const int h = unit & 3, bc = unit >> 2, t0 = bc * 64, cb = h * 128, k = tid & 127, seg = tid >> 7;
    LAS bf16_t* QS = (LAS bf16_t*)lds; LAS bf16_t* KS = (LAS bf16_t*)(lds + 17408); LAS bf16_t* VT = (LAS bf16_t*)(lds + 34816);
    LAS bf16_t* PS = (LAS bf16_t*)(lds + 53248); LAS float* tot = (LAS float*)(lds + 62464); LAS float* RS = (LAS float*)(lds + 64512);
    float fzv[16]; unsigned vv[16], qv[16];
    const size_t rb = (size_t)(t0 + seg * 16) * DH + cb + k;
#pragma unroll
    for (int i = 0; i < 16; ++i) { fzv[i] = M.FZ[rb + (size_t)i * DH]; vv[i] = M.V[rb + (size_t)i * DH]; qv[i] = M.Q[rb + (size_t)i * DH]; }
    bf16x8 bs[4];
#pragma unroll
    for (int ks = 0; ks < 4; ++ks) bs[ks] = *(const bf16x8*)(M.LT + ((size_t)unit * 128 + 16 * wave + fr) * 128 + ks * 32 + fq * 8);
    const int ocol = cb + 16 * wave + 4 * fq;
    u32x2 sgv[4];
#pragma unroll
    for (int tr = 0; tr < 4; ++tr) sgv[tr] = *(const u32x2*)(M.SG + (size_t)(t0 + 16 * tr + fr) * DH + ocol);
    const f32x4 gn = *(const f32x4*)(M.hnorm + ocol);
    const float l0 = M.lb[cb + k], l1 = M.lb[512 + cb + k];
    const float lb = __builtin_amdgcn_rcpf(1.f + __expf(l1 - l0));
    HgrnScan hs; hgrn_scan(fzv, lb, k, seg, tot, hs);
#pragma unroll
    for (int i = 0; i < 16; ++i) {
        const float q = __uint_as_float(qv[i] << 16);
        QS[(seg * 16 + i) * 136 + k] = f2bf(q * __expf(hs.cum[i]));
        KS[(seg * 16 + i) * 136 + k] = f2bf(hs.kk[i] * __expf(-hs.cum[i]));
    }
    *(LAS u32x4*)(VT + k * 72 + seg * 16) = (u32x4){vv[0] | (vv[1] << 16), vv[2] | (vv[3] << 16), vv[4] | (vv[5] << 16), vv[6] | (vv[7] << 16)};
    *(LAS u32x4*)(VT + k * 72 + seg * 16 + 8) = (u32x4){vv[8] | (vv[9] << 16), vv[10] | (vv[11] << 16), vv[12] | (vv[13] << 16), vv[14] | (vv[15] << 16)};
    __syncthreads();
#pragma unroll
    for (int r = 0; r < 2; ++r) {
        const int idx = wave + 8 * r, tr = idx >> 2, tc = idx & 3;
        f32x4 acc = {0.f, 0.f, 0.f, 0.f};
        if (tc <= tr) {
#pragma unroll
            for (int ks = 0; ks < 4; ++ks) {
                const bf16x8 a = *(const LAS bf16x8*)(QS + (16 * tr + fr) * 136 + ks * 32 + fq * 8), b = *(const LAS bf16x8*)(KS + (16 * tc + fr) * 136 + ks * 32 + fq * 8);
                acc = __builtin_amdgcn_mfma_f32_16x16x32_bf16(b, a, acc, 0, 0, 0);
            }
#pragma unroll
            for (int j = 0; j < 4; ++j) if (16 * tc + 4 * fq + j > 16 * tr + fr) acc[j] = 0.f;
        }
        u32x2 w; w.x = cvt_pk_bf16(acc[0], acc[1]); w.y = cvt_pk_bf16(acc[2], acc[3]);
        *(LAS u32x2*)(PS + (16 * tr + fr) * 72 + 16 * tc + 4 * fq) = w;
    }
    __syncthreads();
    bf16x8 bv[2];
#pragma unroll
    for (int ks = 0; ks < 2; ++ks) bv[ks] = *(const LAS bf16x8*)(VT + (16 * wave + fr) * 72 + ks * 32 + fq * 8);
    f32x4 o[4];
#pragma unroll
    for (int tr = 0; tr < 4; ++tr) {
        f32x4 acc = {0.f, 0.f, 0.f, 0.f};
#pragma unroll
        for (int ks = 0; ks < 2; ++ks) { const bf16x8 a = *(const LAS bf16x8*)(PS + (16 * tr + fr) * 72 + ks * 32 + fq * 8); acc = __builtin_amdgcn_mfma_f32_16x16x32_bf16(bv[ks], a, acc, 0, 0, 0); }
#pragma unroll
        for (int ks = 0; ks < 4; ++ks) { const bf16x8 a = *(const LAS bf16x8*)(QS + (16 * tr + fr) * 136 + ks * 32 + fq * 8); acc = __builtin_amdgcn_mfma_f32_16x16x32_bf16(bs[ks], a, acc, 0, 0, 0); }
        o[tr] = acc;
        float ss = (acc[0] * acc[0] + acc[1] * acc[1]) + (acc[2] * acc[2] + acc[3] * acc[3]);
        ss += __shfl_xor(ss, 16); ss += __shfl_xor(ss, 32);
        if (fq == 0) RS[wave * 64 + 16 * tr + fr] = ss;
    }
    __syncthreads();
#pragma unroll
    for (int tr = 0; tr < 4; ++tr) {
        const int tl = 16 * tr + fr; float tt = 0.f;
#pragma unroll
        for (int w = 0; w < 8; ++w) tt += RS[w * 64 + tl];
        const float rinv = rsqrtf(tt * (1.f / 128.f) + EPS);
        const u32x2 sg = sgv[tr];
        u32x2 w;
        w.x = cvt_pk_bf16(o[tr][0] * rinv * gn[0] * bflo(sg.x), o[tr][1] * rinv * gn[1] * bfhi(sg.x));
        w.y = cvt_pk_bf16(o[tr][2] * rinv * gn[2] * bflo(sg.y), o[tr][3] * rinv * gn[3] * bfhi(sg.y));
        *(u32x2*)(M.O + (size_t)(t0 + tl) * DM + ocol) = w;
    }
    __syncthreads();
}

__device__ __forceinline__ void lru_unit(const Mix& M, int unit, int mode, LAS unsigned char* lds) {
    const int tid = threadIdx.x, lane = tid & 63, wave = tid >> 6, fr = lane & 15, fq = lane >> 4;
    const int n = unit & 7, bc = unit >> 3, c = bc & 31, b = bc >> 5, t0 = bc * 64, ch0 = n * 64;
    const int j = tid & 63, seg = tid >> 6, ch = ch0 + j;
    LAS float* XC32 = (LAS float*)lds; LAS bf16_t* XC16 = (LAS bf16_t*)(lds + 16640); LAS float* GR = (LAS float*)(lds + 25856); LAS float* GI = (LAS float*)(lds + 42496);
    LAS float* SEGA = (LAS float*)(lds + 59136); LAS float* SEGU = (LAS float*)(lds + 61184);
    const int tl0 = seg * 8; const bool first = (c == 0 && seg == 0);
    const float* xp = M.XB + (size_t)(t0 + tl0) * DH + ch;
    float xm3 = first ? 0.f : xp[-3 * DH], xm2 = first ? 0.f : xp[-2 * DH], xm1 = first ? 0.f : xp[-1 * DH];
    float xr[8];
#pragma unroll
    for (int i = 0; i < 8; ++i) xr[i] = xp[i * DH];
    const float w0 = M.convw[ch], w1 = M.convw[512 + ch], w2 = M.convw[1024 + ch], w3 = M.convw[1536 + ch], cbias = M.convb[ch];
    const int gate = wave >> 2, tr = wave & 3;
    const bf16_t* WT = (gate ? M.WXT : M.WAT) + n * 4096;
    const float* bias = (gate ? M.bx : M.ba) + ch0;
    bf16x8 wb[4][2]; float bbv[4];
#pragma unroll
    for (int ct = 0; ct < 4; ++ct) { wb[ct][0] = *(const bf16x8*)(WT + (16 * ct + fr) * 64 + fq * 8); wb[ct][1] = *(const bf16x8*)(WT + (16 * ct + fr) * 64 + 32 + fq * 8); bbv[ct] = bias[16 * ct + fr]; }
    const float lamv = M.lam[ch];
    float hin = (mode == 1) ? M.HST[(size_t)bc * 512 + ch] : 0.f;
    unsigned gyv[8];
    if (mode == 1) {
#pragma unroll
        for (int i = 0; i < 8; ++i) gyv[i] = M.GY[(size_t)(t0 + tl0 + i) * DH + ch];
    }
    float cpv = 0.f;
    if (mode == 1 && c == 31 && tid < 192) cpv = M.XB[(size_t)(b * SEQ + SEQ - 3 + (tid >> 6)) * DH + ch0 + j];
    float xcv[8];
#pragma unroll
    for (int i = 0; i < 8; ++i) {
        const float x = xr[i];
        const float xc = cbias + w0 * xm3 + w1 * xm2 + w2 * xm1 + w3 * x;
        xcv[i] = xc; XC16[(tl0 + i) * 72 + j] = f2bf(xc);
        xm3 = xm2; xm2 = xm1; xm1 = x;
    }
    __syncthreads();
    {
        LAS float* Gd = gate ? GI : GR;
        const bf16x8 a0 = *(const LAS bf16x8*)(XC16 + (16 * tr + fr) * 72 + fq * 8), a1 = *(const LAS bf16x8*)(XC16 + (16 * tr + fr) * 72 + 32 + fq * 8);
#pragma unroll
        for (int ct = 0; ct < 4; ++ct) {
            f32x4 acc = {0.f, 0.f, 0.f, 0.f};
            acc = __builtin_amdgcn_mfma_f32_16x16x32_bf16(a0, wb[ct][0], acc, 0, 0, 0);
            acc = __builtin_amdgcn_mfma_f32_16x16x32_bf16(a1, wb[ct][1], acc, 0, 0, 0);
#pragma unroll
            for (int jj = 0; jj < 4; ++jj) Gd[(16 * tr + 4 * fq + jj) * 65 + 16 * ct + fr] = sigm(acc[jj] + bbv[ct]);
        }
    }
    __syncthreads();
    const float sp = log1pf(__expf(-lamv));
    float av[8], uv[8]; float A = 1.f, U = 0.f;
#pragma unroll
    for (int i = 0; i < 8; ++i) {
        const int tl = tl0 + i; const float r = GR[tl * 65 + j], ig = GI[tl * 65 + j];
        const float la = -8.f * r * sp, a = __expf(la); float mult = sqrtf(fmaxf(1.f - a * a, 0.f));
        if (la > -0.05f) mult = sqrtf(-expm1f(2.f * la));
        if (c == 0 && tl == 0) mult = 1.f;
        const float u = mult * ig * xcv[i];
        av[i] = a; uv[i] = u; U = a * U + u; A *= a;
    }
    SEGA[seg * 64 + j] = A; SEGU[seg * 64 + j] = U;
    __syncthreads();
#pragma unroll
    for (int s = 0; s < 8; ++s) if (s < seg) hin = SEGA[s * 64 + j] * hin + SEGU[s * 64 + j];
    if (mode == 0) {
        if (seg == 7) { float At = 1.f;
#pragma unroll
            for (int s = 0; s < 8; ++s) At *= SEGA[s * 64 + j];
            M.ACH[(size_t)bc * 512 + ch] = At; M.UCH[(size_t)bc * 512 + ch] = A * hin + U; }
    } else {
        float hh = hin;
#pragma unroll
        for (int i = 0; i < 8; ++i) {
            hh = av[i] * hh + uv[i];
            M.O[(size_t)(t0 + tl0 + i) * DM + 512 + ch] = f2bf(hh * __uint_as_float(gyv[i] << 16));
        }
        if (c == 31 && seg == 7) M.out[OUT_LP + b * 512 + ch] = hh;
        if (c == 31 && tid < 192) M.out[OUT_CP + (size_t)(b * 3 + (tid >> 6)) * 512 + ch0 + j] = cpv;
    }
    __syncthreads();
}

__device__ __forceinline__ void hgrn_sample_unit(const Mix& M, int unit, LAS unsigned char* lds) {
    const int tid = threadIdx.x, lane = tid & 63, wave = tid >> 6;
    const int h = unit & 3, b = unit >> 2, cb = h * 128, tb = TP + b * 4;
    LAS float* SQ = (LAS float*)lds;
    LAS float* SK = SQ + 512;
    LAS float* SD = SK + 512;
    LAS float* SP = SD + 128;
    LAS float* OP = SP + 32;
    LAS float* RS = OP + 2048;
    const int v = tid & 127, kq = tid >> 7;
    const size_t sb = ((size_t)(b * 4 + h) * 128) * 128;
    float s0v[32];
#pragma unroll
    for (int kx = 0; kx < 32; ++kx) s0v[kx] = M.st_h[sb + (size_t)(kq * 32 + kx) * 128 + v];
    float vv[4];
#pragma unroll
    for (int s = 0; s < 4; ++s) vv[s] = bf2f(M.V[(size_t)(tb + s) * DH + cb + v]);
    const float sgo = bf2f(M.SG[(size_t)(tb + kq) * DH + cb + v]), hno = M.hnorm[cb + v];
    if (tid < 128) {
        const int k = tid;
        const float l0 = M.lb[cb + k], l1 = M.lb[512 + cb + k];
        const float lb = 1.f / (1.f + expf(l1 - l0));
        float cum[4], kk[4], qv[4]; float run = 0.f;
#pragma unroll
        for (int s = 0; s < 4; ++s) {
            const float fz = M.FZ[(size_t)(tb + s) * DH + cb + k];
            const float sg = 1.f / (1.f + expf(-fz)), sn = 1.f / (1.f + expf(fz));
            run += logf(lb + (1.f - lb) * sg); cum[s] = run; kk[s] = (1.f - lb) * sn;
            qv[s] = bf2f(M.Q[(size_t)(tb + s) * DH + cb + k]);
        }
#pragma unroll
        for (int s = 0; s < 4; ++s) { SQ[s * 128 + k] = qv[s] * expf(cum[s]); SK[s * 128 + k] = kk[s] * expf(cum[3] - cum[s]); }
        SD[k] = expf(cum[3]);
        float pr[10]; int c = 0;
#pragma unroll
        for (int t = 0; t < 4; ++t)
#pragma unroll
            for (int s = 0; s <= t; ++s) { pr[c] = qv[t] * kk[s] * expf(cum[t] - cum[s]); ++c; }
#pragma unroll
        for (int i = 0; i < 10; ++i) { const float v = wave_sum(pr[i]); if (lane == 0) SP[wave * 16 + i] = v; }
    }
    __syncthreads();
    {
        float o[4] = {0.f, 0.f, 0.f, 0.f};
#pragma unroll
        for (int kx = 0; kx < 32; ++kx) {
            const int k = kq * 32 + kx;
            const float s0 = s0v[kx];
            float sn = SD[k] * s0;
#pragma unroll
            for (int s = 0; s < 4; ++s) { o[s] += SQ[s * 128 + k] * s0; sn += SK[s * 128 + k] * vv[s]; }
            M.out[OUT_HS + sb + (size_t)k * 128 + v] = sn;
        }
#pragma unroll
        for (int s = 0; s < 4; ++s) OP[(kq * 4 + s) * 128 + v] = o[s];
    }
    __syncthreads();
    {
        const int t = kq;
        float ov = (OP[(0 * 4 + t) * 128 + v] + OP[(1 * 4 + t) * 128 + v]) + (OP[(2 * 4 + t) * 128 + v] + OP[(3 * 4 + t) * 128 + v]);
        const int base = t * (t + 1) / 2;
        for (int s = 0; s <= t; ++s) ov += (SP[base + s] + SP[16 + base + s]) * vv[s];
        const float ssq = wave_sum(ov * ov);
        if (lane == 0) RS[wave] = ssq;
        __syncthreads();
        const float tt = RS[2 * t] + RS[2 * t + 1];
        const float rinv = rsqrtf(tt * (1.f / 128.f) + EPS);
        const size_t tok = (size_t)(tb + t);
        M.O[tok * DM + cb + v] = f2bf(ov * rinv * hno * sgo);
    }
    __syncthreads();
}

__device__ __forceinline__ void lru_sample_unit(const Mix& M, int b, LAS unsigned char* lds) {
    const int tid = threadIdx.x, ch = tid, n = ch >> 6, j = ch & 63, tb = TP + b * 4;
    LAS float* XC = (LAS float*)lds;
    float x[7];
#pragma unroll
    for (int r = 0; r < 3; ++r) x[r] = M.st_c[(size_t)(b * 3 + r) * 512 + ch];
#pragma unroll
    for (int s = 0; s < 4; ++s) x[3 + s] = M.XB[(size_t)(tb + s) * DH + ch];
    const float w0 = M.convw[ch], w1 = M.convw[512 + ch], w2 = M.convw[1024 + ch], w3 = M.convw[1536 + ch], cbias = M.convb[ch];
    float xc[4];
#pragma unroll
    for (int s = 0; s < 4; ++s) { xc[s] = cbias + w0 * x[s] + w1 * x[s + 1] + w2 * x[s + 2] + w3 * x[s + 3]; XC[s * 512 + ch] = xc[s]; }
#pragma unroll
    for (int r = 0; r < 3; ++r) M.out[OUT_CS + (size_t)(b * 3 + r) * 512 + ch] = x[4 + r];
    __syncthreads();
    float ra[4], rx[4];
    const float ba = M.ba[ch], bx = M.bx[ch];
#pragma unroll
    for (int s = 0; s < 4; ++s) { ra[s] = ba; rx[s] = bx; }
    const float* wa = M.wa + (size_t)n * 4096 + j; const float* wx = M.wx + (size_t)n * 4096 + j;
#pragma unroll 16
    for (int i = 0; i < 64; ++i) {
        const float a = wa[i * 64], xw = wx[i * 64];
#pragma unroll
        for (int s = 0; s < 4; ++s) { const float xv = XC[s * 512 + n * 64 + i]; ra[s] += xv * a; rx[s] += xv * xw; }
    }
    const float sp = log1pf(expf(-M.lam[ch]));
    float hh = M.st_l[(size_t)b * 512 + ch];
#pragma unroll
    for (int s = 0; s < 4; ++s) {
        const float r = 1.f / (1.f + expf(-ra[s])), ig = 1.f / (1.f + expf(-rx[s]));
        const float la = -8.f * r * sp, a = expf(la), mult = sqrtf(-expm1f(2.f * la));
        hh = a * hh + mult * ig * xc[s];
        M.O[(size_t)(tb + s) * DM + 512 + ch] = f2bf(hh * bf2f(M.GY[(size_t)(tb + s) * DH + ch]));
    }
    M.out[OUT_LS + (size_t)b * 512 + ch] = hh;
    __syncthreads();
}

__device__ __forceinline__ void scan_item(const Mix& M, int item) {
    const int tid = threadIdx.x;
    if (item < 1024) {
        const int e = item * 512 + tid, bh = e >> 14, vk = e & 16383, b = bh >> 2, h = bh & 3, v = vk >> 7, k = vk & 127;
        float l[32], d[32];
#pragma unroll
        for (int c = 0; c < 32; ++c) { const int unit = (b * 32 + c) * 4 + h; l[c] = bf2f(M.LT[(size_t)unit * 16384 + vk]); d[c] = M.DC[unit * 128 + k]; }
        float S = 0.f;
#pragma unroll
        for (int c = 0; c < 32; ++c) { const int unit = (b * 32 + c) * 4 + h; M.LT[(size_t)unit * 16384 + vk] = f2bf(S); S = d[c] * S + l[c]; }
        M.out[OUT_HP + ((size_t)(b * 4 + h) * 128 + k) * 128 + v] = S;
    } else {
        const int e = (item - 1024) * 512 + tid, b = e >> 9, ch = e & 511;
        float hcar = 0.f;
        for (int c = 0; c < 32; ++c) { const size_t idx = (size_t)(b * 32 + c) * 512 + ch; M.HST[idx] = hcar; hcar = M.ACH[idx] * hcar + M.UCH[idx]; }
    }
}

__global__ void __launch_bounds__(512, 2) mk_fwd(Params p) {
    extern __shared__ __attribute__((aligned(16))) unsigned char lds_raw[];
    LAS unsigned char* lds = (LAS unsigned char*)lds_raw;
    const int lo = p.ph_lo, hi = p.ph_hi, G = gridDim.x;
    unsigned char* ws = p.ws;
#define IN(k) (lo <= (k) && (k) < hi)
    volatile LAS unsigned* xst = (volatile LAS unsigned*)(lds + 131072);
    if (threadIdx.x < 16) xst[threadIdx.x] = 0u;
    __syncthreads();
    XcdBarrier xbar; xbar.bar = (unsigned*)(ws + WS_BAR); xbar.x = 0; xbar.st = xst;
    if (hi - lo > 1) xbar = xcd_barrier_post((unsigned*)(ws + WS_BAR), xst);
    if (hi == 0x7fffffff) cg::this_grid().sync();
#define SEAM(k) do { if (IN(k) && IN((k) + 1)) { xcd_barrier(xbar); } } while (0)
    bf16_t* B0 = (bf16_t*)(ws + WS_B0); bf16_t* B1 = (bf16_t*)(ws + WS_B1); bf16_t* H = (bf16_t*)(ws + WS_H);
    float* SS0 = (float*)(ws + WS_SS0); float* SS1 = (float*)(ws + WS_SS1); float* SS2 = (float*)(ws + WS_SS2); float* SS3 = (float*)(ws + WS_SS3);

    if (IN(0)) { phase0(p, lds); __syncthreads(); }
    SEAM(0);
    if (IN(1)) {
        pg8::Gemm g{B0, (const bf16_t*)(ws + WS_WG1), T_ALL, 2 * DFF, DM}; pg8::StaticOrder S; S.init(T_ALL, 2 * DFF, G, (int)blockIdx.x);
        EpiGateUp E{H, SS0};
        pg8::gemm_phase<EpiGateUp, pg8::StaticOrder, PG8_ALIGN, PG8_SP2>(lds, g, S, E);
    }
    SEAM(1);
    if (IN(2)) {
        pg8::Gemm g{H, (const bf16_t*)(ws + WS_WD1), TP, DM, DFF}; pg8::StaticOrder S; S.init(TP, DM, G, (int)blockIdx.x);
        EpiResid E{p.in[0], p.in[1], p.out, B0, p.in[9], SS1, 0.5f};
        pg8::gemm_phase<EpiResid, pg8::StaticOrder, PG8_ALIGN, PG8_SP2>(lds, g, S, E);
        SmallResid Es{p.in[1] - (size_t)TP * DM, p.out, B0, p.in[9], SS1, 0.5f};
        small_gemm<SmallResid>(H, (const bf16_t*)(ws + WS_WD1), DM, DFF, Es, lds);
    }
    SEAM(2);
    if (IN(3)) {
        pg8::Gemm g{B0, (const bf16_t*)(ws + WS_WIN), TP, DIN, DM}; pg8::StaticOrder S; S.init(TP, DIN, G, (int)blockIdx.x);
        EpiProj E{(bf16_t*)(ws + WS_Q), (bf16_t*)(ws + WS_V), (bf16_t*)(ws + WS_SG), (bf16_t*)(ws + WS_GY), (float*)(ws + WS_FZ), (float*)(ws + WS_XB), SS1};
        pg8::gemm_phase<EpiProj, pg8::StaticOrder, PG8_ALIGN, PG8_SP2>(lds, g, S, E);
        SmallProj Es{(bf16_t*)(ws + WS_Q), (bf16_t*)(ws + WS_V), (bf16_t*)(ws + WS_SG), (bf16_t*)(ws + WS_GY), (float*)(ws + WS_FZ), (float*)(ws + WS_XB), SS1};
        small_gemm<SmallProj>(B0, (const bf16_t*)(ws + WS_WIN), DIN, DM, Es, lds);
    }
    SEAM(3);
    Mix M;
    M.Q = (const bf16_t*)(ws + WS_Q); M.V = (const bf16_t*)(ws + WS_V); M.SG = (const bf16_t*)(ws + WS_SG); M.GY = (const bf16_t*)(ws + WS_GY);
    M.FZ = (const float*)(ws + WS_FZ); M.XB = (const float*)(ws + WS_XB); M.LT = (bf16_t*)(ws + WS_LT); M.DC = (float*)(ws + WS_DC);
    M.ACH = (float*)(ws + WS_ACH); M.UCH = (float*)(ws + WS_UCH); M.HST = (float*)(ws + WS_HST); M.O = B0;
    M.WAT = (const bf16_t*)(ws + WS_WAT); M.WXT = (const bf16_t*)(ws + WS_WXT);
    M.lb = p.in[11]; M.hnorm = p.in[12]; M.convw = p.in[13]; M.convb = p.in[14]; M.wa = p.in[15]; M.ba = p.in[16]; M.wx = p.in[17]; M.bx = p.in[18]; M.lam = p.in[19];
    M.st_h = p.in[2]; M.st_l = p.in[3]; M.st_c = p.in[4]; M.out = p.out;
    if (IN(4)) {
        for (int u = blockIdx.x; u < 3712; u += G) {
            if (u < 512) hgrn_sample_unit(M, u, lds);
            else if (u < 1536) hgrn_local_unit(M, u - 512, lds);
            else if (u < 3584) lru_unit(M, u - 1536, 0, lds);
            else lru_sample_unit(M, u - 3584, lds);
        }
    }
    SEAM(4);
    if (IN(5)) { for (int it = blockIdx.x; it < 1032; it += G) scan_item(M, it); }
    SEAM(5);
    if (IN(6)) {
        for (int u = blockIdx.x; u < 3072; u += G) {
            if (u < 1024) hgrn_out_unit(M, u, lds);
            else lru_unit(M, u - 1024, 1, lds);
        }
    }
    SEAM(6);
    if (IN(7)) {
        pg8::Gemm g{B0, (const bf16_t*)(ws + WS_WO), TP, DM, DM}; pg8::StaticOrder S; S.init(TP, DM, G, (int)blockIdx.x);
        EpiResid E{p.out, p.out + (size_t)TP * DM, p.out, B1, p.in[21], SS2, 1.0f};
        pg8::gemm_phase<EpiResid, pg8::StaticOrder, PG8_ALIGN, PG8_SP2>(lds, g, S, E);
        SmallResid Es{p.out, p.out, B1, p.in[21], SS2, 1.0f};
        small_gemm<SmallResid>(B0, (const bf16_t*)(ws + WS_WO), DM, DM, Es, lds);
    }
    SEAM(7);
    if (IN(8)) {
        pg8::Gemm g{B1, (const bf16_t*)(ws + WS_WG2), T_ALL, 2 * DFF, DM}; pg8::StaticOrder S; S.init(T_ALL, 2 * DFF, G, (int)blockIdx.x);
        EpiGateUp E{H, SS2};
        pg8::gemm_phase<EpiGateUp, pg8::StaticOrder, PG8_ALIGN, PG8_SP2>(lds, g, S, E);
    }
    SEAM(8);
    if (IN(9)) {
        pg8::Gemm g{H, (const bf16_t*)(ws + WS_WD2), TP, DM, DFF}; pg8::StaticOrder S; S.init(TP, DM, G, (int)blockIdx.x);
        EpiResid E{p.out, p.out + (size_t)TP * DM, p.out, nullptr, nullptr, SS3, 0.5f};
        pg8::gemm_phase<EpiResid, pg8::StaticOrder, PG8_ALIGN, PG8_SP2>(lds, g, S, E);
        SmallResid Es{p.out, p.out, nullptr, nullptr, SS3, 0.5f};
        small_gemm<SmallResid>(H, (const bf16_t*)(ws + WS_WD2), DM, DFF, Es, lds);
    }
    SEAM(9);
    if (IN(10)) phase_final(p);
#undef IN
#undef SEAM
}

extern "C" void kernel_launch(void* const* d_in, const int* in_sizes, int n_in, void* d_out, int out_size, void* d_ws, size_t ws_size, hipStream_t stream) {
    static int grid = 0;
    if (grid == 0) {
        if (n_in != 26 || ws_size < WS_END2) { fprintf(stderr, "kernel_launch: unexpected n_in %d or ws_size %zu (need %zu)\n", n_in, ws_size, (size_t)WS_END2); grid = -1; return; }
        int dev = 0, cus = 0, per_cu = 0;
        hipGetDevice(&dev); hipDeviceGetAttribute(&cus, hipDeviceAttributeMultiprocessorCount, dev);
        if (hipFuncSetAttribute((const void*)mk_fwd, hipFuncAttributeMaxDynamicSharedMemorySize, LDS_BYTES) != hipSuccess) { fprintf(stderr, "kernel_launch: hipFuncSetAttribute failed\n"); grid = -1; return; }
        if (hipOccupancyMaxActiveBlocksPerMultiprocessor(&per_cu, (const void*)mk_fwd, 512, LDS_BYTES) != hipSuccess || per_cu < 1) { fprintf(stderr, "kernel_launch: occupancy query says %d\n", per_cu); per_cu = 1; }
        (void)hipGetLastError();
        grid = cus;
    }
    if (grid < 0) return;
    Params p{};
    for (int i = 0; i < 26; ++i) p.in[i] = (const float*)d_in[i];
    p.out = (float*)d_out; p.ws = (unsigned char*)d_ws;
#if MK_PER_PHASE
    for (int ph = 0; ph < MK_NPH; ++ph) { p.ph_lo = ph; p.ph_hi = ph + 1; hipLaunchKernelGGL(mk_fwd, dim3(grid), dim3(512), LDS_BYTES, stream, p); if ((MK_DUP >> ph) & 1) hipLaunchKernelGGL(mk_fwd, dim3(grid), dim3(512), LDS_BYTES, stream, p); }
#else
    p.ph_lo = 0; p.ph_hi = MK_NPH;
    if (hipMemsetAsync((char*)d_ws + WS_BAR, 0, 16384, stream) != hipSuccess) { fprintf(stderr, "memset failed\n"); return; }
    void* args[] = {&p};
    hipError_t e = hipLaunchCooperativeKernel((const void*)mk_fwd, dim3(grid), dim3(512), args, LDS_BYTES, stream);
    if (e != hipSuccess) fprintf(stderr, "cooperative launch failed: %s (grid %d)\n", hipGetErrorString(e), grid);
#endif
}
```

```cpp
#include <hip/hip_runtime.h>
#include <hip/hip_cooperative_groups.h>
#include <cstdio>
#include <cstdint>
namespace cg = cooperative_groups;

#ifndef MK_DUP
#define MK_DUP 0
#endif
#ifndef MK_NPH
#define MK_NPH 11
#endif
#ifndef MK_PER_PHASE
#define MK_PER_PHASE 0
#endif

#define LAS __attribute__((address_space(3)))
typedef unsigned short bf16_t;
typedef short bf16x8 __attribute__((ext_vector_type(8)));
typedef float f32x4 __attribute__((ext_vector_type(4)));
typedef unsigned u32x4 __attribute__((ext_vector_type(4)));
typedef unsigned u32x2 __attribute__((ext_vector_type(2)));

constexpr int T_ALL = 16896, TP = 16384, DM = 1024, DFF = 2816, DIN = 3072, DH = 512;
constexpr int SEQ = 2048, NB = 8, NCH = 32, DECB = 128;
constexpr float EPS = 1e-6f;

constexpr size_t OUT_Y = 0, OUT_HP = 17301504, OUT_LP = 17825792, OUT_CP = 17829888, OUT_HS = 17842176, OUT_LS = 26230784, OUT_CS = 26296320;

constexpr size_t WS_WG1 = 0;
constexpr size_t WS_WD1 = WS_WG1 + (size_t)5632 * 1024 * 2;
constexpr size_t WS_WIN = WS_WD1 + (size_t)1024 * 2816 * 2;
constexpr size_t WS_WO  = WS_WIN + (size_t)3072 * 1024 * 2;
constexpr size_t WS_WG2 = WS_WO + (size_t)1024 * 1024 * 2;
constexpr size_t WS_WD2 = WS_WG2 + (size_t)5632 * 1024 * 2;
constexpr size_t WS_WAT = WS_WD2 + (size_t)1024 * 2816 * 2;
constexpr size_t WS_WXT = WS_WAT + 65536;
constexpr size_t WS_SS0 = WS_WXT + 65536;
constexpr size_t SS_BYTES = (size_t)T_ALL * 16 * 4;
constexpr size_t WS_SS1 = WS_SS0 + SS_BYTES, WS_SS2 = WS_SS1 + SS_BYTES, WS_SS3 = WS_SS2 + SS_BYTES;
constexpr size_t WS_DC  = WS_SS3 + SS_BYTES;
constexpr size_t WS_ACH = WS_DC + (size_t)1024 * 128 * 4;
constexpr size_t WS_UCH = WS_ACH + (size_t)NB * NCH * 512 * 4;
constexpr size_t WS_HST = WS_UCH + (size_t)NB * NCH * 512 * 4;
constexpr size_t WS_B0  = WS_HST + (size_t)NB * NCH * 512 * 4;
constexpr size_t WS_R   = WS_B0 + (size_t)T_ALL * 1024 * 2;
constexpr size_t WS_H   = WS_R;
constexpr size_t WS_B1  = WS_H + (size_t)T_ALL * 2816 * 2;
constexpr size_t WS_Q   = WS_R;
constexpr size_t WS_V   = WS_Q + (size_t)T_ALL * 512 * 2;
constexpr size_t WS_SG  = WS_V + (size_t)T_ALL * 512 * 2;
constexpr size_t WS_GY  = WS_SG + (size_t)T_ALL * 512 * 2;
constexpr size_t WS_FZ  = WS_GY + (size_t)T_ALL * 512 * 2;
constexpr size_t WS_XB  = WS_FZ + (size_t)T_ALL * 512 * 4;
constexpr size_t WS_LT  = WS_XB + (size_t)T_ALL * 512 * 4;
constexpr size_t WS_END = WS_LT + (size_t)1024 * 16384 * 2;
constexpr size_t WS_BAR = WS_END;
constexpr size_t WS_END2 = WS_BAR + 16384;
static_assert(WS_END2 <= 268435456, "workspace budget");
static_assert(WS_B1 + (size_t)T_ALL * 1024 * 2 <= WS_END, "B1 inside R");

constexpr int LDS_BYTES = 131072 + 64;

typedef __bf16 nbf16x2 __attribute__((ext_vector_type(2)));
typedef float f32x2 __attribute__((ext_vector_type(2)));
__device__ __forceinline__ unsigned cvt_pk_bf16(float lo, float hi) { const nbf16x2 r = __builtin_convertvector((f32x2){lo, hi}, nbf16x2); return __builtin_bit_cast(unsigned, r); }
__device__ __forceinline__ bf16_t f2bf(float f) { return (bf16_t)(cvt_pk_bf16(f, 0.f) & 0xffffu); }
__device__ __forceinline__ float bf2f(bf16_t b) { return __uint_as_float(((unsigned)b) << 16); }
__device__ __forceinline__ float bflo(unsigned w) { return __uint_as_float(w << 16); }
__device__ __forceinline__ float bfhi(unsigned w) { return __uint_as_float(w & 0xffff0000u); }
__device__ __forceinline__ float sigm(float x) { return __builtin_amdgcn_rcpf(1.f + __expf(-x)); }
__device__ __forceinline__ float rowscale(const float* ss, int row) {
    const f32x4* p = (const f32x4*)(ss + (size_t)row * 16);
    const f32x4 a = p[0], b = p[1], c = p[2], d = p[3];
    const float s = (((a.x + a.y) + (a.z + a.w)) + ((b.x + b.y) + (b.z + b.w))) + (((c.x + c.y) + (c.z + c.w)) + ((d.x + d.y) + (d.z + d.w)));
    return rsqrtf(s * (1.f / 1024.f) + EPS);
}
__device__ __forceinline__ void rowscale8(const float* ss, int row0, int fq, float (&rs)[8]) {
    f32x4 q[8];
#pragma unroll
    for (int i = 0; i < 8; ++i) q[i] = *(const f32x4*)(ss + (size_t)(row0 + (i >> 2) * 128 + (i & 3) * 16) * 16 + 4 * fq);
#pragma unroll
    for (int i = 0; i < 8; ++i) { float t = (q[i].x + q[i].y) + (q[i].z + q[i].w); t += __shfl_xor(t, 16); t += __shfl_xor(t, 32); rs[i] = rsqrtf(t * (1.f / 1024.f) + EPS); }
}
__device__ __forceinline__ float wave_sum(float v) {
#pragma unroll
    for (int o = 1; o < 64; o <<= 1) v += __shfl_xor(v, o);
    return v;
}
#define LDS_WAIT() asm volatile("s_waitcnt lgkmcnt(0)" ::: "memory")

namespace pg8 {
constexpr int BM = 256, BK = 64, HALF = 128, HTB = HALF * BK * 2, STAGE_BYTES = 8 * HTB, NXCD = 8, WGM = 8;
__host__ __device__ __forceinline__ int lds_byte(int r, int c) { const int st = (r >> 4) * 2 + (c >> 5), rr = r & 15, cc = c & 31, ob = rr * 64 + cc * 2; return st * 1024 + (ob ^ (((ob >> 9) & 1) << 5)); }
__host__ __device__ __forceinline__ void stage_rc(int b, int& R, int& C) { const int st = b / 1024, sb = b % 1024, swz = sb ^ (((sb >> 9) & 1) << 5); R = (st >> 1) * 16 + swz / 64; C = (st & 1) * 32 + (swz % 64) / 2; }
__host__ __device__ __forceinline__ int perm32(int rho) { const int n = rho >> 4, i = rho & 15; return 8 * (i >> 2) + 4 * n + (i & 3); }
struct Unit { int pm, pn; };
struct Gemm { const bf16_t* A; const bf16_t* Bt; int M, N, K; };
struct StaticOrder {
    int nM, nN, nwg, G, c;
    __host__ __device__ void init(int M, int N, int G_, int c_) { nM = M / BM; nN = N / BM; nwg = nM * nN; G = G_; c = c_; }
    __host__ __device__ bool next(int i, Unit& u) const {
        const long L = (long)i * G + c; if (L >= nwg) return false;
        int wgid = (int)L; { const int q = nwg / NXCD, r = nwg % NXCD, xcd = wgid % NXCD, off = wgid / NXCD; wgid = (xcd < r ? xcd * (q + 1) : r * (q + 1) + (xcd - r) * q) + off; }
        const int nig = WGM * nN, gid = wgid / nig, fm = gid * WGM, gsz = (nM - fm) < WGM ? (nM - fm) : WGM;
        u.pm = fm + ((wgid % nig) % gsz); u.pn = (wgid % nig) / gsz; return true;
    }
    __device__ __forceinline__ void a_ready(const Unit&) const {}
    __device__ __forceinline__ void done(const Unit&) const {}
};

template <class Epi, class Sched, bool ALIGN_EPI = false, bool SP2 = false>
__device__ __forceinline__ void gemm_phase(LAS unsigned char* lds, const Gemm g, const Sched& S, const Epi& E) {
    const int tid = threadIdx.x, wid = __builtin_amdgcn_readfirstlane(tid >> 6), lane = tid & 63, wr = wid >> 2, wc = wid & 3, fr = lane & 15, fq = lane >> 4;
    const int K = g.K, nt = K / BK;
    unsigned voffA[2], voffB[2];
#pragma unroll
    for (int i = 0; i < 2; ++i) { int R, C; stage_rc(tid * 16 + i * 8192, R, C); const int Rb = Epi::PERM ? ((R & ~31) + perm32(R & 31)) : R;
        voffA[i] = (unsigned)(R * K + C) * 2u; voffB[i] = (unsigned)(Rb * K + C) * 2u; }
    const size_t kstep = (size_t)(BK * 2);
    const size_t hstep = (size_t)HALF * K * 2;
    const size_t tstep = 2 * hstep;
    const unsigned ldsw = (unsigned)wid * 1024u;
    const int aoff = lds_byte(wr * 64 + fr, fq * 8), boff = lds_byte(wc * 32 + fr, fq * 8);
#define PG8_SA(b, h) (((b) * 2 + (h)) * HTB)
#define PG8_SB(b, h) ((4 + (b) * 2 + (h)) * HTB)
#define PG8_STAGE(bufoff, gbase, voff) do { _Pragma("unroll") for (int _i = 0; _i < 2; ++_i) \
        __builtin_amdgcn_global_load_lds((const unsigned*)((const char*)(gbase) + (voff)[_i]), (LAS unsigned*)(lds + (bufoff) + ldsw + _i * 8192), 16, 0, 0); } while (0)
#define PG8_LDA(dst, b, h) do { _Pragma("unroll") for (int m = 0; m < 4; ++m) _Pragma("unroll") for (int k = 0; k < 2; ++k) dst[m][k] = *(const LAS bf16x8*)(lds + PG8_SA(b, h) + aoff + m * 2048 + k * 1024); } while (0)
#define PG8_LDB(dst, b, h) do { _Pragma("unroll") for (int n = 0; n < 2; ++n) _Pragma("unroll") for (int k = 0; k < 2; ++k) dst[n][k] = *(const LAS bf16x8*)(lds + PG8_SB(b, h) + boff + n * 2048 + k * 1024); } while (0)
#define PG8_MMA(ai, bj, At, Bt) do { __builtin_amdgcn_s_setprio(1); _Pragma("unroll") for (int m = 0; m < 4; ++m) _Pragma("unroll") for (int n = 0; n < 2; ++n) _Pragma("unroll") for (int k = 0; k < 2; ++k) \
        acc[ai][bj][m][n] = __builtin_amdgcn_mfma_f32_16x16x32_bf16(Bt[n][k], At[m][k], acc[ai][bj][m][n], 0, 0, 0); __builtin_amdgcn_s_setprio(0); } while (0)
#define PG8_WAIT_V(n) asm volatile("s_waitcnt vmcnt(" #n ")" ::: "memory")
#define PG8_WAIT_L(n) asm volatile("s_waitcnt lgkmcnt(" #n ")" ::: "memory")
#define PG8_BAR __builtin_amdgcn_s_barrier()
#define PG8_SCHED __builtin_amdgcn_sched_barrier(0)
    Unit cur, nxt; int ui = 0;
    if (!S.next(0, cur)) return;
    f32x4 acc[2][2][4][2];
#pragma unroll
    for (int a = 0; a < 2; ++a)
#pragma unroll
        for (int b = 0; b < 2; ++b)
#pragma unroll
            for (int m = 0; m < 4; ++m)
#pragma unroll
                for (int n = 0; n < 2; ++n) acc[a][b][m][n] = (f32x4){0.f, 0.f, 0.f, 0.f};
    bf16x8 At[4][2], B0[2][2], B1[2][2];
    const char* cA = (const char*)g.A + (size_t)cur.pm * tstep; const char* cB = (const char*)g.Bt + (size_t)cur.pn * tstep;
    S.a_ready(cur);
    if constexpr (SP2) {
        PG8_STAGE(PG8_SB(0, 0), cB, voffB); PG8_STAGE(PG8_SB(0, 1), cB + hstep, voffB); PG8_STAGE(PG8_SA(0, 0), cA, voffA); PG8_STAGE(PG8_SA(0, 1), cA + hstep, voffA);
        if (wr == 1) PG8_BAR;
        PG8_WAIT_V(2); PG8_BAR;
        PG8_STAGE(PG8_SB(1, 0), cB + kstep, voffB); PG8_STAGE(PG8_SA(1, 0), cA + kstep, voffA); PG8_STAGE(PG8_SB(1, 1), cB + hstep + kstep, voffB);
        PG8_WAIT_V(6); PG8_BAR;
    } else {
        PG8_STAGE(PG8_SB(0, 0), cB, voffB); PG8_STAGE(PG8_SA(0, 0), cA, voffA); PG8_STAGE(PG8_SB(0, 1), cB + hstep, voffB); PG8_STAGE(PG8_SA(0, 1), cA + hstep, voffA);
        if (wr == 1) PG8_BAR;
        PG8_WAIT_V(4); PG8_BAR;
        PG8_STAGE(PG8_SB(1, 0), cB + kstep, voffB); PG8_STAGE(PG8_SA(1, 0), cA + kstep, voffA); PG8_STAGE(PG8_SB(1, 1), cB + hstep + kstep, voffB);
        PG8_WAIT_V(6); PG8_BAR;
    }
    for (;;) {
        const bool has_next = S.next(ui + 1, nxt);
        const char* nA = has_next ? (const char*)g.A + (size_t)nxt.pm * tstep : cA; const char* nB = has_next ? (const char*)g.Bt + (size_t)nxt.pn * tstep : cB;
        for (int t = 0; t < nt; t += 2) {
            const bool last = (t == nt - 2);
            const char* a1 = cA + (size_t)(t + 1) * kstep;
            const char* a2 = last ? nA : cA + (size_t)(t + 2) * kstep; const char* b2 = last ? nB : cB + (size_t)(t + 2) * kstep;
            const char* a3 = a2 + kstep; const char* b3 = b2 + kstep;
            if (last && has_next) S.a_ready(nxt);
            if constexpr (SP2) {
            PG8_LDB(B0, 0, 0); PG8_LDB(B1, 0, 1); PG8_SCHED; PG8_LDA(At, 0, 0); PG8_STAGE(PG8_SA(1, 1), a1 + hstep, voffA);
            PG8_WAIT_V(8); PG8_WAIT_L(0); PG8_BAR; PG8_MMA(0, 0, At, B0); PG8_MMA(0, 1, At, B1); PG8_BAR; PG8_SCHED;
            PG8_LDA(At, 0, 1); PG8_STAGE(PG8_SB(0, 0), b2, voffB); PG8_STAGE(PG8_SB(0, 1), b2 + hstep, voffB); PG8_STAGE(PG8_SA(0, 0), a2, voffA);
            PG8_WAIT_V(8); PG8_WAIT_L(0); PG8_BAR; PG8_MMA(1, 0, At, B0); PG8_MMA(1, 1, At, B1); PG8_BAR; PG8_SCHED;
            PG8_LDB(B0, 1, 0); PG8_LDB(B1, 1, 1); PG8_SCHED; PG8_LDA(At, 1, 0); PG8_STAGE(PG8_SA(0, 1), a2 + hstep, voffA);
            PG8_WAIT_V(8); PG8_WAIT_L(0); PG8_BAR; PG8_MMA(0, 0, At, B0); PG8_MMA(0, 1, At, B1); PG8_BAR; PG8_SCHED;
            PG8_LDA(At, 1, 1); PG8_STAGE(PG8_SB(1, 0), b3, voffB); PG8_STAGE(PG8_SB(1, 1), b3 + hstep, voffB); PG8_STAGE(PG8_SA(1, 0), a3, voffA);
            PG8_WAIT_V(8); PG8_WAIT_L(0); PG8_BAR; PG8_MMA(1, 0, At, B0); PG8_MMA(1, 1, At, B1); PG8_BAR; PG8_SCHED;
            } else {
            PG8_LDB(B0, 0, 0); PG8_SCHED; PG8_LDA(At, 0, 0); PG8_STAGE(PG8_SA(1, 1), a1 + hstep, voffA);
            PG8_WAIT_L(8); PG8_BAR; PG8_WAIT_L(0); PG8_MMA(0, 0, At, B0); PG8_BAR; PG8_SCHED;
            PG8_LDB(B1, 0, 1); PG8_STAGE(PG8_SB(0, 0), b2, voffB);
            PG8_BAR; PG8_WAIT_L(0); PG8_MMA(0, 1, At, B1); PG8_BAR;
            PG8_LDA(At, 0, 1); PG8_STAGE(PG8_SA(0, 0), a2, voffA);
            PG8_BAR; PG8_WAIT_L(0); PG8_MMA(1, 0, At, B0); PG8_BAR; PG8_SCHED;
            PG8_STAGE(PG8_SB(0, 1), b2 + hstep, voffB);
            PG8_WAIT_V(6); PG8_BAR; PG8_MMA(1, 1, At, B1); PG8_BAR;
            PG8_LDB(B0, 1, 0); PG8_SCHED; PG8_LDA(At, 1, 0); PG8_STAGE(PG8_SA(0, 1), a2 + hstep, voffA);
            PG8_WAIT_L(8); PG8_BAR; PG8_WAIT_L(0); PG8_MMA(0, 0, At, B0); PG8_BAR; PG8_SCHED;
            PG8_LDB(B1, 1, 1); PG8_STAGE(PG8_SB(1, 0), b3, voffB);
            PG8_BAR; PG8_WAIT_L(0); PG8_MMA(0, 1, At, B1); PG8_BAR;
            PG8_LDA(At, 1, 1); PG8_STAGE(PG8_SA(1, 0), a3, voffA);
            PG8_BAR; PG8_WAIT_L(0); PG8_MMA(1, 0, At, B0); PG8_BAR; PG8_SCHED;
            PG8_STAGE(PG8_SB(1, 1), b3 + hstep, voffB);
            PG8_WAIT_V(6); PG8_BAR; PG8_MMA(1, 1, At, B1); PG8_BAR;
            }
        }
        if constexpr (ALIGN_EPI) { if (wr == 0) PG8_BAR; }
        E(acc, cur, wr, wc, fr, fq); S.done(cur);
        if (!has_next) break;
#pragma unroll
        for (int a = 0; a < 2; ++a)
#pragma unroll
            for (int b = 0; b < 2; ++b)
#pragma unroll
                for (int m = 0; m < 4; ++m)
#pragma unroll
                    for (int n = 0; n < 2; ++n) acc[a][b][m][n] = (f32x4){0.f, 0.f, 0.f, 0.f};
        cur = nxt; cA = nA; cB = nB; ++ui;
        if constexpr (ALIGN_EPI) { if (wr == 1) PG8_BAR; }
    }
    PG8_WAIT_V(0);
    if constexpr (!ALIGN_EPI) { if (wr == 0) PG8_BAR; }
    PG8_BAR;
#undef PG8_SA
#undef PG8_SB
#undef PG8_STAGE
#undef PG8_LDA
#undef PG8_LDB
#undef PG8_MMA
#undef PG8_WAIT_V
#undef PG8_WAIT_L
#undef PG8_BAR
#undef PG8_SCHED
}
}

#ifndef PG8_SP2
#define PG8_SP2 true
#endif
#ifndef PG8_ALIGN
#define PG8_ALIGN true
#endif

struct EpiGateUp {
    static constexpr bool PERM = true;
    bf16_t* H; const float* ss;
    __device__ __forceinline__ void operator()(const f32x4 (&acc)[2][2][4][2], const pg8::Unit& u, int wr, int wc, int fr, int fq) const {
        const int row0 = u.pm * 256 + wr * 64 + fr, col0 = u.pn * 128 + wc * 32 + 8 * fq;
        float rsv[8]; rowscale8(ss, row0, fq, rsv);
#pragma unroll
        for (int ai = 0; ai < 2; ++ai)
#pragma unroll
            for (int m = 0; m < 4; ++m) {
                const int row = row0 + ai * 128 + m * 16; const float rs = rsv[ai * 4 + m];
                float h[8];
#pragma unroll
                for (int n = 0; n < 2; ++n)
#pragma unroll
                    for (int j = 0; j < 4; ++j) { const float g = acc[ai][0][m][n][j] * rs, up = acc[ai][1][m][n][j] * rs; h[n * 4 + j] = g * sigm(g) * up; }
                u32x4 w; w.x = cvt_pk_bf16(h[0], h[1]); w.y = cvt_pk_bf16(h[2], h[3]); w.z = cvt_pk_bf16(h[4], h[5]); w.w = cvt_pk_bf16(h[6], h[7]);
                *(u32x4*)(H + (size_t)row * DFF + col0) = w;
            }
    }
};
struct EpiResid {
    static constexpr bool PERM = true;
    const float* xin_p; const float* xin_s; float* xout; bf16_t* ax; const float* gnext; float* ssout; float scale;
    __device__ __forceinline__ void operator()(const f32x4 (&acc)[2][2][4][2], const pg8::Unit& u, int wr, int wc, int fr, int fq) const {
        const int row0 = u.pm * 256 + wr * 64 + fr, col0 = u.pn * 256 + wc * 32 + 8 * fq;
        const float* xb = (u.pm < 64) ? xin_p : (xin_s - (size_t)TP * DM);
        f32x4 gn[2][2];
#pragma unroll
        for (int bj = 0; bj < 2; ++bj)
#pragma unroll
            for (int n = 0; n < 2; ++n) gn[bj][n] = ax ? *(const f32x4*)(gnext + col0 + bj * 128 + 4 * n) : (f32x4){1.f, 1.f, 1.f, 1.f};
#pragma unroll
        for (int ai = 0; ai < 2; ++ai) {
            f32x4 xr[4][2][2];
#pragma unroll
            for (int m = 0; m < 4; ++m)
#pragma unroll
                for (int bj = 0; bj < 2; ++bj) { const float* px = xb + (size_t)(row0 + ai * 128 + m * 16) * DM + col0 + bj * 128; xr[m][bj][0] = *(const f32x4*)px; xr[m][bj][1] = *(const f32x4*)(px + 4); }
#pragma unroll
            for (int m = 0; m < 4; ++m) {
                const int row = row0 + ai * 128 + m * 16; const size_t off = (size_t)row * DM + col0; float sq = 0.f;
#pragma unroll
                for (int bj = 0; bj < 2; ++bj) {
                    const f32x4 x0 = xr[m][bj][0], x1 = xr[m][bj][1];
                    const f32x4 v0 = x0 + acc[ai][bj][m][0] * scale, v1 = x1 + acc[ai][bj][m][1] * scale;
                    *(f32x4*)(xout + off + bj * 128) = v0; *(f32x4*)(xout + off + bj * 128 + 4) = v1;
                    sq += ((v0[0] * v0[0] + v0[1] * v0[1]) + (v0[2] * v0[2] + v0[3] * v0[3])) + ((v1[0] * v1[0] + v1[1] * v1[1]) + (v1[2] * v1[2] + v1[3] * v1[3]));
                    if (ax) { const f32x4 a0 = v0 * gn[bj][0], a1 = v1 * gn[bj][1];
                        u32x4 w; w.x = cvt_pk_bf16(a0[0], a0[1]); w.y = cvt_pk_bf16(a0[2], a0[3]); w.z = cvt_pk_bf16(a1[0], a1[1]); w.w = cvt_pk_bf16(a1[2], a1[3]);
                        *(u32x4*)(ax + off + bj * 128) = w; }
                }
                sq += __shfl_xor(sq, 16); sq += __shfl_xor(sq, 32);
                if (fq == 0) ssout[(size_t)row * 16 + u.pn * 4 + wc] = sq;
            }
        }
    }
};
struct EpiProj {
    static constexpr bool PERM = true;
    bf16_t *Q, *V, *SG, *GY; float *FZ, *XB; const float* ss;
    __device__ __forceinline__ void operator()(const f32x4 (&acc)[2][2][4][2], const pg8::Unit& u, int wr, int wc, int fr, int fq) const {
        const int seg = u.pn >> 1;
        const int row0 = u.pm * 256 + wr * 64 + fr, col0 = (u.pn & 1) * 256 + wc * 32 + 8 * fq;
        float* fdst = (seg == 1) ? FZ : XB;
        bf16_t* bdst = (seg == 0) ? Q : (seg == 2) ? V : (seg == 3) ? SG : GY;
        const bool isf = (seg == 1) || (seg == 4);
        float rsv[8]; rowscale8(ss, row0, fq, rsv);
#pragma unroll
        for (int ai = 0; ai < 2; ++ai)
#pragma unroll
            for (int m = 0; m < 4; ++m) {
                const int row = row0 + ai * 128 + m * 16; const float rs = rsv[ai * 4 + m]; const size_t off = (size_t)row * DH + col0;
#pragma unroll
                for (int bj = 0; bj < 2; ++bj) {
                    f32x4 v0 = acc[ai][bj][m][0] * rs, v1 = acc[ai][bj][m][1] * rs;
                    if (isf) { *(f32x4*)(fdst + off + bj * 128) = v0; *(f32x4*)(fdst + off + bj * 128 + 4) = v1; }
                    else {
                        float h[8] = {v0[0], v0[1], v0[2], v0[3], v1[0], v1[1], v1[2], v1[3]};
                        if (seg == 0) {
#pragma unroll
                            for (int j = 0; j < 8; ++j) h[j] = h[j] * sigm(h[j]);
                        } else if (seg == 3) {
#pragma unroll
                            for (int j = 0; j < 8; ++j) h[j] = sigm(h[j]);
                        } else if (seg == 5) {
#pragma unroll
                            for (int j = 0; j < 8; ++j) { const float y = h[j]; h[j] = y * sigm(1.5957691216f * (y + 0.044715f * y * y * y)); }
                        }
                        u32x4 w; w.x = cvt_pk_bf16(h[0], h[1]); w.y = cvt_pk_bf16(h[2], h[3]); w.z = cvt_pk_bf16(h[4], h[5]); w.w = cvt_pk_bf16(h[6], h[7]);
                        *(u32x4*)(bdst + off + bj * 128) = w;
                    }
                }
            }
    }
};


struct SmallResid {
    const float* xin; float* xout; bf16_t* ax; const float* gnext; float* ssout; float scale;
    __device__ __forceinline__ void apply(const f32x4& acc, int grow, int c, int cn, int c16, int r16, int fr, int fq, LAS unsigned char* lds) const {
        const size_t off = (size_t)grow * DM + c;
        const f32x4 x = *(const f32x4*)(xin + off);
        const f32x4 v = x + acc * scale;
        *(f32x4*)(xout + off) = v;
        float sq = (v[0] * v[0] + v[1] * v[1]) + (v[2] * v[2] + v[3] * v[3]);
        if (ax) { const f32x4 g = *(const f32x4*)(gnext + c); const f32x4 a = v * g; u32x2 w; w.x = cvt_pk_bf16(a[0], a[1]); w.y = cvt_pk_bf16(a[2], a[3]); *(u32x2*)(ax + off) = w; }
        sq += __shfl_xor(sq, 16); sq += __shfl_xor(sq, 32);
        LAS float* P = (LAS float*)lds;
        if (fq == 0) P[(r16 * 16 + fr) * 4 + c16] = sq;
        __syncthreads();
        if (c16 == 0 && fq == 0) { const LAS float* q = P + (r16 * 16 + fr) * 4; ssout[(size_t)grow * 16 + cn] = (q[0] + q[1]) + (q[2] + q[3]); }
        __syncthreads();
    }
};
struct SmallProj {
    bf16_t *Q, *V, *SG, *GY; float *FZ, *XB; const float* ss;
    __device__ __forceinline__ void apply(const f32x4& acc, int grow, int c, int cn, int c16, int r16, int fr, int fq, LAS unsigned char* lds) const {
        const int seg = cn >> 3, cs = c & 511;
        const float rs = rowscale(ss, grow);
        const f32x4 v = acc * rs;
        const size_t off = (size_t)grow * DH + cs;
        if (seg == 1 || seg == 4) { *(f32x4*)(((seg == 1) ? FZ : XB) + off) = v; }
        else {
            float h[4] = {v[0], v[1], v[2], v[3]};
            if (seg == 0) {
#pragma unroll
                for (int j = 0; j < 4; ++j) h[j] = h[j] * sigm(h[j]);
            } else if (seg == 3) {
#pragma unroll
                for (int j = 0; j < 4; ++j) h[j] = sigm(h[j]);
            } else if (seg == 5) {
#pragma unroll
                for (int j = 0; j < 4; ++j) { const float y = h[j]; h[j] = y * sigm(1.5957691216f * (y + 0.044715f * y * y * y)); }
            }
            bf16_t* bdst = (seg == 0) ? Q : (seg == 2) ? V : (seg == 3) ? SG : GY;
            u32x2 w; w.x = cvt_pk_bf16(h[0], h[1]); w.y = cvt_pk_bf16(h[2], h[3]);
            *(u32x2*)(bdst + off) = w;
        }
    }
};
template <class Epi, int K>
__device__ __forceinline__ void small_gemm(const bf16_t* A, const bf16_t* Bt, int N, const Epi& E, LAS unsigned char* lds) {
    const int tid = threadIdx.x, lane = tid & 63, wave = tid >> 6, fr = lane & 15, fq = lane >> 4, r16 = wave >> 2, c16 = wave & 3;
    constexpr int KW = K / 8, NS = KW / 32;
    const int nunits = 16 * (N / 64), G = gridDim.x;
    LAS f32x4* PB = (LAS f32x4*)lds;
    for (int u = G - 1 - (int)blockIdx.x; u < nunits; u += G) {
        const int rm = u & 15, cn = u >> 4;
        const bf16_t* ap = A + (size_t)(TP + rm * 32 + fr) * K + wave * KW + fq * 8;
        const bf16_t* bp = Bt + (size_t)(cn * 64 + fr) * K + wave * KW + fq * 8;
        f32x4 acc[2][4];
#pragma unroll
        for (int rr = 0; rr < 2; ++rr)
#pragma unroll
            for (int cc = 0; cc < 4; ++cc) acc[rr][cc] = (f32x4){0.f, 0.f, 0.f, 0.f};
#pragma unroll
        for (int s0 = 0; s0 < NS; s0 += 4) {
            bf16x8 a[4][2], b[4][4];
#pragma unroll
            for (int i = 0; i < 4; ++i) if (s0 + i < NS) {
#pragma unroll
                for (int rr = 0; rr < 2; ++rr) a[i][rr] = *(const bf16x8*)(ap + (size_t)rr * 16 * K + (s0 + i) * 32);
#pragma unroll
                for (int cc = 0; cc < 4; ++cc) b[i][cc] = *(const bf16x8*)(bp + (size_t)cc * 16 * K + (s0 + i) * 32);
            }
#pragma unroll
            for (int i = 0; i < 4; ++i) if (s0 + i < NS) {
#pragma unroll
                for (int rr = 0; rr < 2; ++rr)
#pragma unroll
                    for (int cc = 0; cc < 4; ++cc) acc[rr][cc] = __builtin_amdgcn_mfma_f32_16x16x32_bf16(b[i][cc], a[i][rr], acc[rr][cc], 0, 0, 0);
            }
        }
#pragma unroll
        for (int rr = 0; rr < 2; ++rr)
#pragma unroll
            for (int cc = 0; cc < 4; ++cc) PB[(wave * 8 + rr * 4 + cc) * 64 + lane] = acc[rr][cc];
        __syncthreads();
        f32x4 r = PB[(0 * 8 + wave) * 64 + lane];
#pragma unroll
        for (int w = 1; w < 8; ++w) r += PB[(w * 8 + wave) * 64 + lane];
        E.apply(r, TP + rm * 32 + r16 * 16 + fr, cn * 64 + c16 * 16 + 4 * fq, cn, c16, r16, fr, fq, lds + 65536);
        __syncthreads();
    }
}

#define XB_TMO      128
#define XB_XCNT(j)  (256  + 64 * (j))
#define XB_XSUB(j)  (1280 + 64 * (j))
#define XB_XGEN(j)  (2304 + 64 * (j))
#define XB_TOP      3328
#define XB_TOPGEN   3392
#define XCD_BAR_WORDS 3456
#define XB_SPIN_CAP (1u << 22)
__device__ __forceinline__ unsigned xb_ld(unsigned* p)              { return __hip_atomic_load(p, __ATOMIC_RELAXED, __HIP_MEMORY_SCOPE_AGENT); }
__device__ __forceinline__ unsigned xb_add(unsigned* p, unsigned v) { return __hip_atomic_fetch_add(p, v, __ATOMIC_RELAXED, __HIP_MEMORY_SCOPE_AGENT); }
__device__ __forceinline__ unsigned xb_xcc_id() { return (unsigned)__builtin_amdgcn_s_getreg((3 << 11) | 20) & 0xFu; }
#define XB_SPIN(cond, bar) do { unsigned _sp = 0; while (cond) { __builtin_amdgcn_s_sleep(1); \
    if ((++_sp & 255u) == 0u) { if (xb_ld(&(bar)[XB_TMO])) break; if (_sp > XB_SPIN_CAP) { atomicAdd(&(bar)[XB_TMO], 1u); break; } } } } while (0)
struct XcdBarrier { unsigned* bar; unsigned x; volatile LAS unsigned* st; };
__device__ __forceinline__ XcdBarrier xcd_barrier_post(unsigned* bar, volatile LAS unsigned* st) {
    XcdBarrier b; b.bar = bar; b.x = xb_xcc_id(); b.st = st;
    if (threadIdx.x == 0) (void)xb_add(&bar[XB_XCNT(b.x)], 1u);
    return b;
}
__device__ __forceinline__ void xcd_barrier_complete(unsigned* bar, unsigned x, unsigned& nloc, unsigned& nx) {
    const unsigned G = gridDim.x * gridDim.y * gridDim.z;
    unsigned sum, cnt, mine, sp = 0u;
    for (;;) {
        sum = 0u; cnt = 0u; mine = 0u;
#pragma unroll
        for (unsigned j = 0; j < 16; ++j) { const unsigned c = xb_ld(&bar[XB_XCNT(j)]); sum += c; cnt += (c > 0u) ? 1u : 0u; mine = (j == x) ? c : mine; }
        if (sum == G) break;
        __builtin_amdgcn_s_sleep(1);
        if ((++sp & 255u) == 0u) { if (xb_ld(&bar[XB_TMO])) break; if (sp > XB_SPIN_CAP) { atomicAdd(&bar[XB_TMO], 1u); break; } }
    }
    nloc = mine > 0u ? mine : 1u; nx = cnt > 0u ? cnt : 1u;
}
__device__ __forceinline__ void xcd_barrier(const XcdBarrier& b) {
    asm volatile("s_waitcnt vmcnt(0) lgkmcnt(0)" ::: "memory");
    __syncthreads();
    if (threadIdx.x == 0) {
        unsigned* bar = b.bar;
        __builtin_amdgcn_s_waitcnt(0);
        unsigned nloc = b.st[0], nx = b.st[1];
        if (nloc == 0u) { xcd_barrier_complete(bar, b.x, nloc, nx); b.st[0] = nloc; b.st[1] = nx; }
        const unsigned old = xb_add(&bar[XB_XSUB(b.x)], 1u);
        const unsigned gen = old / nloc;
        if (old + 1u == (gen + 1u) * nloc) {
            __builtin_amdgcn_fence(__ATOMIC_RELEASE, "agent");
            asm volatile("s_waitcnt vmcnt(0)" ::: "memory");
            const unsigned og = xb_add(&bar[XB_TOP], 1u);
            const unsigned tg = og / nx;
            if (og + 1u == (tg + 1u) * nx) xb_add(&bar[XB_TOPGEN], 1u);
            else XB_SPIN(xb_ld(&bar[XB_TOPGEN]) == tg, bar);
            __builtin_amdgcn_fence(__ATOMIC_ACQUIRE, "agent");
            xb_add(&bar[XB_XGEN(b.x)], 1u);
            asm volatile("s_waitcnt vmcnt(0)" ::: "memory");
        } else {
            XB_SPIN(xb_ld(&bar[XB_XGEN(b.x)]) == gen, bar);
            __builtin_amdgcn_fence(__ATOMIC_ACQUIRE, "agent");
            asm volatile("s_waitcnt vmcnt(0)" ::: "memory");
        }
    }
    __syncthreads();
}

struct Params { const float* in[26]; float* out; unsigned char* ws; int ph_lo, ph_hi; };

__device__ __forceinline__ void transpose_item(const float* W, int K, int N, bf16_t* WT, int dst_row0, LAS float* scr, int k0, int n0, int lane) {
    float wv[32];
#pragma unroll
    for (int i = 0; i < 32; ++i) wv[i] = W[(size_t)(k0 + 2 * i + (lane >> 5)) * N + n0 + (lane & 31)];
#pragma unroll
    for (int i = 0; i < 32; ++i) scr[(2 * i + (lane >> 5)) * 33 + (lane & 31)] = wv[i];
    LDS_WAIT();
    const int c = lane & 7;
#pragma unroll
    for (int j = 0; j < 4; ++j) { const int n = (lane >> 3) + 8 * j; const LAS float* s = scr + (8 * c) * 33 + n;
        u32x4 o; o.x = cvt_pk_bf16(s[0 * 33], s[1 * 33]); o.y = cvt_pk_bf16(s[2 * 33], s[3 * 33]); o.z = cvt_pk_bf16(s[4 * 33], s[5 * 33]); o.w = cvt_pk_bf16(s[6 * 33], s[7 * 33]);
        *(u32x4*)(WT + (size_t)(dst_row0 + n) * K + k0 + 8 * c) = o; }
    LDS_WAIT();
}
__device__ __forceinline__ void transpose_mat(const float* W, int K, int N, bf16_t* WT, int mode, LAS float* scr, int item, int lane) {
    const int nblk = N / 32, kb = item / nblk, nb = item % nblk, n0 = 32 * nb;
    const int dst = (mode == 0) ? n0 : (256 * (n0 >> 7) + (n0 & 127) + (mode == 2 ? 128 : 0));
    transpose_item(W, K, N, WT, dst, scr, 64 * kb, n0, lane);
}

__device__ __forceinline__ void phase0(const Params& p, LAS unsigned char* lds) {
    const int tid = threadIdx.x, lane = tid & 63, wave = tid >> 6;
    const int G = gridDim.x, gw = blockIdx.x * 8 + wave, NGW = G * 8;
    unsigned char* ws = p.ws;
    LAS float* scr = (LAS float*)(lds + wave * 16384);
    constexpr int I_GU = 16 * 88, I_D = 44 * 32, I_IN = 16 * 96, I_O = 16 * 32;
    constexpr int NIT = 4 * I_GU + 2 * I_D + I_IN + I_O;
    for (int it = gw; it < NIT; it += NGW) {
        int r = it;
        if (r < I_GU) { transpose_mat(p.in[6], 1024, 2816, (bf16_t*)(ws + WS_WG1), 1, scr, r, lane); continue; } r -= I_GU;
        if (r < I_GU) { transpose_mat(p.in[7], 1024, 2816, (bf16_t*)(ws + WS_WG1), 2, scr, r, lane); continue; } r -= I_GU;
        if (r < I_D)  { transpose_mat(p.in[8], 2816, 1024, (bf16_t*)(ws + WS_WD1), 0, scr, r, lane); continue; } r -= I_D;
        if (r < I_IN) { transpose_mat(p.in[10], 1024, 3072, (bf16_t*)(ws + WS_WIN), 0, scr, r, lane); continue; } r -= I_IN;
        if (r < I_O)  { transpose_mat(p.in[20], 1024, 1024, (bf16_t*)(ws + WS_WO), 0, scr, r, lane); continue; } r -= I_O;
        if (r < I_GU) { transpose_mat(p.in[22], 1024, 2816, (bf16_t*)(ws + WS_WG2), 1, scr, r, lane); continue; } r -= I_GU;
        if (r < I_GU) { transpose_mat(p.in[23], 1024, 2816, (bf16_t*)(ws + WS_WG2), 2, scr, r, lane); continue; } r -= I_GU;
        transpose_mat(p.in[24], 2816, 1024, (bf16_t*)(ws + WS_WD2), 0, scr, r, lane);
    }
    for (int e = blockIdx.x * 512 + tid; e < 2 * 32768; e += G * 512) {
        const int which = e >> 15, r = e & 32767, n = r >> 12, j = (r >> 6) & 63, i = r & 63;
        const float* W = which ? p.in[17] : p.in[15];
        bf16_t* WT = (bf16_t*)(ws + (which ? WS_WXT : WS_WAT));
        WT[r] = f2bf(W[(n * 64 + i) * 64 + j]);
    }
    bf16_t* A1 = (bf16_t*)(ws + WS_B0); float* SS0 = (float*)(ws + WS_SS0);
    const float* g1 = p.in[5];
    f32x4 gv[4];
#pragma unroll
    for (int j = 0; j < 4; ++j) gv[j] = ((const f32x4*)g1)[lane + 64 * j];
    for (int row0 = gw; row0 < T_ALL; row0 += 3 * NGW) {
        f32x4 v[3][4];
#pragma unroll
        for (int r = 0; r < 3; ++r) { const int row = row0 + r * NGW; if (row < T_ALL) {
            const float* xr = (row < TP) ? p.in[0] + (size_t)row * DM : p.in[1] + (size_t)(row - TP) * DM;
#pragma unroll
            for (int j = 0; j < 4; ++j) v[r][j] = ((const f32x4*)xr)[lane + 64 * j]; } }
#pragma unroll
        for (int r = 0; r < 3; ++r) { const int row = row0 + r * NGW; if (row < T_ALL) {
            float s = 0.f;
#pragma unroll
            for (int j = 0; j < 4; ++j) s += (v[r][j].x * v[r][j].x + v[r][j].y * v[r][j].y) + (v[r][j].z * v[r][j].z + v[r][j].w * v[r][j].w);
            s = wave_sum(s);
            u32x2* o8 = (u32x2*)(A1 + (size_t)row * DM);
#pragma unroll
            for (int j = 0; j < 4; ++j) { const f32x4 a = v[r][j] * gv[j]; u32x2 w; w.x = cvt_pk_bf16(a.x, a.y); w.y = cvt_pk_bf16(a.z, a.w); o8[lane + 64 * j] = w; }
            if (lane < 16) SS0[(size_t)row * 16 + lane] = (lane == 0) ? s : 0.f; } }
    }
}

__device__ __forceinline__ void phase_final(const Params& p) {
    const int tid = threadIdx.x, lane = tid & 63, wave = tid >> 6;
    const int gw = blockIdx.x * 8 + wave, NGW = gridDim.x * 8;
    const float* SS3 = (const float*)(p.ws + WS_SS3); const float* gf = p.in[25];
    f32x4 gv[4];
#pragma unroll
    for (int j = 0; j < 4; ++j) gv[j] = ((const f32x4*)gf)[lane + 64 * j];
    for (int row0 = gw; row0 < T_ALL; row0 += 3 * NGW) {
        f32x4 v[3][4]; float rs[3];
#pragma unroll
        for (int r = 0; r < 3; ++r) { const int row = row0 + r * NGW; if (row < T_ALL) {
            rs[r] = rowscale(SS3, row);
            const f32x4* xr = (const f32x4*)(p.out + (size_t)row * DM);
#pragma unroll
            for (int j = 0; j < 4; ++j) v[r][j] = xr[lane + 64 * j]; } }
#pragma unroll
        for (int r = 0; r < 3; ++r) { const int row = row0 + r * NGW; if (row < T_ALL) {
            f32x4* xr = (f32x4*)(p.out + (size_t)row * DM);
#pragma unroll
            for (int j = 0; j < 4; ++j) xr[lane + 64 * j] = v[r][j] * rs[r] * gv[j]; } }
    }
}

struct Mix {
    const bf16_t *Q, *V, *SG, *GY; const float *FZ, *XB; bf16_t* LT; float* DC; float *ACH, *UCH, *HST; bf16_t* O;
    const bf16_t *WAT, *WXT;
    const float *lb, *hnorm, *convw, *convb, *ba, *bx, *lam, *wa, *wx, *st_h, *st_l, *st_c;
    float* out;
};

struct HgrnScan { float cum[16]; float kk[16]; float last; };
__device__ __forceinline__ void hgrn_scan(const float (&fzv)[16], float lb, int k, int seg, LAS float* tot, HgrnScan& hs) {
    float run = 0.f;
#pragma unroll
    for (int i = 0; i < 16; ++i) {
        const float e = __expf(-fmaxf(fzv[i], -80.f));
        const float sg = __builtin_amdgcn_rcpf(1.f + e), sn = e * sg;
        const float f = lb + (1.f - lb) * sg;
        run += __logf(f); hs.cum[i] = run; hs.kk[i] = (1.f - lb) * sn;
    }
    tot[seg * 128 + k] = run;
    __syncthreads();
    float off = 0.f, all = 0.f;
#pragma unroll
    for (int s = 0; s < 4; ++s) { const float v = tot[s * 128 + k]; if (s < seg) off += v; all += v; }
#pragma unroll
    for (int i = 0; i < 16; ++i) hs.cum[i] += off;
    hs.last = all;
}

__device__ __forceinline__ void hgrn_local_unit(const Mix& M, int unit, LAS unsigned char* lds) {
    const int tid = threadIdx.x, lane = tid & 63, wave = tid >> 6, fr = lane & 15, fq = lane >> 4;
    const int h = unit & 3, bc = unit >> 2, t0 = bc * 64, cb = h * 128, k = tid & 127, seg = tid >> 7;
    LAS bf16_t* KT = (LAS bf16_t*)lds; LAS bf16_t* VT = (LAS bf16_t*)(lds + 18432); LAS float* tot = (LAS float*)(lds + 36864);
    float fzv[16]; unsigned vv[16];
    const size_t rb = (size_t)(t0 + seg * 16) * DH + cb + k;
#pragma unroll
    for (int i = 0; i < 16; ++i) { fzv[i] = M.FZ[rb + (size_t)i * DH]; vv[i] = M.V[rb + (size_t)i * DH]; }
    const float l0 = M.lb[cb + k], l1 = M.lb[512 + cb + k];
    const float lb = __builtin_amdgcn_rcpf(1.f + __expf(l1 - l0));
    HgrnScan hs; hgrn_scan(fzv, lb, k, seg, tot, hs);
    unsigned pk[8];
#pragma unroll
    for (int i = 0; i < 8; ++i) pk[i] = cvt_pk_bf16(hs.kk[2 * i] * __expf(hs.last - hs.cum[2 * i]), hs.kk[2 * i + 1] * __expf(hs.last - hs.cum[2 * i + 1]));
    *(LAS u32x4*)(KT + k * 72 + seg * 16) = (u32x4){pk[0], pk[1], pk[2], pk[3]};
    *(LAS u32x4*)(KT + k * 72 + seg * 16 + 8) = (u32x4){pk[4], pk[5], pk[6], pk[7]};
    *(LAS u32x4*)(VT + k * 72 + seg * 16) = (u32x4){vv[0] | (vv[1] << 16), vv[2] | (vv[3] << 16), vv[4] | (vv[5] << 16), vv[6] | (vv[7] << 16)};
    *(LAS u32x4*)(VT + k * 72 + seg * 16 + 8) = (u32x4){vv[8] | (vv[9] << 16), vv[10] | (vv[11] << 16), vv[12] | (vv[13] << 16), vv[14] | (vv[15] << 16)};
    if (seg == 0) M.DC[unit * 128 + k] = __expf(hs.last);
    __syncthreads();
    const bf16x8 a0 = *(const LAS bf16x8*)(VT + (16 * wave + fr) * 72 + fq * 8), a1 = *(const LAS bf16x8*)(VT + (16 * wave + fr) * 72 + 32 + fq * 8);
#pragma unroll
    for (int ct = 0; ct < 8; ++ct) {
        const bf16x8 b0 = *(const LAS bf16x8*)(KT + (16 * ct + fr) * 72 + fq * 8), b1 = *(const LAS bf16x8*)(KT + (16 * ct + fr) * 72 + 32 + fq * 8);
        f32x4 acc = {0.f, 0.f, 0.f, 0.f};
        acc = __builtin_amdgcn_mfma_f32_16x16x32_bf16(b0, a0, acc, 0, 0, 0);
        acc = __builtin_amdgcn_mfma_f32_16x16x32_bf16(b1, a1, acc, 0, 0, 0);
        u32x2 w; w.x = cvt_pk_bf16(acc[0], acc[1]); w.y = cvt_pk_bf16(acc[2], acc[3]);
        *(u32x2*)(M.LT + ((size_t)unit * 128 + 16 * wave + fr) * 128 + 16 * ct + 4 * fq) = w;
    }
    __syncthreads();
}

__device__ __forceinline__ void hgrn_out_unit(const Mix& M, int unit, LAS unsigned char* lds) {
    const int tid = threadIdx.x, lane = tid & 63, wave = tid >> 6, fr = lane & 15, fq = lane >> 4;
    const int h = unit & 3, bc = unit >> 2, t0 = bc * 64, cb = h * 128, k = tid & 127, seg = tid >> 7;
    LAS bf16_t* QS = (LAS bf16_t*)lds; LAS bf16_t* KS = (LAS bf16_t*)(lds + 17408); LAS bf16_t* VT = (LAS bf16_t*)(lds + 34816);
    LAS bf16_t* PS = (LAS bf16_t*)(lds + 53248); LAS float* tot = (LAS float*)(lds + 62464); LAS float* RS = (LAS float*)(lds + 64512);
    float fzv[16]; unsigned vv[16], qv[16];
    const size_t rb = (size_t)(t0 + seg * 16) * DH + cb + k;
#pragma unroll
    for (int i = 0; i < 16; ++i) { fzv[i] = M.FZ[rb + (size_t)i * DH]; vv[i] = M.V[rb + (size_t)i * DH]; qv[i] = M.Q[rb + (size_t)i * DH]; }
    bf16x8 bs[4];
#pragma unroll
    for (int ks = 0; ks < 4; ++ks) bs[ks] = *(const bf16x8*)(M.LT + ((size_t)unit * 128 + 16 * wave + fr) * 128 + ks * 32 + fq * 8);
    const int ocol = cb + 16 * wave + 4 * fq;
    u32x2 sgv[4];
#pragma unroll
    for (int tr = 0; tr < 4; ++tr) sgv[tr] = *(const u32x2*)(M.SG + (size_t)(t0 + 16 * tr + fr) * DH + ocol);
    const f32x4 gn = *(const f32x4*)(M.hnorm + ocol);
    const float l0 = M.lb[cb + k], l1 = M.lb[512 + cb + k];
    const float lb = __builtin_amdgcn_rcpf(1.f + __expf(l1 - l0));
    HgrnScan hs; hgrn_scan(fzv, lb, k, seg, tot, hs);
#pragma unroll
    for (int i = 0; i < 16; ++i) {
        const float q = __uint_as_float(qv[i] << 16);
        QS[(seg * 16 + i) * 136 + k] = f2bf(q * __expf(hs.cum[i]));
        KS[(seg * 16 + i) * 136 + k] = f2bf(hs.kk[i] * __expf(-hs.cum[i]));
    }
    *(LAS u32x4*)(VT + k * 72 + seg * 16) = (u32x4){vv[0] | (vv[1] << 16), vv[2] | (vv[3] << 16), vv[4] | (vv[5] << 16), vv[6] | (vv[7] << 16)};
    *(LAS u32x4*)(VT + k * 72 + seg * 16 + 8) = (u32x4){vv[8] | (vv[9] << 16), vv[10] | (vv[11] << 16), vv[12] | (vv[13] << 16), vv[14] | (vv[15] << 16)};
    __syncthreads();
#pragma unroll
    for (int r = 0; r < 2; ++r) {
        const int idx = wave + 8 * r, tr = idx >> 2, tc = idx & 3;
        f32x4 acc = {0.f, 0.f, 0.f, 0.f};
        if (tc <= tr) {
#pragma unroll
            for (int ks = 0; ks < 4; ++ks) {
                const bf16x8 a = *(const LAS bf16x8*)(QS + (16 * tr + fr) * 136 + ks * 32 + fq * 8), b = *(const LAS bf16x8*)(KS + (16 * tc + fr) * 136 + ks * 32 + fq * 8);
                acc = __builtin_amdgcn_mfma_f32_16x16x32_bf16(b, a, acc, 0, 0, 0);
            }
#pragma unroll
            for (int j = 0; j < 4; ++j) if (16 * tc + 4 * fq + j > 16 * tr + fr) acc[j] = 0.f;
        }
        u32x2 w; w.x = cvt_pk_bf16(acc[0], acc[1]); w.y = cvt_pk_bf16(acc[2], acc[3]);
        *(LAS u32x2*)(PS + (16 * tr + fr) * 72 + 16 * tc + 4 * fq) = w;
    }
    __syncthreads();
    bf16x8 bv[2];
#pragma unroll
    for (int ks = 0; ks < 2; ++ks) bv[ks] = *(const LAS bf16x8*)(VT + (16 * wave + fr) * 72 + ks * 32 + fq * 8);
    f32x4 o[4];
#pragma unroll
    for (int tr = 0; tr < 4; ++tr) {
        f32x4 acc = {0.f, 0.f, 0.f, 0.f};
#pragma unroll
        for (int ks = 0; ks < 2; ++ks) { const bf16x8 a = *(const LAS bf16x8*)(PS + (16 * tr + fr) * 72 + ks * 32 + fq * 8); acc = __builtin_amdgcn_mfma_f32_16x16x32_bf16(bv[ks], a, acc, 0, 0, 0); }
#pragma unroll
        for (int ks = 0; ks < 4; ++ks) { const bf16x8 a = *(const LAS bf16x8*)(QS + (16 * tr + fr) * 136 + ks * 32 + fq * 8); acc = __builtin_amdgcn_mfma_f32_16x16x32_bf16(bs[ks], a, acc, 0, 0, 0); }
        o[tr] = acc;
        float ss = (acc[0] * acc[0] + acc[1] * acc[1]) + (acc[2] * acc[2] + acc[3] * acc[3]);
        ss += __shfl_xor(ss, 16); ss += __shfl_xor(ss, 32);
        if (fq == 0) RS[wave * 64 + 16 * tr + fr] = ss;
    }
    __syncthreads();
#pragma unroll
    for (int tr = 0; tr < 4; ++tr) {
        const int tl = 16 * tr + fr; float tt = 0.f;
#pragma unroll
        for (int w = 0; w < 8; ++w) tt += RS[w * 64 + tl];
        const float rinv = rsqrtf(tt * (1.f / 128.f) + EPS);
        const u32x2 sg = sgv[tr];
        u32x2 w;
        w.x = cvt_pk_bf16(o[tr][0] * rinv * gn[0] * bflo(sg.x), o[tr][1] * rinv * gn[1] * bfhi(sg.x));
        w.y = cvt_pk_bf16(o[tr][2] * rinv * gn[2] * bflo(sg.y), o[tr][3] * rinv * gn[3] * bfhi(sg.y));
        *(u32x2*)(M.O + (size_t)(t0 + tl) * DM + ocol) = w;
    }
    __syncthreads();
}

__device__ __forceinline__ void lru_unit(const Mix& M, int unit, int mode, LAS unsigned char* lds) {
    const int tid = threadIdx.x, lane = tid & 63, wave = tid >> 6, fr = lane & 15, fq = lane >> 4;
    const int n = unit & 7, bc = unit >> 3, c = bc & 31, b = bc >> 5, t0 = bc * 64, ch0 = n * 64;
    const int j = tid & 63, seg = tid >> 6, ch = ch0 + j;
    LAS float* XC32 = (LAS float*)lds; LAS bf16_t* XC16 = (LAS bf16_t*)(lds + 16640); LAS float* GR = (LAS float*)(lds + 25856); LAS float* GI = (LAS float*)(lds + 42496);
    LAS float* SEGA = (LAS float*)(lds + 59136); LAS float* SEGU = (LAS float*)(lds + 61184);
    const int tl0 = seg * 8; const bool first = (c == 0 && seg == 0);
    const float* xp = M.XB + (size_t)(t0 + tl0) * DH + ch;
    float xm3 = first ? 0.f : xp[-3 * DH], xm2 = first ? 0.f : xp[-2 * DH], xm1 = first ? 0.f : xp[-1 * DH];
    float xr[8];
#pragma unroll
    for (int i = 0; i < 8; ++i) xr[i] = xp[i * DH];
    const float w0 = M.convw[ch], w1 = M.convw[512 + ch], w2 = M.convw[1024 + ch], w3 = M.convw[1536 + ch], cbias = M.convb[ch];
    const int gate = wave >> 2, tr = wave & 3;
    const bf16_t* WT = (gate ? M.WXT : M.WAT) + n * 4096;
    const float* bias = (gate ? M.bx : M.ba) + ch0;
    bf16x8 wb[4][2]; float bbv[4];
#pragma unroll
    for (int ct = 0; ct < 4; ++ct) { wb[ct][0] = *(const bf16x8*)(WT + (16 * ct + fr) * 64 + fq * 8); wb[ct][1] = *(const bf16x8*)(WT + (16 * ct + fr) * 64 + 32 + fq * 8); bbv[ct] = bias[16 * ct + fr]; }
    const float lamv = M.lam[ch];
    float hin = (mode == 1) ? M.HST[(size_t)bc * 512 + ch] : 0.f;
    unsigned gyv[8];
    if (mode == 1) {
#pragma unroll
        for (int i = 0; i < 8; ++i) gyv[i] = M.GY[(size_t)(t0 + tl0 + i) * DH + ch];
    }
    float cpv = 0.f;
    if (mode == 1 && c == 31 && tid < 192) cpv = M.XB[(size_t)(b * SEQ + SEQ - 3 + (tid >> 6)) * DH + ch0 + j];
    float xcv[8];
#pragma unroll
    for (int i = 0; i < 8; ++i) {
        const float x = xr[i];
        const float xc = cbias + w0 * xm3 + w1 * xm2 + w2 * xm1 + w3 * x;
        xcv[i] = xc; XC16[(tl0 + i) * 72 + j] = f2bf(xc);
        xm3 = xm2; xm2 = xm1; xm1 = x;
    }
    __syncthreads();
    {
        LAS float* Gd = gate ? GI : GR;
        const bf16x8 a0 = *(const LAS bf16x8*)(XC16 + (16 * tr + fr) * 72 + fq * 8), a1 = *(const LAS bf16x8*)(XC16 + (16 * tr + fr) * 72 + 32 + fq * 8);
#pragma unroll
        for (int ct = 0; ct < 4; ++ct) {
            f32x4 acc = {0.f, 0.f, 0.f, 0.f};
            acc = __builtin_amdgcn_mfma_f32_16x16x32_bf16(a0, wb[ct][0], acc, 0, 0, 0);
            acc = __builtin_amdgcn_mfma_f32_16x16x32_bf16(a1, wb[ct][1], acc, 0, 0, 0);
#pragma unroll
            for (int jj = 0; jj < 4; ++jj) Gd[(16 * tr + 4 * fq + jj) * 65 + 16 * ct + fr] = sigm(acc[jj] + bbv[ct]);
        }
    }
    __syncthreads();
    const float sp = log1pf(__expf(-lamv));
    float av[8], uv[8]; float A = 1.f, U = 0.f;
#pragma unroll
    for (int i = 0; i < 8; ++i) {
        const int tl = tl0 + i; const float r = GR[tl * 65 + j], ig = GI[tl * 65 + j];
        const float la = -8.f * r * sp, a = __expf(la); float mult = sqrtf(fmaxf(1.f - a * a, 0.f));
        if (la > -0.05f) mult = sqrtf(-expm1f(2.f * la));
        if (c == 0 && tl == 0) mult = 1.f;
        const float u = mult * ig * xcv[i];
        av[i] = a; uv[i] = u; U = a * U + u; A *= a;
    }
    SEGA[seg * 64 + j] = A; SEGU[seg * 64 + j] = U;
    __syncthreads();
#pragma unroll
    for (int s = 0; s < 8; ++s) if (s < seg) hin = SEGA[s * 64 + j] * hin + SEGU[s * 64 + j];
    if (mode == 0) {
        if (seg == 7) { float At = 1.f;
#pragma unroll
            for (int s = 0; s < 8; ++s) At *= SEGA[s * 64 + j];
            M.ACH[(size_t)bc * 512 + ch] = At; M.UCH[(size_t)bc * 512 + ch] = A * hin + U; }
    } else {
        float hh = hin;
#pragma unroll
        for (int i = 0; i < 8; ++i) {
            hh = av[i] * hh + uv[i];
            M.O[(size_t)(t0 + tl0 + i) * DM + 512 + ch] = f2bf(hh * __uint_as_float(gyv[i] << 16));
        }
        if (c == 31 && seg == 7) M.out[OUT_LP + b * 512 + ch] = hh;
        if (c == 31 && tid < 192) M.out[OUT_CP + (size_t)(b * 3 + (tid >> 6)) * 512 + ch0 + j] = cpv;
    }
    __syncthreads();
}

__device__ __forceinline__ void hgrn_sample_unit(const Mix& M, int unit, LAS unsigned char* lds) {
    const int tid = threadIdx.x, lane = tid & 63, wave = tid >> 6;
    const int h = unit & 3, b = unit >> 2, cb = h * 128, tb = TP + b * 4;
    LAS float* SQ = (LAS float*)lds;
    LAS float* SK = SQ + 512;
    LAS float* SD = SK + 512;
    LAS float* SP = SD + 128;
    LAS float* OP = SP + 32;
    LAS float* RS = OP + 2048;
    const int v = tid & 127, kq = tid >> 7;
    const size_t sb = ((size_t)(b * 4 + h) * 128) * 128;
    float s0v[32];
#pragma unroll
    for (int kx = 0; kx < 32; ++kx) s0v[kx] = M.st_h[sb + (size_t)(kq * 32 + kx) * 128 + v];
    float vv[4];
#pragma unroll
    for (int s = 0; s < 4; ++s) vv[s] = bf2f(M.V[(size_t)(tb + s) * DH + cb + v]);
    const float sgo = bf2f(M.SG[(size_t)(tb + kq) * DH + cb + v]), hno = M.hnorm[cb + v];
    if (tid < 128) {
        const int k = tid;
        const float l0 = M.lb[cb + k], l1 = M.lb[512 + cb + k];
        const float lb = 1.f / (1.f + expf(l1 - l0));
        float cum[4], kk[4], qv[4]; float run = 0.f;
#pragma unroll
        for (int s = 0; s < 4; ++s) {
            const float fz = M.FZ[(size_t)(tb + s) * DH + cb + k];
            const float sg = 1.f / (1.f + expf(-fz)), sn = 1.f / (1.f + expf(fz));
            run += logf(lb + (1.f - lb) * sg); cum[s] = run; kk[s] = (1.f - lb) * sn;
            qv[s] = bf2f(M.Q[(size_t)(tb + s) * DH + cb + k]);
        }
#pragma unroll
        for (int s = 0; s < 4; ++s) { SQ[s * 128 + k] = qv[s] * expf(cum[s]); SK[s * 128 + k] = kk[s] * expf(cum[3] - cum[s]); }
        SD[k] = expf(cum[3]);
        float pr[10]; int c = 0;
#pragma unroll
        for (int t = 0; t < 4; ++t)
#pragma unroll
            for (int s = 0; s <= t; ++s) { pr[c] = qv[t] * kk[s] * expf(cum[t] - cum[s]); ++c; }
#pragma unroll
        for (int i = 0; i < 10; ++i) { const float v = wave_sum(pr[i]); if (lane == 0) SP[wave * 16 + i] = v; }
    }
    __syncthreads();
    {
        float o[4] = {0.f, 0.f, 0.f, 0.f};
#pragma unroll
        for (int kx = 0; kx < 32; ++kx) {
            const int k = kq * 32 + kx;
            const float s0 = s0v[kx];
            float sn = SD[k] * s0;
#pragma unroll
            for (int s = 0; s < 4; ++s) { o[s] += SQ[s * 128 + k] * s0; sn += SK[s * 128 + k] * vv[s]; }
            M.out[OUT_HS + sb + (size_t)k * 128 + v] = sn;
        }
#pragma unroll
        for (int s = 0; s < 4; ++s) OP[(kq * 4 + s) * 128 + v] = o[s];
    }
    __syncthreads();
    {
        const int t = kq;
        float ov = (OP[(0 * 4 + t) * 128 + v] + OP[(1 * 4 + t) * 128 + v]) + (OP[(2 * 4 + t) * 128 + v] + OP[(3 * 4 + t) * 128 + v]);
        const int base = t * (t + 1) / 2;
        for (int s = 0; s <= t; ++s) ov += (SP[base + s] + SP[16 + base + s]) * vv[s];
        const float ssq = wave_sum(ov * ov);
        if (lane == 0) RS[wave] = ssq;
        __syncthreads();
        const float tt = RS[2 * t] + RS[2 * t + 1];
        const float rinv = rsqrtf(tt * (1.f / 128.f) + EPS);
        const size_t tok = (size_t)(tb + t);
        M.O[tok * DM + cb + v] = f2bf(ov * rinv * hno * sgo);
    }
    __syncthreads();
}

__device__ __forceinline__ void lru_sample_unit(const Mix& M, int b, LAS unsigned char* lds) {
    const int tid = threadIdx.x, ch = tid, n = ch >> 6, j = ch & 63, tb = TP + b * 4;
    LAS float* XC = (LAS float*)lds;
    float x[7];
#pragma unroll
    for (int r = 0; r < 3; ++r) x[r] = M.st_c[(size_t)(b * 3 + r) * 512 + ch];
#pragma unroll
    for (int s = 0; s < 4; ++s) x[3 + s] = M.XB[(size_t)(tb + s) * DH + ch];
    const float w0 = M.convw[ch], w1 = M.convw[512 + ch], w2 = M.convw[1024 + ch], w3 = M.convw[1536 + ch], cbias = M.convb[ch];
    float xc[4];
#pragma unroll
    for (int s = 0; s < 4; ++s) { xc[s] = cbias + w0 * x[s] + w1 * x[s + 1] + w2 * x[s + 2] + w3 * x[s + 3]; XC[s * 512 + ch] = xc[s]; }
#pragma unroll
    for (int r = 0; r < 3; ++r) M.out[OUT_CS + (size_t)(b * 3 + r) * 512 + ch] = x[4 + r];
    __syncthreads();
    float ra[4], rx[4];
    const float ba = M.ba[ch], bx = M.bx[ch];
#pragma unroll
    for (int s = 0; s < 4; ++s) { ra[s] = ba; rx[s] = bx; }
    const float* wa = M.wa + (size_t)n * 4096 + j; const float* wx = M.wx + (size_t)n * 4096 + j;
#pragma unroll 16
    for (int i = 0; i < 64; ++i) {
        const float a = wa[i * 64], xw = wx[i * 64];
#pragma unroll
        for (int s = 0; s < 4; ++s) { const float xv = XC[s * 512 + n * 64 + i]; ra[s] += xv * a; rx[s] += xv * xw; }
    }
    const float sp = log1pf(expf(-M.lam[ch]));
    float hh = M.st_l[(size_t)b * 512 + ch];
#pragma unroll
    for (int s = 0; s < 4; ++s) {
        const float r = 1.f / (1.f + expf(-ra[s])), ig = 1.f / (1.f + expf(-rx[s]));
        const float la = -8.f * r * sp, a = expf(la), mult = sqrtf(-expm1f(2.f * la));
        hh = a * hh + mult * ig * xc[s];
        M.O[(size_t)(tb + s) * DM + 512 + ch] = f2bf(hh * bf2f(M.GY[(size_t)(tb + s) * DH + ch]));
    }
    M.out[OUT_LS + (size_t)b * 512 + ch] = hh;
    __syncthreads();
}

__device__ __forceinline__ void scan_item(const Mix& M, int item) {
    const int tid = threadIdx.x;
    if (item < 1024) {
        const int e = item * 512 + tid, bh = e >> 14, vk = e & 16383, b = bh >> 2, h = bh & 3, v = vk >> 7, k = vk & 127;
        float l[32], d[32];
#pragma unroll
        for (int c = 0; c < 32; ++c) { const int unit = (b * 32 + c) * 4 + h; l[c] = bf2f(M.LT[(size_t)unit * 16384 + vk]); d[c] = M.DC[unit * 128 + k]; }
        float S = 0.f;
#pragma unroll
        for (int c = 0; c < 32; ++c) { const int unit = (b * 32 + c) * 4 + h; M.LT[(size_t)unit * 16384 + vk] = f2bf(S); S = d[c] * S + l[c]; }
        M.out[OUT_HP + ((size_t)(b * 4 + h) * 128 + k) * 128 + v] = S;
    } else {
        const int e = (item - 1024) * 512 + tid, b = e >> 9, ch = e & 511;
        float hcar = 0.f;
        for (int c = 0; c < 32; ++c) { const size_t idx = (size_t)(b * 32 + c) * 512 + ch; M.HST[idx] = hcar; hcar = M.ACH[idx] * hcar + M.UCH[idx]; }
    }
}

__global__ void __launch_bounds__(512, 2) mk_fwd(Params p) {
    extern __shared__ __attribute__((aligned(16))) unsigned char lds_raw[];
    LAS unsigned char* lds = (LAS unsigned char*)lds_raw;
    const int lo = p.ph_lo, hi = p.ph_hi, G = gridDim.x;
    unsigned char* ws = p.ws;
#define IN(k) (lo <= (k) && (k) < hi)
    volatile LAS unsigned* xst = (volatile LAS unsigned*)(lds + 131072);
    if (threadIdx.x < 16) xst[threadIdx.x] = 0u;
    __syncthreads();
    XcdBarrier xbar; xbar.bar = (unsigned*)(ws + WS_BAR); xbar.x = 0; xbar.st = xst;
    if (hi - lo > 1) xbar = xcd_barrier_post((unsigned*)(ws + WS_BAR), xst);
    if (hi == 0x7fffffff) cg::this_grid().sync();
#define SEAM(k) do { if (IN(k) && IN((k) + 1)) { xcd_barrier(xbar); } } while (0)
    bf16_t* B0 = (bf16_t*)(ws + WS_B0); bf16_t* B1 = (bf16_t*)(ws + WS_B1); bf16_t* H = (bf16_t*)(ws + WS_H);
    float* SS0 = (float*)(ws + WS_SS0); float* SS1 = (float*)(ws + WS_SS1); float* SS2 = (float*)(ws + WS_SS2); float* SS3 = (float*)(ws + WS_SS3);

    if (IN(0)) { phase0(p, lds); __syncthreads(); }
    SEAM(0);
    if (IN(1)) {
        pg8::Gemm g{B0, (const bf16_t*)(ws + WS_WG1), T_ALL, 2 * DFF, DM}; pg8::StaticOrder S; S.init(T_ALL, 2 * DFF, G, (int)blockIdx.x);
        EpiGateUp E{H, SS0};
        pg8::gemm_phase<EpiGateUp, pg8::StaticOrder, PG8_ALIGN, PG8_SP2>(lds, g, S, E);
    }
    SEAM(1);
    if (IN(2)) {
        pg8::Gemm g{H, (const bf16_t*)(ws + WS_WD1), TP, DM, DFF}; pg8::StaticOrder S; S.init(TP, DM, G, (int)blockIdx.x);
        EpiResid E{p.in[0], p.in[1], p.out, B0, p.in[9], SS1, 0.5f};
        pg8::gemm_phase<EpiResid, pg8::StaticOrder, PG8_ALIGN, PG8_SP2>(lds, g, S, E);
        SmallResid Es{p.in[1] - (size_t)TP * DM, p.out, B0, p.in[9], SS1, 0.5f};
        small_gemm<SmallResid, DFF>(H, (const bf16_t*)(ws + WS_WD1), DM, Es, lds);
    }
    SEAM(2);
    if (IN(3)) {
        pg8::Gemm g{B0, (const bf16_t*)(ws + WS_WIN), TP, DIN, DM}; pg8::StaticOrder S; S.init(TP, DIN, G, (int)blockIdx.x);
        EpiProj E{(bf16_t*)(ws + WS_Q), (bf16_t*)(ws + WS_V), (bf16_t*)(ws + WS_SG), (bf16_t*)(ws + WS_GY), (float*)(ws + WS_FZ), (float*)(ws + WS_XB), SS1};
        pg8::gemm_phase<EpiProj, pg8::StaticOrder, PG8_ALIGN, PG8_SP2>(lds, g, S, E);
        SmallProj Es{(bf16_t*)(ws + WS_Q), (bf16_t*)(ws + WS_V), (bf16_t*)(ws + WS_SG), (bf16_t*)(ws + WS_GY), (float*)(ws + WS_FZ), (float*)(ws + WS_XB), SS1};
        small_gemm<SmallProj, DM>(B0, (const bf16_t*)(ws + WS_WIN), DIN, Es, lds);
    }
    SEAM(3);
    Mix M;
    M.Q = (const bf16_t*)(ws + WS_Q); M.V = (const bf16_t*)(ws + WS_V); M.SG = (const bf16_t*)(ws + WS_SG); M.GY = (const bf16_t*)(ws + WS_GY);
    M.FZ = (const float*)(ws + WS_FZ); M.XB = (const float*)(ws + WS_XB); M.LT = (bf16_t*)(ws + WS_LT); M.DC = (float*)(ws + WS_DC);
    M.ACH = (float*)(ws + WS_ACH); M.UCH = (float*)(ws + WS_UCH); M.HST = (float*)(ws + WS_HST); M.O = B0;
    M.WAT = (const bf16_t*)(ws + WS_WAT); M.WXT = (const bf16_t*)(ws + WS_WXT);
    M.lb = p.in[11]; M.hnorm = p.in[12]; M.convw = p.in[13]; M.convb = p.in[14]; M.wa = p.in[15]; M.ba = p.in[16]; M.wx = p.in[17]; M.bx = p.in[18]; M.lam = p.in[19];
    M.st_h = p.in[2]; M.st_l = p.in[3]; M.st_c = p.in[4]; M.out = p.out;
    if (IN(4)) {
        for (int u = blockIdx.x; u < 3712; u += G) {
            if (u < 512) hgrn_sample_unit(M, u, lds);
            else if (u < 1536) hgrn_local_unit(M, u - 512, lds);
            else if (u < 3584) lru_unit(M, u - 1536, 0, lds);
            else lru_sample_unit(M, u - 3584, lds);
        }
    }
    SEAM(4);
    if (IN(5)) { for (int it = blockIdx.x; it < 1032; it += G) scan_item(M, it); }
    SEAM(5);
    if (IN(6)) {
        for (int u = blockIdx.x; u < 3072; u += G) {
            if (u < 1024) hgrn_out_unit(M, u, lds);
            else lru_unit(M, u - 1024, 1, lds);
        }
    }
    SEAM(6);
    if (IN(7)) {
        pg8::Gemm g{B0, (const bf16_t*)(ws + WS_WO), TP, DM, DM}; pg8::StaticOrder S; S.init(TP, DM, G, (int)blockIdx.x);
        EpiResid E{p.out, p.out + (size_t)TP * DM, p.out, B1, p.in[21], SS2, 1.0f};
        pg8::gemm_phase<EpiResid, pg8::StaticOrder, PG8_ALIGN, PG8_SP2>(lds, g, S, E);
        SmallResid Es{p.out, p.out, B1, p.in[21], SS2, 1.0f};
        small_gemm<SmallResid, DM>(B0, (const bf16_t*)(ws + WS_WO), DM, Es, lds);
    }
    SEAM(7);
    if (IN(8)) {
        pg8::Gemm g{B1, (const bf16_t*)(ws + WS_WG2), T_ALL, 2 * DFF, DM}; pg8::StaticOrder S; S.init(T_ALL, 2 * DFF, G, (int)blockIdx.x);
        EpiGateUp E{H, SS2};
        pg8::gemm_phase<EpiGateUp, pg8::StaticOrder, PG8_ALIGN, PG8_SP2>(lds, g, S, E);
    }
    SEAM(8);
    if (IN(9)) {
        pg8::Gemm g{H, (const bf16_t*)(ws + WS_WD2), TP, DM, DFF}; pg8::StaticOrder S; S.init(TP, DM, G, (int)blockIdx.x);
        EpiResid E{p.out, p.out + (size_t)TP * DM, p.out, nullptr, nullptr, SS3, 0.5f};
        pg8::gemm_phase<EpiResid, pg8::StaticOrder, PG8_ALIGN, PG8_SP2>(lds, g, S, E);
        SmallResid Es{p.out, p.out, nullptr, nullptr, SS3, 0.5f};
        small_gemm<SmallResid, DFF>(H, (const bf16_t*)(ws + WS_WD2), DM, Es, lds);
    }
    SEAM(9);
    if (IN(10)) phase_final(p);
#undef IN
#undef SEAM
}

extern "C" void kernel_launch(void* const* d_in, const int* in_sizes, int n_in, void* d_out, int out_size, void* d_ws, size_t ws_size, hipStream_t stream) {
    static int grid = 0;
    if (grid == 0) {
        if (n_in != 26 || ws_size < WS_END2) { fprintf(stderr, "kernel_launch: unexpected n_in %d or ws_size %zu (need %zu)\n", n_in, ws_size, (size_t)WS_END2); grid = -1; return; }
        int dev = 0, cus = 0, per_cu = 0;
        hipGetDevice(&dev); hipDeviceGetAttribute(&cus, hipDeviceAttributeMultiprocessorCount, dev);
        if (hipFuncSetAttribute((const void*)mk_fwd, hipFuncAttributeMaxDynamicSharedMemorySize, LDS_BYTES) != hipSuccess) { fprintf(stderr, "kernel_launch: hipFuncSetAttribute failed\n"); grid = -1; return; }
        if (hipOccupancyMaxActiveBlocksPerMultiprocessor(&per_cu, (const void*)mk_fwd, 512, LDS_BYTES) != hipSuccess || per_cu < 1) { fprintf(stderr, "kernel_launch: occupancy query says %d\n", per_cu); per_cu = 1; }
        (void)hipGetLastError();
        grid = cus;
    }
    if (grid < 0) return;
    Params p{};
    for (int i = 0; i < 26; ++i) p.in[i] = (const float*)d_in[i];
    p.out = (float*)d_out; p.ws = (unsigned char*)d_ws;
#if MK_PER_PHASE
    for (int ph = 0; ph < MK_NPH; ++ph) { p.ph_lo = ph; p.ph_hi = ph + 1; hipLaunchKernelGGL(mk_fwd, dim3(grid), dim3(512), LDS_BYTES, stream, p); if ((MK_DUP >> ph) & 1) hipLaunchKernelGGL(mk_fwd, dim3(grid), dim3(512), LDS_BYTES, stream, p); }
#else
    p.ph_lo = 0; p.ph_hi = MK_NPH;
    if (hipMemsetAsync((char*)d_ws + WS_BAR, 0, 16384, stream) != hipSuccess) { fprintf(stderr, "memset failed\n"); return; }
    void* args[] = {&p};
    hipError_t e = hipLaunchCooperativeKernel((const void*)mk_fwd, dim3(grid), dim3(512), args, LDS_BYTES, stream);
    if (e != hipSuccess) fprintf(stderr, "cooperative launch failed: %s (grid %d)\n", hipGetErrorString(e), grid);
#endif
}
```

```cpp
#include <hip/hip_runtime.h>
#include <hip/hip_cooperative_groups.h>
#include <cstdio>
#include <cstdint>
namespace cg = cooperative_groups;

#ifndef MK_DUP
#define MK_DUP 0
#endif
#ifndef MK_NPH
#define MK_NPH 11
#endif
#ifndef MK_PER_PHASE
#define MK_PER_PHASE 0
#endif

#define LAS __attribute__((address_space(3)))
typedef unsigned short bf16_t;
typedef short bf16x8 __attribute__((ext_vector_type(8)));
typedef float f32x4 __attribute__((ext_vector_type(4)));
typedef unsigned u32x4 __attribute__((ext_vector_type(4)));
typedef unsigned u32x2 __attribute__((ext_vector_type(2)));

constexpr int T_ALL = 16896, TP = 16384, DM = 1024, DFF = 2816, DIN = 3072, DH = 512;
constexpr int SEQ = 2048, NB = 8, NCH = 32, DECB = 128;
constexpr float EPS = 1e-6f;

constexpr size_t OUT_Y = 0, OUT_HP = 17301504, OUT_LP = 17825792, OUT_CP = 17829888, OUT_HS = 17842176, OUT_LS = 26230784, OUT_CS = 26296320;

constexpr size_t WS_WG1 = 0;
constexpr size_t WS_WD1 = WS_WG1 + (size_t)5632 * 1024 * 2;
constexpr size_t WS_WIN = WS_WD1 + (size_t)1024 * 2816 * 2;
constexpr size_t WS_WO  = WS_WIN + (size_t)3072 * 1024 * 2;
constexpr size_t WS_WG2 = WS_WO + (size_t)1024 * 1024 * 2;
constexpr size_t WS_WD2 = WS_WG2 + (size_t)5632 * 1024 * 2;
constexpr size_t WS_WAT = WS_WD2 + (size_t)1024 * 2816 * 2;
constexpr size_t WS_WXT = WS_WAT + 65536;
constexpr size_t WS_SS0 = WS_WXT + 65536;
constexpr size_t SS_BYTES = (size_t)T_ALL * 16 * 4;
constexpr size_t WS_SS1 = WS_SS0 + SS_BYTES, WS_SS2 = WS_SS1 + SS_BYTES, WS_SS3 = WS_SS2 + SS_BYTES;
constexpr size_t WS_DC  = WS_SS3 + SS_BYTES;
constexpr size_t WS_ACH = WS_DC + (size_t)1024 * 128 * 4;
constexpr size_t WS_UCH = WS_ACH + (size_t)NB * NCH * 512 * 4;
constexpr size_t WS_HST = WS_UCH + (size_t)NB * NCH * 512 * 4;
constexpr size_t WS_B0  = WS_HST + (size_t)NB * NCH * 512 * 4;
constexpr size_t WS_R   = WS_B0 + (size_t)T_ALL * 1024 * 2;
constexpr size_t WS_H   = WS_R;
constexpr size_t WS_B1  = WS_H + (size_t)T_ALL * 2816 * 2;
constexpr size_t WS_Q   = WS_R;
constexpr size_t WS_V   = WS_Q + (size_t)T_ALL * 512 * 2;
constexpr size_t WS_SG  = WS_V + (size_t)T_ALL * 512 * 2;
constexpr size_t WS_GY  = WS_SG + (size_t)T_ALL * 512 * 2;
constexpr size_t WS_FZ  = WS_GY + (size_t)T_ALL * 512 * 2;
constexpr size_t WS_XB  = WS_FZ + (size_t)T_ALL * 512 * 4;
constexpr size_t WS_LT  = WS_XB + (size_t)T_ALL * 512 * 4;
constexpr size_t WS_END = WS_LT + (size_t)1024 * 16384 * 2;
constexpr size_t WS_BAR = WS_END;
constexpr size_t WS_END2 = WS_BAR + 16384;
static_assert(WS_END2 <= 268435456, "workspace budget");
static_assert(WS_B1 + (size_t)T_ALL * 1024 * 2 <= WS_END, "B1 inside R");

constexpr int LDS_BYTES = 131072 + 64;

typedef __bf16 nbf16x2 __attribute__((ext_vector_type(2)));
typedef float f32x2 __attribute__((ext_vector_type(2)));
__device__ __forceinline__ unsigned cvt_pk_bf16(float lo, float hi) { const nbf16x2 r = __builtin_convertvector((f32x2){lo, hi}, nbf16x2); return __builtin_bit_cast(unsigned, r); }
__device__ __forceinline__ bf16_t f2bf(float f) { return (bf16_t)(cvt_pk_bf16(f, 0.f) & 0xffffu); }
__device__ __forceinline__ float bf2f(bf16_t b) { return __uint_as_float(((unsigned)b) << 16); }
__device__ __forceinline__ float bflo(unsigned w) { return __uint_as_float(w << 16); }
__device__ __forceinline__ float bfhi(unsigned w) { return __uint_as_float(w & 0xffff0000u); }
__device__ __forceinline__ float sigm(float x) { return __builtin_amdgcn_rcpf(1.f + __expf(-x)); }
__device__ __forceinline__ float rowscale(const float* ss, int row) {
    const f32x4* p = (const f32x4*)(ss + (size_t)row * 16);
    const f32x4 a = p[0], b = p[1], c = p[2], d = p[3];
    const float s = (((a.x + a.y) + (a.z + a.w)) + ((b.x + b.y) + (b.z + b.w))) + (((c.x + c.y) + (c.z + c.w)) + ((d.x + d.y) + (d.z + d.w)));
    return rsqrtf(s * (1.f / 1024.f) + EPS);
}
__device__ __forceinline__ void rowscale8(const float* ss, int row0, int fq, float (&rs)[8]) {
    f32x4 q[8];
#pragma unroll
    for (int i = 0; i < 8; ++i) q[i] = *(const f32x4*)(ss + (size_t)(row0 + (i >> 2) * 128 + (i & 3) * 16) * 16 + 4 * fq);
#pragma unroll
    for (int i = 0; i < 8; ++i) { float t = (q[i].x + q[i].y) + (q[i].z + q[i].w); t += __shfl_xor(t, 16); t += __shfl_xor(t, 32); rs[i] = rsqrtf(t * (1.f / 1024.f) + EPS); }
}
__device__ __forceinline__ float wave_sum(float v) {
#pragma unroll
    for (int o = 1; o < 64; o <<= 1) v += __shfl_xor(v, o);
    return v;
}
#define LDS_WAIT() asm volatile("s_waitcnt lgkmcnt(0)" ::: "memory")

namespace pg8 {
constexpr int BM = 256, BK = 64, HALF = 128, HTB = HALF * BK * 2, STAGE_BYTES = 8 * HTB, NXCD = 8, WGM = 8;
__host__ __device__ __forceinline__ int lds_byte(int r, int c) { const int st = (r >> 4) * 2 + (c >> 5), rr = r & 15, cc = c & 31, ob = rr * 64 + cc * 2; return st * 1024 + (ob ^ (((ob >> 9) & 1) << 5)); }
__host__ __device__ __forceinline__ void stage_rc(int b, int& R, int& C) { const int st = b / 1024, sb = b % 1024, swz = sb ^ (((sb >> 9) & 1) << 5); R = (st >> 1) * 16 + swz / 64; C = (st & 1) * 32 + (swz % 64) / 2; }
__host__ __device__ __forceinline__ int perm32(int rho) { const int n = rho >> 4, i = rho & 15; return 8 * (i >> 2) + 4 * n + (i & 3); }
struct Unit { int pm, pn; };
struct Gemm { const bf16_t* A; const bf16_t* Bt; int M, N, K; };
struct StaticOrder {
    int nM, nN, nwg, G, c;
    __host__ __device__ void init(int M, int N, int G_, int c_) { nM = M / BM; nN = N / BM; nwg = nM * nN; G = G_; c = c_; }
    __host__ __device__ bool next(int i, Unit& u) const {
        const long L = (long)i * G + c; if (L >= nwg) return false;
        int wgid = (int)L; { const int q = nwg / NXCD, r = nwg % NXCD, xcd = wgid % NXCD, off = wgid / NXCD; wgid = (xcd < r ? xcd * (q + 1) : r * (q + 1) + (xcd - r) * q) + off; }
        const int nig = WGM * nN, gid = wgid / nig, fm = gid * WGM, gsz = (nM - fm) < WGM ? (nM - fm) : WGM;
        u.pm = fm + ((wgid % nig) % gsz); u.pn = (wgid % nig) / gsz; return true;
    }
    __device__ __forceinline__ void a_ready(const Unit&) const {}
    __device__ __forceinline__ void done(const Unit&) const {}
};

template <class Epi, class Sched, bool ALIGN_EPI = false, bool SP2 = false>
__device__ __forceinline__ void gemm_phase(LAS unsigned char* lds, const Gemm g, const Sched& S, const Epi& E) {
    const int tid = threadIdx.x, wid = __builtin_amdgcn_readfirstlane(tid >> 6), lane = tid & 63, wr = wid >> 2, wc = wid & 3, fr = lane & 15, fq = lane >> 4;
    const int K = g.K, nt = K / BK;
    unsigned voffA[2], voffB[2];
#pragma unroll
    for (int i = 0; i < 2; ++i) { int R, C; stage_rc(tid * 16 + i * 8192, R, C); const int Rb = Epi::PERM ? ((R & ~31) + perm32(R & 31)) : R;
        voffA[i] = (unsigned)(R * K + C) * 2u; voffB[i] = (unsigned)(Rb * K + C) * 2u; }
    const size_t kstep = (size_t)(BK * 2);
    const size_t hstep = (size_t)HALF * K * 2;
    const size_t tstep = 2 * hstep;
    const unsigned ldsw = (unsigned)wid * 1024u;
    const int aoff = lds_byte(wr * 64 + fr, fq * 8), boff = lds_byte(wc * 32 + fr, fq * 8);
#define PG8_SA(b, h) (((b) * 2 + (h)) * HTB)
#define PG8_SB(b, h) ((4 + (b) * 2 + (h)) * HTB)
#define PG8_STAGE(bufoff, gbase, voff) do { _Pragma("unroll") for (int _i = 0; _i < 2; ++_i) \
        __builtin_amdgcn_global_load_lds((const unsigned*)((const char*)(gbase) + (voff)[_i]), (LAS unsigned*)(lds + (bufoff) + ldsw + _i * 8192), 16, 0, 0); } while (0)
#define PG8_LDA(dst, b, h) do { _Pragma("unroll") for (int m = 0; m < 4; ++m) _Pragma("unroll") for (int k = 0; k < 2; ++k) dst[m][k] = *(const LAS bf16x8*)(lds + PG8_SA(b, h) + aoff + m * 2048 + k * 1024); } while (0)
#define PG8_LDB(dst, b, h) do { _Pragma("unroll") for (int n = 0; n < 2; ++n) _Pragma("unroll") for (int k = 0; k < 2; ++k) dst[n][k] = *(const LAS bf16x8*)(lds + PG8_SB(b, h) + boff + n * 2048 + k * 1024); } while (0)
#define PG8_MMA(ai, bj, At, Bt) do { __builtin_amdgcn_s_setprio(1); _Pragma("unroll") for (int m = 0; m < 4; ++m) _Pragma("unroll") for (int n = 0; n < 2; ++n) _Pragma("unroll") for (int k = 0; k < 2; ++k) \
        acc[ai][bj][m][n] = __builtin_amdgcn_mfma_f32_16x16x32_bf16(Bt[n][k], At[m][k], acc[ai][bj][m][n], 0, 0, 0); __builtin_amdgcn_s_setprio(0); } while (0)
#define PG8_WAIT_V(n) asm volatile("s_waitcnt vmcnt(" #n ")" ::: "memory")
#define PG8_WAIT_L(n) asm volatile("s_waitcnt lgkmcnt(" #n ")" ::: "memory")
#define PG8_BAR __builtin_amdgcn_s_barrier()
#define PG8_SCHED __builtin_amdgcn_sched_barrier(0)
    Unit cur, nxt; int ui = 0;
    if (!S.next(0, cur)) return;
    f32x4 acc[2][2][4][2];
#pragma unroll
    for (int a = 0; a < 2; ++a)
#pragma unroll
        for (int b = 0; b < 2; ++b)
#pragma unroll
            for (int m = 0; m < 4; ++m)
#pragma unroll
                for (int n = 0; n < 2; ++n) acc[a][b][m][n] = (f32x4){0.f, 0.f, 0.f, 0.f};
    bf16x8 At[4][2], B0[2][2], B1[2][2];
    const char* cA = (const char*)g.A + (size_t)cur.pm * tstep; const char* cB = (const char*)g.Bt + (size_t)cur.pn * tstep;
    S.a_ready(cur);
    if constexpr (SP2) {
        PG8_STAGE(PG8_SB(0, 0), cB, voffB); PG8_STAGE(PG8_SB(0, 1), cB + hstep, voffB); PG8_STAGE(PG8_SA(0, 0), cA, voffA); PG8_STAGE(PG8_SA(0, 1), cA + hstep, voffA);
        if (wr == 1) PG8_BAR;
        PG8_WAIT_V(2); PG8_BAR;
        PG8_STAGE(PG8_SB(1, 0), cB + kstep, voffB); PG8_STAGE(PG8_SA(1, 0), cA + kstep, voffA); PG8_STAGE(PG8_SB(1, 1), cB + hstep + kstep, voffB);
        PG8_WAIT_V(6); PG8_BAR;
    } else {
        PG8_STAGE(PG8_SB(0, 0), cB, voffB); PG8_STAGE(PG8_SA(0, 0), cA, voffA); PG8_STAGE(PG8_SB(0, 1), cB + hstep, voffB); PG8_STAGE(PG8_SA(0, 1), cA + hstep, voffA);
        if (wr == 1) PG8_BAR;
        PG8_WAIT_V(4); PG8_BAR;
        PG8_STAGE(PG8_SB(1, 0), cB + kstep, voffB); PG8_STAGE(PG8_SA(1, 0), cA + kstep, voffA); PG8_STAGE(PG8_SB(1, 1), cB + hstep + kstep, voffB);
        PG8_WAIT_V(6); PG8_BAR;
    }
    for (;;) {
        const bool has_next = S.next(ui + 1, nxt);
        const char* nA = has_next ? (const char*)g.A + (size_t)nxt.pm * tstep : cA; const char* nB = has_next ? (const char*)g.Bt + (size_t)nxt.pn * tstep : cB;
        for (int t = 0; t < nt; t += 2) {
            const bool last = (t == nt - 2);
            const char* a1 = cA + (size_t)(t + 1) * kstep;
            const char* a2 = last ? nA : cA + (size_t)(t + 2) * kstep; const char* b2 = last ? nB : cB + (size_t)(t + 2) * kstep;
            const char* a3 = a2 + kstep; const char* b3 = b2 + kstep;
            if (last && has_next) S.a_ready(nxt);
            if constexpr (SP2) {
            PG8_LDB(B0, 0, 0); PG8_LDB(B1, 0, 1); PG8_SCHED; PG8_LDA(At, 0, 0); PG8_STAGE(PG8_SA(1, 1), a1 + hstep, voffA);
            PG8_WAIT_V(8); PG8_WAIT_L(0); PG8_BAR; PG8_MMA(0, 0, At, B0); PG8_MMA(0, 1, At, B1); PG8_BAR; PG8_SCHED;
            PG8_LDA(At, 0, 1); PG8_STAGE(PG8_SB(0, 0), b2, voffB); PG8_STAGE(PG8_SB(0, 1), b2 + hstep, voffB); PG8_STAGE(PG8_SA(0, 0), a2, voffA);
            PG8_WAIT_V(8); PG8_WAIT_L(0); PG8_BAR; PG8_MMA(1, 0, At, B0); PG8_MMA(1, 1, At, B1); PG8_BAR; PG8_SCHED;
            PG8_LDB(B0, 1, 0); PG8_LDB(B1, 1, 1); PG8_SCHED; PG8_LDA(At, 1, 0); PG8_STAGE(PG8_SA(0, 1), a2 + hstep, voffA);
            PG8_WAIT_V(8); PG8_WAIT_L(0); PG8_BAR; PG8_MMA(0, 0, At, B0); PG8_MMA(0, 1, At, B1); PG8_BAR; PG8_SCHED;
            PG8_LDA(At, 1, 1); PG8_STAGE(PG8_SB(1, 0), b3, voffB); PG8_STAGE(PG8_SB(1, 1), b3 + hstep, voffB); PG8_STAGE(PG8_SA(1, 0), a3, voffA);
            PG8_WAIT_V(8); PG8_WAIT_L(0); PG8_BAR; PG8_MMA(1, 0, At, B0); PG8_MMA(1, 1, At, B1); PG8_BAR; PG8_SCHED;
            } else {
            PG8_LDB(B0, 0, 0); PG8_SCHED; PG8_LDA(At, 0, 0); PG8_STAGE(PG8_SA(1, 1), a1 + hstep, voffA);
            PG8_WAIT_L(8); PG8_BAR; PG8_WAIT_L(0); PG8_MMA(0, 0, At, B0); PG8_BAR; PG8_SCHED;
            PG8_LDB(B1, 0, 1); PG8_STAGE(PG8_SB(0, 0), b2, voffB);
            PG8_BAR; PG8_WAIT_L(0); PG8_MMA(0, 1, At, B1); PG8_BAR;
            PG8_LDA(At, 0, 1); PG8_STAGE(PG8_SA(0, 0), a2, voffA);
            PG8_BAR; PG8_WAIT_L(0); PG8_MMA(1, 0, At, B0); PG8_BAR; PG8_SCHED;
            PG8_STAGE(PG8_SB(0, 1), b2 + hstep, voffB);
            PG8_WAIT_V(6); PG8_BAR; PG8_MMA(1, 1, At, B1); PG8_BAR;
            PG8_LDB(B0, 1, 0); PG8_SCHED; PG8_LDA(At, 1, 0); PG8_STAGE(PG8_SA(0, 1), a2 + hstep, voffA);
            PG8_WAIT_L(8); PG8_BAR; PG8_WAIT_L(0); PG8_MMA(0, 0, At, B0); PG8_BAR; PG8_SCHED;
            PG8_LDB(B1, 1, 1); PG8_STAGE(PG8_SB(1, 0), b3, voffB);
            PG8_BAR; PG8_WAIT_L(0); PG8_MMA(0, 1, At, B1); PG8_BAR;
            PG8_LDA(At, 1, 1); PG8_STAGE(PG8_SA(1, 0), a3, voffA);
            PG8_BAR; PG8_WAIT_L(0); PG8_MMA(1, 0, At, B0); PG8_BAR; PG8_SCHED;
            PG8_STAGE(PG8_SB(1, 1), b3 + hstep, voffB);
            PG8_WAIT_V(6); PG8_BAR; PG8_MMA(1, 1, At, B1); PG8_BAR;
            }
        }
        if constexpr (ALIGN_EPI) { if (wr == 0) PG8_BAR; }
        E(acc, cur, wr, wc, fr, fq); S.done(cur);
        if (!has_next) break;
#pragma unroll
        for (int a = 0; a < 2; ++a)
#pragma unroll
            for (int b = 0; b < 2; ++b)
#pragma unroll
                for (int m = 0; m < 4; ++m)
#pragma unroll
                    for (int n = 0; n < 2; ++n) acc[a][b][m][n] = (f32x4){0.f, 0.f, 0.f, 0.f};
        cur = nxt; cA = nA; cB = nB; ++ui;
        if constexpr (ALIGN_EPI) { if (wr == 1) PG8_BAR; }
    }
    PG8_WAIT_V(0);
    if constexpr (!ALIGN_EPI) { if (wr == 0) PG8_BAR; }
    PG8_BAR;
#undef PG8_SA
#undef PG8_SB
#undef PG8_STAGE
#undef PG8_LDA
#undef PG8_LDB
#undef PG8_MMA
#undef PG8_WAIT_V
#undef PG8_WAIT_L
#undef PG8_BAR
#undef PG8_SCHED
}
}

#ifndef PG8_SP2
#define PG8_SP2 true
#endif
#ifndef PG8_ALIGN
#define PG8_ALIGN true
#endif

struct EpiGateUp {
    static constexpr bool PERM = true;
    bf16_t* H; const float* ss;
    __device__ __forceinline__ void operator()(const f32x4 (&acc)[2][2][4][2], const pg8::Unit& u, int wr, int wc, int fr, int fq) const {
        const int row0 = u.pm * 256 + wr * 64 + fr, col0 = u.pn * 128 + wc * 32 + 8 * fq;
        float rsv[8]; rowscale8(ss, row0, fq, rsv);
#pragma unroll
        for (int ai = 0; ai < 2; ++ai)
#pragma unroll
            for (int m = 0; m < 4; ++m) {
                const int row = row0 + ai * 128 + m * 16; const float rs = rsv[ai * 4 + m];
                float h[8];
#pragma unroll
                for (int n = 0; n < 2; ++n)
#pragma unroll
                    for (int j = 0; j < 4; ++j) { const float g = acc[ai][0][m][n][j] * rs, up = acc[ai][1][m][n][j] * rs; h[n * 4 + j] = g * sigm(g) * up; }
                u32x4 w; w.x = cvt_pk_bf16(h[0], h[1]); w.y = cvt_pk_bf16(h[2], h[3]); w.z = cvt_pk_bf16(h[4], h[5]); w.w = cvt_pk_bf16(h[6], h[7]);
                *(u32x4*)(H + (size_t)row * DFF + col0) = w;
            }
    }
};
struct EpiResid {
    static constexpr bool PERM = true;
    const float* xin_p; const float* xin_s; float* xout; bf16_t* ax; const float* gnext; float* ssout; float scale;
    __device__ __forceinline__ void operator()(const f32x4 (&acc)[2][2][4][2], const pg8::Unit& u, int wr, int wc, int fr, int fq) const {
        const int row0 = u.pm * 256 + wr * 64 + fr, col0 = u.pn * 256 + wc * 32 + 8 * fq;
        const float* xb = (u.pm < 64) ? xin_p : (xin_s - (size_t)TP * DM);
        f32x4 gn[2][2];
#pragma unroll
        for (int bj = 0; bj < 2; ++bj)
#pragma unroll
            for (int n = 0; n < 2; ++n) gn[bj][n] = ax ? *(const f32x4*)(gnext + col0 + bj * 128 + 4 * n) : (f32x4){1.f, 1.f, 1.f, 1.f};
#pragma unroll
        for (int ai = 0; ai < 2; ++ai) {
            f32x4 xr[4][2][2];
#pragma unroll
            for (int m = 0; m < 4; ++m)
#pragma unroll
                for (int bj = 0; bj < 2; ++bj) { const float* px = xb + (size_t)(row0 + ai * 128 + m * 16) * DM + col0 + bj * 128; xr[m][bj][0] = *(const f32x4*)px; xr[m][bj][1] = *(const f32x4*)(px + 4); }
#pragma unroll
            for (int m = 0; m < 4; ++m) {
                const int row = row0 + ai * 128 + m * 16; const size_t off = (size_t)row * DM + col0; float sq = 0.f;
#pragma unroll
                for (int bj = 0; bj < 2; ++bj) {
                    const f32x4 x0 = xr[m][bj][0], x1 = xr[m][bj][1];
                    const f32x4 v0 = x0 + acc[ai][bj][m][0] * scale, v1 = x1 + acc[ai][bj][m][1] * scale;
                    *(f32x4*)(xout + off + bj * 128) = v0; *(f32x4*)(xout + off + bj * 128 + 4) = v1;
                    sq += ((v0[0] * v0[0] + v0[1] * v0[1]) + (v0[2] * v0[2] + v0[3] * v0[3])) + ((v1[0] * v1[0] + v1[1] * v1[1]) + (v1[2] * v1[2] + v1[3] * v1[3]));
                    if (ax) { const f32x4 a0 = v0 * gn[bj][0], a1 = v1 * gn[bj][1];
                        u32x4 w; w.x = cvt_pk_bf16(a0[0], a0[1]); w.y = cvt_pk_bf16(a0[2], a0[3]); w.z = cvt_pk_bf16(a1[0], a1[1]); w.w = cvt_pk_bf16(a1[2], a1[3]);
                        *(u32x4*)(ax + off + bj * 128) = w; }
                }
                sq += __shfl_xor(sq, 16); sq += __shfl_xor(sq, 32);
                if (fq == 0) ssout[(size_t)row * 16 + u.pn * 4 + wc] = sq;
            }
        }
    }
};
struct EpiProj {
    static constexpr bool PERM = true;
    bf16_t *Q, *V, *SG, *GY; float *FZ, *XB; const float* ss;
    __device__ __forceinline__ void operator()(const f32x4 (&acc)[2][2][4][2], const pg8::Unit& u, int wr, int wc, int fr, int fq) const {
        const int seg = u.pn >> 1;
        const int row0 = u.pm * 256 + wr * 64 + fr, col0 = (u.pn & 1) * 256 + wc * 32 + 8 * fq;
        float* fdst = (seg == 1) ? FZ : XB;
        bf16_t* bdst = (seg == 0) ? Q : (seg == 2) ? V : (seg == 3) ? SG : GY;
        const bool isf = (seg == 1) || (seg == 4);
        float rsv[8]; rowscale8(ss, row0, fq, rsv);
#pragma unroll
        for (int ai = 0; ai < 2; ++ai)
#pragma unroll
            for (int m = 0; m < 4; ++m) {
                const int row = row0 + ai * 128 + m * 16; const float rs = rsv[ai * 4 + m]; const size_t off = (size_t)row * DH + col0;
#pragma unroll
                for (int bj = 0; bj < 2; ++bj) {
                    f32x4 v0 = acc[ai][bj][m][0] * rs, v1 = acc[ai][bj][m][1] * rs;
                    if (isf) { *(f32x4*)(fdst + off + bj * 128) = v0; *(f32x4*)(fdst + off + bj * 128 + 4) = v1; }
                    else {
                        float h[8] = {v0[0], v0[1], v0[2], v0[3], v1[0], v1[1], v1[2], v1[3]};
                        if (seg == 0) {
#pragma unroll
                            for (int j = 0; j < 8; ++j) h[j] = h[j] * sigm(h[j]);
                        } else if (seg == 3) {
#pragma unroll
                            for (int j = 0; j < 8; ++j) h[j] = sigm(h[j]);
                        } else if (seg == 5) {
#pragma unroll
                            for (int j = 0; j < 8; ++j) { const float y = h[j]; h[j] = y * sigm(1.5957691216f * (y + 0.044715f * y * y * y)); }
                        }
                        u32x4 w; w.x = cvt_pk_bf16(h[0], h[1]); w.y = cvt_pk_bf16(h[2], h[3]); w.z = cvt_pk_bf16(h[4], h[5]); w.w = cvt_pk_bf16(h[6], h[7]);
                        *(u32x4*)(bdst + off + bj * 128) = w;
                    }
                }
            }
    }
};


struct SmallResid {
    const float* xin; float* xout; bf16_t* ax; const float* gnext; float* ssout; float scale;
    __device__ __forceinline__ void apply(const f32x4& acc, int grow, int c, int cn, int c16, int r16, int fr, int fq, LAS unsigned char* lds) const {
        const size_t off = (size_t)grow * DM + c;
        const f32x4 x = *(const f32x4*)(xin + off);
        const f32x4 v = x + acc * scale;
        *(f32x4*)(xout + off) = v;
        float sq = (v[0] * v[0] + v[1] * v[1]) + (v[2] * v[2] + v[3] * v[3]);
        if (ax) { const f32x4 g = *(const f32x4*)(gnext + c); const f32x4 a = v * g; u32x2 w; w.x = cvt_pk_bf16(a[0], a[1]); w.y = cvt_pk_bf16(a[2], a[3]); *(u32x2*)(ax + off) = w; }
        sq += __shfl_xor(sq, 16); sq += __shfl_xor(sq, 32);
        LAS float* P = (LAS float*)lds;
        if (fq == 0) P[(r16 * 16 + fr) * 4 + c16] = sq;
        __syncthreads();
        if (c16 == 0 && fq == 0) { const LAS float* q = P + (r16 * 16 + fr) * 4; ssout[(size_t)grow * 16 + cn] = (q[0] + q[1]) + (q[2] + q[3]); }
        __syncthreads();
    }
};
struct SmallProj {
    bf16_t *Q, *V, *SG, *GY; float *FZ, *XB; const float* ss;
    __device__ __forceinline__ void apply(const f32x4& acc, int grow, int c, int cn, int c16, int r16, int fr, int fq, LAS unsigned char* lds) const {
        const int seg = cn >> 3, cs = c & 511;
        const float rs = rowscale(ss, grow);
        const f32x4 v = acc * rs;
        const size_t off = (size_t)grow * DH + cs;
        if (seg == 1 || seg == 4) { *(f32x4*)(((seg == 1) ? FZ : XB) + off) = v; }
        else {
            float h[4] = {v[0], v[1], v[2], v[3]};
            if (seg == 0) {
#pragma unroll
                for (int j = 0; j < 4; ++j) h[j] = h[j] * sigm(h[j]);
            } else if (seg == 3) {
#pragma unroll
                for (int j = 0; j < 4; ++j) h[j] = sigm(h[j]);
            } else if (seg == 5) {
#pragma unroll
                for (int j = 0; j < 4; ++j) { const float y = h[j]; h[j] = y * sigm(1.5957691216f * (y + 0.044715f * y * y * y)); }
            }
            bf16_t* bdst = (seg == 0) ? Q : (seg == 2) ? V : (seg == 3) ? SG : GY;
            u32x2 w; w.x = cvt_pk_bf16(h[0], h[1]); w.y = cvt_pk_bf16(h[2], h[3]);
            *(u32x2*)(bdst + off) = w;
        }
    }
};
template <class Epi, int K>
__device__ __forceinline__ void small_gemm(const bf16_t* A, const bf16_t* Bt, int N, const Epi& E, LAS unsigned char* lds) {
    const int tid = threadIdx.x, lane = tid & 63, wave = tid >> 6, fr = lane & 15, fq = lane >> 4, r16 = wave >> 2, c16 = wave & 3;
    constexpr int KW = K / 8, NS = KW / 32;
    const int nunits = 16 * (N / 64), G = gridDim.x;
    LAS f32x4* PB = (LAS f32x4*)lds;
    for (int u = G - 1 - (int)blockIdx.x; u < nunits; u += G) {
        const int rm = u & 15, cn = u >> 4;
        const bf16_t* ap = A + (size_t)(TP + rm * 32 + fr) * K + wave * KW + fq * 8;
        const bf16_t* bp = Bt + (size_t)(cn * 64 + fr) * K + wave * KW + fq * 8;
        f32x4 acc[2][4];
#pragma unroll
        for (int rr = 0; rr < 2; ++rr)
#pragma unroll
            for (int cc = 0; cc < 4; ++cc) acc[rr][cc] = (f32x4){0.f, 0.f, 0.f, 0.f};
#pragma unroll
        for (int s0 = 0; s0 < NS; s0 += 4) {
            bf16x8 a[4][2], b[4][4];
#pragma unroll
            for (int i = 0; i < 4; ++i) if (s0 + i < NS) {
#pragma unroll
                for (int rr = 0; rr < 2; ++rr) a[i][rr] = *(const bf16x8*)(ap + (size_t)rr * 16 * K + (s0 + i) * 32);
#pragma unroll
                for (int cc = 0; cc < 4; ++cc) b[i][cc] = *(const bf16x8*)(bp + (size_t)cc * 16 * K + (s0 + i) * 32);
            }
#pragma unroll
            for (int i = 0; i < 4; ++i) if (s0 + i < NS) {
#pragma unroll
                for (int rr = 0; rr < 2; ++rr)
#pragma unroll
                    for (int cc = 0; cc < 4; ++cc) acc[rr][cc] = __builtin_amdgcn_mfma_f32_16x16x32_bf16(b[i][cc], a[i][rr], acc[rr][cc], 0, 0, 0);
            }
        }
#pragma unroll
        for (int rr = 0; rr < 2; ++rr)
#pragma unroll
            for (int cc = 0; cc < 4; ++cc) PB[(wave * 8 + rr * 4 + cc) * 64 + lane] = acc[rr][cc];
        __syncthreads();
        f32x4 r = PB[(0 * 8 + wave) * 64 + lane];
#pragma unroll
        for (int w = 1; w < 8; ++w) r += PB[(w * 8 + wave) * 64 + lane];
        E.apply(r, TP + rm * 32 + r16 * 16 + fr, cn * 64 + c16 * 16 + 4 * fq, cn, c16, r16, fr, fq, lds + 65536);
        __syncthreads();
    }
}

#define XB_TMO      128
#define XB_XCNT(j)  (256  + 64 * (j))
#define XB_XSUB(j)  (1280 + 64 * (j))
#define XB_XGEN(j)  (2304 + 64 * (j))
#define XB_TOP      3328
#define XB_TOPGEN   3392
#define XCD_BAR_WORDS 3456
#define XB_SPIN_CAP (1u << 22)
__device__ __forceinline__ unsigned xb_ld(unsigned* p)              { return __hip_atomic_load(p, __ATOMIC_RELAXED, __HIP_MEMORY_SCOPE_AGENT); }
__device__ __forceinline__ unsigned xb_add(unsigned* p, unsigned v) { return __hip_atomic_fetch_add(p, v, __ATOMIC_RELAXED, __HIP_MEMORY_SCOPE_AGENT); }
__device__ __forceinline__ unsigned xb_xcc_id() { return (unsigned)__builtin_amdgcn_s_getreg((3 << 11) | 20) & 0xFu; }
#define XB_SPIN(cond, bar) do { unsigned _sp = 0; while (cond) { __builtin_amdgcn_s_sleep(1); \
    if ((++_sp & 255u) == 0u) { if (xb_ld(&(bar)[XB_TMO])) break; if (_sp > XB_SPIN_CAP) { atomicAdd(&(bar)[XB_TMO], 1u); break; } } } } while (0)
struct XcdBarrier { unsigned* bar; unsigned x; volatile LAS unsigned* st; };
__device__ __forceinline__ XcdBarrier xcd_barrier_post(unsigned* bar, volatile LAS unsigned* st) {
    XcdBarrier b; b.bar = bar; b.x = xb_xcc_id(); b.st = st;
    if (threadIdx.x == 0) (void)xb_add(&bar[XB_XCNT(b.x)], 1u);
    return b;
}
__device__ __forceinline__ void xcd_barrier_complete(unsigned* bar, unsigned x, unsigned& nloc, unsigned& nx) {
    const unsigned G = gridDim.x * gridDim.y * gridDim.z;
    unsigned sum, cnt, mine, sp = 0u;
    for (;;) {
        sum = 0u; cnt = 0u; mine = 0u;
#pragma unroll
        for (unsigned j = 0; j < 16; ++j) { const unsigned c = xb_ld(&bar[XB_XCNT(j)]); sum += c; cnt += (c > 0u) ? 1u : 0u; mine = (j == x) ? c : mine; }
        if (sum == G) break;
        __builtin_amdgcn_s_sleep(1);
        if ((++sp & 255u) == 0u) { if (xb_ld(&bar[XB_TMO])) break; if (sp > XB_SPIN_CAP) { atomicAdd(&bar[XB_TMO], 1u); break; } }
    }
    nloc = mine > 0u ? mine : 1u; nx = cnt > 0u ? cnt : 1u;
}
__device__ __forceinline__ void xcd_barrier(const XcdBarrier& b) {
    asm volatile("s_waitcnt vmcnt(0) lgkmcnt(0)" ::: "memory");
    __syncthreads();
    if (threadIdx.x == 0) {
        unsigned* bar = b.bar;
        __builtin_amdgcn_s_waitcnt(0);
        unsigned nloc = b.st[0], nx = b.st[1];
        if (nloc == 0u) { xcd_barrier_complete(bar, b.x, nloc, nx); b.st[0] = nloc; b.st[1] = nx; }
        const unsigned old = xb_add(&bar[XB_XSUB(b.x)], 1u);
        const unsigned gen = old / nloc;
        if (old + 1u == (gen + 1u) * nloc) {
            __builtin_amdgcn_fence(__ATOMIC_RELEASE, "agent");
            asm volatile("s_waitcnt vmcnt(0)" ::: "memory");
            const unsigned og = xb_add(&bar[XB_TOP], 1u);
            const unsigned tg = og / nx;
            if (og + 1u == (tg + 1u) * nx) xb_add(&bar[XB_TOPGEN], 1u);
            else XB_SPIN(xb_ld(&bar[XB_TOPGEN]) == tg, bar);
            __builtin_amdgcn_fence(__ATOMIC_ACQUIRE, "agent");
            xb_add(&bar[XB_XGEN(b.x)], 1u);
            asm volatile("s_waitcnt vmcnt(0)" ::: "memory");
        } else {
            XB_SPIN(xb_ld(&bar[XB_XGEN(b.x)]) == gen, bar);
            __builtin_amdgcn_fence(__ATOMIC_ACQUIRE, "agent");
            asm volatile("s_waitcnt vmcnt(0)" ::: "memory");
        }
    }
    __syncthreads();
}

struct Params { const float* in[26]; float* out; unsigned char* ws; int ph_lo, ph_hi; };

__device__ __forceinline__ void transpose_item(const float* W, int K, int N, bf16_t* WT, int dst_row0, LAS float* scr, int k0, int n0, int lane) {
    float wv[32];
#pragma unroll
    for (int i = 0; i < 32; ++i) wv[i] = W[(size_t)(k0 + 2 * i + (lane >> 5)) * N + n0 + (lane & 31)];
#pragma unroll
    for (int i = 0; i < 32; ++i) scr[(2 * i + (lane >> 5)) * 33 + (lane & 31)] = wv[i];
    LDS_WAIT();
    const int c = lane & 7;
#pragma unroll
    for (int j = 0; j < 4; ++j) { const int n = (lane >> 3) + 8 * j; const LAS float* s = scr + (8 * c) * 33 + n;
        u32x4 o; o.x = cvt_pk_bf16(s[0 * 33], s[1 * 33]); o.y = cvt_pk_bf16(s[2 * 33], s[3 * 33]); o.z = cvt_pk_bf16(s[4 * 33], s[5 * 33]); o.w = cvt_pk_bf16(s[6 * 33], s[7 * 33]);
        *(u32x4*)(WT + (size_t)(dst_row0 + n) * K + k0 + 8 * c) = o; }
    LDS_WAIT();
}
__device__ __forceinline__ void transpose_mat(const float* W, int K, int N, bf16_t* WT, int mode, LAS float* scr, int item, int lane) {
    const int nblk = N / 32, kb = item / nblk, nb = item % nblk, n0 = 32 * nb;
    const int dst = (mode == 0) ? n0 : (256 * (n0 >> 7) + (n0 & 127) + (mode == 2 ? 128 : 0));
    transpose_item(W, K, N, WT, dst, scr, 64 * kb, n0, lane);
}

__device__ __forceinline__ void phase0(const Params& p, LAS unsigned char* lds) {
    const int tid = threadIdx.x, lane = tid & 63, wave = tid >> 6;
    const int G = gridDim.x, gw = blockIdx.x * 8 + wave, NGW = G * 8;
    unsigned char* ws = p.ws;
    LAS float* scr = (LAS float*)(lds + wave * 16384);
    constexpr int I_GU = 16 * 88, I_D = 44 * 32, I_IN = 16 * 96, I_O = 16 * 32;
    constexpr int NIT = 4 * I_GU + 2 * I_D + I_IN + I_O;
    for (int it = gw; it < NIT; it += NGW) {
        int r = it;
        if (r < I_GU) { transpose_mat(p.in[6], 1024, 2816, (bf16_t*)(ws + WS_WG1), 1, scr, r, lane); continue; } r -= I_GU;
        if (r < I_GU) { transpose_mat(p.in[7], 1024, 2816, (bf16_t*)(ws + WS_WG1), 2, scr, r, lane); continue; } r -= I_GU;
        if (r < I_D)  { transpose_mat(p.in[8], 2816, 1024, (bf16_t*)(ws + WS_WD1), 0, scr, r, lane); continue; } r -= I_D;
        if (r < I_IN) { transpose_mat(p.in[10], 1024, 3072, (bf16_t*)(ws + WS_WIN), 0, scr, r, lane); continue; } r -= I_IN;
        if (r < I_O)  { transpose_mat(p.in[20], 1024, 1024, (bf16_t*)(ws + WS_WO), 0, scr, r, lane); continue; } r -= I_O;
        if (r < I_GU) { transpose_mat(p.in[22], 1024, 2816, (bf16_t*)(ws + WS_WG2), 1, scr, r, lane); continue; } r -= I_GU;
        if (r < I_GU) { transpose_mat(p.in[23], 1024, 2816, (bf16_t*)(ws + WS_WG2), 2, scr, r, lane); continue; } r -= I_GU;
        transpose_mat(p.in[24], 2816, 1024, (bf16_t*)(ws + WS_WD2), 0, scr, r, lane);
    }
    for (int e = blockIdx.x * 512 + tid; e < 2 * 32768; e += G * 512) {
        const int which = e >> 15, r = e & 32767, n = r >> 12, j = (r >> 6) & 63, i = r & 63;
        const float* W = which ? p.in[17] : p.in[15];
        bf16_t* WT = (bf16_t*)(ws + (which ? WS_WXT : WS_WAT));
        WT[r] = f2bf(W[(n * 64 + i) * 64 + j]);
    }
    bf16_t* A1 = (bf16_t*)(ws + WS_B0); float* SS0 = (float*)(ws + WS_SS0);
    const float* g1 = p.in[5];
    f32x4 gv[4];
#pragma unroll
    for (int j = 0; j < 4; ++j) gv[j] = ((const f32x4*)g1)[lane + 64 * j];
    for (int row0 = gw; row0 < T_ALL; row0 += 3 * NGW) {
        f32x4 v[3][4];
#pragma unroll
        for (int r = 0; r < 3; ++r) { const int row = row0 + r * NGW; if (row < T_ALL) {
            const float* xr = (row < TP) ? p.in[0] + (size_t)row * DM : p.in[1] + (size_t)(row - TP) * DM;
#pragma unroll
            for (int j = 0; j < 4; ++j) v[r][j] = ((const f32x4*)xr)[lane + 64 * j]; } }
#pragma unroll
        for (int r = 0; r < 3; ++r) { const int row = row0 + r * NGW; if (row < T_ALL) {
            float s = 0.f;
#pragma unroll
            for (int j = 0; j < 4; ++j) s += (v[r][j].x * v[r][j].x + v[r][j].y * v[r][j].y) + (v[r][j].z * v[r][j].z + v[r][j].w * v[r][j].w);
            s = wave_sum(s);
            u32x2* o8 = (u32x2*)(A1 + (size_t)row * DM);
#pragma unroll
            for (int j = 0; j < 4; ++j) { const f32x4 a = v[r][j] * gv[j]; u32x2 w; w.x = cvt_pk_bf16(a.x, a.y); w.y = cvt_pk_bf16(a.z, a.w); o8[lane + 64 * j] = w; }
            if (lane < 16) SS0[(size_t)row * 16 + lane] = (lane == 0) ? s : 0.f; } }
    }
}

__device__ __forceinline__ void phase_final(const Params& p) {
    const int tid = threadIdx.x, lane = tid & 63, wave = tid >> 6;
    const int gw = blockIdx.x * 8 + wave, NGW = gridDim.x * 8;
    const float* SS3 = (const float*)(p.ws + WS_SS3); const float* gf = p.in[25];
    f32x4 gv[4];
#pragma unroll
    for (int j = 0; j < 4; ++j) gv[j] = ((const f32x4*)gf)[lane + 64 * j];
    for (int row0 = gw; row0 < T_ALL; row0 += 3 * NGW) {
        f32x4 v[3][4]; float rs[3];
#pragma unroll
        for (int r = 0; r < 3; ++r) { const int row = row0 + r * NGW; if (row < T_ALL) {
            rs[r] = rowscale(SS3, row);
            const f32x4* xr = (const f32x4*)(p.out + (size_t)row * DM);
#pragma unroll
            for (int j = 0; j < 4; ++j) v[r][j] = xr[lane + 64 * j]; } }
#pragma unroll
        for (int r = 0; r < 3; ++r) { const int row = row0 + r * NGW; if (row < T_ALL) {
            f32x4* xr = (f32x4*)(p.out + (size_t)row * DM);
#pragma unroll
            for (int j = 0; j < 4; ++j) xr[lane + 64 * j] = v[r][j] * rs[r] * gv[j]; } }
    }
}

struct Mix {
    const bf16_t *Q, *V, *SG, *GY; const float *FZ, *XB; bf16_t* LT; float* DC; float *ACH, *UCH, *HST; bf16_t* O;
    const bf16_t *WAT, *WXT;
    const float *lb, *hnorm, *convw, *convb, *ba, *bx, *lam, *wa, *wx, *st_h, *st_l, *st_c;
    float* out;
};

struct HgrnScan { float cum[16]; float kk[16]; float last; };
__device__ __forceinline__ void hgrn_scan(const float (&fzv)[16], float lb, int k, int seg, LAS float* tot, HgrnScan& hs) {
    float run = 0.f;
#pragma unroll
    for (int i = 0; i < 16; ++i) {
        const float e = __expf(-fmaxf(fzv[i], -80.f));
        const float sg = __builtin_amdgcn_rcpf(1.f + e), sn = e * sg;
        const float f = lb + (1.f - lb) * sg;
        run += __logf(f); hs.cum[i] = run; hs.kk[i] = (1.f - lb) * sn;
    }
    tot[seg * 128 + k] = run;
    __syncthreads();
    float off = 0.f, all = 0.f;
#pragma unroll
    for (int s = 0; s < 4; ++s) { const float v = tot[s * 128 + k]; if (s < seg) off += v; all += v; }
#pragma unroll
    for (int i = 0; i < 16; ++i) hs.cum[i] += off;
    hs.last = all;
}

__device__ __forceinline__ void hgrn_local_unit(const Mix& M, int unit, LAS unsigned char* lds) {
    const int tid = threadIdx.x, lane = tid & 63, wave = tid >> 6, fr = lane & 15, fq = lane >> 4;
    const int h = unit & 3, bc = unit >> 2, t0 = bc * 64, cb = h * 128, k = tid & 127, seg = tid >> 7;
    LAS bf16_t* KT = (LAS bf16_t*)lds; LAS bf16_t* VT = (LAS bf16_t*)(lds + 18432); LAS float* tot = (LAS float*)(lds + 36864);
    float fzv[16]; unsigned vv[16];
    const size_t rb = (size_t)(t0 + seg * 16) * DH + cb + k;
#pragma unroll
    for (int i = 0; i < 16; ++i) { fzv[i] = M.FZ[rb + (size_t)i * DH]; vv[i] = M.V[rb + (size_t)i * DH]; }
    const float l0 = M.lb[cb + k], l1 = M.lb[512 + cb + k];
    const float lb = __builtin_amdgcn_rcpf(1.f + __expf(l1 - l0));
    HgrnScan hs; hgrn_scan(fzv, lb, k, seg, tot, hs);
    unsigned pk[8];
#pragma unroll
    for (int i = 0; i < 8; ++i) pk[i] = cvt_pk_bf16(hs.kk[2 * i] * __expf(hs.last - hs.cum[2 * i]), hs.kk[2 * i + 1] * __expf(hs.last - hs.cum[2 * i + 1]));
    *(LAS u32x4*)(KT + k * 72 + seg * 16) = (u32x4){pk[0], pk[1], pk[2], pk[3]};
    *(LAS u32x4*)(KT + k * 72 + seg * 16 + 8) = (u32x4){pk[4], pk[5], pk[6], pk[7]};
    *(LAS u32x4*)(VT + k * 72 + seg * 16) = (u32x4){vv[0] | (vv[1] << 16), vv[2] | (vv[3] << 16), vv[4] | (vv[5] << 16), vv[6] | (vv[7] << 16)};
    *(LAS u32x4*)(VT + k * 72 + seg * 16 + 8) = (u32x4){vv[8] | (vv[9] << 16), vv[10] | (vv[11] << 16), vv[12] | (vv[13] << 16), vv[14] | (vv[15] << 16)};
    if (seg == 0) M.DC[unit * 128 + k] = __expf(hs.last);
    __syncthreads();
    const bf16x8 a0 = *(const LAS bf16x8*)(VT + (16 * wave + fr) * 72 + fq * 8), a1 = *(const LAS bf16x8*)(VT + (16 * wave + fr) * 72 + 32 + fq * 8);
#pragma unroll
    for (int ct = 0; ct < 8; ++ct) {
        const bf16x8 b0 = *(const LAS bf16x8*)(KT + (16 * ct + fr) * 72 + fq * 8), b1 = *(const LAS bf16x8*)(KT + (16 * ct + fr) * 72 + 32 + fq * 8);
        f32x4 acc = {0.f, 0.f, 0.f, 0.f};
        acc = __builtin_amdgcn_mfma_f32_16x16x32_bf16(b0, a0, acc, 0, 0, 0);
        acc = __builtin_amdgcn_mfma_f32_16x16x32_bf16(b1, a1, acc, 0, 0, 0);
        u32x2 w; w.x = cvt_pk_bf16(acc[0], acc[1]); w.y = cvt_pk_bf16(acc[2], acc[3]);
        *(u32x2*)(M.LT + ((size_t)unit * 128 + 16 * wave + fr) * 128 + 16 * ct + 4 * fq) = w;
    }
    __syncthreads();
}

__device__ __forceinline__ void hgrn_out_unit(const Mix& M, int unit, LAS unsigned char* lds) {
    const int tid = threadIdx.x, lane = tid & 63, wave = tid >> 6, fr = lane & 15, fq = lane >> 4;
    const int h = unit & 3, bc = unit >> 2, t0 = bc * 64, cb = h * 128, k = tid & 127, seg = tid >> 7;
    LAS bf16_t* QS = (LAS bf16_t*)lds; LAS bf16_t* KS = (LAS bf16_t*)(lds + 17408); LAS bf16_t* VT = (LAS bf16_t*)(lds + 34816);
    LAS bf16_t* PS = (LAS bf16_t*)(lds + 53248); LAS float* tot = (LAS float*)(lds + 62464); LAS float* RS = (LAS float*)(lds + 64512);
    float fzv[16]; unsigned vv[16], qv[16];
    const size_t rb = (size_t)(t0 + seg * 16) * DH + cb + k;
#pragma unroll
    for (int i = 0; i < 16; ++i) { fzv[i] = M.FZ[rb + (size_t)i * DH]; vv[i] = M.V[rb + (size_t)i * DH]; qv[i] = M.Q[rb + (size_t)i * DH]; }
    bf16x8 bs[4];
#pragma unroll
    for (int ks = 0; ks < 4; ++ks) bs[ks] = *(const bf16x8*)(M.LT + ((size_t)unit * 128 + 16 * wave + fr) * 128 + ks * 32 + fq * 8);
    const int ocol = cb + 16 * wave + 4 * fq;
    u32x2 sgv[4];
#pragma unroll
    for (int tr = 0; tr < 4; ++tr) sgv[tr] = *(const u32x2*)(M.SG + (size_t)(t0 + 16 * tr + fr) * DH + ocol);
    const f32x4 gn = *(const f32x4*)(M.hnorm + ocol);
    const float l0 = M.lb[cb + k], l1 = M.lb[512 + cb + k];
    const float lb = __builtin_amdgcn_rcpf(1.f + __expf(l1 - l0));
    HgrnScan hs; hgrn_scan(fzv, lb, k, seg, tot, hs);
#pragma unroll
    for (int i = 0; i < 16; ++i) {
        const float q = __uint_as_float(qv[i] << 16);
        QS[(seg * 16 + i) * 136 + k] = f2bf(q * __expf(hs.cum[i]));
        KS[(seg * 16 + i) * 136 + k] = f2bf(hs.kk[i] * __expf(-hs.cum[i]));
    }
    *(LAS u32x4*)(VT + k * 72 + seg * 16) = (u32x4){vv[0] | (vv[1] << 16), vv[2] | (vv[3] << 16), vv[4] | (vv[5] << 16), vv[6] | (vv[7] << 16)};
    *(LAS u32x4*)(VT + k * 72 + seg * 16 + 8) = (u32x4){vv[8] | (vv[9] << 16), vv[10] | (vv[11] << 16), vv[12] | (vv[13] << 16), vv[14] | (vv[15] << 16)};
    __syncthreads();
#pragma unroll
    for (int r = 0; r < 2; ++r) {
        const int idx = wave + 8 * r, tr = idx >> 2, tc = idx & 3;
        f32x4 acc = {0.f, 0.f, 0.f, 0.f};
        if (tc <= tr) {
#pragma unroll
            for (int ks = 0; ks < 4; ++ks) {
                const bf16x8 a = *(const LAS bf16x8*)(QS + (16 * tr + fr) * 136 + ks * 32 + fq * 8), b = *(const LAS bf16x8*)(KS + (16 * tc + fr) * 136 + ks * 32 + fq * 8);
                acc = __builtin_amdgcn_mfma_f32_16x16x32_bf16(b, a, acc, 0, 0, 0);
            }
#pragma unroll
            for (int j = 0; j < 4; ++j) if (16 * tc + 4 * fq + j > 16 * tr + fr) acc[j] = 0.f;
        }
        u32x2 w; w.x = cvt_pk_bf16(acc[0], acc[1]); w.y = cvt_pk_bf16(acc[2], acc[3]);
        *(LAS u32x2*)(PS + (16 * tr + fr) * 72 + 16 * tc + 4 * fq) = w;
    }
    __syncthreads();
    bf16x8 bv[2];
#pragma unroll
    for (int ks = 0; ks < 2; ++ks) bv[ks] = *(const LAS bf16x8*)(VT + (16 * wave + fr) * 72 + ks * 32 + fq * 8);
    f32x4 o[4];
#pragma unroll
    for (int tr = 0; tr < 4; ++tr) {
        f32x4 acc = {0.f, 0.f, 0.f, 0.f};
#pragma unroll
        for (int ks = 0; ks < 2; ++ks) { const bf16x8 a = *(const LAS bf16x8*)(PS + (16 * tr + fr) * 72 + ks * 32 + fq * 8); acc = __builtin_amdgcn_mfma_f32_16x16x32_bf16(bv[ks], a, acc, 0, 0, 0); }
#pragma unroll
        for (int ks = 0; ks < 4; ++ks) { const bf16x8 a = *(const LAS bf16x8*)(QS + (16 * tr + fr) * 136 + ks * 32 + fq * 8); acc = __builtin_amdgcn_mfma_f32_16x16x32_bf16(bs[ks], a, acc, 0, 0, 0); }
        o[tr] = acc;
        float ss = (acc[0] * acc[0] + acc[1] * acc[1]) + (acc[2] * acc[2] + acc[3] * acc[3]);
        ss += __shfl_xor(ss, 16); ss += __shfl_xor(ss, 32);
        if (fq == 0) RS[wave * 64 + 16 * tr + fr] = ss;
    }
    __syncthreads();
#pragma unroll
    for (int tr = 0; tr < 4; ++tr) {
        const int tl = 16 * tr + fr; float tt = 0.f;
#pragma unroll
        for (int w = 0; w < 8; ++w) tt += RS[w * 64 + tl];
        const float rinv = rsqrtf(tt * (1.f / 128.f) + EPS);
        const u32x2 sg = sgv[tr];
        u32x2 w;
        w.x = cvt_pk_bf16(o[tr][0] * rinv * gn[0] * bflo(sg.x), o[tr][1] * rinv * gn[1] * bfhi(sg.x));
        w.y = cvt_pk_bf16(o[tr][2] * rinv * gn[2] * bflo(sg.y), o[tr][3] * rinv * gn[3] * bfhi(sg.y));
        *(u32x2*)(M.O + (size_t)(t0 + tl) * DM + ocol) = w;
    }
    __syncthreads();
}

struct LruIn { float xm3, xm2, xm1; float xr[8]; unsigned gyv[8]; float hin; float cpv; };
__device__ __forceinline__ void lru_load(const Mix& M, int unit, int mode, LruIn& in) {
    const int tid = threadIdx.x, j = tid & 63, seg = tid >> 6;
    const int n = unit & 7, bc = unit >> 3, c = bc & 31, b = bc >> 5, t0 = bc * 64, ch0 = n * 64, ch = ch0 + j, tl0 = seg * 8;
    const bool first = (c == 0 && seg == 0);
    const float* xp = M.XB + (size_t)(t0 + tl0) * DH + ch;
    in.xm3 = first ? 0.f : xp[-3 * DH]; in.xm2 = first ? 0.f : xp[-2 * DH]; in.xm1 = first ? 0.f : xp[-1 * DH];
#pragma unroll
    for (int i = 0; i < 8; ++i) in.xr[i] = xp[i * DH];
    in.hin = (mode == 1) ? M.HST[(size_t)bc * 512 + ch] : 0.f;
#pragma unroll
    for (int i = 0; i < 8; ++i) in.gyv[i] = (mode == 1) ? (unsigned)M.GY[(size_t)(t0 + tl0 + i) * DH + ch] : 0u;
    in.cpv = (mode == 1 && c == 31 && tid < 192) ? M.XB[(size_t)(b * SEQ + SEQ - 3 + (tid >> 6)) * DH + ch0 + j] : 0.f;
}
__device__ __forceinline__ void lru_loop(const Mix& M, int mode, LAS unsigned char* lds) {
    const int tid = threadIdx.x, lane = tid & 63, wave = tid >> 6, fr = lane & 15, fq = lane >> 4, G = gridDim.x;
    const int j = tid & 63, seg = tid >> 6, tl0 = seg * 8;
    LAS bf16_t* XC16 = (LAS bf16_t*)(lds + 16640); LAS float* GR = (LAS float*)(lds + 25856); LAS float* GI = (LAS float*)(lds + 42496);
    LAS float* SEGA = (LAS float*)(lds + 59136); LAS float* SEGU = (LAS float*)(lds + 61184);
    int unit = blockIdx.x; if (unit >= 2048) return;
    const int gate = wave >> 2, tr = wave & 3;
    int ncache = -1; float w0 = 0.f, w1 = 0.f, w2 = 0.f, w3 = 0.f, cbias = 0.f, sp = 0.f; bf16x8 wb[4][2]; float bbv[4];
    LruIn cur; lru_load(M, unit, mode, cur);
    for (;;) {
        const int un = unit + G; const bool has = un < 2048;
        LruIn nxt; if (has) lru_load(M, un, mode, nxt);
        const int n = unit & 7, bc = unit >> 3, c = bc & 31, b = bc >> 5, t0 = bc * 64, ch0 = n * 64, ch = ch0 + j;
        if (n != ncache) {
            ncache = n;
            w0 = M.convw[ch]; w1 = M.convw[512 + ch]; w2 = M.convw[1024 + ch]; w3 = M.convw[1536 + ch]; cbias = M.convb[ch];
            const bf16_t* WT = (gate ? M.WXT : M.WAT) + n * 4096; const float* bias = (gate ? M.bx : M.ba) + ch0;
#pragma unroll
            for (int ct = 0; ct < 4; ++ct) { wb[ct][0] = *(const bf16x8*)(WT + (16 * ct + fr) * 64 + fq * 8); wb[ct][1] = *(const bf16x8*)(WT + (16 * ct + fr) * 64 + 32 + fq * 8); bbv[ct] = bias[16 * ct + fr]; }
            sp = log1pf(__expf(-M.lam[ch]));
        }
        float xm3 = cur.xm3, xm2 = cur.xm2, xm1 = cur.xm1; float xcv[8];
#pragma unroll
        for (int i = 0; i < 8; ++i) {
            const float x = cur.xr[i];
            const float xc = cbias + w0 * xm3 + w1 * xm2 + w2 * xm1 + w3 * x;
            xcv[i] = xc; XC16[(tl0 + i) * 72 + j] = f2bf(xc);
            xm3 = xm2; xm2 = xm1; xm1 = x;
        }
        __syncthreads();
        {
            LAS float* Gd = gate ? GI : GR;
            const bf16x8 a0 = *(const LAS bf16x8*)(XC16 + (16 * tr + fr) * 72 + fq * 8), a1 = *(const LAS bf16x8*)(XC16 + (16 * tr + fr) * 72 + 32 + fq * 8);
#pragma unroll
            for (int ct = 0; ct < 4; ++ct) {
                f32x4 acc = {0.f, 0.f, 0.f, 0.f};
                acc = __builtin_amdgcn_mfma_f32_16x16x32_bf16(a0, wb[ct][0], acc, 0, 0, 0);
                acc = __builtin_amdgcn_mfma_f32_16x16x32_bf16(a1, wb[ct][1], acc, 0, 0, 0);
#pragma unroll
                for (int jj = 0; jj < 4; ++jj) Gd[(16 * tr + 4 * fq + jj) * 65 + 16 * ct + fr] = sigm(acc[jj] + bbv[ct]);
            }
        }
        __syncthreads();
        float av[8], uv[8]; float A = 1.f, U = 0.f;
#pragma unroll
        for (int i = 0; i < 8; ++i) {
            const int tl = tl0 + i; const float r = GR[tl * 65 + j], ig = GI[tl * 65 + j];
            const float la = -8.f * r * sp, a = __expf(la); float mult = sqrtf(fmaxf(1.f - a * a, 0.f));
            if (la > -0.05f) mult = sqrtf(-expm1f(2.f * la));
            if (c == 0 && tl == 0) mult = 1.f;
            const float u = mult * ig * xcv[i];
            av[i] = a; uv[i] = u; U = a * U + u; A *= a;
        }
        SEGA[seg * 64 + j] = A; SEGU[seg * 64 + j] = U;
        __syncthreads();
        float hin = cur.hin;
#pragma unroll
        for (int s = 0; s < 8; ++s) if (s < seg) hin = SEGA[s * 64 + j] * hin + SEGU[s * 64 + j];
        if (mode == 0) {
            if (seg == 7) { float At = 1.f;
#pragma unroll
                for (int s = 0; s < 8; ++s) At *= SEGA[s * 64 + j];
                M.ACH[(size_t)bc * 512 + ch] = At; M.UCH[(size_t)bc * 512 + ch] = A * hin + U; }
        } else {
            float hh = hin;
#pragma unroll
            for (int i = 0; i < 8; ++i) {
                hh = av[i] * hh + uv[i];
                M.O[(size_t)(t0 + tl0 + i) * DM + 512 + ch] = f2bf(hh * __uint_as_float(cur.gyv[i] << 16));
            }
            if (c == 31 && seg == 7) M.out[OUT_LP + b * 512 + ch] = hh;
            if (c == 31 && tid < 192) M.out[OUT_CP + (size_t)(b * 3 + (tid >> 6)) * 512 + ch0 + j] = cur.cpv;
        }
        __syncthreads();
        if (!has) break;
        cur = nxt; unit = un;
    }
}

__device__ __forceinline__ void hgrn_sample_unit(const Mix& M, int unit, LAS unsigned char* lds) {
    const int tid = threadIdx.x, lane = tid & 63, wave = tid >> 6;
    const int h = unit & 3, b = unit >> 2, cb = h * 128, tb = TP + b * 4;
    LAS float* SQ = (LAS float*)lds;
    LAS float* SK = SQ + 512;
    LAS float* SD = SK + 512;
    LAS float* SP = SD + 128;
    LAS float* OP = SP + 32;
    LAS float* RS = OP + 2048;
    const int v = tid & 127, kq = tid >> 7;
    const size_t sb = ((size_t)(b * 4 + h) * 128) * 128;
    float s0v[32];
#pragma unroll
    for (int kx = 0; kx < 32; ++kx) s0v[kx] = M.st_h[sb + (size_t)(kq * 32 + kx) * 128 + v];
    float vv[4];
#pragma unroll
    for (int s = 0; s < 4; ++s) vv[s] = bf2f(M.V[(size_t)(tb + s) * DH + cb + v]);
    const float sgo = bf2f(M.SG[(size_t)(tb + kq) * DH + cb + v]), hno = M.hnorm[cb + v];
    if (tid < 128) {
        const int k = tid;
        const float l0 = M.lb[cb + k], l1 = M.lb[512 + cb + k];
        const float lb = 1.f / (1.f + expf(l1 - l0));
        float cum[4], kk[4], qv[4]; float run = 0.f;
#pragma unroll
        for (int s = 0; s < 4; ++s) {
            const float fz = M.FZ[(size_t)(tb + s) * DH + cb + k];
            const float sg = 1.f / (1.f + expf(-fz)), sn = 1.f / (1.f + expf(fz));
            run += logf(lb + (1.f - lb) * sg); cum[s] = run; kk[s] = (1.f - lb) * sn;
            qv[s] = bf2f(M.Q[(size_t)(tb + s) * DH + cb + k]);
        }
#pragma unroll
        for (int s = 0; s < 4; ++s) { SQ[s * 128 + k] = qv[s] * expf(cum[s]); SK[s * 128 + k] = kk[s] * expf(cum[3] - cum[s]); }
        SD[k] = expf(cum[3]);
        float pr[10]; int c = 0;
#pragma unroll
        for (int t = 0; t < 4; ++t)
#pragma unroll
            for (int s = 0; s <= t; ++s) { pr[c] = qv[t] * kk[s] * expf(cum[t] - cum[s]); ++c; }
#pragma unroll
        for (int i = 0; i < 10; ++i) { const float v = wave_sum(pr[i]); if (lane == 0) SP[wave * 16 + i] = v; }
    }
    __syncthreads();
    {
        float o[4] = {0.f, 0.f, 0.f, 0.f};
#pragma unroll
        for (int kx = 0; kx < 32; ++kx) {
            const int k = kq * 32 + kx;
            const float s0 = s0v[kx];
            float sn = SD[k] * s0;
#pragma unroll
            for (int s = 0; s < 4; ++s) { o[s] += SQ[s * 128 + k] * s0; sn += SK[s * 128 + k] * vv[s]; }
            M.out[OUT_HS + sb + (size_t)k * 128 + v] = sn;
        }
#pragma unroll
        for (int s = 0; s < 4; ++s) OP[(kq * 4 + s) * 128 + v] = o[s];
    }
    __syncthreads();
    {
        const int t = kq;
        float ov = (OP[(0 * 4 + t) * 128 + v] + OP[(1 * 4 + t) * 128 + v]) + (OP[(2 * 4 + t) * 128 + v] + OP[(3 * 4 + t) * 128 + v]);
        const int base = t * (t + 1) / 2;
        for (int s = 0; s <= t; ++s) ov += (SP[base + s] + SP[16 + base + s]) * vv[s];
        const float ssq = wave_sum(ov * ov);
        if (lane == 0) RS[wave] = ssq;
        __syncthreads();
        const float tt = RS[2 * t] + RS[2 * t + 1];
        const float rinv = rsqrtf(tt * (1.f / 128.f) + EPS);
        const size_t tok = (size_t)(tb + t);
        M.O[tok * DM + cb + v] = f2bf(ov * rinv * hno * sgo);
    }
    __syncthreads();
}

__device__ __forceinline__ void lru_sample_unit(const Mix& M, int b, LAS unsigned char* lds) {
    const int tid = threadIdx.x, ch = tid, n = ch >> 6, j = ch & 63, tb = TP + b * 4;
    LAS float* XC = (LAS float*)lds;
    float x[7];
#pragma unroll
    for (int r = 0; r < 3; ++r) x[r] = M.st_c[(size_t)(b * 3 + r) * 512 + ch];
#pragma unroll
    for (int s = 0; s < 4; ++s) x[3 + s] = M.XB[(size_t)(tb + s) * DH + ch];
    const float w0 = M.convw[ch], w1 = M.convw[512 + ch], w2 = M.convw[1024 + ch], w3 = M.convw[1536 + ch], cbias = M.convb[ch];
    float xc[4];
#pragma unroll
    for (int s = 0; s < 4; ++s) { xc[s] = cbias + w0 * x[s] + w1 * x[s + 1] + w2 * x[s + 2] + w3 * x[s + 3]; XC[s * 512 + ch] = xc[s]; }
#pragma unroll
    for (int r = 0; r < 3; ++r) M.out[OUT_CS + (size_t)(b * 3 + r) * 512 + ch] = x[4 + r];
    __syncthreads();
    float ra[4], rx[4];
    const float ba = M.ba[ch], bx = M.bx[ch];
#pragma unroll
    for (int s = 0; s < 4; ++s) { ra[s] = ba; rx[s] = bx; }
    const float* wa = M.wa + (size_t)n * 4096 + j; const float* wx = M.wx + (size_t)n * 4096 + j;
#pragma unroll 16
    for (int i = 0; i < 64; ++i) {
        const float a = wa[i * 64], xw = wx[i * 64];
#pragma unroll
        for (int s = 0; s < 4; ++s) { const float xv = XC[s * 512 + n * 64 + i]; ra[s] += xv * a; rx[s] += xv * xw; }
    }
    const float sp = log1pf(expf(-M.lam[ch]));
    float hh = M.st_l[(size_t)b * 512 + ch];
#pragma unroll
    for (int s = 0; s < 4; ++s) {
        const float r = 1.f / (1.f + expf(-ra[s])), ig = 1.f / (1.f + expf(-rx[s]));
        const float la = -8.f * r * sp, a = expf(la), mult = sqrtf(-expm1f(2.f * la));
        hh = a * hh + mult * ig * xc[s];
        M.O[(size_t)(tb + s) * DM + 512 + ch] = f2bf(hh * bf2f(M.GY[(size_t)(tb + s) * DH + ch]));
    }
    M.out[OUT_LS + (size_t)b * 512 + ch] = hh;
    __syncthreads();
}

__device__ __forceinline__ void scan_item(const Mix& M, int item) {
    const int tid = threadIdx.x;
    if (item < 1024) {
        const int e = item * 512 + tid, bh = e >> 14, vk = e & 16383, b = bh >> 2, h = bh & 3, v = vk >> 7, k = vk & 127;
        float l[32], d[32];
#pragma unroll
        for (int c = 0; c < 32; ++c) { const int unit = (b * 32 + c) * 4 + h; l[c] = bf2f(M.LT[(size_t)unit * 16384 + vk]); d[c] = M.DC[unit * 128 + k]; }
        float S = 0.f;
#pragma unroll
        for (int c = 0; c < 32; ++c) { const int unit = (b * 32 + c) * 4 + h; M.LT[(size_t)unit * 16384 + vk] = f2bf(S); S = d[c] * S + l[c]; }
        M.out[OUT_HP + ((size_t)(b * 4 + h) * 128 + k) * 128 + v] = S;
    } else {
        const int e = (item - 1024) * 512 + tid, b = e >> 9, ch = e & 511;
        float hcar = 0.f;
        for (int c = 0; c < 32; ++c) { const size_t idx = (size_t)(b * 32 + c) * 512 + ch; M.HST[idx] = hcar; hcar = M.ACH[idx] * hcar + M.UCH[idx]; }
    }
}

__global__ void __launch_bounds__(512, 2) mk_fwd(Params p) {
    extern __shared__ __attribute__((aligned(16))) unsigned char lds_raw[];
    LAS unsigned char* lds = (LAS unsigned char*)lds_raw;
    const int lo = p.ph_lo, hi = p.ph_hi, G = gridDim.x;
    unsigned char* ws = p.ws;
#define IN(k) (lo <= (k) && (k) < hi)
    volatile LAS unsigned* xst = (volatile LAS unsigned*)(lds + 131072);
    if (threadIdx.x < 16) xst[threadIdx.x] = 0u;
    __syncthreads();
    XcdBarrier xbar; xbar.bar = (unsigned*)(ws + WS_BAR); xbar.x = 0; xbar.st = xst;
    if (hi - lo > 1) xbar = xcd_barrier_post((unsigned*)(ws + WS_BAR), xst);
    if (hi == 0x7fffffff) cg::this_grid().sync();
#define SEAM(k) do { if (IN(k) && IN((k) + 1)) { xcd_barrier(xbar); } } while (0)
    bf16_t* B0 = (bf16_t*)(ws + WS_B0); bf16_t* B1 = (bf16_t*)(ws + WS_B1); bf16_t* H = (bf16_t*)(ws + WS_H);
    float* SS0 = (float*)(ws + WS_SS0); float* SS1 = (float*)(ws + WS_SS1); float* SS2 = (float*)(ws + WS_SS2); float* SS3 = (float*)(ws + WS_SS3);

    if (IN(0)) { phase0(p, lds); __syncthreads(); }
    SEAM(0);
    if (IN(1)) {
        pg8::Gemm g{B0, (const bf16_t*)(ws + WS_WG1), T_ALL, 2 * DFF, DM}; pg8::StaticOrder S; S.init(T_ALL, 2 * DFF, G, (int)blockIdx.x);
        EpiGateUp E{H, SS0};
        pg8::gemm_phase<EpiGateUp, pg8::StaticOrder, PG8_ALIGN, PG8_SP2>(lds, g, S, E);
    }
    SEAM(1);
    if (IN(2)) {
        pg8::Gemm g{H, (const bf16_t*)(ws + WS_WD1), TP, DM, DFF}; pg8::StaticOrder S; S.init(TP, DM, G, (int)blockIdx.x);
        EpiResid E{p.in[0], p.in[1], p.out, B0, p.in[9], SS1, 0.5f};
        pg8::gemm_phase<EpiResid, pg8::StaticOrder, PG8_ALIGN, PG8_SP2>(lds, g, S, E);
        SmallResid Es{p.in[1] - (size_t)TP * DM, p.out, B0, p.in[9], SS1, 0.5f};
        small_gemm<SmallResid, DFF>(H, (const bf16_t*)(ws + WS_WD1), DM, Es, lds);
    }
    SEAM(2);
    if (IN(3)) {
        pg8::Gemm g{B0, (const bf16_t*)(ws + WS_WIN), TP, DIN, DM}; pg8::StaticOrder S; S.init(TP, DIN, G, (int)blockIdx.x);
        EpiProj E{(bf16_t*)(ws + WS_Q), (bf16_t*)(ws + WS_V), (bf16_t*)(ws + WS_SG), (bf16_t*)(ws + WS_GY), (float*)(ws + WS_FZ), (float*)(ws + WS_XB), SS1};
        pg8::gemm_phase<EpiProj, pg8::StaticOrder, PG8_ALIGN, PG8_SP2>(lds, g, S, E);
        SmallProj Es{(bf16_t*)(ws + WS_Q), (bf16_t*)(ws + WS_V), (bf16_t*)(ws + WS_SG), (bf16_t*)(ws + WS_GY), (float*)(ws + WS_FZ), (float*)(ws + WS_XB), SS1};
        small_gemm<SmallProj, DM>(B0, (const bf16_t*)(ws + WS_WIN), DIN, Es, lds);
    }
    SEAM(3);
    Mix M;
    M.Q = (const bf16_t*)(ws + WS_Q); M.V = (const bf16_t*)(ws + WS_V); M.SG = (const bf16_t*)(ws + WS_SG); M.GY = (const bf16_t*)(ws + WS_GY);
    M.FZ = (const float*)(ws + WS_FZ); M.XB = (const float*)(ws + WS_XB); M.LT = (bf16_t*)(ws + WS_LT); M.DC = (float*)(ws + WS_DC);
    M.ACH = (float*)(ws + WS_ACH); M.UCH = (float*)(ws + WS_UCH); M.HST = (float*)(ws + WS_HST); M.O = B0;
    M.WAT = (const bf16_t*)(ws + WS_WAT); M.WXT = (const bf16_t*)(ws + WS_WXT);
    M.lb = p.in[11]; M.hnorm = p.in[12]; M.convw = p.in[13]; M.convb = p.in[14]; M.wa = p.in[15]; M.ba = p.in[16]; M.wx = p.in[17]; M.bx = p.in[18]; M.lam = p.in[19];
    M.st_h = p.in[2]; M.st_l = p.in[3]; M.st_c = p.in[4]; M.out = p.out;
    if (IN(4)) {
        for (int u = blockIdx.x; u < 512; u += G) hgrn_sample_unit(M, u, lds);
        for (int u = blockIdx.x; u < 1024; u += G) hgrn_local_unit(M, u, lds);
        lru_loop(M, 0, lds);
        for (int u = G - 1 - (int)blockIdx.x; u < 128; u += G) lru_sample_unit(M, u, lds);
    }
    SEAM(4);
    if (IN(5)) { for (int it = blockIdx.x; it < 1032; it += G) scan_item(M, it); }
    SEAM(5);
    if (IN(6)) {
        for (int u = blockIdx.x; u < 1024; u += G) hgrn_out_unit(M, u, lds);
        lru_loop(M, 1, lds);
    }
    SEAM(6);
    if (IN(7)) {
        pg8::Gemm g{B0, (const bf16_t*)(ws + WS_WO), TP, DM, DM}; pg8::StaticOrder S; S.init(TP, DM, G, (int)blockIdx.x);
        EpiResid E{p.out, p.out + (size_t)TP * DM, p.out, B1, p.in[21], SS2, 1.0f};
        pg8::gemm_phase<EpiResid, pg8::StaticOrder, PG8_ALIGN, PG8_SP2>(lds, g, S, E);
        SmallResid Es{p.out, p.out, B1, p.in[21], SS2, 1.0f};
        small_gemm<SmallResid, DM>(B0, (const bf16_t*)(ws + WS_WO), DM, Es, lds);
    }
    SEAM(7);
    if (IN(8)) {
        pg8::Gemm g{B1, (const bf16_t*)(ws + WS_WG2), T_ALL, 2 * DFF, DM}; pg8::StaticOrder S; S.init(T_ALL, 2 * DFF, G, (int)blockIdx.x);
        EpiGateUp E{H, SS2};
        pg8::gemm_phase<EpiGateUp, pg8::StaticOrder, PG8_ALIGN, PG8_SP2>(lds, g, S, E);
    }
    SEAM(8);
    if (IN(9)) {
        pg8::Gemm g{H, (const bf16_t*)(ws + WS_WD2), TP, DM, DFF}; pg8::StaticOrder S; S.init(TP, DM, G, (int)blockIdx.x);
        EpiResid E{p.out, p.out + (size_t)TP * DM, p.out, nullptr, nullptr, SS3, 0.5f};
        pg8::gemm_phase<EpiResid, pg8::StaticOrder, PG8_ALIGN, PG8_SP2>(lds, g, S, E);
        SmallResid Es{p.out, p.out, nullptr, nullptr, SS3, 0.5f};
        small_gemm<SmallResid, DFF>(H, (const bf16_t*)(ws + WS_WD2), DM, Es, lds);
    }
    SEAM(9);
    if (IN(10)) phase_final(p);
#undef IN
#undef SEAM
}

extern "C" void kernel_launch(void* const* d_in, const int* in_sizes, int n_in, void* d_out, int out_size, void* d_ws, size_t ws_size, hipStream_t stream) {
    static int grid = 0;
    if (grid == 0) {
        if (n_in != 26 || ws_size < WS_END2) { fprintf(stderr, "kernel_launch: unexpected n_in %d or ws_size %zu (need %zu)\n", n_in, ws_size, (size_t)WS_END2); grid = -1; return; }
        int dev = 0, cus = 0, per_cu = 0;
        hipGetDevice(&dev); hipDeviceGetAttribute(&cus, hipDeviceAttributeMultiprocessorCount, dev);
        if (hipFuncSetAttribute((const void*)mk_fwd, hipFuncAttributeMaxDynamicSharedMemorySize, LDS_BYTES) != hipSuccess) { fprintf(stderr, "kernel_launch: hipFuncSetAttribute failed\n"); grid = -1; return; }
        if (hipOccupancyMaxActiveBlocksPerMultiprocessor(&per_cu, (const void*)mk_fwd, 512, LDS_BYTES) != hipSuccess || per_cu < 1) { fprintf(stderr, "kernel_launch: occupancy query says %d\n", per_cu); per_cu = 1; }
        (void)hipGetLastError();
        grid = cus;
    }
    if (grid < 0) return;
    Params p{};
    for (int i = 0; i < 26; ++i) p.in[i] = (const float*)d_in[i];
    p.out = (float*)d_out; p.ws = (unsigned char*)d_ws;
#if MK_PER_PHASE
    for (int ph = 0; ph < MK_NPH; ++ph) { p.ph_lo = ph; p.ph_hi = ph + 1; hipLaunchKernelGGL(mk_fwd, dim3(grid), dim3(512), LDS_BYTES, stream, p); if ((MK_DUP >> ph) & 1) hipLaunchKernelGGL(mk_fwd, dim3(grid), dim3(512), LDS_BYTES, stream, p); }
#else
    p.ph_lo = 0; p.ph_hi = MK_NPH;
    if (hipMemsetAsync((char*)d_ws + WS_BAR, 0, 16384, stream) != hipSuccess) { fprintf(stderr, "memset failed\n"); return; }
    void* args[] = {&p};
    hipError_t e = hipLaunchCooperativeKernel((const void*)mk_fwd, dim3(grid), dim3(512), args, LDS_BYTES, stream);
    if (e != hipSuccess) fprintf(stderr, "cooperative launch failed: %s (grid %d)\n", hipGetErrorString(e), grid);
#endif
}
```

```cpp
#include <hip/hip_runtime.h>
#include <hip/hip_cooperative_groups.h>
#include <cstdio>
#include <cstdint>
namespace cg = cooperative_groups;

#ifndef MK_DUP
#define MK_DUP 0
#endif
#ifndef MK_NPH
#define MK_NPH 11
#endif
#ifndef MK_PER_PHASE
#define MK_PER_PHASE 0
#endif

#define LAS __attribute__((address_space(3)))
typedef unsigned short bf16_t;
typedef short bf16x8 __attribute__((ext_vector_type(8)));
typedef float f32x4 __attribute__((ext_vector_type(4)));
typedef unsigned u32x4 __attribute__((ext_vector_type(4)));
typedef unsigned u32x2 __attribute__((ext_vector_type(2)));

constexpr int T_ALL = 16896, TP = 16384, DM = 1024, DFF = 2816, DIN = 3072, DH = 512;
constexpr int SEQ = 2048, NB = 8, NCH = 32, DECB = 128;
constexpr float EPS = 1e-6f;

constexpr size_t OUT_Y = 0, OUT_HP = 17301504, OUT_LP = 17825792, OUT_CP = 17829888, OUT_HS = 17842176, OUT_LS = 26230784, OUT_CS = 26296320;

constexpr size_t WS_WG1 = 0;
constexpr size_t WS_WD1 = WS_WG1 + (size_t)5632 * 1024 * 2;
constexpr size_t WS_WIN = WS_WD1 + (size_t)1024 * 2816 * 2;
constexpr size_t WS_WO  = WS_WIN + (size_t)3072 * 1024 * 2;
constexpr size_t WS_WG2 = WS_WO + (size_t)1024 * 1024 * 2;
constexpr size_t WS_WD2 = WS_WG2 + (size_t)5632 * 1024 * 2;
constexpr size_t WS_WAT = WS_WD2 + (size_t)1024 * 2816 * 2;
constexpr size_t WS_WXT = WS_WAT + 65536;
constexpr size_t WS_SS0 = WS_WXT + 65536;
constexpr size_t SS_BYTES = (size_t)T_ALL * 16 * 4;
constexpr size_t WS_SS1 = WS_SS0 + SS_BYTES, WS_SS2 = WS_SS1 + SS_BYTES, WS_SS3 = WS_SS2 + SS_BYTES;
constexpr size_t WS_DC  = WS_SS3 + SS_BYTES;
constexpr size_t WS_ACH = WS_DC + (size_t)1024 * 128 * 4;
constexpr size_t WS_UCH = WS_ACH + (size_t)NB * NCH * 512 * 4;
constexpr size_t WS_HST = WS_UCH + (size_t)NB * NCH * 512 * 4;
constexpr size_t WS_B0  = WS_HST + (size_t)NB * NCH * 512 * 4;
constexpr size_t WS_R   = WS_B0 + (size_t)T_ALL * 1024 * 2;
constexpr size_t WS_H   = WS_R;
constexpr size_t WS_B1  = WS_H + (size_t)T_ALL * 2816 * 2;
constexpr size_t WS_Q   = WS_R;
constexpr size_t WS_V   = WS_Q + (size_t)T_ALL * 512 * 2;
constexpr size_t WS_SG  = WS_V + (size_t)T_ALL * 512 * 2;
constexpr size_t WS_GY  = WS_SG + (size_t)T_ALL * 512 * 2;
constexpr size_t WS_FZ  = WS_GY + (size_t)T_ALL * 512 * 2;
constexpr size_t WS_XB  = WS_FZ + (size_t)T_ALL * 512 * 4;
constexpr size_t WS_LT  = WS_XB + (size_t)T_ALL * 512 * 4;
constexpr size_t WS_END = WS_LT + (size_t)1024 * 16384 * 2;
constexpr size_t WS_BAR = WS_END;
constexpr size_t WS_END2 = WS_BAR + 16384;
static_assert(WS_END2 <= 268435456, "workspace budget");
static_assert(WS_B1 + (size_t)T_ALL * 1024 * 2 <= WS_END, "B1 inside R");

constexpr int LDS_BYTES = 131072 + 64;

typedef __bf16 nbf16x2 __attribute__((ext_vector_type(2)));
typedef float f32x2 __attribute__((ext_vector_type(2)));
__device__ __forceinline__ unsigned cvt_pk_bf16(float lo, float hi) { const nbf16x2 r = __builtin_convertvector((f32x2){lo, hi}, nbf16x2); return __builtin_bit_cast(unsigned, r); }
__device__ __forceinline__ bf16_t f2bf(float f) { return (bf16_t)(cvt_pk_bf16(f, 0.f) & 0xffffu); }
__device__ __forceinline__ float bf2f(bf16_t b) { return __uint_as_float(((unsigned)b) << 16); }
__device__ __forceinline__ float bflo(unsigned w) { return __uint_as_float(w << 16); }
__device__ __forceinline__ float bfhi(unsigned w) { return __uint_as_float(w & 0xffff0000u); }
__device__ __forceinline__ float sigm(float x) { return __builtin_amdgcn_rcpf(1.f + __expf(-x)); }
__device__ __forceinline__ float rowscale(const float* ss, int row) {
    const f32x4* p = (const f32x4*)(ss + (size_t)row * 16);
    const f32x4 a = p[0], b = p[1], c = p[2], d = p[3];
    const float s = (((a.x + a.y) + (a.z + a.w)) + ((b.x + b.y) + (b.z + b.w))) + (((c.x + c.y) + (c.z + c.w)) + ((d.x + d.y) + (d.z + d.w)));
    return rsqrtf(s * (1.f / 1024.f) + EPS);
}
__device__ __forceinline__ void rowscale8(const float* ss, int row0, int fq, float (&rs)[8]) {
    f32x4 q[8];
#pragma unroll
    for (int i = 0; i < 8; ++i) q[i] = *(const f32x4*)(ss + (size_t)(row0 + (i >> 2) * 128 + (i & 3) * 16) * 16 + 4 * fq);
#pragma unroll
    for (int i = 0; i < 8; ++i) { float t = (q[i].x + q[i].y) + (q[i].z + q[i].w); t += __shfl_xor(t, 16); t += __shfl_xor(t, 32); rs[i] = rsqrtf(t * (1.f / 1024.f) + EPS); }
}
__device__ __forceinline__ float wave_sum(float v) {
#pragma unroll
    for (int o = 1; o < 64; o <<= 1) v += __shfl_xor(v, o);
    return v;
}
#define LDS_WAIT() asm volatile("s_waitcnt lgkmcnt(0)" ::: "memory")

namespace pg8 {
constexpr int BM = 256, BK = 64, HALF = 128, HTB = HALF * BK * 2, STAGE_BYTES = 8 * HTB, NXCD = 8, WGM = 8;
__host__ __device__ __forceinline__ int lds_byte(int r, int c) { const int st = (r >> 4) * 2 + (c >> 5), rr = r & 15, cc = c & 31, ob = rr * 64 + cc * 2; return st * 1024 + (ob ^ (((ob >> 9) & 1) << 5)); }
__host__ __device__ __forceinline__ void stage_rc(int b, int& R, int& C) { const int st = b / 1024, sb = b % 1024, swz = sb ^ (((sb >> 9) & 1) << 5); R = (st >> 1) * 16 + swz / 64; C = (st & 1) * 32 + (swz % 64) / 2; }
__host__ __device__ __forceinline__ int perm32(int rho) { const int n = rho >> 4, i = rho & 15; return 8 * (i >> 2) + 4 * n + (i & 3); }
struct Unit { int pm, pn; };
struct Gemm { const bf16_t* A; const bf16_t* Bt; int M, N, K; };
struct StaticOrder {
    int nM, nN, nwg, G, c;
    __host__ __device__ void init(int M, int N, int G_, int c_) { nM = M / BM; nN = N / BM; nwg = nM * nN; G = G_; c = c_; }
    __host__ __device__ bool next(int i, Unit& u) const {
        const long L = (long)i * G + c; if (L >= nwg) return false;
        int wgid = (int)L; { const int q = nwg / NXCD, r = nwg % NXCD, xcd = wgid % NXCD, off = wgid / NXCD; wgid = (xcd < r ? xcd * (q + 1) : r * (q + 1) + (xcd - r) * q) + off; }
        const int nig = WGM * nN, gid = wgid / nig, fm = gid * WGM, gsz = (nM - fm) < WGM ? (nM - fm) : WGM;
        u.pm = fm + ((wgid % nig) % gsz); u.pn = (wgid % nig) / gsz; return true;
    }
    __device__ __forceinline__ void a_ready(const Unit&) const {}
    __device__ __forceinline__ void done(const Unit&) const {}
};

template <class Epi, class Sched, bool ALIGN_EPI = false, bool SP2 = false>
__device__ __forceinline__ void gemm_phase(LAS unsigned char* lds, const Gemm g, const Sched& S, const Epi& E) {
    const int tid = threadIdx.x, wid = __builtin_amdgcn_readfirstlane(tid >> 6), lane = tid & 63, wr = wid >> 2, wc = wid & 3, fr = lane & 15, fq = lane >> 4;
    const int K = g.K, nt = K / BK;
    unsigned voffA[2], voffB[2];
#pragma unroll
    for (int i = 0; i < 2; ++i) { int R, C; stage_rc(tid * 16 + i * 8192, R, C); const int Rb = Epi::PERM ? ((R & ~31) + perm32(R & 31)) : R;
        voffA[i] = (unsigned)(R * K + C) * 2u; voffB[i] = (unsigned)(Rb * K + C) * 2u; }
    const size_t kstep = (size_t)(BK * 2);
    const size_t hstep = (size_t)HALF * K * 2;
    const size_t tstep = 2 * hstep;
    const unsigned ldsw = (unsigned)wid * 1024u;
    const int aoff = lds_byte(wr * 64 + fr, fq * 8), boff = lds_byte(wc * 32 + fr, fq * 8);
#define PG8_SA(b, h) (((b) * 2 + (h)) * HTB)
#define PG8_SB(b, h) ((4 + (b) * 2 + (h)) * HTB)
#define PG8_STAGE(bufoff, gbase, voff) do { _Pragma("unroll") for (int _i = 0; _i < 2; ++_i) \
        __builtin_amdgcn_global_load_lds((const unsigned*)((const char*)(gbase) + (voff)[_i]), (LAS unsigned*)(lds + (bufoff) + ldsw + _i * 8192), 16, 0, 0); } while (0)
#define PG8_LDA(dst, b, h) do { _Pragma("unroll") for (int m = 0; m < 4; ++m) _Pragma("unroll") for (int k = 0; k < 2; ++k) dst[m][k] = *(const LAS bf16x8*)(lds + PG8_SA(b, h) + aoff + m * 2048 + k * 1024); } while (0)
#define PG8_LDB(dst, b, h) do { _Pragma("unroll") for (int n = 0; n < 2; ++n) _Pragma("unroll") for (int k = 0; k < 2; ++k) dst[n][k] = *(const LAS bf16x8*)(lds + PG8_SB(b, h) + boff + n * 2048 + k * 1024); } while (0)
#define PG8_MMA(ai, bj, At, Bt) do { __builtin_amdgcn_s_setprio(1); _Pragma("unroll") for (int m = 0; m < 4; ++m) _Pragma("unroll") for (int n = 0; n < 2; ++n) _Pragma("unroll") for (int k = 0; k < 2; ++k) \
        acc[ai][bj][m][n] = __builtin_amdgcn_mfma_f32_16x16x32_bf16(Bt[n][k], At[m][k], acc[ai][bj][m][n], 0, 0, 0); __builtin_amdgcn_s_setprio(0); } while (0)
#define PG8_WAIT_V(n) asm volatile("s_waitcnt vmcnt(" #n ")" ::: "memory")
#define PG8_WAIT_L(n) asm volatile("s_waitcnt lgkmcnt(" #n ")" ::: "memory")
#define PG8_BAR __builtin_amdgcn_s_barrier()
#define PG8_SCHED __builtin_amdgcn_sched_barrier(0)
    Unit cur, nxt; int ui = 0;
    if (!S.next(0, cur)) return;
    f32x4 acc[2][2][4][2];
#pragma unroll
    for (int a = 0; a < 2; ++a)
#pragma unroll
        for (int b = 0; b < 2; ++b)
#pragma unroll
            for (int m = 0; m < 4; ++m)
#pragma unroll
                for (int n = 0; n < 2; ++n) acc[a][b][m][n] = (f32x4){0.f, 0.f, 0.f, 0.f};
    bf16x8 At[4][2], B0[2][2], B1[2][2];
    const char* cA = (const char*)g.A + (size_t)cur.pm * tstep; const char* cB = (const char*)g.Bt + (size_t)cur.pn * tstep;
    S.a_ready(cur);
    if constexpr (SP2) {
        PG8_STAGE(PG8_SB(0, 0), cB, voffB); PG8_STAGE(PG8_SB(0, 1), cB + hstep, voffB); PG8_STAGE(PG8_SA(0, 0), cA, voffA); PG8_STAGE(PG8_SA(0, 1), cA + hstep, voffA);
        if (wr == 1) PG8_BAR;
        PG8_WAIT_V(2); PG8_BAR;
        PG8_STAGE(PG8_SB(1, 0), cB + kstep, voffB); PG8_STAGE(PG8_SA(1, 0), cA + kstep, voffA); PG8_STAGE(PG8_SB(1, 1), cB + hstep + kstep, voffB);
        PG8_WAIT_V(6); PG8_BAR;
    } else {
        PG8_STAGE(PG8_SB(0, 0), cB, voffB); PG8_STAGE(PG8_SA(0, 0), cA, voffA); PG8_STAGE(PG8_SB(0, 1), cB + hstep, voffB); PG8_STAGE(PG8_SA(0, 1), cA + hstep, voffA);
        if (wr == 1) PG8_BAR;
        PG8_WAIT_V(4); PG8_BAR;
        PG8_STAGE(PG8_SB(1, 0), cB + kstep, voffB); PG8_STAGE(PG8_SA(1, 0), cA + kstep, voffA); PG8_STAGE(PG8_SB(1, 1), cB + hstep + kstep, voffB);
        PG8_WAIT_V(6); PG8_BAR;
    }
    for (;;) {
        const bool has_next = S.next(ui + 1, nxt);
        const char* nA = has_next ? (const char*)g.A + (size_t)nxt.pm * tstep : cA; const char* nB = has_next ? (const char*)g.Bt + (size_t)nxt.pn * tstep : cB;
        for (int t = 0; t < nt; t += 2) {
            const bool last = (t == nt - 2);
            const char* a1 = cA + (size_t)(t + 1) * kstep;
            const char* a2 = last ? nA : cA + (size_t)(t + 2) * kstep; const char* b2 = last ? nB : cB + (size_t)(t + 2) * kstep;
            const char* a3 = a2 + kstep; const char* b3 = b2 + kstep;
            if (last && has_next) S.a_ready(nxt);
            if constexpr (SP2) {
            PG8_LDB(B0, 0, 0); PG8_LDB(B1, 0, 1); PG8_SCHED; PG8_LDA(At, 0, 0); PG8_STAGE(PG8_SA(1, 1), a1 + hstep, voffA);
            PG8_WAIT_V(8); PG8_WAIT_L(0); PG8_BAR; PG8_MMA(0, 0, At, B0); PG8_MMA(0, 1, At, B1); PG8_BAR; PG8_SCHED;
            PG8_LDA(At, 0, 1); PG8_STAGE(PG8_SB(0, 0), b2, voffB); PG8_STAGE(PG8_SB(0, 1), b2 + hstep, voffB); PG8_STAGE(PG8_SA(0, 0), a2, voffA);
            PG8_WAIT_V(8); PG8_WAIT_L(0); PG8_BAR; PG8_MMA(1, 0, At, B0); PG8_MMA(1, 1, At, B1); PG8_BAR; PG8_SCHED;
            PG8_LDB(B0, 1, 0); PG8_LDB(B1, 1, 1); PG8_SCHED; PG8_LDA(At, 1, 0); PG8_STAGE(PG8_SA(0, 1), a2 + hstep, voffA);
            PG8_WAIT_V(8); PG8_WAIT_L(0); PG8_BAR; PG8_MMA(0, 0, At, B0); PG8_MMA(0, 1, At, B1); PG8_BAR; PG8_SCHED;
            PG8_LDA(At, 1, 1); PG8_STAGE(PG8_SB(1, 0), b3, voffB); PG8_STAGE(PG8_SB(1, 1), b3 + hstep, voffB); PG8_STAGE(PG8_SA(1, 0), a3, voffA);
            PG8_WAIT_V(8); PG8_WAIT_L(0); PG8_BAR; PG8_MMA(1, 0, At, B0); PG8_MMA(1, 1, At, B1); PG8_BAR; PG8_SCHED;
            } else {
            PG8_LDB(B0, 0, 0); PG8_SCHED; PG8_LDA(At, 0, 0); PG8_STAGE(PG8_SA(1, 1), a1 + hstep, voffA);
            PG8_WAIT_L(8); PG8_BAR; PG8_WAIT_L(0); PG8_MMA(0, 0, At, B0); PG8_BAR; PG8_SCHED;
            PG8_LDB(B1, 0, 1); PG8_STAGE(PG8_SB(0, 0), b2, voffB);
            PG8_BAR; PG8_WAIT_L(0); PG8_MMA(0, 1, At, B1); PG8_BAR;
            PG8_LDA(At, 0, 1); PG8_STAGE(PG8_SA(0, 0), a2, voffA);
            PG8_BAR; PG8_WAIT_L(0); PG8_MMA(1, 0, At, B0); PG8_BAR; PG8_SCHED;
            PG8_STAGE(PG8_SB(0, 1), b2 + hstep, voffB);
            PG8_WAIT_V(6); PG8_BAR; PG8_MMA(1, 1, At, B1); PG8_BAR;
            PG8_LDB(B0, 1, 0); PG8_SCHED; PG8_LDA(At, 1, 0); PG8_STAGE(PG8_SA(0, 1), a2 + hstep, voffA);
            PG8_WAIT_L(8); PG8_BAR; PG8_WAIT_L(0); PG8_MMA(0, 0, At, B0); PG8_BAR; PG8_SCHED;
            PG8_LDB(B1, 1, 1); PG8_STAGE(PG8_SB(1, 0), b3, voffB);
            PG8_BAR; PG8_WAIT_L(0); PG8_MMA(0, 1, At, B1); PG8_BAR;
            PG8_LDA(At, 1, 1); PG8_STAGE(PG8_SA(1, 0), a3, voffA);
            PG8_BAR; PG8_WAIT_L(0); PG8_MMA(1, 0, At, B0); PG8_BAR; PG8_SCHED;
            PG8_STAGE(PG8_SB(1, 1), b3 + hstep, voffB);
            PG8_WAIT_V(6); PG8_BAR; PG8_MMA(1, 1, At, B1); PG8_BAR;
            }
        }
        if constexpr (ALIGN_EPI) { if (wr == 0) PG8_BAR; }
        E(acc, cur, wr, wc, fr, fq); S.done(cur);
        if (!has_next) break;
#pragma unroll
        for (int a = 0; a < 2; ++a)
#pragma unroll
            for (int b = 0; b < 2; ++b)
#pragma unroll
                for (int m = 0; m < 4; ++m)
#pragma unroll
                    for (int n = 0; n < 2; ++n) acc[a][b][m][n] = (f32x4){0.f, 0.f, 0.f, 0.f};
        cur = nxt; cA = nA; cB = nB; ++ui;
        if constexpr (ALIGN_EPI) { if (wr == 1) PG8_BAR; }
    }
    PG8_WAIT_V(0);
    if constexpr (!ALIGN_EPI) { if (wr == 0) PG8_BAR; }
    PG8_BAR;
#undef PG8_SA
#undef PG8_SB
#undef PG8_STAGE
#undef PG8_LDA
#undef PG8_LDB
#undef PG8_MMA
#undef PG8_WAIT_V
#undef PG8_WAIT_L
#undef PG8_BAR
#undef PG8_SCHED
}
}

#ifndef PG8_SP2
#define PG8_SP2 true
#endif
#ifndef PG8_ALIGN
#define PG8_ALIGN true
#endif

struct EpiGateUp {
    static constexpr bool PERM = true;
    bf16_t* H; const float* ss;
    __device__ __forceinline__ void operator()(const f32x4 (&acc)[2][2][4][2], const pg8::Unit& u, int wr, int wc, int fr, int fq) const {
        const int row0 = u.pm * 256 + wr * 64 + fr, col0 = u.pn * 128 + wc * 32 + 8 * fq;
        float rsv[8]; rowscale8(ss, row0, fq, rsv);
#pragma unroll
        for (int ai = 0; ai < 2; ++ai)
#pragma unroll
            for (int m = 0; m < 4; ++m) {
                const int row = row0 + ai * 128 + m * 16; const float rs = rsv[ai * 4 + m];
                float h[8];
#pragma unroll
                for (int n = 0; n < 2; ++n)
#pragma unroll
                    for (int j = 0; j < 4; ++j) { const float g = acc[ai][0][m][n][j] * rs, up = acc[ai][1][m][n][j] * rs; h[n * 4 + j] = g * sigm(g) * up; }
                u32x4 w; w.x = cvt_pk_bf16(h[0], h[1]); w.y = cvt_pk_bf16(h[2], h[3]); w.z = cvt_pk_bf16(h[4], h[5]); w.w = cvt_pk_bf16(h[6], h[7]);
                *(u32x4*)(H + (size_t)row * DFF + col0) = w;
            }
    }
};
struct EpiResid {
    static constexpr bool PERM = true;
    const float* xin_p; const float* xin_s; float* xout; bf16_t* ax; const float* gnext; float* ssout; float scale;
    __device__ __forceinline__ void operator()(const f32x4 (&acc)[2][2][4][2], const pg8::Unit& u, int wr, int wc, int fr, int fq) const {
        const int row0 = u.pm * 256 + wr * 64 + fr, col0 = u.pn * 256 + wc * 32 + 8 * fq;
        const float* xb = (u.pm < 64) ? xin_p : (xin_s - (size_t)TP * DM);
        f32x4 gn[2][2];
#pragma unroll
        for (int bj = 0; bj < 2; ++bj)
#pragma unroll
            for (int n = 0; n < 2; ++n) gn[bj][n] = ax ? *(const f32x4*)(gnext + col0 + bj * 128 + 4 * n) : (f32x4){1.f, 1.f, 1.f, 1.f};
#pragma unroll
        for (int ai = 0; ai < 2; ++ai) {
            f32x4 xr[4][2][2];
#pragma unroll
            for (int m = 0; m < 4; ++m)
#pragma unroll
                for (int bj = 0; bj < 2; ++bj) { const float* px = xb + (size_t)(row0 + ai * 128 + m * 16) * DM + col0 + bj * 128; xr[m][bj][0] = *(const f32x4*)px; xr[m][bj][1] = *(const f32x4*)(px + 4); }
#pragma unroll
            for (int m = 0; m < 4; ++m) {
                const int row = row0 + ai * 128 + m * 16; const size_t off = (size_t)row * DM + col0; float sq = 0.f;
#pragma unroll
                for (int bj = 0; bj < 2; ++bj) {
                    const f32x4 x0 = xr[m][bj][0], x1 = xr[m][bj][1];
                    const f32x4 v0 = x0 + acc[ai][bj][m][0] * scale, v1 = x1 + acc[ai][bj][m][1] * scale;
                    *(f32x4*)(xout + off + bj * 128) = v0; *(f32x4*)(xout + off + bj * 128 + 4) = v1;
                    sq += ((v0[0] * v0[0] + v0[1] * v0[1]) + (v0[2] * v0[2] + v0[3] * v0[3])) + ((v1[0] * v1[0] + v1[1] * v1[1]) + (v1[2] * v1[2] + v1[3] * v1[3]));
                    if (ax) { const f32x4 a0 = v0 * gn[bj][0], a1 = v1 * gn[bj][1];
                        u32x4 w; w.x = cvt_pk_bf16(a0[0], a0[1]); w.y = cvt_pk_bf16(a0[2], a0[3]); w.z = cvt_pk_bf16(a1[0], a1[1]); w.w = cvt_pk_bf16(a1[2], a1[3]);
                        *(u32x4*)(ax + off + bj * 128) = w; }
                }
                sq += __shfl_xor(sq, 16); sq += __shfl_xor(sq, 32);
                if (fq == 0) ssout[(size_t)row * 16 + u.pn * 4 + wc] = sq;
            }
        }
    }
};
struct EpiProj {
    static constexpr bool PERM = true;
    bf16_t *Q, *V, *SG, *GY; float *FZ, *XB; const float* ss;
    __device__ __forceinline__ void operator()(const f32x4 (&acc)[2][2][4][2], const pg8::Unit& u, int wr, int wc, int fr, int fq) const {
        const int seg = u.pn >> 1;
        const int row0 = u.pm * 256 + wr * 64 + fr, col0 = (u.pn & 1) * 256 + wc * 32 + 8 * fq;
        float* fdst = (seg == 1) ? FZ : XB;
        bf16_t* bdst = (seg == 0) ? Q : (seg == 2) ? V : (seg == 3) ? SG : GY;
        const bool isf = (seg == 1) || (seg == 4);
        float rsv[8]; rowscale8(ss, row0, fq, rsv);
#pragma unroll
        for (int ai = 0; ai < 2; ++ai)
#pragma unroll
            for (int m = 0; m < 4; ++m) {
                const int row = row0 + ai * 128 + m * 16; const float rs = rsv[ai * 4 + m]; const size_t off = (size_t)row * DH + col0;
#pragma unroll
                for (int bj = 0; bj < 2; ++bj) {
                    f32x4 v0 = acc[ai][bj][m][0] * rs, v1 = acc[ai][bj][m][1] * rs;
                    if (isf) { *(f32x4*)(fdst + off + bj * 128) = v0; *(f32x4*)(fdst + off + bj * 128 + 4) = v1; }
                    else {
                        float h[8] = {v0[0], v0[1], v0[2], v0[3], v1[0], v1[1], v1[2], v1[3]};
                        if (seg == 0) {
#pragma unroll
                            for (int j = 0; j < 8; ++j) h[j] = h[j] * sigm(h[j]);
                        } else if (seg == 3) {
#pragma unroll
                            for (int j = 0; j < 8; ++j) h[j] = sigm(h[j]);
                        } else if (seg == 5) {
#pragma unroll
                            for (int j = 0; j < 8; ++j) { const float y = h[j]; h[j] = y * sigm(1.5957691216f * (y + 0.044715f * y * y * y)); }
                        }
                        u32x4 w; w.x = cvt_pk_bf16(h[0], h[1]); w.y = cvt_pk_bf16(h[2], h[3]); w.z = cvt_pk_bf16(h[4], h[5]); w.w = cvt_pk_bf16(h[6], h[7]);
                        *(u32x4*)(bdst + off + bj * 128) = w;
                    }
                }
            }
    }
};


struct SmallResid {
    const float* xin; float* xout; bf16_t* ax; const float* gnext; float* ssout; float scale;
    __device__ __forceinline__ void apply(const f32x4& acc, int grow, int c, int cn, int c16, int r16, int fr, int fq, LAS unsigned char* lds) const {
        const size_t off = (size_t)grow * DM + c;
        const f32x4 x = *(const f32x4*)(xin + off);
        const f32x4 v = x + acc * scale;
        *(f32x4*)(xout + off) = v;
        float sq = (v[0] * v[0] + v[1] * v[1]) + (v[2] * v[2] + v[3] * v[3]);
        if (ax) { const f32x4 g = *(const f32x4*)(gnext + c); const f32x4 a = v * g; u32x2 w; w.x = cvt_pk_bf16(a[0], a[1]); w.y = cvt_pk_bf16(a[2], a[3]); *(u32x2*)(ax + off) = w; }
        sq += __shfl_xor(sq, 16); sq += __shfl_xor(sq, 32);
        LAS float* P = (LAS float*)lds;
        if (fq == 0) P[(r16 * 16 + fr) * 4 + c16] = sq;
        __syncthreads();
        if (c16 == 0 && fq == 0) { const LAS float* q = P + (r16 * 16 + fr) * 4; ssout[(size_t)grow * 16 + cn] = (q[0] + q[1]) + (q[2] + q[3]); }
        __syncthreads();
    }
};
struct SmallProj {
    bf16_t *Q, *V, *SG, *GY; float *FZ, *XB; const float* ss;
    __device__ __forceinline__ void apply(const f32x4& acc, int grow, int c, int cn, int c16, int r16, int fr, int fq, LAS unsigned char* lds) const {
        const int seg = cn >> 3, cs = c & 511;
        const float rs = rowscale(ss, grow);
        const f32x4 v = acc * rs;
        const size_t off = (size_t)grow * DH + cs;
        if (seg == 1 || seg == 4) { *(f32x4*)(((seg == 1) ? FZ : XB) + off) = v; }
        else {
            float h[4] = {v[0], v[1], v[2], v[3]};
            if (seg == 0) {
#pragma unroll
                for (int j = 0; j < 4; ++j) h[j] = h[j] * sigm(h[j]);
            } else if (seg == 3) {
#pragma unroll
                for (int j = 0; j < 4; ++j) h[j] = sigm(h[j]);
            } else if (seg == 5) {
#pragma unroll
                for (int j = 0; j < 4; ++j) { const float y = h[j]; h[j] = y * sigm(1.5957691216f * (y + 0.044715f * y * y * y)); }
            }
            bf16_t* bdst = (seg == 0) ? Q : (seg == 2) ? V : (seg == 3) ? SG : GY;
            u32x2 w; w.x = cvt_pk_bf16(h[0], h[1]); w.y = cvt_pk_bf16(h[2], h[3]);
            *(u32x2*)(bdst + off) = w;
        }
    }
};
template <class Epi, int K>
__device__ __forceinline__ void small_gemm(const bf16_t* A, const bf16_t* Bt, int N, const Epi& E, LAS unsigned char* lds) {
    const int tid = threadIdx.x, lane = tid & 63, wave = tid >> 6, fr = lane & 15, fq = lane >> 4, r16 = wave >> 2, c16 = wave & 3;
    constexpr int KW = K / 8, NS = KW / 32;
    const int nunits = 16 * (N / 64), G = gridDim.x;
    LAS f32x4* PB = (LAS f32x4*)lds;
    for (int u = G - 1 - (int)blockIdx.x; u < nunits; u += G) {
        const int rm = u & 15, cn = u >> 4;
        const bf16_t* ap = A + (size_t)(TP + rm * 32 + fr) * K + wave * KW + fq * 8;
        const bf16_t* bp = Bt + (size_t)(cn * 64 + fr) * K + wave * KW + fq * 8;
        f32x4 acc[2][4];
#pragma unroll
        for (int rr = 0; rr < 2; ++rr)
#pragma unroll
            for (int cc = 0; cc < 4; ++cc) acc[rr][cc] = (f32x4){0.f, 0.f, 0.f, 0.f};
#pragma unroll
        for (int s0 = 0; s0 < NS; s0 += 4) {
            bf16x8 a[4][2], b[4][4];
#pragma unroll
            for (int i = 0; i < 4; ++i) if (s0 + i < NS) {
#pragma unroll
                for (int rr = 0; rr < 2; ++rr) a[i][rr] = *(const bf16x8*)(ap + (size_t)rr * 16 * K + (s0 + i) * 32);
#pragma unroll
                for (int cc = 0; cc < 4; ++cc) b[i][cc] = *(const bf16x8*)(bp + (size_t)cc * 16 * K + (s0 + i) * 32);
            }
#pragma unroll
            for (int i = 0; i < 4; ++i) if (s0 + i < NS) {
#pragma unroll
                for (int rr = 0; rr < 2; ++rr)
#pragma unroll
                    for (int cc = 0; cc < 4; ++cc) acc[rr][cc] = __builtin_amdgcn_mfma_f32_16x16x32_bf16(b[i][cc], a[i][rr], acc[rr][cc], 0, 0, 0);
            }
        }
#pragma unroll
        for (int rr = 0; rr < 2; ++rr)
#pragma unroll
            for (int cc = 0; cc < 4; ++cc) PB[(wave * 8 + rr * 4 + cc) * 64 + lane] = acc[rr][cc];
        __syncthreads();
        f32x4 r = PB[(0 * 8 + wave) * 64 + lane];
#pragma unroll
        for (int w = 1; w < 8; ++w) r += PB[(w * 8 + wave) * 64 + lane];
        E.apply(r, TP + rm * 32 + r16 * 16 + fr, cn * 64 + c16 * 16 + 4 * fq, cn, c16, r16, fr, fq, lds + 65536);
        __syncthreads();
    }
}

#define XB_TMO      128
#define XB_XCNT(j)  (256  + 64 * (j))
#define XB_XSUB(j)  (1280 + 64 * (j))
#define XB_XGEN(j)  (2304 + 64 * (j))
#define XB_TOP      3328
#define XB_TOPGEN   3392
#define XCD_BAR_WORDS 3456
#define XB_SPIN_CAP (1u << 22)
__device__ __forceinline__ unsigned xb_ld(unsigned* p)              { return __hip_atomic_load(p, __ATOMIC_RELAXED, __HIP_MEMORY_SCOPE_AGENT); }
__device__ __forceinline__ unsigned xb_add(unsigned* p, unsigned v) { return __hip_atomic_fetch_add(p, v, __ATOMIC_RELAXED, __HIP_MEMORY_SCOPE_AGENT); }
__device__ __forceinline__ unsigned xb_xcc_id() { return (unsigned)__builtin_amdgcn_s_getreg((3 << 11) | 20) & 0xFu; }
#define XB_SPIN(cond, bar) do { unsigned _sp = 0; while (cond) { __builtin_amdgcn_s_sleep(1); \
    if ((++_sp & 255u) == 0u) { if (xb_ld(&(bar)[XB_TMO])) break; if (_sp > XB_SPIN_CAP) { atomicAdd(&(bar)[XB_TMO], 1u); break; } } } } while (0)
struct XcdBarrier { unsigned* bar; unsigned x; volatile LAS unsigned* st; };
__device__ __forceinline__ XcdBarrier xcd_barrier_post(unsigned* bar, volatile LAS unsigned* st) {
    XcdBarrier b; b.bar = bar; b.x = xb_xcc_id(); b.st = st;
    if (threadIdx.x == 0) (void)xb_add(&bar[XB_XCNT(b.x)], 1u);
    return b;
}
__device__ __forceinline__ void xcd_barrier_complete(unsigned* bar, unsigned x, unsigned& nloc, unsigned& nx) {
    const unsigned G = gridDim.x * gridDim.y * gridDim.z;
    unsigned sum, cnt, mine, sp = 0u;
    for (;;) {
        sum = 0u; cnt = 0u; mine = 0u;
#pragma unroll
        for (unsigned j = 0; j < 16; ++j) { const unsigned c = xb_ld(&bar[XB_XCNT(j)]); sum += c; cnt += (c > 0u) ? 1u : 0u; mine = (j == x) ? c : mine; }
        if (sum == G) break;
        __builtin_amdgcn_s_sleep(1);
        if ((++sp & 255u) == 0u) { if (xb_ld(&bar[XB_TMO])) break; if (sp > XB_SPIN_CAP) { atomicAdd(&bar[XB_TMO], 1u); break; } }
    }
    nloc = mine > 0u ? mine : 1u; nx = cnt > 0u ? cnt : 1u;
}
__device__ __forceinline__ void xcd_barrier(const XcdBarrier& b) {
    asm volatile("s_waitcnt vmcnt(0) lgkmcnt(0)" ::: "memory");
    __syncthreads();
    if (threadIdx.x == 0) {
        unsigned* bar = b.bar;
        __builtin_amdgcn_s_waitcnt(0);
        unsigned nloc = b.st[0], nx = b.st[1];
        if (nloc == 0u) { xcd_barrier_complete(bar, b.x, nloc, nx); b.st[0] = nloc; b.st[1] = nx; }
        const unsigned old = xb_add(&bar[XB_XSUB(b.x)], 1u);
        const unsigned gen = old / nloc;
        if (old + 1u == (gen + 1u) * nloc) {
            __builtin_amdgcn_fence(__ATOMIC_RELEASE, "agent");
            asm volatile("s_waitcnt vmcnt(0)" ::: "memory");
            const unsigned og = xb_add(&bar[XB_TOP], 1u);
            const unsigned tg = og / nx;
            if (og + 1u == (tg + 1u) * nx) xb_add(&bar[XB_TOPGEN], 1u);
            else XB_SPIN(xb_ld(&bar[XB_TOPGEN]) == tg, bar);
            __builtin_amdgcn_fence(__ATOMIC_ACQUIRE, "agent");
            xb_add(&bar[XB_XGEN(b.x)], 1u);
            asm volatile("s_waitcnt vmcnt(0)" ::: "memory");
        } else {
            XB_SPIN(xb_ld(&bar[XB_XGEN(b.x)]) == gen, bar);
            __builtin_amdgcn_fence(__ATOMIC_ACQUIRE, "agent");
            asm volatile("s_waitcnt vmcnt(0)" ::: "memory");
        }
    }
    __syncthreads();
}

struct Params { const float* in[26]; float* out; unsigned char* ws; int ph_lo, ph_hi; };

__device__ __forceinline__ void transpose_item(const float* W, int K, int N, bf16_t* WT, int dst_row0, LAS float* scr, int k0, int n0, int lane) {
    float wv[32];
#pragma unroll
    for (int i = 0; i < 32; ++i) wv[i] = W[(size_t)(k0 + 2 * i + (lane >> 5)) * N + n0 + (lane & 31)];
#pragma unroll
    for (int i = 0; i < 32; ++i) scr[(2 * i + (lane >> 5)) * 33 + (lane & 31)] = wv[i];
    LDS_WAIT();
    const int c = lane & 7;
#pragma unroll
    for (int j = 0; j < 4; ++j) { const int n = (lane >> 3) + 8 * j; const LAS float* s = scr + (8 * c) * 33 + n;
        u32x4 o; o.x = cvt_pk_bf16(s[0 * 33], s[1 * 33]); o.y = cvt_pk_bf16(s[2 * 33], s[3 * 33]); o.z = cvt_pk_bf16(s[4 * 33], s[5 * 33]); o.w = cvt_pk_bf16(s[6 * 33], s[7 * 33]);
        *(u32x4*)(WT + (size_t)(dst_row0 + n) * K + k0 + 8 * c) = o; }
    LDS_WAIT();
}
__device__ __forceinline__ void transpose_mat(const float* W, int K, int N, bf16_t* WT, int mode, LAS float* scr, int item, int lane) {
    const int nblk = N / 32, kb = item / nblk, nb = item % nblk, n0 = 32 * nb;
    const int dst = (mode == 0) ? n0 : (256 * (n0 >> 7) + (n0 & 127) + (mode == 2 ? 128 : 0));
    transpose_item(W, K, N, WT, dst, scr, 64 * kb, n0, lane);
}

__device__ __forceinline__ void phase0(const Params& p, LAS unsigned char* lds) {
    const int tid = threadIdx.x, lane = tid & 63, wave = tid >> 6;
    const int G = gridDim.x, gw = blockIdx.x * 8 + wave, NGW = G * 8;
    unsigned char* ws = p.ws;
    LAS float* scr = (LAS float*)(lds + wave * 16384);
    constexpr int I_GU = 16 * 88, I_D = 44 * 32, I_IN = 16 * 96, I_O = 16 * 32;
    constexpr int NIT = 4 * I_GU + 2 * I_D + I_IN + I_O;
    for (int it = gw; it < NIT; it += NGW) {
        int r = it;
        if (r < I_GU) { transpose_mat(p.in[6], 1024, 2816, (bf16_t*)(ws + WS_WG1), 1, scr, r, lane); continue; } r -= I_GU;
        if (r < I_GU) { transpose_mat(p.in[7], 1024, 2816, (bf16_t*)(ws + WS_WG1), 2, scr, r, lane); continue; } r -= I_GU;
        if (r < I_D)  { transpose_mat(p.in[8], 2816, 1024, (bf16_t*)(ws + WS_WD1), 0, scr, r, lane); continue; } r -= I_D;
        if (r < I_IN) { transpose_mat(p.in[10], 1024, 3072, (bf16_t*)(ws + WS_WIN), 0, scr, r, lane); continue; } r -= I_IN;
        if (r < I_O)  { transpose_mat(p.in[20], 1024, 1024, (bf16_t*)(ws + WS_WO), 0, scr, r, lane); continue; } r -= I_O;
        if (r < I_GU) { transpose_mat(p.in[22], 1024, 2816, (bf16_t*)(ws + WS_WG2), 1, scr, r, lane); continue; } r -= I_GU;
        if (r < I_GU) { transpose_mat(p.in[23], 1024, 2816, (bf16_t*)(ws + WS_WG2), 2, scr, r, lane); continue; } r -= I_GU;
        transpose_mat(p.in[24], 2816, 1024, (bf16_t*)(ws + WS_WD2), 0, scr, r, lane);
    }
    for (int e = blockIdx.x * 512 + tid; e < 2 * 32768; e += G * 512) {
        const int which = e >> 15, r = e & 32767, n = r >> 12, j = (r >> 6) & 63, i = r & 63;
        const float* W = which ? p.in[17] : p.in[15];
        bf16_t* WT = (bf16_t*)(ws + (which ? WS_WXT : WS_WAT));
        WT[r] = f2bf(W[(n * 64 + i) * 64 + j]);
    }
    bf16_t* A1 = (bf16_t*)(ws + WS_B0); float* SS0 = (float*)(ws + WS_SS0);
    const float* g1 = p.in[5];
    f32x4 gv[4];
#pragma unroll
    for (int j = 0; j < 4; ++j) gv[j] = ((const f32x4*)g1)[lane + 64 * j];
    for (int row0 = gw; row0 < T_ALL; row0 += 3 * NGW) {
        f32x4 v[3][4];
#pragma unroll
        for (int r = 0; r < 3; ++r) { const int row = row0 + r * NGW; if (row < T_ALL) {
            const float* xr = (row < TP) ? p.in[0] + (size_t)row * DM : p.in[1] + (size_t)(row - TP) * DM;
#pragma unroll
            for (int j = 0; j < 4; ++j) v[r][j] = ((const f32x4*)xr)[lane + 64 * j]; } }
#pragma unroll
        for (int r = 0; r < 3; ++r) { const int row = row0 + r * NGW; if (row < T_ALL) {
            float s = 0.f;
#pragma unroll
            for (int j = 0; j < 4; ++j) s += (v[r][j].x * v[r][j].x + v[r][j].y * v[r][j].y) + (v[r][j].z * v[r][j].z + v[r][j].w * v[r][j].w);
            s = wave_sum(s);
            u32x2* o8 = (u32x2*)(A1 + (size_t)row * DM);
#pragma unroll
            for (int j = 0; j < 4; ++j) { const f32x4 a = v[r][j] * gv[j]; u32x2 w; w.x = cvt_pk_bf16(a.x, a.y); w.y = cvt_pk_bf16(a.z, a.w); o8[lane + 64 * j] = w; }
            if (lane < 16) SS0[(size_t)row * 16 + lane] = (lane == 0) ? s : 0.f; } }
    }
}

__device__ __forceinline__ void phase_final(const Params& p) {
    const int tid = threadIdx.x, lane = tid & 63, wave = tid >> 6;
    const int gw = blockIdx.x * 8 + wave, NGW = gridDim.x * 8;
    const float* SS3 = (const float*)(p.ws + WS_SS3); const float* gf = p.in[25];
    f32x4 gv[4];
#pragma unroll
    for (int j = 0; j < 4; ++j) gv[j] = ((const f32x4*)gf)[lane + 64 * j];
    for (int row0 = gw; row0 < T_ALL; row0 += 3 * NGW) {
        f32x4 v[3][4]; float rs[3];
#pragma unroll
        for (int r = 0; r < 3; ++r) { const int row = row0 + r * NGW; if (row < T_ALL) {
            rs[r] = rowscale(SS3, row);
            const f32x4* xr = (const f32x4*)(p.out + (size_t)row * DM);
#pragma unroll
            for (int j = 0; j < 4; ++j) v[r][j] = xr[lane + 64 * j]; } }
#pragma unroll
        for (int r = 0; r < 3; ++r) { const int row = row0 + r * NGW; if (row < T_ALL) {
            f32x4* xr = (f32x4*)(p.out + (size_t)row * DM);
#pragma unroll
            for (int j = 0; j < 4; ++j) xr[lane + 64 * j] = v[r][j] * rs[r] * gv[j]; } }
    }
}

struct Mix {
    const bf16_t *Q, *V, *SG, *GY; const float *FZ, *XB; bf16_t* LT; float* DC; float *ACH, *UCH, *HST; bf16_t* O;
    const bf16_t *WAT, *WXT;
    const float *lb, *hnorm, *convw, *convb, *ba, *bx, *lam, *wa, *wx, *st_h, *st_l, *st_c;
    float* out;
};

struct HgrnScan { float cum[16]; float kk[16]; float last; };
__device__ __forceinline__ void hgrn_scan(const float (&fzv)[16], float lb, int k, int seg, LAS float* tot, HgrnScan& hs) {
    float run = 0.f;
#pragma unroll
    for (int i = 0; i < 16; ++i) {
        const float e = __expf(-fmaxf(fzv[i], -80.f));
        const float sg = __builtin_amdgcn_rcpf(1.f + e), sn = e * sg;
        const float f = lb + (1.f - lb) * sg;
        run += __logf(f); hs.cum[i] = run; hs.kk[i] = (1.f - lb) * sn;
    }
    tot[seg * 128 + k] = run;
    __syncthreads();
    float off = 0.f, all = 0.f;
#pragma unroll
    for (int s = 0; s < 4; ++s) { const float v = tot[s * 128 + k]; if (s < seg) off += v; all += v; }
#pragma unroll
    for (int i = 0; i < 16; ++i) hs.cum[i] += off;
    hs.last = all;
}

struct HgIn { float fzv[16]; unsigned vv[16]; unsigned qv[16]; bf16x8 bs[4]; u32x2 sgv[4]; };
template <int MODE>
__device__ __forceinline__ void hg_load(const Mix& M, int unit, HgIn& in) {
    const int tid = threadIdx.x, lane = tid & 63, wave = tid >> 6, fr = lane & 15, fq = lane >> 4;
    const int h = unit & 3, bc = unit >> 2, t0 = bc * 64, cb = h * 128, k = tid & 127, seg = tid >> 7;
    const size_t rb = (size_t)(t0 + seg * 16) * DH + cb + k;
#pragma unroll
    for (int i = 0; i < 16; ++i) { in.fzv[i] = M.FZ[rb + (size_t)i * DH]; in.vv[i] = M.V[rb + (size_t)i * DH]; if (MODE == 1) in.qv[i] = M.Q[rb + (size_t)i * DH]; }
    if (MODE == 1) {
#pragma unroll
        for (int ks = 0; ks < 4; ++ks) in.bs[ks] = *(const bf16x8*)(M.LT + ((size_t)unit * 128 + 16 * wave + fr) * 128 + ks * 32 + fq * 8);
#pragma unroll
        for (int tr = 0; tr < 4; ++tr) in.sgv[tr] = *(const u32x2*)(M.SG + (size_t)(t0 + 16 * tr + fr) * DH + cb + 16 * wave + 4 * fq);
    }
}
template <int MODE>
__device__ __forceinline__ void hgrn_loop(const Mix& M, LAS unsigned char* lds) {
    const int tid = threadIdx.x, lane = tid & 63, wave = tid >> 6, fr = lane & 15, fq = lane >> 4, G = gridDim.x;
    const int k = tid & 127, seg = tid >> 7;
    int unit = blockIdx.x; if (unit >= 1024) return;
    int hcache = -1; float lb = 0.f; f32x4 gn = {0.f, 0.f, 0.f, 0.f};
    HgIn cur; hg_load<MODE>(M, unit, cur);
    for (;;) {
        const int un = unit + G; const bool has = un < 1024;
        HgIn nxt; if (has) hg_load<MODE>(M, un, nxt);
        const int h = unit & 3, bc = unit >> 2, t0 = bc * 64, cb = h * 128;
        if (h != hcache) { hcache = h; const float l0 = M.lb[cb + k], l1 = M.lb[512 + cb + k]; lb = __builtin_amdgcn_rcpf(1.f + __expf(l1 - l0)); gn = *(const f32x4*)(M.hnorm + cb + 16 * wave + 4 * fq); }
        if (MODE == 0) {
            LAS bf16_t* KT = (LAS bf16_t*)lds; LAS bf16_t* VT = (LAS bf16_t*)(lds + 18432); LAS float* tot = (LAS float*)(lds + 36864);
            HgrnScan hs; hgrn_scan(cur.fzv, lb, k, seg, tot, hs);
            unsigned pk[8];
#pragma unroll
            for (int i = 0; i < 8; ++i) pk[i] = cvt_pk_bf16(hs.kk[2 * i] * __expf(hs.last - hs.cum[2 * i]), hs.kk[2 * i + 1] * __expf(hs.last - hs.cum[2 * i + 1]));
            *(LAS u32x4*)(KT + k * 72 + seg * 16) = (u32x4){pk[0], pk[1], pk[2], pk[3]};
            *(LAS u32x4*)(KT + k * 72 + seg * 16 + 8) = (u32x4){pk[4], pk[5], pk[6], pk[7]};
            const unsigned* vv = cur.vv;
            *(LAS u32x4*)(VT + k * 72 + seg * 16) = (u32x4){vv[0] | (vv[1] << 16), vv[2] | (vv[3] << 16), vv[4] | (vv[5] << 16), vv[6] | (vv[7] << 16)};
            *(LAS u32x4*)(VT + k * 72 + seg * 16 + 8) = (u32x4){vv[8] | (vv[9] << 16), vv[10] | (vv[11] << 16), vv[12] | (vv[13] << 16), vv[14] | (vv[15] << 16)};
            if (seg == 0) M.DC[unit * 128 + k] = __expf(hs.last);
            __syncthreads();
            const bf16x8 a0 = *(const LAS bf16x8*)(VT + (16 * wave + fr) * 72 + fq * 8), a1 = *(const LAS bf16x8*)(VT + (16 * wave + fr) * 72 + 32 + fq * 8);
#pragma unroll
            for (int ct = 0; ct < 8; ++ct) {
                const bf16x8 b0 = *(const LAS bf16x8*)(KT + (16 * ct + fr) * 72 + fq * 8), b1 = *(const LAS bf16x8*)(KT + (16 * ct + fr) * 72 + 32 + fq * 8);
                f32x4 acc = {0.f, 0.f, 0.f, 0.f};
                acc = __builtin_amdgcn_mfma_f32_16x16x32_bf16(b0, a0, acc, 0, 0, 0);
                acc = __builtin_amdgcn_mfma_f32_16x16x32_bf16(b1, a1, acc, 0, 0, 0);
                u32x2 w; w.x = cvt_pk_bf16(acc[0], acc[1]); w.y = cvt_pk_bf16(acc[2], acc[3]);
                *(u32x2*)(M.LT + ((size_t)unit * 128 + 16 * wave + fr) * 128 + 16 * ct + 4 * fq) = w;
            }
            __syncthreads();
        } else {
            LAS bf16_t* QS = (LAS bf16_t*)lds; LAS bf16_t* KS = (LAS bf16_t*)(lds + 17408); LAS bf16_t* VT = (LAS bf16_t*)(lds + 34816);
            LAS bf16_t* PS = (LAS bf16_t*)(lds + 53248); LAS float* tot = (LAS float*)(lds + 62464); LAS float* RS = (LAS float*)(lds + 64512);
            HgrnScan hs; hgrn_scan(cur.fzv, lb, k, seg, tot, hs);
#pragma unroll
            for (int i = 0; i < 16; ++i) {
                const float q = __uint_as_float(cur.qv[i] << 16);
                QS[(seg * 16 + i) * 136 + k] = f2bf(q * __expf(hs.cum[i]));
                KS[(seg * 16 + i) * 136 + k] = f2bf(hs.kk[i] * __expf(-hs.cum[i]));
            }
            const unsigned* vv = cur.vv;
            *(LAS u32x4*)(VT + k * 72 + seg * 16) = (u32x4){vv[0] | (vv[1] << 16), vv[2] | (vv[3] << 16), vv[4] | (vv[5] << 16), vv[6] | (vv[7] << 16)};
            *(LAS u32x4*)(VT + k * 72 + seg * 16 + 8) = (u32x4){vv[8] | (vv[9] << 16), vv[10] | (vv[11] << 16), vv[12] | (vv[13] << 16), vv[14] | (vv[15] << 16)};
            __syncthreads();
#pragma unroll
            for (int r = 0; r < 2; ++r) {
                const int idx = wave + 8 * r, tr = idx >> 2, tc = idx & 3;
                f32x4 acc = {0.f, 0.f, 0.f, 0.f};
                if (tc <= tr) {
#pragma unroll
                    for (int ks = 0; ks < 4; ++ks) {
                        const bf16x8 a = *(const LAS bf16x8*)(QS + (16 * tr + fr) * 136 + ks * 32 + fq * 8), b = *(const LAS bf16x8*)(KS + (16 * tc + fr) * 136 + ks * 32 + fq * 8);
                        acc = __builtin_amdgcn_mfma_f32_16x16x32_bf16(b, a, acc, 0, 0, 0);
                    }
#pragma unroll
                    for (int j = 0; j < 4; ++j) if (16 * tc + 4 * fq + j > 16 * tr + fr) acc[j] = 0.f;
                }
                u32x2 w; w.x = cvt_pk_bf16(acc[0], acc[1]); w.y = cvt_pk_bf16(acc[2], acc[3]);
                *(LAS u32x2*)(PS + (16 * tr + fr) * 72 + 16 * tc + 4 * fq) = w;
            }
            __syncthreads();
            bf16x8 bv[2];
#pragma unroll
            for (int ks = 0; ks < 2; ++ks) bv[ks] = *(const LAS bf16x8*)(VT + (16 * wave + fr) * 72 + ks * 32 + fq * 8);
            f32x4 o[4];
#pragma unroll
            for (int tr = 0; tr < 4; ++tr) {
                f32x4 acc = {0.f, 0.f, 0.f, 0.f};
#pragma unroll
                for (int ks = 0; ks < 2; ++ks) { const bf16x8 a = *(const LAS bf16x8*)(PS + (16 * tr + fr) * 72 + ks * 32 + fq * 8); acc = __builtin_amdgcn_mfma_f32_16x16x32_bf16(bv[ks], a, acc, 0, 0, 0); }
#pragma unroll
                for (int ks = 0; ks < 4; ++ks) { const bf16x8 a = *(const LAS bf16x8*)(QS + (16 * tr + fr) * 136 + ks * 32 + fq * 8); acc = __builtin_amdgcn_mfma_f32_16x16x32_bf16(cur.bs[ks], a, acc, 0, 0, 0); }
                o[tr] = acc;
                float ss = (acc[0] * acc[0] + acc[1] * acc[1]) + (acc[2] * acc[2] + acc[3] * acc[3]);
                ss += __shfl_xor(ss, 16); ss += __shfl_xor(ss, 32);
                if (fq == 0) RS[wave * 64 + 16 * tr + fr] = ss;
            }
            __syncthreads();
            const int ocol = cb + 16 * wave + 4 * fq;
#pragma unroll
            for (int tr = 0; tr < 4; ++tr) {
                const int tl = 16 * tr + fr; float tt = 0.f;
#pragma unroll
                for (int w = 0; w < 8; ++w) tt += RS[w * 64 + tl];
                const float rinv = rsqrtf(tt * (1.f / 128.f) + EPS);
                const u32x2 sg = cur.sgv[tr];
                u32x2 w;
                w.x = cvt_pk_bf16(o[tr][0] * rinv * gn[0] * bflo(sg.x), o[tr][1] * rinv * gn[1] * bfhi(sg.x));
                w.y = cvt_pk_bf16(o[tr][2] * rinv * gn[2] * bflo(sg.y), o[tr][3] * rinv * gn[3] * bfhi(sg.y));
                *(u32x2*)(M.O + (size_t)(t0 + tl) * DM + ocol) = w;
            }
            __syncthreads();
        }
        if (!has) break;
        cur = nxt; unit = un;
    }
}

struct LruIn { float xm3, xm2, xm1; float xr[8]; unsigned gyv[8]; float hin; float cpv; };
__device__ __forceinline__ void lru_load(const Mix& M, int unit, int mode, LruIn& in) {
    const int tid = threadIdx.x, j = tid & 63, seg = tid >> 6;
    const int n = unit & 7, bc = unit >> 3, c = bc & 31, b = bc >> 5, t0 = bc * 64, ch0 = n * 64, ch = ch0 + j, tl0 = seg * 8;
    const bool first = (c == 0 && seg == 0);
    const float* xp = M.XB + (size_t)(t0 + tl0) * DH + ch;
    in.xm3 = first ? 0.f : xp[-3 * DH]; in.xm2 = first ? 0.f : xp[-2 * DH]; in.xm1 = first ? 0.f : xp[-1 * DH];
#pragma unroll
    for (int i = 0; i < 8; ++i) in.xr[i] = xp[i * DH];
    in.hin = (mode == 1) ? M.HST[(size_t)bc * 512 + ch] : 0.f;
#pragma unroll
    for (int i = 0; i < 8; ++i) in.gyv[i] = (mode == 1) ? (unsigned)M.GY[(size_t)(t0 + tl0 + i) * DH + ch] : 0u;
    in.cpv = (mode == 1 && c == 31 && tid < 192) ? M.XB[(size_t)(b * SEQ + SEQ - 3 + (tid >> 6)) * DH + ch0 + j] : 0.f;
}
__device__ __forceinline__ void lru_loop(const Mix& M, int mode, LAS unsigned char* lds) {
    const int tid = threadIdx.x, lane = tid & 63, wave = tid >> 6, fr = lane & 15, fq = lane >> 4, G = gridDim.x;
    const int j = tid & 63, seg = tid >> 6, tl0 = seg * 8;
    LAS bf16_t* XC16 = (LAS bf16_t*)(lds + 16640); LAS float* GR = (LAS float*)(lds + 25856); LAS float* GI = (LAS float*)(lds + 42496);
    LAS float* SEGA = (LAS float*)(lds + 59136); LAS float* SEGU = (LAS float*)(lds + 61184);
    int unit = blockIdx.x; if (unit >= 2048) return;
    const int gate = wave >> 2, tr = wave & 3;
    int ncache = -1; float w0 = 0.f, w1 = 0.f, w2 = 0.f, w3 = 0.f, cbias = 0.f, sp = 0.f; bf16x8 wb[4][2]; float bbv[4];
    LruIn cur; lru_load(M, unit, mode, cur);
    for (;;) {
        const int un = unit + G; const bool has = un < 2048;
        LruIn nxt; if (has) lru_load(M, un, mode, nxt);
        const int n = unit & 7, bc = unit >> 3, c = bc & 31, b = bc >> 5, t0 = bc * 64, ch0 = n * 64, ch = ch0 + j;
        if (n != ncache) {
            ncache = n;
            w0 = M.convw[ch]; w1 = M.convw[512 + ch]; w2 = M.convw[1024 + ch]; w3 = M.convw[1536 + ch]; cbias = M.convb[ch];
            const bf16_t* WT = (gate ? M.WXT : M.WAT) + n * 4096; const float* bias = (gate ? M.bx : M.ba) + ch0;
#pragma unroll
            for (int ct = 0; ct < 4; ++ct) { wb[ct][0] = *(const bf16x8*)(WT + (16 * ct + fr) * 64 + fq * 8); wb[ct][1] = *(const bf16x8*)(WT + (16 * ct + fr) * 64 + 32 + fq * 8); bbv[ct] = bias[16 * ct + fr]; }
            sp = log1pf(__expf(-M.lam[ch]));
        }
        float xm3 = cur.xm3, xm2 = cur.xm2, xm1 = cur.xm1; float xcv[8];
#pragma unroll
        for (int i = 0; i < 8; ++i) {
            const float x = cur.xr[i];
            const float xc = cbias + w0 * xm3 + w1 * xm2 + w2 * xm1 + w3 * x;
            xcv[i] = xc; XC16[(tl0 + i) * 72 + j] = f2bf(xc);
            xm3 = xm2; xm2 = xm1; xm1 = x;
        }
        __syncthreads();
        {
            LAS float* Gd = gate ? GI : GR;
            const bf16x8 a0 = *(const LAS bf16x8*)(XC16 + (16 * tr + fr) * 72 + fq * 8), a1 = *(const LAS bf16x8*)(XC16 + (16 * tr + fr) * 72 + 32 + fq * 8);
#pragma unroll
            for (int ct = 0; ct < 4; ++ct) {
                f32x4 acc = {0.f, 0.f, 0.f, 0.f};
                acc = __builtin_amdgcn_mfma_f32_16x16x32_bf16(a0, wb[ct][0], acc, 0, 0, 0);
                acc = __builtin_amdgcn_mfma_f32_16x16x32_bf16(a1, wb[ct][1], acc, 0, 0, 0);
#pragma unroll
                for (int jj = 0; jj < 4; ++jj) Gd[(16 * tr + 4 * fq + jj) * 65 + 16 * ct + fr] = sigm(acc[jj] + bbv[ct]);
            }
        }
        __syncthreads();
        float av[8], uv[8]; float A = 1.f, U = 0.f;
#pragma unroll
        for (int i = 0; i < 8; ++i) {
            const int tl = tl0 + i; const float r = GR[tl * 65 + j], ig = GI[tl * 65 + j];
            const float la = -8.f * r * sp, a = __expf(la); float mult = sqrtf(fmaxf(1.f - a * a, 0.f));
            if (la > -0.05f) mult = sqrtf(-expm1f(2.f * la));
            if (c == 0 && tl == 0) mult = 1.f;
            const float u = mult * ig * xcv[i];
            av[i] = a; uv[i] = u; U = a * U + u; A *= a;
        }
        SEGA[seg * 64 + j] = A; SEGU[seg * 64 + j] = U;
        __syncthreads();
        float hin = cur.hin;
#pragma unroll
        for (int s = 0; s < 8; ++s) if (s < seg) hin = SEGA[s * 64 + j] * hin + SEGU[s * 64 + j];
        if (mode == 0) {
            if (seg == 7) { float At = 1.f;
#pragma unroll
                for (int s = 0; s < 8; ++s) At *= SEGA[s * 64 + j];
                M.ACH[(size_t)bc * 512 + ch] = At; M.UCH[(size_t)bc * 512 + ch] = A * hin + U; }
        } else {
            float hh = hin;
#pragma unroll
            for (int i = 0; i < 8; ++i) {
                hh = av[i] * hh + uv[i];
                M.O[(size_t)(t0 + tl0 + i) * DM + 512 + ch] = f2bf(hh * __uint_as_float(cur.gyv[i] << 16));
            }
            if (c == 31 && seg == 7) M.out[OUT_LP + b * 512 + ch] = hh;
            if (c == 31 && tid < 192) M.out[OUT_CP + (size_t)(b * 3 + (tid >> 6)) * 512 + ch0 + j] = cur.cpv;
        }
        __syncthreads();
        if (!has) break;
        cur = nxt; unit = un;
    }
}

__device__ __forceinline__ void hgrn_sample_unit(const Mix& M, int unit, LAS unsigned char* lds) {
    const int tid = threadIdx.x, lane = tid & 63, wave = tid >> 6;
    const int h = unit & 3, b = unit >> 2, cb = h * 128, tb = TP + b * 4;
    LAS float* SQ = (LAS float*)lds;
    LAS float* SK = SQ + 512;
    LAS float* SD = SK + 512;
    LAS float* SP = SD + 128;
    LAS float* OP = SP + 32;
    LAS float* RS = OP + 2048;
    const int v = tid & 127, kq = tid >> 7;
    const size_t sb = ((size_t)(b * 4 + h) * 128) * 128;
    float s0v[32];
#pragma unroll
    for (int kx = 0; kx < 32; ++kx) s0v[kx] = M.st_h[sb + (size_t)(kq * 32 + kx) * 128 + v];
    float vv[4];
#pragma unroll
    for (int s = 0; s < 4; ++s) vv[s] = bf2f(M.V[(size_t)(tb + s) * DH + cb + v]);
    const float sgo = bf2f(M.SG[(size_t)(tb + kq) * DH + cb + v]), hno = M.hnorm[cb + v];
    if (tid < 128) {
        const int k = tid;
        const float l0 = M.lb[cb + k], l1 = M.lb[512 + cb + k];
        const float lb = 1.f / (1.f + expf(l1 - l0));
        float cum[4], kk[4], qv[4]; float run = 0.f;
#pragma unroll
        for (int s = 0; s < 4; ++s) {
            const float fz = M.FZ[(size_t)(tb + s) * DH + cb + k];
            const float sg = 1.f / (1.f + expf(-fz)), sn = 1.f / (1.f + expf(fz));
            run += logf(lb + (1.f - lb) * sg); cum[s] = run; kk[s] = (1.f - lb) * sn;
            qv[s] = bf2f(M.Q[(size_t)(tb + s) * DH + cb + k]);
        }
#pragma unroll
        for (int s = 0; s < 4; ++s) { SQ[s * 128 + k] = qv[s] * expf(cum[s]); SK[s * 128 + k] = kk[s] * expf(cum[3] - cum[s]); }
        SD[k] = expf(cum[3]);
        float pr[10]; int c = 0;
#pragma unroll
        for (int t = 0; t < 4; ++t)
#pragma unroll
            for (int s = 0; s <= t; ++s) { pr[c] = qv[t] * kk[s] * expf(cum[t] - cum[s]); ++c; }
#pragma unroll
        for (int i = 0; i < 10; ++i) { const float v = wave_sum(pr[i]); if (lane == 0) SP[wave * 16 + i] = v; }
    }
    __syncthreads();
    {
        float o[4] = {0.f, 0.f, 0.f, 0.f};
#pragma unroll
        for (int kx = 0; kx < 32; ++kx) {
            const int k = kq * 32 + kx;
            const float s0 = s0v[kx];
            float sn = SD[k] * s0;
#pragma unroll
            for (int s = 0; s < 4; ++s) { o[s] += SQ[s * 128 + k] * s0; sn += SK[s * 128 + k] * vv[s]; }
            M.out[OUT_HS + sb + (size_t)k * 128 + v] = sn;
        }
#pragma unroll
        for (int s = 0; s < 4; ++s) OP[(kq * 4 + s) * 128 + v] = o[s];
    }
    __syncthreads();
    {
        const int t = kq;
        float ov = (OP[(0 * 4 + t) * 128 + v] + OP[(1 * 4 + t) * 128 + v]) + (OP[(2 * 4 + t) * 128 + v] + OP[(3 * 4 + t) * 128 + v]);
        const int base = t * (t + 1) / 2;
        for (int s = 0; s <= t; ++s) ov += (SP[base + s] + SP[16 + base + s]) * vv[s];
        const float ssq = wave_sum(ov * ov);
        if (lane == 0) RS[wave] = ssq;
        __syncthreads();
        const float tt = RS[2 * t] + RS[2 * t + 1];
        const float rinv = rsqrtf(tt * (1.f / 128.f) + EPS);
        const size_t tok = (size_t)(tb + t);
        M.O[tok * DM + cb + v] = f2bf(ov * rinv * hno * sgo);
    }
    __syncthreads();
}

__device__ __forceinline__ void lru_sample_unit(const Mix& M, int b, LAS unsigned char* lds) {
    const int tid = threadIdx.x, ch = tid, n = ch >> 6, j = ch & 63, tb = TP + b * 4;
    LAS float* XC = (LAS float*)lds;
    float x[7];
#pragma unroll
    for (int r = 0; r < 3; ++r) x[r] = M.st_c[(size_t)(b * 3 + r) * 512 + ch];
#pragma unroll
    for (int s = 0; s < 4; ++s) x[3 + s] = M.XB[(size_t)(tb + s) * DH + ch];
    const float w0 = M.convw[ch], w1 = M.convw[512 + ch], w2 = M.convw[1024 + ch], w3 = M.convw[1536 + ch], cbias = M.convb[ch];
    float xc[4];
#pragma unroll
    for (int s = 0; s < 4; ++s) { xc[s] = cbias + w0 * x[s] + w1 * x[s + 1] + w2 * x[s + 2] + w3 * x[s + 3]; XC[s * 512 + ch] = xc[s]; }
#pragma unroll
    for (int r = 0; r < 3; ++r) M.out[OUT_CS + (size_t)(b * 3 + r) * 512 + ch] = x[4 + r];
    __syncthreads();
    float ra[4], rx[4];
    const float ba = M.ba[ch], bx = M.bx[ch];
#pragma unroll
    for (int s = 0; s < 4; ++s) { ra[s] = ba; rx[s] = bx; }
    const float* wa = M.wa + (size_t)n * 4096 + j; const float* wx = M.wx + (size_t)n * 4096 + j;
#pragma unroll 16
    for (int i = 0; i < 64; ++i) {
        const float a = wa[i * 64], xw = wx[i * 64];
#pragma unroll
        for (int s = 0; s < 4; ++s) { const float xv = XC[s * 512 + n * 64 + i]; ra[s] += xv * a; rx[s] += xv * xw; }
    }
    const float sp = log1pf(expf(-M.lam[ch]));
    float hh = M.st_l[(size_t)b * 512 + ch];
#pragma unroll
    for (int s = 0; s < 4; ++s) {
        const float r = 1.f / (1.f + expf(-ra[s])), ig = 1.f / (1.f + expf(-rx[s]));
        const float la = -8.f * r * sp, a = expf(la), mult = sqrtf(-expm1f(2.f * la));
        hh = a * hh + mult * ig * xc[s];
        M.O[(size_t)(tb + s) * DM + 512 + ch] = f2bf(hh * bf2f(M.GY[(size_t)(tb + s) * DH + ch]));
    }
    M.out[OUT_LS + (size_t)b * 512 + ch] = hh;
    __syncthreads();
}

__device__ __forceinline__ void scan_item(const Mix& M, int item) {
    const int tid = threadIdx.x;
    if (item < 1024) {
        const int e = item * 512 + tid, bh = e >> 14, vk = e & 16383, b = bh >> 2, h = bh & 3, v = vk >> 7, k = vk & 127;
        float l[32], d[32];
#pragma unroll
        for (int c = 0; c < 32; ++c) { const int unit = (b * 32 + c) * 4 + h; l[c] = bf2f(M.LT[(size_t)unit * 16384 + vk]); d[c] = M.DC[unit * 128 + k]; }
        float S = 0.f;
#pragma unroll
        for (int c = 0; c < 32; ++c) { const int unit = (b * 32 + c) * 4 + h; M.LT[(size_t)unit * 16384 + vk] = f2bf(S); S = d[c] * S + l[c]; }
        M.out[OUT_HP + ((size_t)(b * 4 + h) * 128 + k) * 128 + v] = S;
    } else {
        const int e = (item - 1024) * 512 + tid, b = e >> 9, ch = e & 511;
        float hcar = 0.f;
        for (int c = 0; c < 32; ++c) { const size_t idx = (size_t)(b * 32 + c) * 512 + ch; M.HST[idx] = hcar; hcar = M.ACH[idx] * hcar + M.UCH[idx]; }
    }
}

__global__ void __launch_bounds__(512, 2) mk_fwd(Params p) {
    extern __shared__ __attribute__((aligned(16))) unsigned char lds_raw[];
    LAS unsigned char* lds = (LAS unsigned char*)lds_raw;
    const int lo = p.ph_lo, hi = p.ph_hi, G = gridDim.x;
    unsigned char* ws = p.ws;
#define IN(k) (lo <= (k) && (k) < hi)
    volatile LAS unsigned* xst = (volatile LAS unsigned*)(lds + 131072);
    if (threadIdx.x < 16) xst[threadIdx.x] = 0u;
    __syncthreads();
    XcdBarrier xbar; xbar.bar = (unsigned*)(ws + WS_BAR); xbar.x = 0; xbar.st = xst;
    if (hi - lo > 1) xbar = xcd_barrier_post((unsigned*)(ws + WS_BAR), xst);
    if (hi == 0x7fffffff) cg::this_grid().sync();
#define SEAM(k) do { if (IN(k) && IN((k) + 1)) { xcd_barrier(xbar); } } while (0)
    bf16_t* B0 = (bf16_t*)(ws + WS_B0); bf16_t* B1 = (bf16_t*)(ws + WS_B1); bf16_t* H = (bf16_t*)(ws + WS_H);
    float* SS0 = (float*)(ws + WS_SS0); float* SS1 = (float*)(ws + WS_SS1); float* SS2 = (float*)(ws + WS_SS2); float* SS3 = (float*)(ws + WS_SS3);

    if (IN(0)) { phase0(p, lds); __syncthreads(); }
    SEAM(0);
    if (IN(1)) {
        pg8::Gemm g{B0, (const bf16_t*)(ws + WS_WG1), T_ALL, 2 * DFF, DM}; pg8::StaticOrder S; S.init(T_ALL, 2 * DFF, G, (int)blockIdx.x);
        EpiGateUp E{H, SS0};
        pg8::gemm_phase<EpiGateUp, pg8::StaticOrder, PG8_ALIGN, PG8_SP2>(lds, g, S, E);
    }
    SEAM(1);
    if (IN(2)) {
        pg8::Gemm g{H, (const bf16_t*)(ws + WS_WD1), TP, DM, DFF}; pg8::StaticOrder S; S.init(TP, DM, G, (int)blockIdx.x);
        EpiResid E{p.in[0], p.in[1], p.out, B0, p.in[9], SS1, 0.5f};
        pg8::gemm_phase<EpiResid, pg8::StaticOrder, PG8_ALIGN, PG8_SP2>(lds, g, S, E);
        SmallResid Es{p.in[1] - (size_t)TP * DM, p.out, B0, p.in[9], SS1, 0.5f};
        small_gemm<SmallResid, DFF>(H, (const bf16_t*)(ws + WS_WD1), DM, Es, lds);
    }
    SEAM(2);
    if (IN(3)) {
        pg8::Gemm g{B0, (const bf16_t*)(ws + WS_WIN), TP, DIN, DM}; pg8::StaticOrder S; S.init(TP, DIN, G, (int)blockIdx.x);
        EpiProj E{(bf16_t*)(ws + WS_Q), (bf16_t*)(ws + WS_V), (bf16_t*)(ws + WS_SG), (bf16_t*)(ws + WS_GY), (float*)(ws + WS_FZ), (float*)(ws + WS_XB), SS1};
        pg8::gemm_phase<EpiProj, pg8::StaticOrder, PG8_ALIGN, PG8_SP2>(lds, g, S, E);
        SmallProj Es{(bf16_t*)(ws + WS_Q), (bf16_t*)(ws + WS_V), (bf16_t*)(ws + WS_SG), (bf16_t*)(ws + WS_GY), (float*)(ws + WS_FZ), (float*)(ws + WS_XB), SS1};
        small_gemm<SmallProj, DM>(B0, (const bf16_t*)(ws + WS_WIN), DIN, Es, lds);
    }
    SEAM(3);
    Mix M;
    M.Q = (const bf16_t*)(ws + WS_Q); M.V = (const bf16_t*)(ws + WS_V); M.SG = (const bf16_t*)(ws + WS_SG); M.GY = (const bf16_t*)(ws + WS_GY);
    M.FZ = (const float*)(ws + WS_FZ); M.XB = (const float*)(ws + WS_XB); M.LT = (bf16_t*)(ws + WS_LT); M.DC = (float*)(ws + WS_DC);
    M.ACH = (float*)(ws + WS_ACH); M.UCH = (float*)(ws + WS_UCH); M.HST = (float*)(ws + WS_HST); M.O = B0;
    M.WAT = (const bf16_t*)(ws + WS_WAT); M.WXT = (const bf16_t*)(ws + WS_WXT);
    M.lb = p.in[11]; M.hnorm = p.in[12]; M.convw = p.in[13]; M.convb = p.in[14]; M.wa = p.in[15]; M.ba = p.in[16]; M.wx = p.in[17]; M.bx = p.in[18]; M.lam = p.in[19];
    M.st_h = p.in[2]; M.st_l = p.in[3]; M.st_c = p.in[4]; M.out = p.out;
    if (IN(4)) {
        for (int u = blockIdx.x; u < 512; u += G) hgrn_sample_unit(M, u, lds);
        hgrn_loop<0>(M, lds);
        lru_loop(M, 0, lds);
        for (int u = G - 1 - (int)blockIdx.x; u < 128; u += G) lru_sample_unit(M, u, lds);
    }
    SEAM(4);
    if (IN(5)) { for (int it = blockIdx.x; it < 1032; it += G) scan_item(M, it); }
    SEAM(5);
    if (IN(6)) {
        hgrn_loop<1>(M, lds);
        lru_loop(M, 1, lds);
    }
    SEAM(6);
    if (IN(7)) {
        pg8::Gemm g{B0, (const bf16_t*)(ws + WS_WO), TP, DM, DM}; pg8::StaticOrder S; S.init(TP, DM, G, (int)blockIdx.x);
        EpiResid E{p.out, p.out + (size_t)TP * DM, p.out, B1, p.in[21], SS2, 1.0f};
        pg8::gemm_phase<EpiResid, pg8::StaticOrder, PG8_ALIGN, PG8_SP2>(lds, g, S, E);
        SmallResid Es{p.out, p.out, B1, p.in[21], SS2, 1.0f};
        small_gemm<SmallResid, DM>(B0, (const bf16_t*)(ws + WS_WO), DM, Es, lds);
    }
    SEAM(7);
    if (IN(8)) {
        pg8::Gemm g{B1, (const bf16_t*)(ws + WS_WG2), T_ALL, 2 * DFF, DM}; pg8::StaticOrder S; S.init(T_ALL, 2 * DFF, G, (int)blockIdx.x);
        EpiGateUp E{H, SS2};
        pg8::gemm_phase<EpiGateUp, pg8::StaticOrder, PG8_ALIGN, PG8_SP2>(lds, g, S, E);
    }
    SEAM(8);
    if (IN(9)) {
        pg8::Gemm g{H, (const bf16_t*)(ws + WS_WD2), TP, DM, DFF}; pg8::StaticOrder S; S.init(TP, DM, G, (int)blockIdx.x);
        EpiResid E{p.out, p.out + (size_t)TP * DM, p.out, nullptr, nullptr, SS3, 0.5f};
        pg8::gemm_phase<EpiResid, pg8::StaticOrder, PG8_ALIGN, PG8_SP2>(lds, g, S, E);
        SmallResid Es{p.out, p.out, nullptr, nullptr, SS3, 0.5f};
        small_gemm<SmallResid, DFF>(H, (const bf16_t*)(ws + WS_WD2), DM, Es, lds);
    }
    SEAM(9);
    if (IN(10)) phase_final(p);
#undef IN
#undef SEAM
}

extern "C" void kernel_launch(void* const* d_in, const int* in_sizes, int n_in, void* d_out, int out_size, void* d_ws, size_t ws_size, hipStream_t stream) {
    static int grid = 0;
    if (grid == 0) {
        if (n_in != 26 || ws_size < WS_END2) { fprintf(stderr, "kernel_launch: unexpected n_in %d or ws_size %zu (need %zu)\n", n_in, ws_size, (size_t)WS_END2); grid = -1; return; }
        int dev = 0, cus = 0, per_cu = 0;
        hipGetDevice(&dev); hipDeviceGetAttribute(&cus, hipDeviceAttributeMultiprocessorCount, dev);
        if (hipFuncSetAttribute((const void*)mk_fwd, hipFuncAttributeMaxDynamicSharedMemorySize, LDS_BYTES) != hipSuccess) { fprintf(stderr, "kernel_launch: hipFuncSetAttribute failed\n"); grid = -1; return; }
        if (hipOccupancyMaxActiveBlocksPerMultiprocessor(&per_cu, (const void*)mk_fwd, 512, LDS_BYTES) != hipSuccess || per_cu < 1) { fprintf(stderr, "kernel_launch: occupancy query says %d\n", per_cu); per_cu = 1; }
        (void)hipGetLastError();
        grid = cus;
    }
    if (grid < 0) return;
    Params p{};
    for (int i = 0; i < 26; ++i) p.in[i] = (const float*)d_in[i];
    p.out = (float*)d_out; p.ws = (unsigned char*)d_ws;
#if MK_PER_PHASE
    for (int ph = 0; ph < MK_NPH; ++ph) { p.ph_lo = ph; p.ph_hi = ph + 1; hipLaunchKernelGGL(mk_fwd, dim3(grid), dim3(512), LDS_BYTES, stream, p); if ((MK_DUP >> ph) & 1) hipLaunchKernelGGL(mk_fwd, dim3(grid), dim3(512), LDS_BYTES, stream, p); }
#else
    p.ph_lo = 0; p.ph_hi = MK_NPH;
    if (hipMemsetAsync((char*)d_ws + WS_BAR, 0, 16384, stream) != hipSuccess) { fprintf(stderr, "memset failed\n"); return; }
    void* args[] = {&p};
    hipError_t e = hipLaunchCooperativeKernel((const void*)mk_fwd, dim3(grid), dim3(512), args, LDS_BYTES, stream);
    if (e != hipSuccess) fprintf(stderr, "cooperative launch failed: %s (grid %d)\n", hipGetErrorString(e), grid);
#endif
}
```

```cpp
#include <hip/hip_runtime.h>
#include <hip/hip_cooperative_groups.h>
#include <cstdio>
#include <cstdint>
namespace cg = cooperative_groups;

#ifndef MK_DUP
#define MK_DUP 0
#endif
#ifndef MK_NPH
#define MK_NPH 11
#endif
#ifndef MK_PER_PHASE
#define MK_PER_PHASE 0
#endif

#define LAS __attribute__((address_space(3)))
typedef unsigned short bf16_t;
typedef short bf16x8 __attribute__((ext_vector_type(8)));
typedef float f32x4 __attribute__((ext_vector_type(4)));
typedef unsigned u32x4 __attribute__((ext_vector_type(4)));
typedef unsigned u32x2 __attribute__((ext_vector_type(2)));

constexpr int T_ALL = 16896, TP = 16384, DM = 1024, DFF = 2816, DIN = 3072, DH = 512;
constexpr int SEQ = 2048, NB = 8, NCH = 32, DECB = 128;
constexpr float EPS = 1e-6f;

constexpr size_t OUT_Y = 0, OUT_HP = 17301504, OUT_LP = 17825792, OUT_CP = 17829888, OUT_HS = 17842176, OUT_LS = 26230784, OUT_CS = 26296320;

constexpr size_t WS_WG1 = 0;
constexpr size_t WS_WD1 = WS_WG1 + (size_t)5632 * 1024 * 2;
constexpr size_t WS_WIN = WS_WD1 + (size_t)1024 * 2816 * 2;
constexpr size_t WS_WO  = WS_WIN + (size_t)3072 * 1024 * 2;
constexpr size_t WS_WG2 = WS_WO + (size_t)1024 * 1024 * 2;
constexpr size_t WS_WD2 = WS_WG2 + (size_t)5632 * 1024 * 2;
constexpr size_t WS_WAT = WS_WD2 + (size_t)1024 * 2816 * 2;
constexpr size_t WS_WXT = WS_WAT + 65536;
constexpr size_t WS_SS0 = WS_WXT + 65536;
constexpr size_t SS_BYTES = (size_t)T_ALL * 16 * 4;
constexpr size_t WS_SS1 = WS_SS0 + SS_BYTES, WS_SS2 = WS_SS1 + SS_BYTES, WS_SS3 = WS_SS2 + SS_BYTES;
constexpr size_t WS_DC  = WS_SS3 + SS_BYTES;
constexpr size_t WS_ACH = WS_DC + (size_t)1024 * 128 * 4;
constexpr size_t WS_UCH = WS_ACH + (size_t)NB * NCH * 512 * 4;
constexpr size_t WS_HST = WS_UCH + (size_t)NB * NCH * 512 * 4;
constexpr size_t WS_B0  = WS_HST + (size_t)NB * NCH * 512 * 4;
constexpr size_t WS_R   = WS_B0 + (size_t)T_ALL * 1024 * 2;
constexpr size_t WS_H   = WS_R;
constexpr size_t WS_B1  = WS_H + (size_t)T_ALL * 2816 * 2;
constexpr size_t WS_Q   = WS_R;
constexpr size_t WS_V   = WS_Q + (size_t)T_ALL * 512 * 2;
constexpr size_t WS_SG  = WS_V + (size_t)T_ALL * 512 * 2;
constexpr size_t WS_GY  = WS_SG + (size_t)T_ALL * 512 * 2;
constexpr size_t WS_FZ  = WS_GY + (size_t)T_ALL * 512 * 2;
constexpr size_t WS_XB  = WS_FZ + (size_t)T_ALL * 512 * 4;
constexpr size_t WS_LT  = WS_XB + (size_t)T_ALL * 512 * 4;
constexpr size_t WS_END = WS_LT + (size_t)1024 * 16384 * 2;
constexpr size_t WS_BAR = WS_END;
constexpr size_t WS_END2 = WS_BAR + 16384;
static_assert(WS_END2 <= 268435456, "workspace budget");
static_assert(WS_B1 + (size_t)T_ALL * 1024 * 2 <= WS_END, "B1 inside R");

constexpr int LDS_BYTES = 131072 + 64;

typedef __bf16 nbf16x2 __attribute__((ext_vector_type(2)));
typedef float f32x2 __attribute__((ext_vector_type(2)));
__device__ __forceinline__ unsigned cvt_pk_bf16(float lo, float hi) { const nbf16x2 r = __builtin_convertvector((f32x2){lo, hi}, nbf16x2); return __builtin_bit_cast(unsigned, r); }
__device__ __forceinline__ bf16_t f2bf(float f) { return (bf16_t)(cvt_pk_bf16(f, 0.f) & 0xffffu); }
__device__ __forceinline__ float bf2f(bf16_t b) { return __uint_as_float(((unsigned)b) << 16); }
__device__ __forceinline__ float bflo(unsigned w) { return __uint_as_float(w << 16); }
__device__ __forceinline__ float bfhi(unsigned w) { return __uint_as_float(w & 0xffff0000u); }
__device__ __forceinline__ float sigm(float x) { return __builtin_amdgcn_rcpf(1.f + __expf(-x)); }
__device__ __forceinline__ float rowscale(const float* ss, int row) {
    const f32x4* p = (const f32x4*)(ss + (size_t)row * 16);
    const f32x4 a = p[0], b = p[1], c = p[2], d = p[3];
    const float s = (((a.x + a.y) + (a.z + a.w)) + ((b.x + b.y) + (b.z + b.w))) + (((c.x + c.y) + (c.z + c.w)) + ((d.x + d.y) + (d.z + d.w)));
    return rsqrtf(s * (1.f / 1024.f) + EPS);
}
__device__ __forceinline__ void rowscale8(const float* ss, int row0, int fq, float (&rs)[8]) {
    f32x4 q[8];
#pragma unroll
    for (int i = 0; i < 8; ++i) q[i] = *(const f32x4*)(ss + (size_t)(row0 + (i >> 2) * 128 + (i & 3) * 16) * 16 + 4 * fq);
#pragma unroll
    for (int i = 0; i < 8; ++i) { float t = (q[i].x + q[i].y) + (q[i].z + q[i].w); t += __shfl_xor(t, 16); t += __shfl_xor(t, 32); rs[i] = rsqrtf(t * (1.f / 1024.f) + EPS); }
}
__device__ __forceinline__ float wave_sum(float v) {
#pragma unroll
    for (int o = 1; o < 64; o <<= 1) v += __shfl_xor(v, o);
    return v;
}
#define LDS_WAIT() asm volatile("s_waitcnt lgkmcnt(0)" ::: "memory")

namespace pg8 {
constexpr int BM = 256, BK = 64, HALF = 128, HTB = HALF * BK * 2, STAGE_BYTES = 8 * HTB, NXCD = 8, WGM = 8;
__host__ __device__ __forceinline__ int lds_byte(int r, int c) { const int st = (r >> 4) * 2 + (c >> 5), rr = r & 15, cc = c & 31, ob = rr * 64 + cc * 2; return st * 1024 + (ob ^ (((ob >> 9) & 1) << 5)); }
__host__ __device__ __forceinline__ void stage_rc(int b, int& R, int& C) { const int st = b / 1024, sb = b % 1024, swz = sb ^ (((sb >> 9) & 1) << 5); R = (st >> 1) * 16 + swz / 64; C = (st & 1) * 32 + (swz % 64) / 2; }
__host__ __device__ __forceinline__ int perm32(int rho) { const int n = rho >> 4, i = rho & 15; return 8 * (i >> 2) + 4 * n + (i & 3); }
struct Unit { int pm, pn; };
struct Gemm { const bf16_t* A; const bf16_t* Bt; int M, N, K; };
struct StaticOrder {
    int nM, nN, nwg, G, c;
    __host__ __device__ void init(int M, int N, int G_, int c_) { nM = M / BM; nN = N / BM; nwg = nM * nN; G = G_; c = c_; }
    __host__ __device__ bool next(int i, Unit& u) const {
        const long L = (long)i * G + c; if (L >= nwg) return false;
        int wgid = (int)L; { const int q = nwg / NXCD, r = nwg % NXCD, xcd = wgid % NXCD, off = wgid / NXCD; wgid = (xcd < r ? xcd * (q + 1) : r * (q + 1) + (xcd - r) * q) + off; }
        const int nig = WGM * nN, gid = wgid / nig, fm = gid * WGM, gsz = (nM - fm) < WGM ? (nM - fm) : WGM;
        u.pm = fm + ((wgid % nig) % gsz); u.pn = (wgid % nig) / gsz; return true;
    }
    __device__ __forceinline__ void a_ready(const Unit&) const {}
    __device__ __forceinline__ void done(const Unit&) const {}
};

template <class Epi, class Sched, bool ALIGN_EPI = false, bool SP2 = false>
__device__ __forceinline__ void gemm_phase(LAS unsigned char* lds, const Gemm g, const Sched& S, const Epi& E) {
    const int tid = threadIdx.x, wid = __builtin_amdgcn_readfirstlane(tid >> 6), lane = tid & 63, wr = wid >> 2, wc = wid & 3, fr = lane & 15, fq = lane >> 4;
    const int K = g.K, nt = K / BK;
    unsigned voffA[2], voffB[2];
#pragma unroll
    for (int i = 0; i < 2; ++i) { int R, C; stage_rc(tid * 16 + i * 8192, R, C); const int Rb = Epi::PERM ? ((R & ~31) + perm32(R & 31)) : R;
        voffA[i] = (unsigned)(R * K + C) * 2u; voffB[i] = (unsigned)(Rb * K + C) * 2u; }
    const size_t kstep = (size_t)(BK * 2);
    const size_t hstep = (size_t)HALF * K * 2;
    const size_t tstep = 2 * hstep;
    const unsigned ldsw = (unsigned)wid * 1024u;
    const int aoff = lds_byte(wr * 64 + fr, fq * 8), boff = lds_byte(wc * 32 + fr, fq * 8);
#define PG8_SA(b, h) (((b) * 2 + (h)) * HTB)
#define PG8_SB(b, h) ((4 + (b) * 2 + (h)) * HTB)
#define PG8_STAGE(bufoff, gbase, voff) do { _Pragma("unroll") for (int _i = 0; _i < 2; ++_i) \
        __builtin_amdgcn_global_load_lds((const unsigned*)((const char*)(gbase) + (voff)[_i]), (LAS unsigned*)(lds + (bufoff) + ldsw + _i * 8192), 16, 0, 0); } while (0)
#define PG8_LDA(dst, b, h) do { _Pragma("unroll") for (int m = 0; m < 4; ++m) _Pragma("unroll") for (int k = 0; k < 2; ++k) dst[m][k] = *(const LAS bf16x8*)(lds + PG8_SA(b, h) + aoff + m * 2048 + k * 1024); } while (0)
#define PG8_LDB(dst, b, h) do { _Pragma("unroll") for (int n = 0; n < 2; ++n) _Pragma("unroll") for (int k = 0; k < 2; ++k) dst[n][k] = *(const LAS bf16x8*)(lds + PG8_SB(b, h) + boff + n * 2048 + k * 1024); } while (0)
#define PG8_MMA(ai, bj, At, Bt) do { __builtin_amdgcn_s_setprio(1); _Pragma("unroll") for (int m = 0; m < 4; ++m) _Pragma("unroll") for (int n = 0; n < 2; ++n) _Pragma("unroll") for (int k = 0; k < 2; ++k) \
        acc[ai][bj][m][n] = __builtin_amdgcn_mfma_f32_16x16x32_bf16(Bt[n][k], At[m][k], acc[ai][bj][m][n], 0, 0, 0); __builtin_amdgcn_s_setprio(0); } while (0)
#define PG8_WAIT_V(n) asm volatile("s_waitcnt vmcnt(" #n ")" ::: "memory")
#define PG8_WAIT_L(n) asm volatile("s_waitcnt lgkmcnt(" #n ")" ::: "memory")
#define PG8_BAR __builtin_amdgcn_s_barrier()
#define PG8_SCHED __builtin_amdgcn_sched_barrier(0)
    Unit cur, nxt; int ui = 0;
    if (!S.next(0, cur)) return;
    f32x4 acc[2][2][4][2];
#pragma unroll
    for (int a = 0; a < 2; ++a)
#pragma unroll
        for (int b = 0; b < 2; ++b)
#pragma unroll
            for (int m = 0; m < 4; ++m)
#pragma unroll
                for (int n = 0; n < 2; ++n) acc[a][b][m][n] = (f32x4){0.f, 0.f, 0.f, 0.f};
    bf16x8 At[4][2], B0[2][2], B1[2][2];
    const char* cA = (const char*)g.A + (size_t)cur.pm * tstep; const char* cB = (const char*)g.Bt + (size_t)cur.pn * tstep;
    S.a_ready(cur);
    if constexpr (SP2) {
        PG8_STAGE(PG8_SB(0, 0), cB, voffB); PG8_STAGE(PG8_SB(0, 1), cB + hstep, voffB); PG8_STAGE(PG8_SA(0, 0), cA, voffA); PG8_STAGE(PG8_SA(0, 1), cA + hstep, voffA);
        if (wr == 1) PG8_BAR;
        PG8_WAIT_V(2); PG8_BAR;
        PG8_STAGE(PG8_SB(1, 0), cB + kstep, voffB); PG8_STAGE(PG8_SA(1, 0), cA + kstep, voffA); PG8_STAGE(PG8_SB(1, 1), cB + hstep + kstep, voffB);
        PG8_WAIT_V(6); PG8_BAR;
    } else {
        PG8_STAGE(PG8_SB(0, 0), cB, voffB); PG8_STAGE(PG8_SA(0, 0), cA, voffA); PG8_STAGE(PG8_SB(0, 1), cB + hstep, voffB); PG8_STAGE(PG8_SA(0, 1), cA + hstep, voffA);
        if (wr == 1) PG8_BAR;
        PG8_WAIT_V(4); PG8_BAR;
        PG8_STAGE(PG8_SB(1, 0), cB + kstep, voffB); PG8_STAGE(PG8_SA(1, 0), cA + kstep, voffA); PG8_STAGE(PG8_SB(1, 1), cB + hstep + kstep, voffB);
        PG8_WAIT_V(6); PG8_BAR;
    }
    for (;;) {
        const bool has_next = S.next(ui + 1, nxt);
        const char* nA = has_next ? (const char*)g.A + (size_t)nxt.pm * tstep : cA; const char* nB = has_next ? (const char*)g.Bt + (size_t)nxt.pn * tstep : cB;
        for (int t = 0; t < nt; t += 2) {
            const bool last = (t == nt - 2);
            const char* a1 = cA + (size_t)(t + 1) * kstep;
            const char* a2 = last ? nA : cA + (size_t)(t + 2) * kstep; const char* b2 = last ? nB : cB + (size_t)(t + 2) * kstep;
            const char* a3 = a2 + kstep; const char* b3 = b2 + kstep;
            if (last && has_next) S.a_ready(nxt);
            if constexpr (SP2) {
            PG8_LDB(B0, 0, 0); PG8_LDB(B1, 0, 1); PG8_SCHED; PG8_LDA(At, 0, 0); PG8_STAGE(PG8_SA(1, 1), a1 + hstep, voffA);
            PG8_WAIT_V(8); PG8_WAIT_L(0); PG8_BAR; PG8_MMA(0, 0, At, B0); PG8_MMA(0, 1, At, B1); PG8_BAR; PG8_SCHED;
            PG8_LDA(At, 0, 1); PG8_STAGE(PG8_SB(0, 0), b2, voffB); PG8_STAGE(PG8_SB(0, 1), b2 + hstep, voffB); PG8_STAGE(PG8_SA(0, 0), a2, voffA);
            PG8_WAIT_V(8); PG8_WAIT_L(0); PG8_BAR; PG8_MMA(1, 0, At, B0); PG8_MMA(1, 1, At, B1); PG8_BAR; PG8_SCHED;
            PG8_LDB(B0, 1, 0); PG8_LDB(B1, 1, 1); PG8_SCHED; PG8_LDA(At, 1, 0); PG8_STAGE(PG8_SA(0, 1), a2 + hstep, voffA);
            PG8_WAIT_V(8); PG8_WAIT_L(0); PG8_BAR; PG8_MMA(0, 0, At, B0); PG8_MMA(0, 1, At, B1); PG8_BAR; PG8_SCHED;
            PG8_LDA(At, 1, 1); PG8_STAGE(PG8_SB(1, 0), b3, voffB); PG8_STAGE(PG8_SB(1, 1), b3 + hstep, voffB); PG8_STAGE(PG8_SA(1, 0), a3, voffA);
            PG8_WAIT_V(8); PG8_WAIT_L(0); PG8_BAR; PG8_MMA(1, 0, At, B0); PG8_MMA(1, 1, At, B1); PG8_BAR; PG8_SCHED;
            } else {
            PG8_LDB(B0, 0, 0); PG8_SCHED; PG8_LDA(At, 0, 0); PG8_STAGE(PG8_SA(1, 1), a1 + hstep, voffA);
            PG8_WAIT_L(8); PG8_BAR; PG8_WAIT_L(0); PG8_MMA(0, 0, At, B0); PG8_BAR; PG8_SCHED;
            PG8_LDB(B1, 0, 1); PG8_STAGE(PG8_SB(0, 0), b2, voffB);
            PG8_BAR; PG8_WAIT_L(0); PG8_MMA(0, 1, At, B1); PG8_BAR;
            PG8_LDA(At, 0, 1); PG8_STAGE(PG8_SA(0, 0), a2, voffA);
            PG8_BAR; PG8_WAIT_L(0); PG8_MMA(1, 0, At, B0); PG8_BAR; PG8_SCHED;
            PG8_STAGE(PG8_SB(0, 1), b2 + hstep, voffB);
            PG8_WAIT_V(6); PG8_BAR; PG8_MMA(1, 1, At, B1); PG8_BAR;
            PG8_LDB(B0, 1, 0); PG8_SCHED; PG8_LDA(At, 1, 0); PG8_STAGE(PG8_SA(0, 1), a2 + hstep, voffA);
            PG8_WAIT_L(8); PG8_BAR; PG8_WAIT_L(0); PG8_MMA(0, 0, At, B0); PG8_BAR; PG8_SCHED;
            PG8_LDB(B1, 1, 1); PG8_STAGE(PG8_SB(1, 0), b3, voffB);
            PG8_BAR; PG8_WAIT_L(0); PG8_MMA(0, 1, At, B1); PG8_BAR;
            PG8_LDA(At, 1, 1); PG8_STAGE(PG8_SA(1, 0), a3, voffA);
            PG8_BAR; PG8_WAIT_L(0); PG8_MMA(1, 0, At, B0); PG8_BAR; PG8_SCHED;
            PG8_STAGE(PG8_SB(1, 1), b3 + hstep, voffB);
            PG8_WAIT_V(6); PG8_BAR; PG8_MMA(1, 1, At, B1); PG8_BAR;
            }
        }
        if constexpr (ALIGN_EPI) { if (wr == 0) PG8_BAR; }
        E(acc, cur, wr, wc, fr, fq); S.done(cur);
        if (!has_next) break;
#pragma unroll
        for (int a = 0; a < 2; ++a)
#pragma unroll
            for (int b = 0; b < 2; ++b)
#pragma unroll
                for (int m = 0; m < 4; ++m)
#pragma unroll
                    for (int n = 0; n < 2; ++n) acc[a][b][m][n] = (f32x4){0.f, 0.f, 0.f, 0.f};
        cur = nxt; cA = nA; cB = nB; ++ui;
        if constexpr (ALIGN_EPI) { if (wr == 1) PG8_BAR; }
    }
    PG8_WAIT_V(0);
    if constexpr (!ALIGN_EPI) { if (wr == 0) PG8_BAR; }
    PG8_BAR;
#undef PG8_SA
#undef PG8_SB
#undef PG8_STAGE
#undef PG8_LDA
#undef PG8_LDB
#undef PG8_MMA
#undef PG8_WAIT_V
#undef PG8_WAIT_L
#undef PG8_BAR
#undef PG8_SCHED
}
}

#ifndef PG8_SP2
#define PG8_SP2 true
#endif
#ifndef PG8_ALIGN
#define PG8_ALIGN true
#endif

struct EpiGateUp {
    static constexpr bool PERM = true;
    bf16_t* H; const float* ss;
    __device__ __forceinline__ void operator()(const f32x4 (&acc)[2][2][4][2], const pg8::Unit& u, int wr, int wc, int fr, int fq) const {
        const int row0 = u.pm * 256 + wr * 64 + fr, col0 = u.pn * 128 + wc * 32 + 8 * fq;
        float rsv[8]; rowscale8(ss, row0, fq, rsv);
#pragma unroll
        for (int ai = 0; ai < 2; ++ai)
#pragma unroll
            for (int m = 0; m < 4; ++m) {
                const int row = row0 + ai * 128 + m * 16; const float rs = rsv[ai * 4 + m];
                float h[8];
#pragma unroll
                for (int n = 0; n < 2; ++n)
#pragma unroll
                    for (int j = 0; j < 4; ++j) { const float g = acc[ai][0][m][n][j] * rs, up = acc[ai][1][m][n][j] * rs; h[n * 4 + j] = g * sigm(g) * up; }
                u32x4 w; w.x = cvt_pk_bf16(h[0], h[1]); w.y = cvt_pk_bf16(h[2], h[3]); w.z = cvt_pk_bf16(h[4], h[5]); w.w = cvt_pk_bf16(h[6], h[7]);
                *(u32x4*)(H + (size_t)row * DFF + col0) = w;
            }
    }
};
struct EpiResid {
    static constexpr bool PERM = true;
    const float* xin_p; const float* xin_s; float* xout; bf16_t* ax; const float* gnext; float* ssout; float scale;
    __device__ __forceinline__ void operator()(const f32x4 (&acc)[2][2][4][2], const pg8::Unit& u, int wr, int wc, int fr, int fq) const {
        const int row0 = u.pm * 256 + wr * 64 + fr, col0 = u.pn * 256 + wc * 32 + 8 * fq;
        const float* xb = (u.pm < 64) ? xin_p : (xin_s - (size_t)TP * DM);
        f32x4 gn[2][2];
#pragma unroll
        for (int bj = 0; bj < 2; ++bj)
#pragma unroll
            for (int n = 0; n < 2; ++n) gn[bj][n] = ax ? *(const f32x4*)(gnext + col0 + bj * 128 + 4 * n) : (f32x4){1.f, 1.f, 1.f, 1.f};
#pragma unroll
        for (int ai = 0; ai < 2; ++ai) {
            f32x4 xr[4][2][2];
#pragma unroll
            for (int m = 0; m < 4; ++m)
#pragma unroll
                for (int bj = 0; bj < 2; ++bj) { const float* px = xb + (size_t)(row0 + ai * 128 + m * 16) * DM + col0 + bj * 128; xr[m][bj][0] = *(const f32x4*)px; xr[m][bj][1] = *(const f32x4*)(px + 4); }
#pragma unroll
            for (int m = 0; m < 4; ++m) {
                const int row = row0 + ai * 128 + m * 16; const size_t off = (size_t)row * DM + col0; float sq = 0.f;
#pragma unroll
                for (int bj = 0; bj < 2; ++bj) {
                    const f32x4 x0 = xr[m][bj][0], x1 = xr[m][bj][1];
                    const f32x4 v0 = x0 + acc[ai][bj][m][0] * scale, v1 = x1 + acc[ai][bj][m][1] * scale;
                    *(f32x4*)(xout + off + bj * 128) = v0; *(f32x4*)(xout + off + bj * 128 + 4) = v1;
                    sq += ((v0[0] * v0[0] + v0[1] * v0[1]) + (v0[2] * v0[2] + v0[3] * v0[3])) + ((v1[0] * v1[0] + v1[1] * v1[1]) + (v1[2] * v1[2] + v1[3] * v1[3]));
                    if (ax) { const f32x4 a0 = v0 * gn[bj][0], a1 = v1 * gn[bj][1];
                        u32x4 w; w.x = cvt_pk_bf16(a0[0], a0[1]); w.y = cvt_pk_bf16(a0[2], a0[3]); w.z = cvt_pk_bf16(a1[0], a1[1]); w.w = cvt_pk_bf16(a1[2], a1[3]);
                        *(u32x4*)(ax + off + bj * 128) = w; }
                }
                sq += __shfl_xor(sq, 16); sq += __shfl_xor(sq, 32);
                if (fq == 0) ssout[(size_t)row * 16 + u.pn * 4 + wc] = sq;
            }
        }
    }
};
struct EpiProj {
    static constexpr bool PERM = true;
    bf16_t *Q, *V, *SG, *GY; float *FZ, *XB; const float* ss;
    __device__ __forceinline__ void operator()(const f32x4 (&acc)[2][2][4][2], const pg8::Unit& u, int wr, int wc, int fr, int fq) const {
        const int seg = u.pn >> 1;
        const int row0 = u.pm * 256 + wr * 64 + fr, col0 = (u.pn & 1) * 256 + wc * 32 + 8 * fq;
        float* fdst = (seg == 1) ? FZ : XB;
        bf16_t* bdst = (seg == 0) ? Q : (seg == 2) ? V : (seg == 3) ? SG : GY;
        const bool isf = (seg == 1) || (seg == 4);
        float rsv[8]; rowscale8(ss, row0, fq, rsv);
#pragma unroll
        for (int ai = 0; ai < 2; ++ai)
#pragma unroll
            for (int m = 0; m < 4; ++m) {
                const int row = row0 + ai * 128 + m * 16; const float rs = rsv[ai * 4 + m]; const size_t off = (size_t)row * DH + col0;
#pragma unroll
                for (int bj = 0; bj < 2; ++bj) {
                    f32x4 v0 = acc[ai][bj][m][0] * rs, v1 = acc[ai][bj][m][1] * rs;
                    if (isf) { *(f32x4*)(fdst + off + bj * 128) = v0; *(f32x4*)(fdst + off + bj * 128 + 4) = v1; }
                    else {
                        float h[8] = {v0[0], v0[1], v0[2], v0[3], v1[0], v1[1], v1[2], v1[3]};
                        if (seg == 0) {
#pragma unroll
                            for (int j = 0; j < 8; ++j) h[j] = h[j] * sigm(h[j]);
                        } else if (seg == 3) {
#pragma unroll
                            for (int j = 0; j < 8; ++j) h[j] = sigm(h[j]);
                        } else if (seg == 5) {
#pragma unroll
                            for (int j = 0; j < 8; ++j) { const float y = h[j]; h[j] = y * sigm(1.5957691216f * (y + 0.044715f * y * y * y)); }
                        }
                        u32x4 w; w.x = cvt_pk_bf16(h[0], h[1]); w.y = cvt_pk_bf16(h[2], h[3]); w.z = cvt_pk_bf16(h[4], h[5]); w.w = cvt_pk_bf16(h[6], h[7]);
                        *(u32x4*)(bdst + off + bj * 128) = w;
                    }
                }
            }
    }
};


struct SmallResid {
    const float* xin; float* xout; bf16_t* ax; const float* gnext; float* ssout; float scale;
    __device__ __forceinline__ void apply(const f32x4& acc, int grow, int c, int cn, int c16, int r16, int fr, int fq, LAS unsigned char* lds) const {
        const size_t off = (size_t)grow * DM + c;
        const f32x4 x = *(const f32x4*)(xin + off);
        const f32x4 v = x + acc * scale;
        *(f32x4*)(xout + off) = v;
        float sq = (v[0] * v[0] + v[1] * v[1]) + (v[2] * v[2] + v[3] * v[3]);
        if (ax) { const f32x4 g = *(const f32x4*)(gnext + c); const f32x4 a = v * g; u32x2 w; w.x = cvt_pk_bf16(a[0], a[1]); w.y = cvt_pk_bf16(a[2], a[3]); *(u32x2*)(ax + off) = w; }
        sq += __shfl_xor(sq, 16); sq += __shfl_xor(sq, 32);
        LAS float* P = (LAS float*)lds;
        if (fq == 0) P[(r16 * 16 + fr) * 4 + c16] = sq;
        __syncthreads();
        if (c16 == 0 && fq == 0) { const LAS float* q = P + (r16 * 16 + fr) * 4; ssout[(size_t)grow * 16 + cn] = (q[0] + q[1]) + (q[2] + q[3]); }
        __syncthreads();
    }
};
struct SmallProj {
    bf16_t *Q, *V, *SG, *GY; float *FZ, *XB; const float* ss;
    __device__ __forceinline__ void apply(const f32x4& acc, int grow, int c, int cn, int c16, int r16, int fr, int fq, LAS unsigned char* lds) const {
        const int seg = cn >> 3, cs = c & 511;
        const float rs = rowscale(ss, grow);
        const f32x4 v = acc * rs;
        const size_t off = (size_t)grow * DH + cs;
        if (seg == 1 || seg == 4) { *(f32x4*)(((seg == 1) ? FZ : XB) + off) = v; }
        else {
            float h[4] = {v[0], v[1], v[2], v[3]};
            if (seg == 0) {
#pragma unroll
                for (int j = 0; j < 4; ++j) h[j] = h[j] * sigm(h[j]);
            } else if (seg == 3) {
#pragma unroll
                for (int j = 0; j < 4; ++j) h[j] = sigm(h[j]);
            } else if (seg == 5) {
#pragma unroll
                for (int j = 0; j < 4; ++j) { const float y = h[j]; h[j] = y * sigm(1.5957691216f * (y + 0.044715f * y * y * y)); }
            }
            bf16_t* bdst = (seg == 0) ? Q : (seg == 2) ? V : (seg == 3) ? SG : GY;
            u32x2 w; w.x = cvt_pk_bf16(h[0], h[1]); w.y = cvt_pk_bf16(h[2], h[3]);
            *(u32x2*)(bdst + off) = w;
        }
    }
};
template <class Epi, int K>
__device__ __forceinline__ void small_gemm(const bf16_t* A, const bf16_t* Bt, int N, const Epi& E, LAS unsigned char* lds) {
    const int tid = threadIdx.x, lane = tid & 63, wave = tid >> 6, fr = lane & 15, fq = lane >> 4, r16 = wave >> 2, c16 = wave & 3;
    constexpr int KW = K / 8, NS = KW / 32;
    const int nunits = 16 * (N / 64), G = gridDim.x;
    LAS f32x4* PB = (LAS f32x4*)lds;
    for (int u = G - 1 - (int)blockIdx.x; u < nunits; u += G) {
        const int rm = u & 15, cn = u >> 4;
        const bf16_t* ap = A + (size_t)(TP + rm * 32 + fr) * K + wave * KW + fq * 8;
        const bf16_t* bp = Bt + (size_t)(cn * 64 + fr) * K + wave * KW + fq * 8;
        f32x4 acc[2][4];
#pragma unroll
        for (int rr = 0; rr < 2; ++rr)
#pragma unroll
            for (int cc = 0; cc < 4; ++cc) acc[rr][cc] = (f32x4){0.f, 0.f, 0.f, 0.f};
#pragma unroll
        for (int s0 = 0; s0 < NS; s0 += 4) {
            bf16x8 a[4][2], b[4][4];
#pragma unroll
            for (int i = 0; i < 4; ++i) if (s0 + i < NS) {
#pragma unroll
                for (int rr = 0; rr < 2; ++rr) a[i][rr] = *(const bf16x8*)(ap + (size_t)rr * 16 * K + (s0 + i) * 32);
#pragma unroll
                for (int cc = 0; cc < 4; ++cc) b[i][cc] = *(const bf16x8*)(bp + (size_t)cc * 16 * K + (s0 + i) * 32);
            }
#pragma unroll
            for (int i = 0; i < 4; ++i) if (s0 + i < NS) {
#pragma unroll
                for (int rr = 0; rr < 2; ++rr)
#pragma unroll
                    for (int cc = 0; cc < 4; ++cc) acc[rr][cc] = __builtin_amdgcn_mfma_f32_16x16x32_bf16(b[i][cc], a[i][rr], acc[rr][cc], 0, 0, 0);
            }
        }
#pragma unroll
        for (int rr = 0; rr < 2; ++rr)
#pragma unroll
            for (int cc = 0; cc < 4; ++cc) PB[(wave * 8 + rr * 4 + cc) * 64 + lane] = acc[rr][cc];
        __syncthreads();
        f32x4 r = PB[(0 * 8 + wave) * 64 + lane];
#pragma unroll
        for (int w = 1; w < 8; ++w) r += PB[(w * 8 + wave) * 64 + lane];
        E.apply(r, TP + rm * 32 + r16 * 16 + fr, cn * 64 + c16 * 16 + 4 * fq, cn, c16, r16, fr, fq, lds + 65536);
        __syncthreads();
    }
}

#define XB_TMO      128
#define XB_XCNT(j)  (256  + 64 * (j))
#define XB_XSUB(j)  (1280 + 64 * (j))
#define XB_XGEN(j)  (2304 + 64 * (j))
#define XB_TOP      3328
#define XB_TOPGEN   3392
#define XCD_BAR_WORDS 3456
#define XB_SPIN_CAP (1u << 22)
__device__ __forceinline__ unsigned xb_ld(unsigned* p)              { return __hip_atomic_load(p, __ATOMIC_RELAXED, __HIP_MEMORY_SCOPE_AGENT); }
__device__ __forceinline__ unsigned xb_add(unsigned* p, unsigned v) { return __hip_atomic_fetch_add(p, v, __ATOMIC_RELAXED, __HIP_MEMORY_SCOPE_AGENT); }
__device__ __forceinline__ unsigned xb_xcc_id() { return (unsigned)__builtin_amdgcn_s_getreg((3 << 11) | 20) & 0xFu; }
#define XB_SPIN(cond, bar) do { unsigned _sp = 0; while (cond) { __builtin_amdgcn_s_sleep(1); \
    if ((++_sp & 255u) == 0u) { if (xb_ld(&(bar)[XB_TMO])) break; if (_sp > XB_SPIN_CAP) { atomicAdd(&(bar)[XB_TMO], 1u); break; } } } } while (0)
struct XcdBarrier { unsigned* bar; unsigned x; volatile LAS unsigned* st; };
__device__ __forceinline__ XcdBarrier xcd_barrier_post(unsigned* bar, volatile LAS unsigned* st) {
    XcdBarrier b; b.bar = bar; b.x = xb_xcc_id(); b.st = st;
    if (threadIdx.x == 0) (void)xb_add(&bar[XB_XCNT(b.x)], 1u);
    return b;
}
__device__ __forceinline__ void xcd_barrier_complete(unsigned* bar, unsigned x, unsigned& nloc, unsigned& nx) {
    const unsigned G = gridDim.x * gridDim.y * gridDim.z;
    unsigned sum, cnt, mine, sp = 0u;
    for (;;) {
        sum = 0u; cnt = 0u; mine = 0u;
#pragma unroll
        for (unsigned j = 0; j < 16; ++j) { const unsigned c = xb_ld(&bar[XB_XCNT(j)]); sum += c; cnt += (c > 0u) ? 1u : 0u; mine = (j == x) ? c : mine; }
        if (sum == G) break;
        __builtin_amdgcn_s_sleep(1);
        if ((++sp & 255u) == 0u) { if (xb_ld(&bar[XB_TMO])) break; if (sp > XB_SPIN_CAP) { atomicAdd(&bar[XB_TMO], 1u); break; } }
    }
    nloc = mine > 0u ? mine : 1u; nx = cnt > 0u ? cnt : 1u;
}
__device__ __forceinline__ void xcd_barrier(const XcdBarrier& b) {
    asm volatile("s_waitcnt vmcnt(0) lgkmcnt(0)" ::: "memory");
    __syncthreads();
    if (threadIdx.x == 0) {
        unsigned* bar = b.bar;
        __builtin_amdgcn_s_waitcnt(0);
        unsigned nloc = b.st[0], nx = b.st[1];
        if (nloc == 0u) { xcd_barrier_complete(bar, b.x, nloc, nx); b.st[0] = nloc; b.st[1] = nx; }
        const unsigned old = xb_add(&bar[XB_XSUB(b.x)], 1u);
        const unsigned gen = old / nloc;
        if (old + 1u == (gen + 1u) * nloc) {
            __builtin_amdgcn_fence(__ATOMIC_RELEASE, "agent");
            asm volatile("s_waitcnt vmcnt(0)" ::: "memory");
            const unsigned og = xb_add(&bar[XB_TOP], 1u);
            const unsigned tg = og / nx;
            if (og + 1u == (tg + 1u) * nx) xb_add(&bar[XB_TOPGEN], 1u);
            else XB_SPIN(xb_ld(&bar[XB_TOPGEN]) == tg, bar);
            __builtin_amdgcn_fence(__ATOMIC_ACQUIRE, "agent");
            xb_add(&bar[XB_XGEN(b.x)], 1u);
            asm volatile("s_waitcnt vmcnt(0)" ::: "memory");
        } else {
            XB_SPIN(xb_ld(&bar[XB_XGEN(b.x)]) == gen, bar);
            __builtin_amdgcn_fence(__ATOMIC_ACQUIRE, "agent");
            asm volatile("s_waitcnt vmcnt(0)" ::: "memory");
        }
    }
    __syncthreads();
}

struct Params { const float* in[26]; float* out; unsigned char* ws; int ph_lo, ph_hi; };

__device__ __forceinline__ void transpose_item(const float* W, int K, int N, bf16_t* WT, int dst_row0, LAS float* scr, int k0, int n0, int lane) {
    float wv[32];
#pragma unroll
    for (int i = 0; i < 32; ++i) wv[i] = W[(size_t)(k0 + 2 * i + (lane >> 5)) * N + n0 + (lane & 31)];
#pragma unroll
    for (int i = 0; i < 32; ++i) scr[(2 * i + (lane >> 5)) * 33 + (lane & 31)] = wv[i];
    LDS_WAIT();
    const int c = lane & 7;
#pragma unroll
    for (int j = 0; j < 4; ++j) { const int n = (lane >> 3) + 8 * j; const LAS float* s = scr + (8 * c) * 33 + n;
        u32x4 o; o.x = cvt_pk_bf16(s[0 * 33], s[1 * 33]); o.y = cvt_pk_bf16(s[2 * 33], s[3 * 33]); o.z = cvt_pk_bf16(s[4 * 33], s[5 * 33]); o.w = cvt_pk_bf16(s[6 * 33], s[7 * 33]);
        *(u32x4*)(WT + (size_t)(dst_row0 + n) * K + k0 + 8 * c) = o; }
    LDS_WAIT();
}
__device__ __forceinline__ void transpose_mat(const float* W, int K, int N, bf16_t* WT, int mode, LAS float* scr, int item, int lane) {
    const int nblk = N / 32, kb = item / nblk, nb = item % nblk, n0 = 32 * nb;
    const int dst = (mode == 0) ? n0 : (256 * (n0 >> 7) + (n0 & 127) + (mode == 2 ? 128 : 0));
    transpose_item(W, K, N, WT, dst, scr, 64 * kb, n0, lane);
}

__device__ __forceinline__ void phase0(const Params& p, LAS unsigned char* lds) {
    const int tid = threadIdx.x, lane = tid & 63, wave = tid >> 6;
    const int G = gridDim.x, gw = blockIdx.x * 8 + wave, NGW = G * 8;
    unsigned char* ws = p.ws;
    LAS float* scr = (LAS float*)(lds + wave * 16384);
    constexpr int I_GU = 16 * 88, I_D = 44 * 32, I_IN = 16 * 96, I_O = 16 * 32;
    constexpr int NIT = 4 * I_GU + 2 * I_D + I_IN + I_O;
    for (int it = gw; it < NIT; it += NGW) {
        int r = it;
        if (r < I_GU) { transpose_mat(p.in[6], 1024, 2816, (bf16_t*)(ws + WS_WG1), 1, scr, r, lane); continue; } r -= I_GU;
        if (r < I_GU) { transpose_mat(p.in[7], 1024, 2816, (bf16_t*)(ws + WS_WG1), 2, scr, r, lane); continue; } r -= I_GU;
        if (r < I_D)  { transpose_mat(p.in[8], 2816, 1024, (bf16_t*)(ws + WS_WD1), 0, scr, r, lane); continue; } r -= I_D;
        if (r < I_IN) { transpose_mat(p.in[10], 1024, 3072, (bf16_t*)(ws + WS_WIN), 0, scr, r, lane); continue; } r -= I_IN;
        if (r < I_O)  { transpose_mat(p.in[20], 1024, 1024, (bf16_t*)(ws + WS_WO), 0, scr, r, lane); continue; } r -= I_O;
        if (r < I_GU) { transpose_mat(p.in[22], 1024, 2816, (bf16_t*)(ws + WS_WG2), 1, scr, r, lane); continue; } r -= I_GU;
        if (r < I_GU) { transpose_mat(p.in[23], 1024, 2816, (bf16_t*)(ws + WS_WG2), 2, scr, r, lane); continue; } r -= I_GU;
        transpose_mat(p.in[24], 2816, 1024, (bf16_t*)(ws + WS_WD2), 0, scr, r, lane);
    }
    for (int e = blockIdx.x * 512 + tid; e < 2 * 32768; e += G * 512) {
        const int which = e >> 15, r = e & 32767, n = r >> 12, j = (r >> 6) & 63, i = r & 63;
        const float* W = which ? p.in[17] : p.in[15];
        bf16_t* WT = (bf16_t*)(ws + (which ? WS_WXT : WS_WAT));
        WT[r] = f2bf(W[(n * 64 + i) * 64 + j]);
    }
    bf16_t* A1 = (bf16_t*)(ws + WS_B0); float* SS0 = (float*)(ws + WS_SS0);
    const float* g1 = p.in[5];
    f32x4 gv[4];
#pragma unroll
    for (int j = 0; j < 4; ++j) gv[j] = ((const f32x4*)g1)[lane + 64 * j];
    for (int row0 = gw; row0 < T_ALL; row0 += 3 * NGW) {
        f32x4 v[3][4];
#pragma unroll
        for (int r = 0; r < 3; ++r) { const int row = row0 + r * NGW; if (row < T_ALL) {
            const float* xr = (row < TP) ? p.in[0] + (size_t)row * DM : p.in[1] + (size_t)(row - TP) * DM;
#pragma unroll
            for (int j = 0; j < 4; ++j) v[r][j] = ((const f32x4*)xr)[lane + 64 * j]; } }
#pragma unroll
        for (int r = 0; r < 3; ++r) { const int row = row0 + r * NGW; if (row < T_ALL) {
            float s = 0.f;
#pragma unroll
            for (int j = 0; j < 4; ++j) s += (v[r][j].x * v[r][j].x + v[r][j].y * v[r][j].y) + (v[r][j].z * v[r][j].z + v[r][j].w * v[r][j].w);
            s = wave_sum(s);
            u32x2* o8 = (u32x2*)(A1 + (size_t)row * DM);
#pragma unroll
            for (int j = 0; j < 4; ++j) { const f32x4 a = v[r][j] * gv[j]; u32x2 w; w.x = cvt_pk_bf16(a.x, a.y); w.y = cvt_pk_bf16(a.z, a.w); o8[lane + 64 * j] = w; }
            if (lane < 16) SS0[(size_t)row * 16 + lane] = (lane == 0) ? s : 0.f; } }
    }
}

__device__ __forceinline__ void phase_final(const Params& p) {
    const int tid = threadIdx.x, lane = tid & 63, wave = tid >> 6;
    const int gw = blockIdx.x * 8 + wave, NGW = gridDim.x * 8;
    const float* SS3 = (const float*)(p.ws + WS_SS3); const float* gf = p.in[25];
    f32x4 gv[4];
#pragma unroll
    for (int j = 0; j < 4; ++j) gv[j] = ((const f32x4*)gf)[lane + 64 * j];
    for (int row0 = gw; row0 < T_ALL; row0 += 3 * NGW) {
        f32x4 v[3][4]; float rs[3];
#pragma unroll
        for (int r = 0; r < 3; ++r) { const int row = row0 + r * NGW; if (row < T_ALL) {
            rs[r] = rowscale(SS3, row);
            const f32x4* xr = (const f32x4*)(p.out + (size_t)row * DM);
#pragma unroll
            for (int j = 0; j < 4; ++j) v[r][j] = xr[lane + 64 * j]; } }
#pragma unroll
        for (int r = 0; r < 3; ++r) { const int row = row0 + r * NGW; if (row < T_ALL) {
            f32x4* xr = (f32x4*)(p.out + (size_t)row * DM);
#pragma unroll
            for (int j = 0; j < 4; ++j) xr[lane + 64 * j] = v[r][j] * rs[r] * gv[j]; } }
    }
}

struct Mix {
    const bf16_t *Q, *V, *SG, *GY; const float *FZ, *XB; bf16_t* LT; float* DC; float *ACH, *UCH, *HST; bf16_t* O;
    const bf16_t *WAT, *WXT;
    const float *lb, *hnorm, *convw, *convb, *ba, *bx, *lam, *wa, *wx, *st_h, *st_l, *st_c;
    float* out;
};

struct HgrnScan { float cum[16]; float kk[16]; float last; };
__device__ __forceinline__ void hgrn_scan(const float (&fzv)[16], float lb, int k, int seg, LAS float* tot, HgrnScan& hs) {
    float run = 0.f;
#pragma unroll
    for (int i = 0; i < 16; ++i) {
        const float e = __expf(-fmaxf(fzv[i], -80.f));
        const float sg = __builtin_amdgcn_rcpf(1.f + e), sn = e * sg;
        const float f = lb + (1.f - lb) * sg;
        run += __logf(f); hs.cum[i] = run; hs.kk[i] = (1.f - lb) * sn;
    }
    tot[seg * 128 + k] = run;
    __syncthreads();
    float off = 0.f, all = 0.f;
#pragma unroll
    for (int s = 0; s < 4; ++s) { const float v = tot[s * 128 + k]; if (s < seg) off += v; all += v; }
#pragma unroll
    for (int i = 0; i < 16; ++i) hs.cum[i] += off;
    hs.last = all;
}

struct HgIn { float fzv[16]; unsigned vv[16]; unsigned qv[16]; bf16x8 bs[4]; u32x2 sgv[4]; };
template <int MODE>
__device__ __forceinline__ void hg_load(const Mix& M, int unit, HgIn& in) {
    const int tid = threadIdx.x, lane = tid & 63, wave = tid >> 6, fr = lane & 15, fq = lane >> 4;
    const int h = unit & 3, bc = unit >> 2, t0 = bc * 64, cb = h * 128, k = tid & 127, seg = tid >> 7;
    const size_t rb = (size_t)(t0 + seg * 16) * DH + cb + k;
#pragma unroll
    for (int i = 0; i < 16; ++i) { in.fzv[i] = M.FZ[rb + (size_t)i * DH]; in.vv[i] = M.V[rb + (size_t)i * DH]; if (MODE == 1) in.qv[i] = M.Q[rb + (size_t)i * DH]; }
    if (MODE == 1) {
#pragma unroll
        for (int ks = 0; ks < 4; ++ks) in.bs[ks] = *(const bf16x8*)(M.LT + ((size_t)unit * 128 + 16 * wave + fr) * 128 + ks * 32 + fq * 8);
#pragma unroll
        for (int tr = 0; tr < 4; ++tr) in.sgv[tr] = *(const u32x2*)(M.SG + (size_t)(t0 + 16 * tr + fr) * DH + cb + 16 * wave + 4 * fq);
    }
}
template <int MODE>
__device__ __forceinline__ void hgrn_loop(const Mix& M, LAS unsigned char* lds) {
    const int tid = threadIdx.x, lane = tid & 63, wave = tid >> 6, fr = lane & 15, fq = lane >> 4, G = gridDim.x;
    const int k = tid & 127, seg = tid >> 7;
    int unit = blockIdx.x; if (unit >= 1024) return;
    int hcache = -1; float lb = 0.f; f32x4 gn = {0.f, 0.f, 0.f, 0.f};
    HgIn cur; hg_load<MODE>(M, unit, cur);
    for (;;) {
        const int un = unit + G; const bool has = un < 1024;
        HgIn nxt; if (has) hg_load<MODE>(M, un, nxt);
        const int h = unit & 3, bc = unit >> 2, t0 = bc * 64, cb = h * 128;
        if (h != hcache) { hcache = h; const float l0 = M.lb[cb + k], l1 = M.lb[512 + cb + k]; lb = __builtin_amdgcn_rcpf(1.f + __expf(l1 - l0)); gn = *(const f32x4*)(M.hnorm + cb + 16 * wave + 4 * fq); }
        if (MODE == 0) {
            LAS bf16_t* KT = (LAS bf16_t*)lds; LAS bf16_t* VT = (LAS bf16_t*)(lds + 18432); LAS float* tot = (LAS float*)(lds + 36864);
            HgrnScan hs; hgrn_scan(cur.fzv, lb, k, seg, tot, hs);
            unsigned pk[8];
#pragma unroll
            for (int i = 0; i < 8; ++i) pk[i] = cvt_pk_bf16(hs.kk[2 * i] * __expf(hs.last - hs.cum[2 * i]), hs.kk[2 * i + 1] * __expf(hs.last - hs.cum[2 * i + 1]));
            *(LAS u32x4*)(KT + k * 72 + seg * 16) = (u32x4){pk[0], pk[1], pk[2], pk[3]};
            *(LAS u32x4*)(KT + k * 72 + seg * 16 + 8) = (u32x4){pk[4], pk[5], pk[6], pk[7]};
            const unsigned* vv = cur.vv;
            *(LAS u32x4*)(VT + k * 72 + seg * 16) = (u32x4){vv[0] | (vv[1] << 16), vv[2] | (vv[3] << 16), vv[4] | (vv[5] << 16), vv[6] | (vv[7] << 16)};
            *(LAS u32x4*)(VT + k * 72 + seg * 16 + 8) = (u32x4){vv[8] | (vv[9] << 16), vv[10] | (vv[11] << 16), vv[12] | (vv[13] << 16), vv[14] | (vv[15] << 16)};
            if (seg == 0) M.DC[unit * 128 + k] = __expf(hs.last);
            __syncthreads();
            const bf16x8 a0 = *(const LAS bf16x8*)(VT + (16 * wave + fr) * 72 + fq * 8), a1 = *(const LAS bf16x8*)(VT + (16 * wave + fr) * 72 + 32 + fq * 8);
#pragma unroll
            for (int ct = 0; ct < 8; ++ct) {
                const bf16x8 b0 = *(const LAS bf16x8*)(KT + (16 * ct + fr) * 72 + fq * 8), b1 = *(const LAS bf16x8*)(KT + (16 * ct + fr) * 72 + 32 + fq * 8);
                f32x4 acc = {0.f, 0.f, 0.f, 0.f};
                acc = __builtin_amdgcn_mfma_f32_16x16x32_bf16(b0, a0, acc, 0, 0, 0);
                acc = __builtin_amdgcn_mfma_f32_16x16x32_bf16(b1, a1, acc, 0, 0, 0);
                u32x2 w; w.x = cvt_pk_bf16(acc[0], acc[1]); w.y = cvt_pk_bf16(acc[2], acc[3]);
                *(u32x2*)(M.LT + ((size_t)unit * 128 + 16 * wave + fr) * 128 + 16 * ct + 4 * fq) = w;
            }
            __syncthreads();
        } else {
            LAS bf16_t* QS = (LAS bf16_t*)lds; LAS bf16_t* KS = (LAS bf16_t*)(lds + 17408); LAS bf16_t* VT = (LAS bf16_t*)(lds + 34816);
            LAS bf16_t* PS = (LAS bf16_t*)(lds + 53248); LAS float* tot = (LAS float*)(lds + 62464); LAS float* RS = (LAS float*)(lds + 64512);
            HgrnScan hs; hgrn_scan(cur.fzv, lb, k, seg, tot, hs);
#pragma unroll
            for (int i = 0; i < 16; ++i) {
                const float q = __uint_as_float(cur.qv[i] << 16);
                QS[(seg * 16 + i) * 136 + k] = f2bf(q * __expf(hs.cum[i]));
                KS[(seg * 16 + i) * 136 + k] = f2bf(hs.kk[i] * __expf(-hs.cum[i]));
            }
            const unsigned* vv = cur.vv;
            *(LAS u32x4*)(VT + k * 72 + seg * 16) = (u32x4){vv[0] | (vv[1] << 16), vv[2] | (vv[3] << 16), vv[4] | (vv[5] << 16), vv[6] | (vv[7] << 16)};
            *(LAS u32x4*)(VT + k * 72 + seg * 16 + 8) = (u32x4){vv[8] | (vv[9] << 16), vv[10] | (vv[11] << 16), vv[12] | (vv[13] << 16), vv[14] | (vv[15] << 16)};
            __syncthreads();
#pragma unroll
            for (int r = 0; r < 2; ++r) {
                const int idx = wave + 8 * r, tr = idx >> 2, tc = idx & 3;
                f32x4 acc = {0.f, 0.f, 0.f, 0.f};
                if (tc <= tr) {
#pragma unroll
                    for (int ks = 0; ks < 4; ++ks) {
                        const bf16x8 a = *(const LAS bf16x8*)(QS + (16 * tr + fr) * 136 + ks * 32 + fq * 8), b = *(const LAS bf16x8*)(KS + (16 * tc + fr) * 136 + ks * 32 + fq * 8);
                        acc = __builtin_amdgcn_mfma_f32_16x16x32_bf16(b, a, acc, 0, 0, 0);
                    }
#pragma unroll
                    for (int j = 0; j < 4; ++j) if (16 * tc + 4 * fq + j > 16 * tr + fr) acc[j] = 0.f;
                }
                u32x2 w; w.x = cvt_pk_bf16(acc[0], acc[1]); w.y = cvt_pk_bf16(acc[2], acc[3]);
                *(LAS u32x2*)(PS + (16 * tr + fr) * 72 + 16 * tc + 4 * fq) = w;
            }
            __syncthreads();
            bf16x8 bv[2];
#pragma unroll
            for (int ks = 0; ks < 2; ++ks) bv[ks] = *(const LAS bf16x8*)(VT + (16 * wave + fr) * 72 + ks * 32 + fq * 8);
            f32x4 o[4];
#pragma unroll
            for (int tr = 0; tr < 4; ++tr) {
                f32x4 acc = {0.f, 0.f, 0.f, 0.f};
#pragma unroll
                for (int ks = 0; ks < 2; ++ks) { const bf16x8 a = *(const LAS bf16x8*)(PS + (16 * tr + fr) * 72 + ks * 32 + fq * 8); acc = __builtin_amdgcn_mfma_f32_16x16x32_bf16(bv[ks], a, acc, 0, 0, 0); }
#pragma unroll
                for (int ks = 0; ks < 4; ++ks) { const bf16x8 a = *(const LAS bf16x8*)(QS + (16 * tr + fr) * 136 + ks * 32 + fq * 8); acc = __builtin_amdgcn_mfma_f32_16x16x32_bf16(cur.bs[ks], a, acc, 0, 0, 0); }
                o[tr] = acc;
                float ss = (acc[0] * acc[0] + acc[1] * acc[1]) + (acc[2] * acc[2] + acc[3] * acc[3]);
                ss += __shfl_xor(ss, 16); ss += __shfl_xor(ss, 32);
                if (fq == 0) RS[wave * 64 + 16 * tr + fr] = ss;
            }
            __syncthreads();
            const int ocol = cb + 16 * wave + 4 * fq;
#pragma unroll
            for (int tr = 0; tr < 4; ++tr) {
                const int tl = 16 * tr + fr; float tt = 0.f;
#pragma unroll
                for (int w = 0; w < 8; ++w) tt += RS[w * 64 + tl];
                const float rinv = rsqrtf(tt * (1.f / 128.f) + EPS);
                const u32x2 sg = cur.sgv[tr];
                u32x2 w;
                w.x = cvt_pk_bf16(o[tr][0] * rinv * gn[0] * bflo(sg.x), o[tr][1] * rinv * gn[1] * bfhi(sg.x));
                w.y = cvt_pk_bf16(o[tr][2] * rinv * gn[2] * bflo(sg.y), o[tr][3] * rinv * gn[3] * bfhi(sg.y));
                *(u32x2*)(M.O + (size_t)(t0 + tl) * DM + ocol) = w;
            }
            __syncthreads();
        }
        if (!has) break;
        cur = nxt; unit = un;
    }
}

struct LruIn { float xm3, xm2, xm1; float xr[8]; unsigned gyv[8]; float hin; float cpv; };
__device__ __forceinline__ void lru_load(const Mix& M, int unit, int mode, LruIn& in) {
    const int tid = threadIdx.x, j = tid & 63, seg = tid >> 6;
    const int n = unit & 7, bc = unit >> 3, c = bc & 31, b = bc >> 5, t0 = bc * 64, ch0 = n * 64, ch = ch0 + j, tl0 = seg * 8;
    const bool first = (c == 0 && seg == 0);
    const float* xp = M.XB + (size_t)(t0 + tl0) * DH + ch;
    in.xm3 = first ? 0.f : xp[-3 * DH]; in.xm2 = first ? 0.f : xp[-2 * DH]; in.xm1 = first ? 0.f : xp[-1 * DH];
#pragma unroll
    for (int i = 0; i < 8; ++i) in.xr[i] = xp[i * DH];
    in.hin = (mode == 1) ? M.HST[(size_t)bc * 512 + ch] : 0.f;
#pragma unroll
    for (int i = 0; i < 8; ++i) in.gyv[i] = (mode == 1) ? (unsigned)M.GY[(size_t)(t0 + tl0 + i) * DH + ch] : 0u;
    in.cpv = (mode == 1 && c == 31 && tid < 192) ? M.XB[(size_t)(b * SEQ + SEQ - 3 + (tid >> 6)) * DH + ch0 + j] : 0.f;
}
__device__ __forceinline__ void lru_loop(const Mix& M, int mode, LAS unsigned char* lds) {
    const int tid = threadIdx.x, lane = tid & 63, wave = tid >> 6, fr = lane & 15, fq = lane >> 4, G = gridDim.x;
    const int j = tid & 63, seg = tid >> 6, tl0 = seg * 8;
    LAS bf16_t* XC16 = (LAS bf16_t*)(lds + 16640); LAS float* GR = (LAS float*)(lds + 25856); LAS float* GI = (LAS float*)(lds + 42496);
    LAS float* SEGA = (LAS float*)(lds + 59136); LAS float* SEGU = (LAS float*)(lds + 61184);
    int unit = blockIdx.x; if (unit >= 2048) return;
    const int gate = wave >> 2, tr = wave & 3;
    int ncache = -1; float w0 = 0.f, w1 = 0.f, w2 = 0.f, w3 = 0.f, cbias = 0.f, sp = 0.f; bf16x8 wb[4][2]; float bbv[4];
    LruIn cur; lru_load(M, unit, mode, cur);
    for (;;) {
        const int un = unit + G; const bool has = un < 2048;
        LruIn nxt; if (has) lru_load(M, un, mode, nxt);
        const int n = unit & 7, bc = unit >> 3, c = bc & 31, b = bc >> 5, t0 = bc * 64, ch0 = n * 64, ch = ch0 + j;
        if (n != ncache) {
            ncache = n;
            w0 = M.convw[ch]; w1 = M.convw[512 + ch]; w2 = M.convw[1024 + ch]; w3 = M.convw[1536 + ch]; cbias = M.convb[ch];
            const bf16_t* WT = (gate ? M.WXT : M.WAT) + n * 4096; const float* bias = (gate ? M.bx : M.ba) + ch0;
#pragma unroll
            for (int ct = 0; ct < 4; ++ct) { wb[ct][0] = *(const bf16x8*)(WT + (16 * ct + fr) * 64 + fq * 8); wb[ct][1] = *(const bf16x8*)(WT + (16 * ct + fr) * 64 + 32 + fq * 8); bbv[ct] = bias[16 * ct + fr]; }
            sp = log1pf(__expf(-M.lam[ch]));
        }
        float xm3 = cur.xm3, xm2 = cur.xm2, xm1 = cur.xm1; float xcv[8];
#pragma unroll
        for (int i = 0; i < 8; ++i) {
            const float x = cur.xr[i];
            const float xc = cbias + w0 * xm3 + w1 * xm2 + w2 * xm1 + w3 * x;
            xcv[i] = xc; XC16[(tl0 + i) * 72 + j] = f2bf(xc);
            xm3 = xm2; xm2 = xm1; xm1 = x;
        }
        __syncthreads();
        {
            LAS float* Gd = gate ? GI : GR;
            const bf16x8 a0 = *(const LAS bf16x8*)(XC16 + (16 * tr + fr) * 72 + fq * 8), a1 = *(const LAS bf16x8*)(XC16 + (16 * tr + fr) * 72 + 32 + fq * 8);
#pragma unroll
            for (int ct = 0; ct < 4; ++ct) {
                f32x4 acc = {0.f, 0.f, 0.f, 0.f};
                acc = __builtin_amdgcn_mfma_f32_16x16x32_bf16(a0, wb[ct][0], acc, 0, 0, 0);
                acc = __builtin_amdgcn_mfma_f32_16x16x32_bf16(a1, wb[ct][1], acc, 0, 0, 0);
#pragma unroll
                for (int jj = 0; jj < 4; ++jj) Gd[(16 * tr + 4 * fq + jj) * 65 + 16 * ct + fr] = sigm(acc[jj] + bbv[ct]);
            }
        }
        __syncthreads();
        float av[8], uv[8]; float A = 1.f, U = 0.f;
#pragma unroll
        for (int i = 0; i < 8; ++i) {
            const int tl = tl0 + i; const float r = GR[tl * 65 + j], ig = GI[tl * 65 + j];
            const float la = -8.f * r * sp, a = __expf(la);
            const float x = 2.f * la;
            float pe = 1.f / 5040.f; pe = pe * x + 1.f / 720.f; pe = pe * x + 1.f / 120.f; pe = pe * x + 1.f / 24.f; pe = pe * x + 1.f / 6.f; pe = pe * x + 0.5f; pe = pe * x + 1.f; pe = -pe * x;
            const float om = (x > -0.35f) ? pe : (1.f - a * a);
            float mult = __builtin_amdgcn_sqrtf(fmaxf(om, 0.f));
            if (c == 0 && tl == 0) mult = 1.f;
            const float u = mult * ig * xcv[i];
            av[i] = a; uv[i] = u; U = a * U + u; A *= a;
        }
        SEGA[seg * 64 + j] = A; SEGU[seg * 64 + j] = U;
        __syncthreads();
        float hin = cur.hin;
#pragma unroll
        for (int s = 0; s < 8; ++s) if (s < seg) hin = SEGA[s * 64 + j] * hin + SEGU[s * 64 + j];
        if (mode == 0) {
            if (seg == 7) { float At = 1.f;
#pragma unroll
                for (int s = 0; s < 8; ++s) At *= SEGA[s * 64 + j];
                M.ACH[(size_t)bc * 512 + ch] = At; M.UCH[(size_t)bc * 512 + ch] = A * hin + U; }
        } else {
            float hh = hin;
#pragma unroll
            for (int i = 0; i < 8; ++i) {
                hh = av[i] * hh + uv[i];
                M.O[(size_t)(t0 + tl0 + i) * DM + 512 + ch] = f2bf(hh * __uint_as_float(cur.gyv[i] << 16));
            }
            if (c == 31 && seg == 7) M.out[OUT_LP + b * 512 + ch] = hh;
            if (c == 31 && tid < 192) M.out[OUT_CP + (size_t)(b * 3 + (tid >> 6)) * 512 + ch0 + j] = cur.cpv;
        }
        __syncthreads();
        if (!has) break;
        cur = nxt; unit = un;
    }
}

__device__ __forceinline__ void hgrn_sample_unit(const Mix& M, int unit, LAS unsigned char* lds) {
    const int tid = threadIdx.x, lane = tid & 63, wave = tid >> 6;
    const int h = unit & 3, b = unit >> 2, cb = h * 128, tb = TP + b * 4;
    LAS float* SQ = (LAS float*)lds;
    LAS float* SK = SQ + 512;
    LAS float* SD = SK + 512;
    LAS float* SP = SD + 128;
    LAS float* OP = SP + 32;
    LAS float* RS = OP + 2048;
    const int v = tid & 127, kq = tid >> 7;
    const size_t sb = ((size_t)(b * 4 + h) * 128) * 128;
    float s0v[32];
#pragma unroll
    for (int kx = 0; kx < 32; ++kx) s0v[kx] = M.st_h[sb + (size_t)(kq * 32 + kx) * 128 + v];
    float vv[4];
#pragma unroll
    for (int s = 0; s < 4; ++s) vv[s] = bf2f(M.V[(size_t)(tb + s) * DH + cb + v]);
    const float sgo = bf2f(M.SG[(size_t)(tb + kq) * DH + cb + v]), hno = M.hnorm[cb + v];
    if (tid < 128) {
        const int k = tid;
        const float l0 = M.lb[cb + k], l1 = M.lb[512 + cb + k];
        const float lb = 1.f / (1.f + expf(l1 - l0));
        float cum[4], kk[4], qv[4]; float run = 0.f;
#pragma unroll
        for (int s = 0; s < 4; ++s) {
            const float fz = M.FZ[(size_t)(tb + s) * DH + cb + k];
            const float sg = 1.f / (1.f + expf(-fz)), sn = 1.f / (1.f + expf(fz));
            run += logf(lb + (1.f - lb) * sg); cum[s] = run; kk[s] = (1.f - lb) * sn;
            qv[s] = bf2f(M.Q[(size_t)(tb + s) * DH + cb + k]);
        }
#pragma unroll
        for (int s = 0; s < 4; ++s) { SQ[s * 128 + k] = qv[s] * expf(cum[s]); SK[s * 128 + k] = kk[s] * expf(cum[3] - cum[s]); }
        SD[k] = expf(cum[3]);
        float pr[10]; int c = 0;
#pragma unroll
        for (int t = 0; t < 4; ++t)
#pragma unroll
            for (int s = 0; s <= t; ++s) { pr[c] = qv[t] * kk[s] * expf(cum[t] - cum[s]); ++c; }
#pragma unroll
        for (int i = 0; i < 10; ++i) { const float v = wave_sum(pr[i]); if (lane == 0) SP[wave * 16 + i] = v; }
    }
    __syncthreads();
    {
        float o[4] = {0.f, 0.f, 0.f, 0.f};
#pragma unroll
        for (int kx = 0; kx < 32; ++kx) {
            const int k = kq * 32 + kx;
            const float s0 = s0v[kx];
            float sn = SD[k] * s0;
#pragma unroll
            for (int s = 0; s < 4; ++s) { o[s] += SQ[s * 128 + k] * s0; sn += SK[s * 128 + k] * vv[s]; }
            M.out[OUT_HS + sb + (size_t)k * 128 + v] = sn;
        }
#pragma unroll
        for (int s = 0; s < 4; ++s) OP[(kq * 4 + s) * 128 + v] = o[s];
    }
    __syncthreads();
    {
        const int t = kq;
        float ov = (OP[(0 * 4 + t) * 128 + v] + OP[(1 * 4 + t) * 128 + v]) + (OP[(2 * 4 + t) * 128 + v] + OP[(3 * 4 + t) * 128 + v]);
        const int base = t * (t + 1) / 2;
        for (int s = 0; s <= t; ++s) ov += (SP[base + s] + SP[16 + base + s]) * vv[s];
        const float ssq = wave_sum(ov * ov);
        if (lane == 0) RS[wave] = ssq;
        __syncthreads();
        const float tt = RS[2 * t] + RS[2 * t + 1];
        const float rinv = rsqrtf(tt * (1.f / 128.f) + EPS);
        const size_t tok = (size_t)(tb + t);
        M.O[tok * DM + cb + v] = f2bf(ov * rinv * hno * sgo);
    }
    __syncthreads();
}

__device__ __forceinline__ void lru_sample_unit(const Mix& M, int b, LAS unsigned char* lds) {
    const int tid = threadIdx.x, ch = tid, n = ch >> 6, j = ch & 63, tb = TP + b * 4;
    LAS float* XC = (LAS float*)lds;
    float x[7];
#pragma unroll
    for (int r = 0; r < 3; ++r) x[r] = M.st_c[(size_t)(b * 3 + r) * 512 + ch];
#pragma unroll
    for (int s = 0; s < 4; ++s) x[3 + s] = M.XB[(size_t)(tb + s) * DH + ch];
    const float w0 = M.convw[ch], w1 = M.convw[512 + ch], w2 = M.convw[1024 + ch], w3 = M.convw[1536 + ch], cbias = M.convb[ch];
    float xc[4];
#pragma unroll
    for (int s = 0; s < 4; ++s) { xc[s] = cbias + w0 * x[s] + w1 * x[s + 1] + w2 * x[s + 2] + w3 * x[s + 3]; XC[s * 512 + ch] = xc[s]; }
#pragma unroll
    for (int r = 0; r < 3; ++r) M.out[OUT_CS + (size_t)(b * 3 + r) * 512 + ch] = x[4 + r];
    __syncthreads();
    float ra[4], rx[4];
    const float ba = M.ba[ch], bx = M.bx[ch];
#pragma unroll
    for (int s = 0; s < 4; ++s) { ra[s] = ba; rx[s] = bx; }
    const float* wa = M.wa + (size_t)n * 4096 + j; const float* wx = M.wx + (size_t)n * 4096 + j;
#pragma unroll 16
    for (int i = 0; i < 64; ++i) {
        const float a = wa[i * 64], xw = wx[i * 64];
#pragma unroll
        for (int s = 0; s < 4; ++s) { const float xv = XC[s * 512 + n * 64 + i]; ra[s] += xv * a; rx[s] += xv * xw; }
    }
    const float sp = log1pf(expf(-M.lam[ch]));
    float hh = M.st_l[(size_t)b * 512 + ch];
#pragma unroll
    for (int s = 0; s < 4; ++s) {
        const float r = 1.f / (1.f + expf(-ra[s])), ig = 1.f / (1.f + expf(-rx[s]));
        const float la = -8.f * r * sp, a = expf(la), mult = sqrtf(-expm1f(2.f * la));
        hh = a * hh + mult * ig * xc[s];
        M.O[(size_t)(tb + s) * DM + 512 + ch] = f2bf(hh * bf2f(M.GY[(size_t)(tb + s) * DH + ch]));
    }
    M.out[OUT_LS + (size_t)b * 512 + ch] = hh;
    __syncthreads();
}

__device__ __forceinline__ void scan_item(const Mix& M, int item) {
    const int tid = threadIdx.x;
    if (item < 1024) {
        const int e = item * 512 + tid, bh = e >> 14, vk = e & 16383, b = bh >> 2, h = bh & 3, v = vk >> 7, k = vk & 127;
        float l[32], d[32];
#pragma unroll
        for (int c = 0; c < 32; ++c) { const int unit = (b * 32 + c) * 4 + h; l[c] = bf2f(M.LT[(size_t)unit * 16384 + vk]); d[c] = M.DC[unit * 128 + k]; }
        float S = 0.f;
#pragma unroll
        for (int c = 0; c < 32; ++c) { const int unit = (b * 32 + c) * 4 + h; M.LT[(size_t)unit * 16384 + vk] = f2bf(S); S = d[c] * S + l[c]; }
        M.out[OUT_HP + ((size_t)(b * 4 + h) * 128 + k) * 128 + v] = S;
    } else {
        const int e = (item - 1024) * 512 + tid, b = e >> 9, ch = e & 511;
        float hcar = 0.f;
        for (int c = 0; c < 32; ++c) { const size_t idx = (size_t)(b * 32 + c) * 512 + ch; M.HST[idx] = hcar; hcar = M.ACH[idx] * hcar + M.UCH[idx]; }
    }
}

__global__ void __launch_bounds__(512, 2) mk_fwd(Params p) {
    extern __shared__ __attribute__((aligned(16))) unsigned char lds_raw[];
    LAS unsigned char* lds = (LAS unsigned char*)lds_raw;
    const int lo = p.ph_lo, hi = p.ph_hi, G = gridDim.x;
    unsigned char* ws = p.ws;
#define IN(k) (lo <= (k) && (k) < hi)
    volatile LAS unsigned* xst = (volatile LAS unsigned*)(lds + 131072);
    if (threadIdx.x < 16) xst[threadIdx.x] = 0u;
    __syncthreads();
    XcdBarrier xbar; xbar.bar = (unsigned*)(ws + WS_BAR); xbar.x = 0; xbar.st = xst;
    if (hi - lo > 1) xbar = xcd_barrier_post((unsigned*)(ws + WS_BAR), xst);
    if (hi == 0x7fffffff) cg::this_grid().sync();
#define SEAM(k) do { if (IN(k) && IN((k) + 1)) { xcd_barrier(xbar); } } while (0)
    bf16_t* B0 = (bf16_t*)(ws + WS_B0); bf16_t* B1 = (bf16_t*)(ws + WS_B1); bf16_t* H = (bf16_t*)(ws + WS_H);
    float* SS0 = (float*)(ws + WS_SS0); float* SS1 = (float*)(ws + WS_SS1); float* SS2 = (float*)(ws + WS_SS2); float* SS3 = (float*)(ws + WS_SS3);

    if (IN(0)) { phase0(p, lds); __syncthreads(); }
    SEAM(0);
    if (IN(1)) {
        pg8::Gemm g{B0, (const bf16_t*)(ws + WS_WG1), T_ALL, 2 * DFF, DM}; pg8::StaticOrder S; S.init(T_ALL, 2 * DFF, G, (int)blockIdx.x);
        EpiGateUp E{H, SS0};
        pg8::gemm_phase<EpiGateUp, pg8::StaticOrder, PG8_ALIGN, PG8_SP2>(lds, g, S, E);
    }
    SEAM(1);
    if (IN(2)) {
        pg8::Gemm g{H, (const bf16_t*)(ws + WS_WD1), TP, DM, DFF}; pg8::StaticOrder S; S.init(TP, DM, G, (int)blockIdx.x);
        EpiResid E{p.in[0], p.in[1], p.out, B0, p.in[9], SS1, 0.5f};
        pg8::gemm_phase<EpiResid, pg8::StaticOrder, PG8_ALIGN, PG8_SP2>(lds, g, S, E);
        SmallResid Es{p.in[1] - (size_t)TP * DM, p.out, B0, p.in[9], SS1, 0.5f};
        small_gemm<SmallResid, DFF>(H, (const bf16_t*)(ws + WS_WD1), DM, Es, lds);
    }
    SEAM(2);
    if (IN(3)) {
        pg8::Gemm g{B0, (const bf16_t*)(ws + WS_WIN), TP, DIN, DM}; pg8::StaticOrder S; S.init(TP, DIN, G, (int)blockIdx.x);
        EpiProj E{(bf16_t*)(ws + WS_Q), (bf16_t*)(ws + WS_V), (bf16_t*)(ws + WS_SG), (bf16_t*)(ws + WS_GY), (float*)(ws + WS_FZ), (float*)(ws + WS_XB), SS1};
        pg8::gemm_phase<EpiProj, pg8::StaticOrder, PG8_ALIGN, PG8_SP2>(lds, g, S, E);
        SmallProj Es{(bf16_t*)(ws + WS_Q), (bf16_t*)(ws + WS_V), (bf16_t*)(ws + WS_SG), (bf16_t*)(ws + WS_GY), (float*)(ws + WS_FZ), (float*)(ws + WS_XB), SS1};
        small_gemm<SmallProj, DM>(B0, (const bf16_t*)(ws + WS_WIN), DIN, Es, lds);
    }
    SEAM(3);
    Mix M;
    M.Q = (const bf16_t*)(ws + WS_Q); M.V = (const bf16_t*)(ws + WS_V); M.SG = (const bf16_t*)(ws + WS_SG); M.GY = (const bf16_t*)(ws + WS_GY);
    M.FZ = (const float*)(ws + WS_FZ); M.XB = (const float*)(ws + WS_XB); M.LT = (bf16_t*)(ws + WS_LT); M.DC = (float*)(ws + WS_DC);
    M.ACH = (float*)(ws + WS_ACH); M.UCH = (float*)(ws + WS_UCH); M.HST = (float*)(ws + WS_HST); M.O = B0;
    M.WAT = (const bf16_t*)(ws + WS_WAT); M.WXT = (const bf16_t*)(ws + WS_WXT);
    M.lb = p.in[11]; M.hnorm = p.in[12]; M.convw = p.in[13]; M.convb = p.in[14]; M.wa = p.in[15]; M.ba = p.in[16]; M.wx = p.in[17]; M.bx = p.in[18]; M.lam = p.in[19];
    M.st_h = p.in[2]; M.st_l = p.in[3]; M.st_c = p.in[4]; M.out = p.out;
    if (IN(4)) {
        for (int u = blockIdx.x; u < 512; u += G) hgrn_sample_unit(M, u, lds);
        hgrn_loop<0>(M, lds);
        lru_loop(M, 0, lds);
        for (int u = G - 1 - (int)blockIdx.x; u < 128; u += G) lru_sample_unit(M, u, lds);
    }
    SEAM(4);
    if (IN(5)) { for (int it = blockIdx.x; it < 1032; it += G) scan_item(M, it); }
    SEAM(5);
    if (IN(6)) {
        hgrn_loop<1>(M, lds);
        lru_loop(M, 1, lds);
    }
    SEAM(6);
    if (IN(7)) {
        pg8::Gemm g{B0, (const bf16_t*)(ws + WS_WO), TP, DM, DM}; pg8::StaticOrder S; S.init(TP, DM, G, (int)blockIdx.x);
        EpiResid E{p.out, p.out + (size_t)TP * DM, p.out, B1, p.in[21], SS2, 1.0f};
        pg8::gemm_phase<EpiResid, pg8::StaticOrder, PG8_ALIGN, PG8_SP2>(lds, g, S, E);
        SmallResid Es{p.out, p.out, B1, p.in[21], SS2, 1.0f};
        small_gemm<SmallResid, DM>(B0, (const bf16_t*)(ws + WS_WO), DM, Es, lds);
    }
    SEAM(7);
    if (IN(8)) {
        pg8::Gemm g{B1, (const bf16_t*)(ws + WS_WG2), T_ALL, 2 * DFF, DM}; pg8::StaticOrder S; S.init(T_ALL, 2 * DFF, G, (int)blockIdx.x);
        EpiGateUp E{H, SS2};
        pg8::gemm_phase<EpiGateUp, pg8::StaticOrder, PG8_ALIGN, PG8_SP2>(lds, g, S, E);
    }
    SEAM(8);
    if (IN(9)) {
        pg8::Gemm g{H, (const bf16_t*)(ws + WS_WD2), TP, DM, DFF}; pg8::StaticOrder S; S.init(TP, DM, G, (int)blockIdx.x);
        EpiResid E{p.out, p.out + (size_t)TP * DM, p.out, nullptr, nullptr, SS3, 0.5f};
        pg8::gemm_phase<EpiResid, pg8::StaticOrder, PG8_ALIGN, PG8_SP2>(lds, g, S, E);
        SmallResid Es{p.out, p.out, nullptr, nullptr, SS3, 0.5f};
        small_gemm<SmallResid, DFF>(H, (const bf16_t*)(ws + WS_WD2), DM, Es, lds);
    }
    SEAM(9);
    if (IN(10)) phase_final(p);
#undef IN
#undef SEAM
}

extern "C" void kernel_launch(void* const* d_in, const int* in_sizes, int n_in, void* d_out, int out_size, void* d_ws, size_t ws_size, hipStream_t stream) {
    static int grid = 0;
    if (grid == 0) {
        if (n_in != 26 || ws_size < WS_END2) { fprintf(stderr, "kernel_launch: unexpected n_in %d or ws_size %zu (need %zu)\n", n_in, ws_size, (size_t)WS_END2); grid = -1; return; }
        int dev = 0, cus = 0, per_cu = 0;
        hipGetDevice(&dev); hipDeviceGetAttribute(&cus, hipDeviceAttributeMultiprocessorCount, dev);
        if (hipFuncSetAttribute((const void*)mk_fwd, hipFuncAttributeMaxDynamicSharedMemorySize, LDS_BYTES) != hipSuccess) { fprintf(stderr, "kernel_launch: hipFuncSetAttribute failed\n"); grid = -1; return; }
        if (hipOccupancyMaxActiveBlocksPerMultiprocessor(&per_cu, (const void*)mk_fwd, 512, LDS_BYTES) != hipSuccess || per_cu < 1) { fprintf(stderr, "kernel_launch: occupancy query says %d\n", per_cu); per_cu = 1; }
        (void)hipGetLastError();
        grid = cus;
    }
    if (grid < 0) return;
    Params p{};
    for (int i = 0; i < 26; ++i) p.in[i] = (const float*)d_in[i];
    p.out = (float*)d_out; p.ws = (unsigned char*)d_ws;
#if MK_PER_PHASE
    for (int ph = 0; ph < MK_NPH; ++ph) { p.ph_lo = ph; p.ph_hi = ph + 1; hipLaunchKernelGGL(mk_fwd, dim3(grid), dim3(512), LDS_BYTES, stream, p); if ((MK_DUP >> ph) & 1) hipLaunchKernelGGL(mk_fwd, dim3(grid), dim3(512), LDS_BYTES, stream, p); }
#else
    p.ph_lo = 0; p.ph_hi = MK_NPH;
    if (hipMemsetAsync((char*)d_ws + WS_BAR, 0, 16384, stream) != hipSuccess) { fprintf(stderr, "memset failed\n"); return; }
    void* args[] = {&p};
    hipError_t e = hipLaunchCooperativeKernel((const void*)mk_fwd, dim3(grid), dim3(512), args, LDS_BYTES, stream);
    if (e != hipSuccess) fprintf(stderr, "cooperative launch failed: %s (grid %d)\n", hipGetErrorString(e), grid);
#endif
}
```

```cpp
#include <hip/hip_runtime.h>
#include <hip/hip_cooperative_groups.h>
#include <cstdio>
#include <cstdint>
namespace cg = cooperative_groups;

#ifndef MK_DUP
#define MK_DUP 0
#endif
#ifndef MK_NPH
#define MK_NPH 11
#endif
#ifndef MK_PER_PHASE
#define MK_PER_PHASE 0
#endif

#define LAS __attribute__((address_space(3)))
typedef unsigned short bf16_t;
typedef short bf16x8 __attribute__((ext_vector_type(8)));
typedef float f32x4 __attribute__((ext_vector_type(4)));
typedef unsigned u32x4 __attribute__((ext_vector_type(4)));
typedef unsigned u32x2 __attribute__((ext_vector_type(2)));

constexpr int T_ALL = 16896, TP = 16384, DM = 1024, DFF = 2816, DIN = 3072, DH = 512;
constexpr int SEQ = 2048, NB = 8, NCH = 32, DECB = 128;
constexpr float EPS = 1e-6f;

constexpr size_t OUT_Y = 0, OUT_HP = 17301504, OUT_LP = 17825792, OUT_CP = 17829888, OUT_HS = 17842176, OUT_LS = 26230784, OUT_CS = 26296320;

constexpr size_t WS_WG1 = 0;
constexpr size_t WS_WD1 = WS_WG1 + (size_t)5632 * 1024 * 2;
constexpr size_t WS_WIN = WS_WD1 + (size_t)1024 * 2816 * 2;
constexpr size_t WS_WO  = WS_WIN + (size_t)3072 * 1024 * 2;
constexpr size_t WS_WG2 = WS_WO + (size_t)1024 * 1024 * 2;
constexpr size_t WS_WD2 = WS_WG2 + (size_t)5632 * 1024 * 2;
constexpr size_t WS_WAT = WS_WD2 + (size_t)1024 * 2816 * 2;
constexpr size_t WS_WXT = WS_WAT + 65536;
constexpr size_t WS_SS0 = WS_WXT + 65536;
constexpr size_t SS_BYTES = (size_t)T_ALL * 16 * 4;
constexpr size_t WS_SS1 = WS_SS0 + SS_BYTES, WS_SS2 = WS_SS1 + SS_BYTES, WS_SS3 = WS_SS2 + SS_BYTES;
constexpr size_t WS_DC  = WS_SS3 + SS_BYTES;
constexpr size_t WS_ACH = WS_DC + (size_t)1024 * 128 * 4;
constexpr size_t WS_UCH = WS_ACH + (size_t)NB * NCH * 512 * 4;
constexpr size_t WS_HST = WS_UCH + (size_t)NB * NCH * 512 * 4;
constexpr size_t WS_B0  = WS_HST + (size_t)NB * NCH * 512 * 4;
constexpr size_t WS_R   = WS_B0 + (size_t)T_ALL * 1024 * 2;
constexpr size_t WS_H   = WS_R;
constexpr size_t WS_B1  = WS_H + (size_t)T_ALL * 2816 * 2;
constexpr size_t WS_Q   = WS_R;
constexpr size_t WS_V   = WS_Q + (size_t)T_ALL * 512 * 2;
constexpr size_t WS_SG  = WS_V + (size_t)T_ALL * 512 * 2;
constexpr size_t WS_GY  = WS_SG + (size_t)T_ALL * 512 * 2;
constexpr size_t WS_FZ  = WS_GY + (size_t)T_ALL * 512 * 2;
constexpr size_t WS_XB  = WS_FZ + (size_t)T_ALL * 512 * 4;
constexpr size_t WS_LT  = WS_XB + (size_t)T_ALL * 512 * 4;
constexpr size_t WS_END = WS_LT + (size_t)1024 * 16384 * 2;
constexpr size_t WS_BAR = WS_END;
constexpr size_t WS_END2 = WS_BAR + 16384;
static_assert(WS_END2 <= 268435456, "workspace budget");
static_assert(WS_B1 + (size_t)T_ALL * 1024 * 2 <= WS_END, "B1 inside R");

constexpr int LDS_BYTES = 131072 + 64;

typedef __bf16 nbf16x2 __attribute__((ext_vector_type(2)));
typedef float f32x2 __attribute__((ext_vector_type(2)));
__device__ __forceinline__ unsigned cvt_pk_bf16(float lo, float hi) { const nbf16x2 r = __builtin_convertvector((f32x2){lo, hi}, nbf16x2); return __builtin_bit_cast(unsigned, r); }
__device__ __forceinline__ bf16_t f2bf(float f) { return (bf16_t)(cvt_pk_bf16(f, 0.f) & 0xffffu); }
__device__ __forceinline__ float bf2f(bf16_t b) { return __uint_as_float(((unsigned)b) << 16); }
__device__ __forceinline__ float bflo(unsigned w) { return __uint_as_float(w << 16); }
__device__ __forceinline__ float bfhi(unsigned w) { return __uint_as_float(w & 0xffff0000u); }
__device__ __forceinline__ float sigm(float x) { return __builtin_amdgcn_rcpf(1.f + __expf(-x)); }
__device__ __forceinline__ float rowscale(const float* ss, int row) {
    const f32x4* p = (const f32x4*)(ss + (size_t)row * 16);
    const f32x4 a = p[0], b = p[1], c = p[2], d = p[3];
    const float s = (((a.x + a.y) + (a.z + a.w)) + ((b.x + b.y) + (b.z + b.w))) + (((c.x + c.y) + (c.z + c.w)) + ((d.x + d.y) + (d.z + d.w)));
    return rsqrtf(s * (1.f / 1024.f) + EPS);
}
__device__ __forceinline__ void rowscale8(const float* ss, int row0, int fq, float (&rs)[8]) {
    f32x4 q[8];
#pragma unroll
    for (int i = 0; i < 8; ++i) q[i] = *(const f32x4*)(ss + (size_t)(row0 + (i >> 2) * 128 + (i & 3) * 16) * 16 + 4 * fq);
#pragma unroll
    for (int i = 0; i < 8; ++i) { float t = (q[i].x + q[i].y) + (q[i].z + q[i].w); t += __shfl_xor(t, 16); t += __shfl_xor(t, 32); rs[i] = rsqrtf(t * (1.f / 1024.f) + EPS); }
}
__device__ __forceinline__ float wave_sum(float v) {
#pragma unroll
    for (int o = 1; o < 64; o <<= 1) v += __shfl_xor(v, o);
    return v;
}
#define LDS_WAIT() asm volatile("s_waitcnt lgkmcnt(0)" ::: "memory")

namespace pg8 {
constexpr int BM = 256, BK = 64, HALF = 128, HTB = HALF * BK * 2, STAGE_BYTES = 8 * HTB, NXCD = 8, WGM = 8;
__host__ __device__ __forceinline__ int lds_byte(int r, int c) { const int st = (r >> 4) * 2 + (c >> 5), rr = r & 15, cc = c & 31, ob = rr * 64 + cc * 2; return st * 1024 + (ob ^ (((ob >> 9) & 1) << 5)); }
__host__ __device__ __forceinline__ void stage_rc(int b, int& R, int& C) { const int st = b / 1024, sb = b % 1024, swz = sb ^ (((sb >> 9) & 1) << 5); R = (st >> 1) * 16 + swz / 64; C = (st & 1) * 32 + (swz % 64) / 2; }
__host__ __device__ __forceinline__ int perm32(int rho) { const int n = rho >> 4, i = rho & 15; return 8 * (i >> 2) + 4 * n + (i & 3); }
struct Unit { int pm, pn; };
struct Gemm { const bf16_t* A; const bf16_t* Bt; int M, N, K; };
struct StaticOrder {
    int nM, nN, nwg, G, c;
    __host__ __device__ void init(int M, int N, int G_, int c_) { nM = M / BM; nN = N / BM; nwg = nM * nN; G = G_; c = c_; }
    __host__ __device__ bool next(int i, Unit& u) const {
        const long L = (long)i * G + c; if (L >= nwg) return false;
        int wgid = (int)L; { const int q = nwg / NXCD, r = nwg % NXCD, xcd = wgid % NXCD, off = wgid / NXCD; wgid = (xcd < r ? xcd * (q + 1) : r * (q + 1) + (xcd - r) * q) + off; }
        const int nig = WGM * nN, gid = wgid / nig, fm = gid * WGM, gsz = (nM - fm) < WGM ? (nM - fm) : WGM;
        u.pm = fm + ((wgid % nig) % gsz); u.pn = (wgid % nig) / gsz; return true;
    }
    __device__ __forceinline__ void a_ready(const Unit&) const {}
    __device__ __forceinline__ void done(const Unit&) const {}
};

template <class Epi, class Sched, bool ALIGN_EPI = false, bool SP2 = false>
__device__ __forceinline__ void gemm_phase(LAS unsigned char* lds, const Gemm g, const Sched& S, const Epi& E) {
    const int tid = threadIdx.x, wid = __builtin_amdgcn_readfirstlane(tid >> 6), lane = tid & 63, wr = wid >> 2, wc = wid & 3, fr = lane & 15, fq = lane >> 4;
    const int K = g.K, nt = K / BK;
    unsigned voffA[2], voffB[2];
#pragma unroll
    for (int i = 0; i < 2; ++i) { int R, C; stage_rc(tid * 16 + i * 8192, R, C); const int Rb = Epi::PERM ? ((R & ~31) + perm32(R & 31)) : R;
        voffA[i] = (unsigned)(R * K + C) * 2u; voffB[i] = (unsigned)(Rb * K + C) * 2u; }
    const size_t kstep = (size_t)(BK * 2);
    const size_t hstep = (size_t)HALF * K * 2;
    const size_t tstep = 2 * hstep;
    const unsigned ldsw = (unsigned)wid * 1024u;
    const int aoff = lds_byte(wr * 64 + fr, fq * 8), boff = lds_byte(wc * 32 + fr, fq * 8);
#define PG8_SA(b, h) (((b) * 2 + (h)) * HTB)
#define PG8_SB(b, h) ((4 + (b) * 2 + (h)) * HTB)
#define PG8_STAGE(bufoff, gbase, voff) do { _Pragma("unroll") for (int _i = 0; _i < 2; ++_i) \
        __builtin_amdgcn_global_load_lds((const unsigned*)((const char*)(gbase) + (voff)[_i]), (LAS unsigned*)(lds + (bufoff) + ldsw + _i * 8192), 16, 0, 0); } while (0)
#define PG8_LDA(dst, b, h) do { _Pragma("unroll") for (int m = 0; m < 4; ++m) _Pragma("unroll") for (int k = 0; k < 2; ++k) dst[m][k] = *(const LAS bf16x8*)(lds + PG8_SA(b, h) + aoff + m * 2048 + k * 1024); } while (0)
#define PG8_LDB(dst, b, h) do { _Pragma("unroll") for (int n = 0; n < 2; ++n) _Pragma("unroll") for (int k = 0; k < 2; ++k) dst[n][k] = *(const LAS bf16x8*)(lds + PG8_SB(b, h) + boff + n * 2048 + k * 1024); } while (0)
#define PG8_MMA(ai, bj, At, Bt) do { __builtin_amdgcn_s_setprio(1); _Pragma("unroll") for (int m = 0; m < 4; ++m) _Pragma("unroll") for (int n = 0; n < 2; ++n) _Pragma("unroll") for (int k = 0; k < 2; ++k) \
        acc[ai][bj][m][n] = __builtin_amdgcn_mfma_f32_16x16x32_bf16(Bt[n][k], At[m][k], acc[ai][bj][m][n], 0, 0, 0); __builtin_amdgcn_s_setprio(0); } while (0)
#define PG8_WAIT_V(n) asm volatile("s_waitcnt vmcnt(" #n ")" ::: "memory")
#define PG8_WAIT_L(n) asm volatile("s_waitcnt lgkmcnt(" #n ")" ::: "memory")
#define PG8_BAR __builtin_amdgcn_s_barrier()
#define PG8_SCHED __builtin_amdgcn_sched_barrier(0)
    Unit cur, nxt; int ui = 0;
    if (!S.next(0, cur)) return;
    f32x4 acc[2][2][4][2];
#pragma unroll
    for (int a = 0; a < 2; ++a)
#pragma unroll
        for (int b = 0; b < 2; ++b)
#pragma unroll
            for (int m = 0; m < 4; ++m)
#pragma unroll
                for (int n = 0; n < 2; ++n) acc[a][b][m][n] = (f32x4){0.f, 0.f, 0.f, 0.f};
    bf16x8 At[4][2], B0[2][2], B1[2][2];
    const char* cA = (const char*)g.A + (size_t)cur.pm * tstep; const char* cB = (const char*)g.Bt + (size_t)cur.pn * tstep;
    S.a_ready(cur);
    if constexpr (SP2) {
        PG8_STAGE(PG8_SB(0, 0), cB, voffB); PG8_STAGE(PG8_SB(0, 1), cB + hstep, voffB); PG8_STAGE(PG8_SA(0, 0), cA, voffA); PG8_STAGE(PG8_SA(0, 1), cA + hstep, voffA);
        if (wr == 1) PG8_BAR;
        PG8_WAIT_V(2); PG8_BAR;
        PG8_STAGE(PG8_SB(1, 0), cB + kstep, voffB); PG8_STAGE(PG8_SA(1, 0), cA + kstep, voffA); PG8_STAGE(PG8_SB(1, 1), cB + hstep + kstep, voffB);
        PG8_WAIT_V(6); PG8_BAR;
    } else {
        PG8_STAGE(PG8_SB(0, 0), cB, voffB); PG8_STAGE(PG8_SA(0, 0), cA, voffA); PG8_STAGE(PG8_SB(0, 1), cB + hstep, voffB); PG8_STAGE(PG8_SA(0, 1), cA + hstep, voffA);
        if (wr == 1) PG8_BAR;
        PG8_WAIT_V(4); PG8_BAR;
        PG8_STAGE(PG8_SB(1, 0), cB + kstep, voffB); PG8_STAGE(PG8_SA(1, 0), cA + kstep, voffA); PG8_STAGE(PG8_SB(1, 1), cB + hstep + kstep, voffB);
        PG8_WAIT_V(6); PG8_BAR;
    }
    for (;;) {
        const bool has_next = S.next(ui + 1, nxt);
        const char* nA = has_next ? (const char*)g.A + (size_t)nxt.pm * tstep : cA; const char* nB = has_next ? (const char*)g.Bt + (size_t)nxt.pn * tstep : cB;
        for (int t = 0; t < nt; t += 2) {
            const bool last = (t == nt - 2);
            const char* a1 = cA + (size_t)(t + 1) * kstep;
            const char* a2 = last ? nA : cA + (size_t)(t + 2) * kstep; const char* b2 = last ? nB : cB + (size_t)(t + 2) * kstep;
            const char* a3 = a2 + kstep; const char* b3 = b2 + kstep;
            if (last && has_next) S.a_ready(nxt);
            if constexpr (SP2) {
            PG8_LDB(B0, 0, 0); PG8_LDB(B1, 0, 1); PG8_SCHED; PG8_LDA(At, 0, 0); PG8_STAGE(PG8_SA(1, 1), a1 + hstep, voffA);
            PG8_WAIT_V(8); PG8_WAIT_L(0); PG8_BAR; PG8_MMA(0, 0, At, B0); PG8_MMA(0, 1, At, B1); PG8_BAR; PG8_SCHED;
            PG8_LDA(At, 0, 1); PG8_STAGE(PG8_SB(0, 0), b2, voffB); PG8_STAGE(PG8_SB(0, 1), b2 + hstep, voffB); PG8_STAGE(PG8_SA(0, 0), a2, voffA);
            PG8_WAIT_V(8); PG8_WAIT_L(0); PG8_BAR; PG8_MMA(1, 0, At, B0); PG8_MMA(1, 1, At, B1); PG8_BAR; PG8_SCHED;
            PG8_LDB(B0, 1, 0); PG8_LDB(B1, 1, 1); PG8_SCHED; PG8_LDA(At, 1, 0); PG8_STAGE(PG8_SA(0, 1), a2 + hstep, voffA);
            PG8_WAIT_V(8); PG8_WAIT_L(0); PG8_BAR; PG8_MMA(0, 0, At, B0); PG8_MMA(0, 1, At, B1); PG8_BAR; PG8_SCHED;
            PG8_LDA(At, 1, 1); PG8_STAGE(PG8_SB(1, 0), b3, voffB); PG8_STAGE(PG8_SB(1, 1), b3 + hstep, voffB); PG8_STAGE(PG8_SA(1, 0), a3, voffA);
            PG8_WAIT_V(8); PG8_WAIT_L(0); PG8_BAR; PG8_MMA(1, 0, At, B0); PG8_MMA(1, 1, At, B1); PG8_BAR; PG8_SCHED;
            } else {
            PG8_LDB(B0, 0, 0); PG8_SCHED; PG8_LDA(At, 0, 0); PG8_STAGE(PG8_SA(1, 1), a1 + hstep, voffA);
            PG8_WAIT_L(8); PG8_BAR; PG8_WAIT_L(0); PG8_MMA(0, 0, At, B0); PG8_BAR; PG8_SCHED;
            PG8_LDB(B1, 0, 1); PG8_STAGE(PG8_SB(0, 0), b2, voffB);
            PG8_BAR; PG8_WAIT_L(0); PG8_MMA(0, 1, At, B1); PG8_BAR;
            PG8_LDA(At, 0, 1); PG8_STAGE(PG8_SA(0, 0), a2, voffA);
            PG8_BAR; PG8_WAIT_L(0); PG8_MMA(1, 0, At, B0); PG8_BAR; PG8_SCHED;
            PG8_STAGE(PG8_SB(0, 1), b2 + hstep, voffB);
            PG8_WAIT_V(6); PG8_BAR; PG8_MMA(1, 1, At, B1); PG8_BAR;
            PG8_LDB(B0, 1, 0); PG8_SCHED; PG8_LDA(At, 1, 0); PG8_STAGE(PG8_SA(0, 1), a2 + hstep, voffA);
            PG8_WAIT_L(8); PG8_BAR; PG8_WAIT_L(0); PG8_MMA(0, 0, At, B0); PG8_BAR; PG8_SCHED;
            PG8_LDB(B1, 1, 1); PG8_STAGE(PG8_SB(1, 0), b3, voffB);
            PG8_BAR; PG8_WAIT_L(0); PG8_MMA(0, 1, At, B1); PG8_BAR;
            PG8_LDA(At, 1, 1); PG8_STAGE(PG8_SA(1, 0), a3, voffA);
            PG8_BAR; PG8_WAIT_L(0); PG8_MMA(1, 0, At, B0); PG8_BAR; PG8_SCHED;
            PG8_STAGE(PG8_SB(1, 1), b3 + hstep, voffB);
            PG8_WAIT_V(6); PG8_BAR; PG8_MMA(1, 1, At, B1); PG8_BAR;
            }
        }
        if constexpr (ALIGN_EPI) { if (wr == 0) PG8_BAR; }
        E(acc, cur, wr, wc, fr, fq); S.done(cur);
        if (!has_next) break;
#pragma unroll
        for (int a = 0; a < 2; ++a)
#pragma unroll
            for (int b = 0; b < 2; ++b)
#pragma unroll
                for (int m = 0; m < 4; ++m)
#pragma unroll
                    for (int n = 0; n < 2; ++n) acc[a][b][m][n] = (f32x4){0.f, 0.f, 0.f, 0.f};
        cur = nxt; cA = nA; cB = nB; ++ui;
        if constexpr (ALIGN_EPI) { if (wr == 1) PG8_BAR; }
    }
    PG8_WAIT_V(0);
    if constexpr (!ALIGN_EPI) { if (wr == 0) PG8_BAR; }
    PG8_BAR;
#undef PG8_SA
#undef PG8_SB
#undef PG8_STAGE
#undef PG8_LDA
#undef PG8_LDB
#undef PG8_MMA
#undef PG8_WAIT_V
#undef PG8_WAIT_L
#undef PG8_BAR
#undef PG8_SCHED
}
}

#ifndef PG8_SP2
#define PG8_SP2 true
#endif
#ifndef PG8_ALIGN
#define PG8_ALIGN true
#endif

struct EpiGateUp {
    static constexpr bool PERM = true;
    bf16_t* H; const float* ss;
    __device__ __forceinline__ void operator()(const f32x4 (&acc)[2][2][4][2], const pg8::Unit& u, int wr, int wc, int fr, int fq) const {
        const int row0 = u.pm * 256 + wr * 64 + fr, col0 = u.pn * 128 + wc * 32 + 8 * fq;
        float rsv[8]; rowscale8(ss, row0, fq, rsv);
#pragma unroll
        for (int ai = 0; ai < 2; ++ai)
#pragma unroll
            for (int m = 0; m < 4; ++m) {
                const int row = row0 + ai * 128 + m * 16; const float rs = rsv[ai * 4 + m];
                float h[8];
#pragma unroll
                for (int n = 0; n < 2; ++n)
#pragma unroll
                    for (int j = 0; j < 4; ++j) { const float g = acc[ai][0][m][n][j] * rs, up = acc[ai][1][m][n][j] * rs; h[n * 4 + j] = g * sigm(g) * up; }
                u32x4 w; w.x = cvt_pk_bf16(h[0], h[1]); w.y = cvt_pk_bf16(h[2], h[3]); w.z = cvt_pk_bf16(h[4], h[5]); w.w = cvt_pk_bf16(h[6], h[7]);
                *(u32x4*)(H + (size_t)row * DFF + col0) = w;
            }
    }
};
struct EpiResid {
    static constexpr bool PERM = true;
    const float* xin_p; const float* xin_s; float* xout; bf16_t* ax; const float* gnext; float* ssout; float scale;
    __device__ __forceinline__ void operator()(const f32x4 (&acc)[2][2][4][2], const pg8::Unit& u, int wr, int wc, int fr, int fq) const {
        const int row0 = u.pm * 256 + wr * 64 + fr, col0 = u.pn * 256 + wc * 32 + 8 * fq;
        const float* xb = (u.pm < 64) ? xin_p : (xin_s - (size_t)TP * DM);
        f32x4 gn[2][2];
#pragma unroll
        for (int bj = 0; bj < 2; ++bj)
#pragma unroll
            for (int n = 0; n < 2; ++n) gn[bj][n] = ax ? *(const f32x4*)(gnext + col0 + bj * 128 + 4 * n) : (f32x4){1.f, 1.f, 1.f, 1.f};
#pragma unroll
        for (int ai = 0; ai < 2; ++ai) {
            f32x4 xr[4][2][2];
#pragma unroll
            for (int m = 0; m < 4; ++m)
#pragma unroll
                for (int bj = 0; bj < 2; ++bj) { const float* px = xb + (size_t)(row0 + ai * 128 + m * 16) * DM + col0 + bj * 128; xr[m][bj][0] = *(const f32x4*)px; xr[m][bj][1] = *(const f32x4*)(px + 4); }
#pragma unroll
            for (int m = 0; m < 4; ++m) {
                const int row = row0 + ai * 128 + m * 16; const size_t off = (size_t)row * DM + col0; float sq = 0.f;
#pragma unroll
                for (int bj = 0; bj < 2; ++bj) {
                    const f32x4 x0 = xr[m][bj][0], x1 = xr[m][bj][1];
                    const f32x4 v0 = x0 + acc[ai][bj][m][0] * scale, v1 = x1 + acc[ai][bj][m][1] * scale;
                    *(f32x4*)(xout + off + bj * 128) = v0; *(f32x4*)(xout + off + bj * 128 + 4) = v1;
                    sq += ((v0[0] * v0[0] + v0[1] * v0[1]) + (v0[2] * v0[2] + v0[3] * v0[3])) + ((v1[0] * v1[0] + v1[1] * v1[1]) + (v1[2] * v1[2] + v1[3] * v1[3]));
                    if (ax) { const f32x4 a0 = v0 * gn[bj][0], a1 = v1 * gn[bj][1];
                        u32x4 w; w.x = cvt_pk_bf16(a0[0], a0[1]); w.y = cvt_pk_bf16(a0[2], a0[3]); w.z = cvt_pk_bf16(a1[0], a1[1]); w.w = cvt_pk_bf16(a1[2], a1[3]);
                        *(u32x4*)(ax + off + bj * 128) = w; }
                }
                sq += __shfl_xor(sq, 16); sq += __shfl_xor(sq, 32);
                if (fq == 0) ssout[(size_t)row * 16 + u.pn * 4 + wc] = sq;
            }
        }
    }
};
struct EpiProj {
    static constexpr bool PERM = true;
    bf16_t *Q, *V, *SG, *GY; float *FZ, *XB; const float* ss;
    __device__ __forceinline__ void operator()(const f32x4 (&acc)[2][2][4][2], const pg8::Unit& u, int wr, int wc, int fr, int fq) const {
        const int seg = u.pn >> 1;
        const int row0 = u.pm * 256 + wr * 64 + fr, col0 = (u.pn & 1) * 256 + wc * 32 + 8 * fq;
        float* fdst = (seg == 1) ? FZ : XB;
        bf16_t* bdst = (seg == 0) ? Q : (seg == 2) ? V : (seg == 3) ? SG : GY;
        const bool isf = (seg == 1) || (seg == 4);
        float rsv[8]; rowscale8(ss, row0, fq, rsv);
#pragma unroll
        for (int ai = 0; ai < 2; ++ai)
#pragma unroll
            for (int m = 0; m < 4; ++m) {
                const int row = row0 + ai * 128 + m * 16; const float rs = rsv[ai * 4 + m]; const size_t off = (size_t)row * DH + col0;
#pragma unroll
                for (int bj = 0; bj < 2; ++bj) {
                    f32x4 v0 = acc[ai][bj][m][0] * rs, v1 = acc[ai][bj][m][1] * rs;
                    if (isf) { *(f32x4*)(fdst + off + bj * 128) = v0; *(f32x4*)(fdst + off + bj * 128 + 4) = v1; }
                    else {
                        float h[8] = {v0[0], v0[1], v0[2], v0[3], v1[0], v1[1], v1[2], v1[3]};
                        if (seg == 0) {
#pragma unroll
                            for (int j = 0; j < 8; ++j) h[j] = h[j] * sigm(h[j]);
                        } else if (seg == 3) {
#pragma unroll
                            for (int j = 0; j < 8; ++j) h[j] = sigm(h[j]);
                        } else if (seg == 5) {
#pragma unroll
                            for (int j = 0; j < 8; ++j) { const float y = h[j]; h[j] = y * sigm(1.5957691216f * (y + 0.044715f * y * y * y)); }
                        }
                        u32x4 w; w.x = cvt_pk_bf16(h[0], h[1]); w.y = cvt_pk_bf16(h[2], h[3]); w.z = cvt_pk_bf16(h[4], h[5]); w.w = cvt_pk_bf16(h[6], h[7]);
                        *(u32x4*)(bdst + off + bj * 128) = w;
                    }
                }
            }
    }
};


struct SmallResid {
    const float* xin; float* xout; bf16_t* ax; const float* gnext; float* ssout; float scale;
    __device__ __forceinline__ void apply(const f32x4& acc, int grow, int c, int cn, int c16, int r16, int fr, int fq, LAS unsigned char* lds) const {
        const size_t off = (size_t)grow * DM + c;
        const f32x4 x = *(const f32x4*)(xin + off);
        const f32x4 v = x + acc * scale;
        *(f32x4*)(xout + off) = v;
        float sq = (v[0] * v[0] + v[1] * v[1]) + (v[2] * v[2] + v[3] * v[3]);
        if (ax) { const f32x4 g = *(const f32x4*)(gnext + c); const f32x4 a = v * g; u32x2 w; w.x = cvt_pk_bf16(a[0], a[1]); w.y = cvt_pk_bf16(a[2], a[3]); *(u32x2*)(ax + off) = w; }
        sq += __shfl_xor(sq, 16); sq += __shfl_xor(sq, 32);
        LAS float* P = (LAS float*)lds;
        if (fq == 0) P[(r16 * 16 + fr) * 4 + c16] = sq;
        __syncthreads();
        if (c16 == 0 && fq == 0) { const LAS float* q = P + (r16 * 16 + fr) * 4; ssout[(size_t)grow * 16 + cn] = (q[0] + q[1]) + (q[2] + q[3]); }
        __syncthreads();
    }
};
struct SmallProj {
    bf16_t *Q, *V, *SG, *GY; float *FZ, *XB; const float* ss;
    __device__ __forceinline__ void apply(const f32x4& acc, int grow, int c, int cn, int c16, int r16, int fr, int fq, LAS unsigned char* lds) const {
        const int seg = cn >> 3, cs = c & 511;
        const float rs = rowscale(ss, grow);
        const f32x4 v = acc * rs;
        const size_t off = (size_t)grow * DH + cs;
        if (seg == 1 || seg == 4) { *(f32x4*)(((seg == 1) ? FZ : XB) + off) = v; }
        else {
            float h[4] = {v[0], v[1], v[2], v[3]};
            if (seg == 0) {
#pragma unroll
                for (int j = 0; j < 4; ++j) h[j] = h[j] * sigm(h[j]);
            } else if (seg == 3) {
#pragma unroll
                for (int j = 0; j < 4; ++j) h[j] = sigm(h[j]);
            } else if (seg == 5) {
#pragma unroll
                for (int j = 0; j < 4; ++j) { const float y = h[j]; h[j] = y * sigm(1.5957691216f * (y + 0.044715f * y * y * y)); }
            }
            bf16_t* bdst = (seg == 0) ? Q : (seg == 2) ? V : (seg == 3) ? SG : GY;
            u32x2 w; w.x = cvt_pk_bf16(h[0], h[1]); w.y = cvt_pk_bf16(h[2], h[3]);
            *(u32x2*)(bdst + off) = w;
        }
    }
};
template <class Epi, int K>
__device__ __forceinline__ void small_gemm(const bf16_t* A, const bf16_t* Bt, int N, const Epi& E, LAS unsigned char* lds) {
    const int tid = threadIdx.x, lane = tid & 63, wave = tid >> 6, fr = lane & 15, fq = lane >> 4, r16 = wave >> 2, c16 = wave & 3;
    constexpr int KW = K / 8, NS = KW / 32;
    const int nunits = 16 * (N / 64), G = gridDim.x;
    LAS f32x4* PB = (LAS f32x4*)lds;
    for (int u = G - 1 - (int)blockIdx.x; u < nunits; u += G) {
        const int rm = u & 15, cn = u >> 4;
        const bf16_t* ap = A + (size_t)(TP + rm * 32 + fr) * K + wave * KW + fq * 8;
        const bf16_t* bp = Bt + (size_t)(cn * 64 + fr) * K + wave * KW + fq * 8;
        f32x4 acc[2][4];
#pragma unroll
        for (int rr = 0; rr < 2; ++rr)
#pragma unroll
            for (int cc = 0; cc < 4; ++cc) acc[rr][cc] = (f32x4){0.f, 0.f, 0.f, 0.f};
#pragma unroll
        for (int s0 = 0; s0 < NS; s0 += 4) {
            bf16x8 a[4][2], b[4][4];
#pragma unroll
            for (int i = 0; i < 4; ++i) if (s0 + i < NS) {
#pragma unroll
                for (int rr = 0; rr < 2; ++rr) a[i][rr] = *(const bf16x8*)(ap + (size_t)rr * 16 * K + (s0 + i) * 32);
#pragma unroll
                for (int cc = 0; cc < 4; ++cc) b[i][cc] = *(const bf16x8*)(bp + (size_t)cc * 16 * K + (s0 + i) * 32);
            }
#pragma unroll
            for (int i = 0; i < 4; ++i) if (s0 + i < NS) {
#pragma unroll
                for (int rr = 0; rr < 2; ++rr)
#pragma unroll
                    for (int cc = 0; cc < 4; ++cc) acc[rr][cc] = __builtin_amdgcn_mfma_f32_16x16x32_bf16(b[i][cc], a[i][rr], acc[rr][cc], 0, 0, 0);
            }
        }
#pragma unroll
        for (int rr = 0; rr < 2; ++rr)
#pragma unroll
            for (int cc = 0; cc < 4; ++cc) PB[(wave * 8 + rr * 4 + cc) * 64 + lane] = acc[rr][cc];
        __syncthreads();
        f32x4 r = PB[(0 * 8 + wave) * 64 + lane];
#pragma unroll
        for (int w = 1; w < 8; ++w) r += PB[(w * 8 + wave) * 64 + lane];
        E.apply(r, TP + rm * 32 + r16 * 16 + fr, cn * 64 + c16 * 16 + 4 * fq, cn, c16, r16, fr, fq, lds + 65536);
        __syncthreads();
    }
}

#define XB_TMO      128
#define XB_XCNT(j)  (256  + 64 * (j))
#define XB_XSUB(j)  (1280 + 64 * (j))
#define XB_XGEN(j)  (2304 + 64 * (j))
#define XB_TOP      3328
#define XB_TOPGEN   3392
#define XCD_BAR_WORDS 3456
#define XB_SPIN_CAP (1u << 22)
__device__ __forceinline__ unsigned xb_ld(unsigned* p)              { return __hip_atomic_load(p, __ATOMIC_RELAXED, __HIP_MEMORY_SCOPE_AGENT); }
__device__ __forceinline__ unsigned xb_add(unsigned* p, unsigned v) { return __hip_atomic_fetch_add(p, v, __ATOMIC_RELAXED, __HIP_MEMORY_SCOPE_AGENT); }
__device__ __forceinline__ unsigned xb_xcc_id() { return (unsigned)__builtin_amdgcn_s_getreg((3 << 11) | 20) & 0xFu; }
#define XB_SPIN(cond, bar) do { unsigned _sp = 0; while (cond) { __builtin_amdgcn_s_sleep(1); \
    if ((++_sp & 255u) == 0u) { if (xb_ld(&(bar)[XB_TMO])) break; if (_sp > XB_SPIN_CAP) { atomicAdd(&(bar)[XB_TMO], 1u); break; } } } } while (0)
struct XcdBarrier { unsigned* bar; unsigned x; volatile LAS unsigned* st; };
__device__ __forceinline__ XcdBarrier xcd_barrier_post(unsigned* bar, volatile LAS unsigned* st) {
    XcdBarrier b; b.bar = bar; b.x = xb_xcc_id(); b.st = st;
    if (threadIdx.x == 0) (void)xb_add(&bar[XB_XCNT(b.x)], 1u);
    return b;
}
__device__ __forceinline__ void xcd_barrier_complete(unsigned* bar, unsigned x, unsigned& nloc, unsigned& nx) {
    const unsigned G = gridDim.x * gridDim.y * gridDim.z;
    unsigned sum, cnt, mine, sp = 0u;
    for (;;) {
        sum = 0u; cnt = 0u; mine = 0u;
#pragma unroll
        for (unsigned j = 0; j < 16; ++j) { const unsigned c = xb_ld(&bar[XB_XCNT(j)]); sum += c; cnt += (c > 0u) ? 1u : 0u; mine = (j == x) ? c : mine; }
        if (sum == G) break;
        __builtin_amdgcn_s_sleep(1);
        if ((++sp & 255u) == 0u) { if (xb_ld(&bar[XB_TMO])) break; if (sp > XB_SPIN_CAP) { atomicAdd(&bar[XB_TMO], 1u); break; } }
    }
    nloc = mine > 0u ? mine : 1u; nx = cnt > 0u ? cnt : 1u;
}
__device__ __forceinline__ void xcd_barrier(const XcdBarrier& b) {
    asm volatile("s_waitcnt vmcnt(0) lgkmcnt(0)" ::: "memory");
    __syncthreads();
    if (threadIdx.x == 0) {
        unsigned* bar = b.bar;
        __builtin_amdgcn_s_waitcnt(0);
        unsigned nloc = b.st[0], nx = b.st[1];
        if (nloc == 0u) { xcd_barrier_complete(bar, b.x, nloc, nx); b.st[0] = nloc; b.st[1] = nx; }
        const unsigned old = xb_add(&bar[XB_XSUB(b.x)], 1u);
        const unsigned gen = old / nloc;
        if (old + 1u == (gen + 1u) * nloc) {
            __builtin_amdgcn_fence(__ATOMIC_RELEASE, "agent");
            asm volatile("s_waitcnt vmcnt(0)" ::: "memory");
            const unsigned og = xb_add(&bar[XB_TOP], 1u);
            const unsigned tg = og / nx;
            if (og + 1u == (tg + 1u) * nx) xb_add(&bar[XB_TOPGEN], 1u);
            else XB_SPIN(xb_ld(&bar[XB_TOPGEN]) == tg, bar);
            __builtin_amdgcn_fence(__ATOMIC_ACQUIRE, "agent");
            xb_add(&bar[XB_XGEN(b.x)], 1u);
            asm volatile("s_waitcnt vmcnt(0)" ::: "memory");
        } else {
            XB_SPIN(xb_ld(&bar[XB_XGEN(b.x)]) == gen, bar);
            __builtin_amdgcn_fence(__ATOMIC_ACQUIRE, "agent");
            asm volatile("s_waitcnt vmcnt(0)" ::: "memory");
        }
    }
    __syncthreads();
}

struct Params { const float* in[26]; float* out; unsigned char* ws; int ph_lo, ph_hi; };

__device__ __forceinline__ void transpose_item(const float* W, int K, int N, bf16_t* WT, int dst_row0, LAS float* scr, int k0, int n0, int lane) {
    float wv[32];
#pragma unroll
    for (int i = 0; i < 32; ++i) wv[i] = W[(size_t)(k0 + 2 * i + (lane >> 5)) * N + n0 + (lane & 31)];
#pragma unroll
    for (int i = 0; i < 32; ++i) scr[(2 * i + (lane >> 5)) * 33 + (lane & 31)] = wv[i];
    LDS_WAIT();
    const int c = lane & 7;
#pragma unroll
    for (int j = 0; j < 4; ++j) { const int n = (lane >> 3) + 8 * j; const LAS float* s = scr + (8 * c) * 33 + n;
        u32x4 o; o.x = cvt_pk_bf16(s[0 * 33], s[1 * 33]); o.y = cvt_pk_bf16(s[2 * 33], s[3 * 33]); o.z = cvt_pk_bf16(s[4 * 33], s[5 * 33]); o.w = cvt_pk_bf16(s[6 * 33], s[7 * 33]);
        *(u32x4*)(WT + (size_t)(dst_row0 + n) * K + k0 + 8 * c) = o; }
    LDS_WAIT();
}
__device__ __forceinline__ void transpose_mat(const float* W, int K, int N, bf16_t* WT, int mode, LAS float* scr, int item, int lane) {
    const int nblk = N / 32, kb = item / nblk, nb = item % nblk, n0 = 32 * nb;
    const int dst = (mode == 0) ? n0 : (256 * (n0 >> 7) + (n0 & 127) + (mode == 2 ? 128 : 0));
    transpose_item(W, K, N, WT, dst, scr, 64 * kb, n0, lane);
}

__device__ __forceinline__ void convert_set(const Params& p, LAS unsigned char* lds, int set, int widx, int wstride) {
    const int lane = threadIdx.x & 63, wave = threadIdx.x >> 6;
    unsigned char* ws = p.ws;
    LAS float* scr = (LAS float*)(lds + wave * 16384);
    constexpr int I_GU = 16 * 88, I_D = 44 * 32, I_IN = 16 * 96, I_O = 16 * 32;
    const int nit = (set == 0) ? 2 * I_GU : (set == 1) ? (I_D + I_IN + I_O) : (2 * I_GU + I_D);
    for (int it = widx; it < nit; it += wstride) {
        int r = it;
        if (set == 0) {
            if (r < I_GU) { transpose_mat(p.in[6], 1024, 2816, (bf16_t*)(ws + WS_WG1), 1, scr, r, lane); continue; } r -= I_GU;
            transpose_mat(p.in[7], 1024, 2816, (bf16_t*)(ws + WS_WG1), 2, scr, r, lane);
        } else if (set == 1) {
            if (r < I_D)  { transpose_mat(p.in[8], 2816, 1024, (bf16_t*)(ws + WS_WD1), 0, scr, r, lane); continue; } r -= I_D;
            if (r < I_IN) { transpose_mat(p.in[10], 1024, 3072, (bf16_t*)(ws + WS_WIN), 0, scr, r, lane); continue; } r -= I_IN;
            transpose_mat(p.in[20], 1024, 1024, (bf16_t*)(ws + WS_WO), 0, scr, r, lane);
        } else {
            if (r < I_GU) { transpose_mat(p.in[22], 1024, 2816, (bf16_t*)(ws + WS_WG2), 1, scr, r, lane); continue; } r -= I_GU;
            if (r < I_GU) { transpose_mat(p.in[23], 1024, 2816, (bf16_t*)(ws + WS_WG2), 2, scr, r, lane); continue; } r -= I_GU;
            transpose_mat(p.in[24], 2816, 1024, (bf16_t*)(ws + WS_WD2), 0, scr, r, lane);
        }
    }
}
__device__ __forceinline__ void phase0(const Params& p, LAS unsigned char* lds) {
    const int tid = threadIdx.x, lane = tid & 63, wave = tid >> 6;
    const int G = gridDim.x, gw = blockIdx.x * 8 + wave, NGW = G * 8;
    unsigned char* ws = p.ws;
    convert_set(p, lds, 0, gw, NGW);
    for (int e = blockIdx.x * 512 + tid; e < 2 * 32768; e += G * 512) {
        const int which = e >> 15, r = e & 32767, n = r >> 12, j = (r >> 6) & 63, i = r & 63;
        const float* W = which ? p.in[17] : p.in[15];
        bf16_t* WT = (bf16_t*)(ws + (which ? WS_WXT : WS_WAT));
        WT[r] = f2bf(W[(n * 64 + i) * 64 + j]);
    }
    bf16_t* A1 = (bf16_t*)(ws + WS_B0); float* SS0 = (float*)(ws + WS_SS0);
    const float* g1 = p.in[5];
    f32x4 gv[4];
#pragma unroll
    for (int j = 0; j < 4; ++j) gv[j] = ((const f32x4*)g1)[lane + 64 * j];
    for (int row0 = gw; row0 < T_ALL; row0 += 3 * NGW) {
        f32x4 v[3][4];
#pragma unroll
        for (int r = 0; r < 3; ++r) { const int row = row0 + r * NGW; if (row < T_ALL) {
            const float* xr = (row < TP) ? p.in[0] + (size_t)row * DM : p.in[1] + (size_t)(row - TP) * DM;
#pragma unroll
            for (int j = 0; j < 4; ++j) v[r][j] = ((const f32x4*)xr)[lane + 64 * j]; } }
#pragma unroll
        for (int r = 0; r < 3; ++r) { const int row = row0 + r * NGW; if (row < T_ALL) {
            float s = 0.f;
#pragma unroll
            for (int j = 0; j < 4; ++j) s += (v[r][j].x * v[r][j].x + v[r][j].y * v[r][j].y) + (v[r][j].z * v[r][j].z + v[r][j].w * v[r][j].w);
            s = wave_sum(s);
            u32x2* o8 = (u32x2*)(A1 + (size_t)row * DM);
#pragma unroll
            for (int j = 0; j < 4; ++j) { const f32x4 a = v[r][j] * gv[j]; u32x2 w; w.x = cvt_pk_bf16(a.x, a.y); w.y = cvt_pk_bf16(a.z, a.w); o8[lane + 64 * j] = w; }
            if (lane < 16) SS0[(size_t)row * 16 + lane] = (lane == 0) ? s : 0.f; } }
    }
}

__device__ __forceinline__ void phase_final(const Params& p) {
    const int tid = threadIdx.x, lane = tid & 63, wave = tid >> 6;
    const int gw = blockIdx.x * 8 + wave, NGW = gridDim.x * 8;
    const float* SS3 = (const float*)(p.ws + WS_SS3); const float* gf = p.in[25];
    f32x4 gv[4];
#pragma unroll
    for (int j = 0; j < 4; ++j) gv[j] = ((const f32x4*)gf)[lane + 64 * j];
    for (int row0 = gw; row0 < T_ALL; row0 += 3 * NGW) {
        f32x4 v[3][4]; float rs[3];
#pragma unroll
        for (int r = 0; r < 3; ++r) { const int row = row0 + r * NGW; if (row < T_ALL) {
            rs[r] = rowscale(SS3, row);
            const f32x4* xr = (const f32x4*)(p.out + (size_t)row * DM);
#pragma unroll
            for (int j = 0; j < 4; ++j) v[r][j] = xr[lane + 64 * j]; } }
#pragma unroll
        for (int r = 0; r < 3; ++r) { const int row = row0 + r * NGW; if (row < T_ALL) {
            f32x4* xr = (f32x4*)(p.out + (size_t)row * DM);
#pragma unroll
            for (int j = 0; j < 4; ++j) xr[lane + 64 * j] = v[r][j] * rs[r] * gv[j]; } }
    }
}

struct Mix {
    const bf16_t *Q, *V, *SG, *GY; const float *FZ, *XB; bf16_t* LT; float* DC; float *ACH, *UCH, *HST; bf16_t* O;
    const bf16_t *WAT, *WXT;
    const float *lb, *hnorm, *convw, *convb, *ba, *bx, *lam, *wa, *wx, *st_h, *st_l, *st_c;
    float* out;
};

struct HgrnScan { float cum[16]; float kk[16]; float last; };
__device__ __forceinline__ void hgrn_scan(const float (&fzv)[16], float lb, int k, int seg, LAS float* tot, HgrnScan& hs) {
    float run = 0.f;
#pragma unroll
    for (int i = 0; i < 16; ++i) {
        const float e = __expf(-fmaxf(fzv[i], -80.f));
        const float sg = __builtin_amdgcn_rcpf(1.f + e), sn = e * sg;
        const float f = lb + (1.f - lb) * sg;
        run += __logf(f); hs.cum[i] = run; hs.kk[i] = (1.f - lb) * sn;
    }
    tot[seg * 128 + k] = run;
    __syncthreads();
    float off = 0.f, all = 0.f;
#pragma unroll
    for (int s = 0; s < 4; ++s) { const float v = tot[s * 128 + k]; if (s < seg) off += v; all += v; }
#pragma unroll
    for (int i = 0; i < 16; ++i) hs.cum[i] += off;
    hs.last = all;
}

struct HgIn { float fzv[16]; unsigned vv[16]; unsigned qv[16]; bf16x8 bs[4]; u32x2 sgv[4]; };
template <int MODE>
__device__ __forceinline__ void hg_load(const Mix& M, int unit, HgIn& in) {
    const int tid = threadIdx.x, lane = tid & 63, wave = tid >> 6, fr = lane & 15, fq = lane >> 4;
    const int h = unit & 3, bc = unit >> 2, t0 = bc * 64, cb = h * 128, k = tid & 127, seg = tid >> 7;
    const size_t rb = (size_t)(t0 + seg * 16) * DH + cb + k;
#pragma unroll
    for (int i = 0; i < 16; ++i) { in.fzv[i] = M.FZ[rb + (size_t)i * DH]; in.vv[i] = M.V[rb + (size_t)i * DH]; if (MODE == 1) in.qv[i] = M.Q[rb + (size_t)i * DH]; }
    if (MODE == 1) {
#pragma unroll
        for (int ks = 0; ks < 4; ++ks) in.bs[ks] = *(const bf16x8*)(M.LT + ((size_t)unit * 128 + 16 * wave + fr) * 128 + ks * 32 + fq * 8);
#pragma unroll
        for (int tr = 0; tr < 4; ++tr) in.sgv[tr] = *(const u32x2*)(M.SG + (size_t)(t0 + 16 * tr + fr) * DH + cb + 16 * wave + 4 * fq);
    }
}
template <int MODE>
__device__ __forceinline__ void hgrn_loop(const Mix& M, LAS unsigned char* lds) {
    const int tid = threadIdx.x, lane = tid & 63, wave = tid >> 6, fr = lane & 15, fq = lane >> 4, G = gridDim.x;
    const int k = tid & 127, seg = tid >> 7;
    int unit = blockIdx.x; if (unit >= 1024) return;
    int hcache = -1; float lb = 0.f; f32x4 gn = {0.f, 0.f, 0.f, 0.f};
    HgIn cur; hg_load<MODE>(M, unit, cur);
    for (;;) {
        const int un = unit + G; const bool has = un < 1024;
        HgIn nxt; if (has) hg_load<MODE>(M, un, nxt);
        const int h = unit & 3, bc = unit >> 2, t0 = bc * 64, cb = h * 128;
        if (h != hcache) { hcache = h; const float l0 = M.lb[cb + k], l1 = M.lb[512 + cb + k]; lb = __builtin_amdgcn_rcpf(1.f + __expf(l1 - l0)); gn = *(const f32x4*)(M.hnorm + cb + 16 * wave + 4 * fq); }
        if (MODE == 0) {
            LAS bf16_t* KT = (LAS bf16_t*)lds; LAS bf16_t* VT = (LAS bf16_t*)(lds + 18432); LAS float* tot = (LAS float*)(lds + 36864);
            HgrnScan hs; hgrn_scan(cur.fzv, lb, k, seg, tot, hs);
            unsigned pk[8];
#pragma unroll
            for (int i = 0; i < 8; ++i) pk[i] = cvt_pk_bf16(hs.kk[2 * i] * __expf(hs.last - hs.cum[2 * i]), hs.kk[2 * i + 1] * __expf(hs.last - hs.cum[2 * i + 1]));
            *(LAS u32x4*)(KT + k * 72 + seg * 16) = (u32x4){pk[0], pk[1], pk[2], pk[3]};
            *(LAS u32x4*)(KT + k * 72 + seg * 16 + 8) = (u32x4){pk[4], pk[5], pk[6], pk[7]};
            const unsigned* vv = cur.vv;
            *(LAS u32x4*)(VT + k * 72 + seg * 16) = (u32x4){vv[0] | (vv[1] << 16), vv[2] | (vv[3] << 16), vv[4] | (vv[5] << 16), vv[6] | (vv[7] << 16)};
            *(LAS u32x4*)(VT + k * 72 + seg * 16 + 8) = (u32x4){vv[8] | (vv[9] << 16), vv[10] | (vv[11] << 16), vv[12] | (vv[13] << 16), vv[14] | (vv[15] << 16)};
            if (seg == 0) M.DC[unit * 128 + k] = __expf(hs.last);
            __syncthreads();
            const bf16x8 a0 = *(const LAS bf16x8*)(VT + (16 * wave + fr) * 72 + fq * 8), a1 = *(const LAS bf16x8*)(VT + (16 * wave + fr) * 72 + 32 + fq * 8);
#pragma unroll
            for (int ct = 0; ct < 8; ++ct) {
                const bf16x8 b0 = *(const LAS bf16x8*)(KT + (16 * ct + fr) * 72 + fq * 8), b1 = *(const LAS bf16x8*)(KT + (16 * ct + fr) * 72 + 32 + fq * 8);
                f32x4 acc = {0.f, 0.f, 0.f, 0.f};
                acc = __builtin_amdgcn_mfma_f32_16x16x32_bf16(b0, a0, acc, 0, 0, 0);
                acc = __builtin_amdgcn_mfma_f32_16x16x32_bf16(b1, a1, acc, 0, 0, 0);
                u32x2 w; w.x = cvt_pk_bf16(acc[0], acc[1]); w.y = cvt_pk_bf16(acc[2], acc[3]);
                *(u32x2*)(M.LT + ((size_t)unit * 128 + 16 * wave + fr) * 128 + 16 * ct + 4 * fq) = w;
            }
            __syncthreads();
        } else {
            LAS bf16_t* QS = (LAS bf16_t*)lds; LAS bf16_t* KS = (LAS bf16_t*)(lds + 17408); LAS bf16_t* VT = (LAS bf16_t*)(lds + 34816);
            LAS bf16_t* PS = (LAS bf16_t*)(lds + 53248); LAS float* tot = (LAS float*)(lds + 62464); LAS float* RS = (LAS float*)(lds + 64512);
            HgrnScan hs; hgrn_scan(cur.fzv, lb, k, seg, tot, hs);
#pragma unroll
            for (int i = 0; i < 16; ++i) {
                const float q = __uint_as_float(cur.qv[i] << 16);
                QS[(seg * 16 + i) * 136 + k] = f2bf(q * __expf(hs.cum[i]));
                KS[(seg * 16 + i) * 136 + k] = f2bf(hs.kk[i] * __expf(-hs.cum[i]));
            }
            const unsigned* vv = cur.vv;
            *(LAS u32x4*)(VT + k * 72 + seg * 16) = (u32x4){vv[0] | (vv[1] << 16), vv[2] | (vv[3] << 16), vv[4] | (vv[5] << 16), vv[6] | (vv[7] << 16)};
            *(LAS u32x4*)(VT + k * 72 + seg * 16 + 8) = (u32x4){vv[8] | (vv[9] << 16), vv[10] | (vv[11] << 16), vv[12] | (vv[13] << 16), vv[14] | (vv[15] << 16)};
            __syncthreads();
#pragma unroll
            for (int r = 0; r < 2; ++r) {
                const int idx = wave + 8 * r, tr = idx >> 2, tc = idx & 3;
                f32x4 acc = {0.f, 0.f, 0.f, 0.f};
                if (tc <= tr) {
#pragma unroll
                    for (int ks = 0; ks < 4; ++ks) {
                        const bf16x8 a = *(const LAS bf16x8*)(QS + (16 * tr + fr) * 136 + ks * 32 + fq * 8), b = *(const LAS bf16x8*)(KS + (16 * tc + fr) * 136 + ks * 32 + fq * 8);
                        acc = __builtin_amdgcn_mfma_f32_16x16x32_bf16(b, a, acc, 0, 0, 0);
                    }
#pragma unroll
                    for (int j = 0; j < 4; ++j) if (16 * tc + 4 * fq + j > 16 * tr + fr) acc[j] = 0.f;
                }
                u32x2 w; w.x = cvt_pk_bf16(acc[0], acc[1]); w.y = cvt_pk_bf16(acc[2], acc[3]);
                *(LAS u32x2*)(PS + (16 * tr + fr) * 72 + 16 * tc + 4 * fq) = w;
            }
            __syncthreads();
            bf16x8 bv[2];
#pragma unroll
            for (int ks = 0; ks < 2; ++ks) bv[ks] = *(const LAS bf16x8*)(VT + (16 * wave + fr) * 72 + ks * 32 + fq * 8);
            f32x4 o[4];
#pragma unroll
            for (int tr = 0; tr < 4; ++tr) {
                f32x4 acc = {0.f, 0.f, 0.f, 0.f};
#pragma unroll
                for (int ks = 0; ks < 2; ++ks) { const bf16x8 a = *(const LAS bf16x8*)(PS + (16 * tr + fr) * 72 + ks * 32 + fq * 8); acc = __builtin_amdgcn_mfma_f32_16x16x32_bf16(bv[ks], a, acc, 0, 0, 0); }
#pragma unroll
                for (int ks = 0; ks < 4; ++ks) { const bf16x8 a = *(const LAS bf16x8*)(QS + (16 * tr + fr) * 136 + ks * 32 + fq * 8); acc = __builtin_amdgcn_mfma_f32_16x16x32_bf16(cur.bs[ks], a, acc, 0, 0, 0); }
                o[tr] = acc;
                float ss = (acc[0] * acc[0] + acc[1] * acc[1]) + (acc[2] * acc[2] + acc[3] * acc[3]);
                ss += __shfl_xor(ss, 16); ss += __shfl_xor(ss, 32);
                if (fq == 0) RS[wave * 64 + 16 * tr + fr] = ss;
            }
            __syncthreads();
            const int ocol = cb + 16 * wave + 4 * fq;
#pragma unroll
            for (int tr = 0; tr < 4; ++tr) {
                const int tl = 16 * tr + fr; float tt = 0.f;
#pragma unroll
                for (int w = 0; w < 8; ++w) tt += RS[w * 64 + tl];
                const float rinv = rsqrtf(tt * (1.f / 128.f) + EPS);
                const u32x2 sg = cur.sgv[tr];
                u32x2 w;
                w.x = cvt_pk_bf16(o[tr][0] * rinv * gn[0] * bflo(sg.x), o[tr][1] * rinv * gn[1] * bfhi(sg.x));
                w.y = cvt_pk_bf16(o[tr][2] * rinv * gn[2] * bflo(sg.y), o[tr][3] * rinv * gn[3] * bfhi(sg.y));
                *(u32x2*)(M.O + (size_t)(t0 + tl) * DM + ocol) = w;
            }
            __syncthreads();
        }
        if (!has) break;
        cur = nxt; unit = un;
    }
}

struct LruIn { float xm3, xm2, xm1; float xr[8]; unsigned gyv[8]; float hin; float cpv; };
__device__ __forceinline__ void lru_load(const Mix& M, int unit, int mode, LruIn& in) {
    const int tid = threadIdx.x, j = tid & 63, seg = tid >> 6;
    const int n = unit & 7, bc = unit >> 3, c = bc & 31, b = bc >> 5, t0 = bc * 64, ch0 = n * 64, ch = ch0 + j, tl0 = seg * 8;
    const bool first = (c == 0 && seg == 0);
    const float* xp = M.XB + (size_t)(t0 + tl0) * DH + ch;
    in.xm3 = first ? 0.f : xp[-3 * DH]; in.xm2 = first ? 0.f : xp[-2 * DH]; in.xm1 = first ? 0.f : xp[-1 * DH];
#pragma unroll
    for (int i = 0; i < 8; ++i) in.xr[i] = xp[i * DH];
    in.hin = (mode == 1) ? M.HST[(size_t)bc * 512 + ch] : 0.f;
#pragma unroll
    for (int i = 0; i < 8; ++i) in.gyv[i] = (mode == 1) ? (unsigned)M.GY[(size_t)(t0 + tl0 + i) * DH + ch] : 0u;
    in.cpv = (mode == 1 && c == 31 && tid < 192) ? M.XB[(size_t)(b * SEQ + SEQ - 3 + (tid >> 6)) * DH + ch0 + j] : 0.f;
}
__device__ __forceinline__ void lru_loop(const Mix& M, int mode, LAS unsigned char* lds) {
    const int tid = threadIdx.x, lane = tid & 63, wave = tid >> 6, fr = lane & 15, fq = lane >> 4, G = gridDim.x;
    const int j = tid & 63, seg = tid >> 6, tl0 = seg * 8;
    LAS bf16_t* XC16 = (LAS bf16_t*)(lds + 16640); LAS float* GR = (LAS float*)(lds + 25856); LAS float* GI = (LAS float*)(lds + 42496);
    LAS float* SEGA = (LAS float*)(lds + 59136); LAS float* SEGU = (LAS float*)(lds + 61184);
    int unit = blockIdx.x; if (unit >= 2048) return;
    const int gate = wave >> 2, tr = wave & 3;
    int ncache = -1; float w0 = 0.f, w1 = 0.f, w2 = 0.f, w3 = 0.f, cbias = 0.f, sp = 0.f; bf16x8 wb[4][2]; float bbv[4];
    LruIn cur; lru_load(M, unit, mode, cur);
    for (;;) {
        const int un = unit + G; const bool has = un < 2048;
        LruIn nxt; if (has) lru_load(M, un, mode, nxt);
        const int n = unit & 7, bc = unit >> 3, c = bc & 31, b = bc >> 5, t0 = bc * 64, ch0 = n * 64, ch = ch0 + j;
        if (n != ncache) {
            ncache = n;
            w0 = M.convw[ch]; w1 = M.convw[512 + ch]; w2 = M.convw[1024 + ch]; w3 = M.convw[1536 + ch]; cbias = M.convb[ch];
            const bf16_t* WT = (gate ? M.WXT : M.WAT) + n * 4096; const float* bias = (gate ? M.bx : M.ba) + ch0;
#pragma unroll
            for (int ct = 0; ct < 4; ++ct) { wb[ct][0] = *(const bf16x8*)(WT + (16 * ct + fr) * 64 + fq * 8); wb[ct][1] = *(const bf16x8*)(WT + (16 * ct + fr) * 64 + 32 + fq * 8); bbv[ct] = bias[16 * ct + fr]; }
            sp = log1pf(__expf(-M.lam[ch]));
        }
        float xm3 = cur.xm3, xm2 = cur.xm2, xm1 = cur.xm1; float xcv[8];
#pragma unroll
        for (int i = 0; i < 8; ++i) {
            const float x = cur.xr[i];
            const float xc = cbias + w0 * xm3 + w1 * xm2 + w2 * xm1 + w3 * x;
            xcv[i] = xc; XC16[(tl0 + i) * 72 + j] = f2bf(xc);
            xm3 = xm2; xm2 = xm1; xm1 = x;
        }
        __syncthreads();
        {
            LAS float* Gd = gate ? GI : GR;
            const bf16x8 a0 = *(const LAS bf16x8*)(XC16 + (16 * tr + fr) * 72 + fq * 8), a1 = *(const LAS bf16x8*)(XC16 + (16 * tr + fr) * 72 + 32 + fq * 8);
#pragma unroll
            for (int ct = 0; ct < 4; ++ct) {
                f32x4 acc = {0.f, 0.f, 0.f, 0.f};
                acc = __builtin_amdgcn_mfma_f32_16x16x32_bf16(a0, wb[ct][0], acc, 0, 0, 0);
                acc = __builtin_amdgcn_mfma_f32_16x16x32_bf16(a1, wb[ct][1], acc, 0, 0, 0);
#pragma unroll
                for (int jj = 0; jj < 4; ++jj) Gd[(16 * tr + 4 * fq + jj) * 65 + 16 * ct + fr] = sigm(acc[jj] + bbv[ct]);
            }
        }
        __syncthreads();
        float av[8], uv[8]; float A = 1.f, U = 0.f;
#pragma unroll
        for (int i = 0; i < 8; ++i) {
            const int tl = tl0 + i; const float r = GR[tl * 65 + j], ig = GI[tl * 65 + j];
            const float la = -8.f * r * sp, a = __expf(la);
            const float x = 2.f * la;
            float pe = 1.f / 5040.f; pe = pe * x + 1.f / 720.f; pe = pe * x + 1.f / 120.f; pe = pe * x + 1.f / 24.f; pe = pe * x + 1.f / 6.f; pe = pe * x + 0.5f; pe = pe * x + 1.f; pe = -pe * x;
            const float om = (x > -0.35f) ? pe : (1.f - a * a);
            float mult = __builtin_amdgcn_sqrtf(fmaxf(om, 0.f));
            if (c == 0 && tl == 0) mult = 1.f;
            const float u = mult * ig * xcv[i];
            av[i] = a; uv[i] = u; U = a * U + u; A *= a;
        }
        SEGA[seg * 64 + j] = A; SEGU[seg * 64 + j] = U;
        __syncthreads();
        float hin = cur.hin;
#pragma unroll
        for (int s = 0; s < 8; ++s) if (s < seg) hin = SEGA[s * 64 + j] * hin + SEGU[s * 64 + j];
        if (mode == 0) {
            if (seg == 7) { float At = 1.f;
#pragma unroll
                for (int s = 0; s < 8; ++s) At *= SEGA[s * 64 + j];
                M.ACH[(size_t)bc * 512 + ch] = At; M.UCH[(size_t)bc * 512 + ch] = A * hin + U; }
        } else {
            float hh = hin;
#pragma unroll
            for (int i = 0; i < 8; ++i) {
                hh = av[i] * hh + uv[i];
                M.O[(size_t)(t0 + tl0 + i) * DM + 512 + ch] = f2bf(hh * __uint_as_float(cur.gyv[i] << 16));
            }
            if (c == 31 && seg == 7) M.out[OUT_LP + b * 512 + ch] = hh;
            if (c == 31 && tid < 192) M.out[OUT_CP + (size_t)(b * 3 + (tid >> 6)) * 512 + ch0 + j] = cur.cpv;
        }
        __syncthreads();
        if (!has) break;
        cur = nxt; unit = un;
    }
}

__device__ __forceinline__ void hgrn_sample_unit(const Mix& M, int unit, LAS unsigned char* lds) {
    const int tid = threadIdx.x, lane = tid & 63, wave = tid >> 6;
    const int h = unit & 3, b = unit >> 2, cb = h * 128, tb = TP + b * 4;
    LAS float* SQ = (LAS float*)lds;
    LAS float* SK = SQ + 512;
    LAS float* SD = SK + 512;
    LAS float* SP = SD + 128;
    LAS float* OP = SP + 32;
    LAS float* RS = OP + 2048;
    const int v = tid & 127, kq = tid >> 7;
    const size_t sb = ((size_t)(b * 4 + h) * 128) * 128;
    float s0v[32];
#pragma unroll
    for (int kx = 0; kx < 32; ++kx) s0v[kx] = M.st_h[sb + (size_t)(kq * 32 + kx) * 128 + v];
    float vv[4];
#pragma unroll
    for (int s = 0; s < 4; ++s) vv[s] = bf2f(M.V[(size_t)(tb + s) * DH + cb + v]);
    const float sgo = bf2f(M.SG[(size_t)(tb + kq) * DH + cb + v]), hno = M.hnorm[cb + v];
    if (tid < 128) {
        const int k = tid;
        const float l0 = M.lb[cb + k], l1 = M.lb[512 + cb + k];
        const float lb = 1.f / (1.f + expf(l1 - l0));
        float cum[4], kk[4], qv[4]; float run = 0.f;
#pragma unroll
        for (int s = 0; s < 4; ++s) {
            const float fz = M.FZ[(size_t)(tb + s) * DH + cb + k];
            const float sg = 1.f / (1.f + expf(-fz)), sn = 1.f / (1.f + expf(fz));
            run += logf(lb + (1.f - lb) * sg); cum[s] = run; kk[s] = (1.f - lb) * sn;
            qv[s] = bf2f(M.Q[(size_t)(tb + s) * DH + cb + k]);
        }
#pragma unroll
        for (int s = 0; s < 4; ++s) { SQ[s * 128 + k] = qv[s] * expf(cum[s]); SK[s * 128 + k] = kk[s] * expf(cum[3] - cum[s]); }
        SD[k] = expf(cum[3]);
        float pr[10]; int c = 0;
#pragma unroll
        for (int t = 0; t < 4; ++t)
#pragma unroll
            for (int s = 0; s <= t; ++s) { pr[c] = qv[t] * kk[s] * expf(cum[t] - cum[s]); ++c; }
#pragma unroll
        for (int i = 0; i < 10; ++i) { const float v = wave_sum(pr[i]); if (lane == 0) SP[wave * 16 + i] = v; }
    }
    __syncthreads();
    {
        float o[4] = {0.f, 0.f, 0.f, 0.f};
#pragma unroll
        for (int kx = 0; kx < 32; ++kx) {
            const int k = kq * 32 + kx;
            const float s0 = s0v[kx];
            float sn = SD[k] * s0;
#pragma unroll
            for (int s = 0; s < 4; ++s) { o[s] += SQ[s * 128 + k] * s0; sn += SK[s * 128 + k] * vv[s]; }
            M.out[OUT_HS + sb + (size_t)k * 128 + v] = sn;
        }
#pragma unroll
        for (int s = 0; s < 4; ++s) OP[(kq * 4 + s) * 128 + v] = o[s];
    }
    __syncthreads();
    {
        const int t = kq;
        float ov = (OP[(0 * 4 + t) * 128 + v] + OP[(1 * 4 + t) * 128 + v]) + (OP[(2 * 4 + t) * 128 + v] + OP[(3 * 4 + t) * 128 + v]);
        const int base = t * (t + 1) / 2;
        for (int s = 0; s <= t; ++s) ov += (SP[base + s] + SP[16 + base + s]) * vv[s];
        const float ssq = wave_sum(ov * ov);
        if (lane == 0) RS[wave] = ssq;
        __syncthreads();
        const float tt = RS[2 * t] + RS[2 * t + 1];
        const float rinv = rsqrtf(tt * (1.f / 128.f) + EPS);
        const size_t tok = (size_t)(tb + t);
        M.O[tok * DM + cb + v] = f2bf(ov * rinv * hno * sgo);
    }
    __syncthreads();
}

__device__ __forceinline__ void lru_sample_unit(const Mix& M, int b, LAS unsigned char* lds) {
    const int tid = threadIdx.x, ch = tid, n = ch >> 6, j = ch & 63, tb = TP + b * 4;
    LAS float* XC = (LAS float*)lds;
    float x[7];
#pragma unroll
    for (int r = 0; r < 3; ++r) x[r] = M.st_c[(size_t)(b * 3 + r) * 512 + ch];
#pragma unroll
    for (int s = 0; s < 4; ++s) x[3 + s] = M.XB[(size_t)(tb + s) * DH + ch];
    const float w0 = M.convw[ch], w1 = M.convw[512 + ch], w2 = M.convw[1024 + ch], w3 = M.convw[1536 + ch], cbias = M.convb[ch];
    float xc[4];
#pragma unroll
    for (int s = 0; s < 4; ++s) { xc[s] = cbias + w0 * x[s] + w1 * x[s + 1] + w2 * x[s + 2] + w3 * x[s + 3]; XC[s * 512 + ch] = xc[s]; }
#pragma unroll
    for (int r = 0; r < 3; ++r) M.out[OUT_CS + (size_t)(b * 3 + r) * 512 + ch] = x[4 + r];
    __syncthreads();
    float ra[4], rx[4];
    const float ba = M.ba[ch], bx = M.bx[ch];
#pragma unroll
    for (int s = 0; s < 4; ++s) { ra[s] = ba; rx[s] = bx; }
    const float* wa = M.wa + (size_t)n * 4096 + j; const float* wx = M.wx + (size_t)n * 4096 + j;
#pragma unroll 16
    for (int i = 0; i < 64; ++i) {
        const float a = wa[i * 64], xw = wx[i * 64];
#pragma unroll
        for (int s = 0; s < 4; ++s) { const float xv = XC[s * 512 + n * 64 + i]; ra[s] += xv * a; rx[s] += xv * xw; }
    }
    const float sp = log1pf(expf(-M.lam[ch]));
    float hh = M.st_l[(size_t)b * 512 + ch];
#pragma unroll
    for (int s = 0; s < 4; ++s) {
        const float r = 1.f / (1.f + expf(-ra[s])), ig = 1.f / (1.f + expf(-rx[s]));
        const float la = -8.f * r * sp, a = expf(la), mult = sqrtf(-expm1f(2.f * la));
        hh = a * hh + mult * ig * xc[s];
        M.O[(size_t)(tb + s) * DM + 512 + ch] = f2bf(hh * bf2f(M.GY[(size_t)(tb + s) * DH + ch]));
    }
    M.out[OUT_LS + (size_t)b * 512 + ch] = hh;
    __syncthreads();
}

__device__ __forceinline__ void scan_item(const Mix& M, int item) {
    const int tid = threadIdx.x;
    if (item < 1024) {
        const int e = item * 512 + tid, bh = e >> 14, vk = e & 16383, b = bh >> 2, h = bh & 3, v = vk >> 7, k = vk & 127;
        float l[32], d[32];
#pragma unroll
        for (int c = 0; c < 32; ++c) { const int unit = (b * 32 + c) * 4 + h; l[c] = bf2f(M.LT[(size_t)unit * 16384 + vk]); d[c] = M.DC[unit * 128 + k]; }
        float S = 0.f;
#pragma unroll
        for (int c = 0; c < 32; ++c) { const int unit = (b * 32 + c) * 4 + h; M.LT[(size_t)unit * 16384 + vk] = f2bf(S); S = d[c] * S + l[c]; }
        M.out[OUT_HP + ((size_t)(b * 4 + h) * 128 + k) * 128 + v] = S;
    } else {
        const int e = (item - 1024) * 512 + tid, b = e >> 9, ch = e & 511;
        float hcar = 0.f;
        for (int c = 0; c < 32; ++c) { const size_t idx = (size_t)(b * 32 + c) * 512 + ch; M.HST[idx] = hcar; hcar = M.ACH[idx] * hcar + M.UCH[idx]; }
    }
}

__global__ void __launch_bounds__(512, 2) mk_fwd(Params p) {
    extern __shared__ __attribute__((aligned(16))) unsigned char lds_raw[];
    LAS unsigned char* lds = (LAS unsigned char*)lds_raw;
    const int lo = p.ph_lo, hi = p.ph_hi, G = gridDim.x;
    unsigned char* ws = p.ws;
#define IN(k) (lo <= (k) && (k) < hi)
    volatile LAS unsigned* xst = (volatile LAS unsigned*)(lds + 131072);
    if (threadIdx.x < 16) xst[threadIdx.x] = 0u;
    __syncthreads();
    XcdBarrier xbar; xbar.bar = (unsigned*)(ws + WS_BAR); xbar.x = 0; xbar.st = xst;
    if (hi - lo > 1) xbar = xcd_barrier_post((unsigned*)(ws + WS_BAR), xst);
    if (hi == 0x7fffffff) cg::this_grid().sync();
#define SEAM(k) do { if (IN(k) && IN((k) + 1)) { xcd_barrier(xbar); } } while (0)
    bf16_t* B0 = (bf16_t*)(ws + WS_B0); bf16_t* B1 = (bf16_t*)(ws + WS_B1); bf16_t* H = (bf16_t*)(ws + WS_H);
    float* SS0 = (float*)(ws + WS_SS0); float* SS1 = (float*)(ws + WS_SS1); float* SS2 = (float*)(ws + WS_SS2); float* SS3 = (float*)(ws + WS_SS3);

    if (IN(0)) { phase0(p, lds); __syncthreads(); }
    SEAM(0);
    if (IN(1)) {
        pg8::Gemm g{B0, (const bf16_t*)(ws + WS_WG1), T_ALL, 2 * DFF, DM}; pg8::StaticOrder S; S.init(T_ALL, 2 * DFF, G, (int)blockIdx.x);
        EpiGateUp E{H, SS0};
        pg8::gemm_phase<EpiGateUp, pg8::StaticOrder, PG8_ALIGN, PG8_SP2>(lds, g, S, E);
        const int rounds = (S.nwg + G - 1) / G, nfull = S.nwg - (rounds - 1) * G;
        if (nfull >= G) convert_set(p, lds, 1, (int)blockIdx.x * 8 + (int)(threadIdx.x >> 6), G * 8);
        else if ((int)blockIdx.x >= nfull) convert_set(p, lds, 1, ((int)blockIdx.x - nfull) * 8 + (int)(threadIdx.x >> 6), (G - nfull) * 8);
        __syncthreads();
    }
    SEAM(1);
    if (IN(2)) {
        pg8::Gemm g{H, (const bf16_t*)(ws + WS_WD1), TP, DM, DFF}; pg8::StaticOrder S; S.init(TP, DM, G, (int)blockIdx.x);
        EpiResid E{p.in[0], p.in[1], p.out, B0, p.in[9], SS1, 0.5f};
        pg8::gemm_phase<EpiResid, pg8::StaticOrder, PG8_ALIGN, PG8_SP2>(lds, g, S, E);
        SmallResid Es{p.in[1] - (size_t)TP * DM, p.out, B0, p.in[9], SS1, 0.5f};
        small_gemm<SmallResid, DFF>(H, (const bf16_t*)(ws + WS_WD1), DM, Es, lds);
    }
    SEAM(2);
    if (IN(3)) {
        pg8::Gemm g{B0, (const bf16_t*)(ws + WS_WIN), TP, DIN, DM}; pg8::StaticOrder S; S.init(TP, DIN, G, (int)blockIdx.x);
        EpiProj E{(bf16_t*)(ws + WS_Q), (bf16_t*)(ws + WS_V), (bf16_t*)(ws + WS_SG), (bf16_t*)(ws + WS_GY), (float*)(ws + WS_FZ), (float*)(ws + WS_XB), SS1};
        pg8::gemm_phase<EpiProj, pg8::StaticOrder, PG8_ALIGN, PG8_SP2>(lds, g, S, E);
        SmallProj Es{(bf16_t*)(ws + WS_Q), (bf16_t*)(ws + WS_V), (bf16_t*)(ws + WS_SG), (bf16_t*)(ws + WS_GY), (float*)(ws + WS_FZ), (float*)(ws + WS_XB), SS1};
        small_gemm<SmallProj, DM>(B0, (const bf16_t*)(ws + WS_WIN), DIN, Es, lds);
    }
    SEAM(3);
    Mix M;
    M.Q = (const bf16_t*)(ws + WS_Q); M.V = (const bf16_t*)(ws + WS_V); M.SG = (const bf16_t*)(ws + WS_SG); M.GY = (const bf16_t*)(ws + WS_GY);
    M.FZ = (const float*)(ws + WS_FZ); M.XB = (const float*)(ws + WS_XB); M.LT = (bf16_t*)(ws + WS_LT); M.DC = (float*)(ws + WS_DC);
    M.ACH = (float*)(ws + WS_ACH); M.UCH = (float*)(ws + WS_UCH); M.HST = (float*)(ws + WS_HST); M.O = B0;
    M.WAT = (const bf16_t*)(ws + WS_WAT); M.WXT = (const bf16_t*)(ws + WS_WXT);
    M.lb = p.in[11]; M.hnorm = p.in[12]; M.convw = p.in[13]; M.convb = p.in[14]; M.wa = p.in[15]; M.ba = p.in[16]; M.wx = p.in[17]; M.bx = p.in[18]; M.lam = p.in[19];
    M.st_h = p.in[2]; M.st_l = p.in[3]; M.st_c = p.in[4]; M.out = p.out;
    if (IN(4)) {
        for (int u = blockIdx.x; u < 512; u += G) hgrn_sample_unit(M, u, lds);
        hgrn_loop<0>(M, lds);
        lru_loop(M, 0, lds);
        for (int u = G - 1 - (int)blockIdx.x; u < 128; u += G) lru_sample_unit(M, u, lds);
    }
    SEAM(4);
    if (IN(5)) { for (int it = blockIdx.x; it < 1032; it += G) scan_item(M, it); convert_set(p, lds, 2, (int)blockIdx.x * 8 + (int)(threadIdx.x >> 6), G * 8); __syncthreads(); }
    SEAM(5);
    if (IN(6)) {
        hgrn_loop<1>(M, lds);
        lru_loop(M, 1, lds);
    }
    SEAM(6);
    if (IN(7)) {
        pg8::Gemm g{B0, (const bf16_t*)(ws + WS_WO), TP, DM, DM}; pg8::StaticOrder S; S.init(TP, DM, G, (int)blockIdx.x);
        EpiResid E{p.out, p.out + (size_t)TP * DM, p.out, B1, p.in[21], SS2, 1.0f};
        pg8::gemm_phase<EpiResid, pg8::StaticOrder, PG8_ALIGN, PG8_SP2>(lds, g, S, E);
        SmallResid Es{p.out, p.out, B1, p.in[21], SS2, 1.0f};
        small_gemm<SmallResid, DM>(B0, (const bf16_t*)(ws + WS_WO), DM, Es, lds);
    }
    SEAM(7);
    if (IN(8)) {
        pg8::Gemm g{B1, (const bf16_t*)(ws + WS_WG2), T_ALL, 2 * DFF, DM}; pg8::StaticOrder S; S.init(T_ALL, 2 * DFF, G, (int)blockIdx.x);
        EpiGateUp E{H, SS2};
        pg8::gemm_phase<EpiGateUp, pg8::StaticOrder, PG8_ALIGN, PG8_SP2>(lds, g, S, E);
    }
    SEAM(8);
    if (IN(9)) {
        pg8::Gemm g{H, (const bf16_t*)(ws + WS_WD2), TP, DM, DFF}; pg8::StaticOrder S; S.init(TP, DM, G, (int)blockIdx.x);
        EpiResid E{p.out, p.out + (size_t)TP * DM, p.out, nullptr, nullptr, SS3, 0.5f};
        pg8::gemm_phase<EpiResid, pg8::StaticOrder, PG8_ALIGN, PG8_SP2>(lds, g, S, E);
        SmallResid Es{p.out, p.out, nullptr, nullptr, SS3, 0.5f};
        small_gemm<SmallResid, DFF>(H, (const bf16_t*)(ws + WS_WD2), DM, Es, lds);
    }
    SEAM(9);
    if (IN(10)) phase_final(p);
#undef IN
#undef SEAM
}

extern "C" void kernel_launch(void* const* d_in, const int* in_sizes, int n_in, void* d_out, int out_size, void* d_ws, size_t ws_size, hipStream_t stream) {
    static int grid = 0;
    if (grid == 0) {
        if (n_in != 26 || ws_size < WS_END2) { fprintf(stderr, "kernel_launch: unexpected n_in %d or ws_size %zu (need %zu)\n", n_in, ws_size, (size_t)WS_END2); grid = -1; return; }
        int dev = 0, cus = 0, per_cu = 0;
        hipGetDevice(&dev); hipDeviceGetAttribute(&cus, hipDeviceAttributeMultiprocessorCount, dev);
        if (hipFuncSetAttribute((const void*)mk_fwd, hipFuncAttributeMaxDynamicSharedMemorySize, LDS_BYTES) != hipSuccess) { fprintf(stderr, "kernel_launch: hipFuncSetAttribute failed\n"); grid = -1; return; }
        if (hipOccupancyMaxActiveBlocksPerMultiprocessor(&per_cu, (const void*)mk_fwd, 512, LDS_BYTES) != hipSuccess || per_cu < 1) { fprintf(stderr, "kernel_launch: occupancy query says %d\n", per_cu); per_cu = 1; }
        (void)hipGetLastError();
        grid = cus;
    }
    if (grid < 0) return;
    Params p{};
    for (int i = 0; i < 26; ++i) p.in[i] = (const float*)d_in[i];
    p.out = (float*)d_out; p.ws = (unsigned char*)d_ws;
#if MK_PER_PHASE
    for (int ph = 0; ph < MK_NPH; ++ph) { p.ph_lo = ph; p.ph_hi = ph + 1; hipLaunchKernelGGL(mk_fwd, dim3(grid), dim3(512), LDS_BYTES, stream, p); if ((MK_DUP >> ph) & 1) hipLaunchKernelGGL(mk_fwd, dim3(grid), dim3(512), LDS_BYTES, stream, p); }
#else
    p.ph_lo = 0; p.ph_hi = MK_NPH;
    if (hipMemsetAsync((char*)d_ws + WS_BAR, 0, 16384, stream) != hipSuccess) { fprintf(stderr, "memset failed\n"); return; }
    void* args[] = {&p};
    hipError_t e = hipLaunchCooperativeKernel((const void*)mk_fwd, dim3(grid), dim3(512), args, LDS_BYTES, stream);
    if (e != hipSuccess) fprintf(stderr, "cooperative launch failed: %s (grid %d)\n", hipGetErrorString(e), grid);
#endif
}
```

```cpp
#include <hip/hip_runtime.h>
#include <hip/hip_cooperative_groups.h>
#include <cstdio>
#include <cstdint>
namespace cg = cooperative_groups;

#ifndef MK_DUP
#define MK_DUP 0
#endif
#ifndef MK_NPH
#define MK_NPH 11
#endif
#ifndef MK_PER_PHASE
#define MK_PER_PHASE 0
#endif

#define LAS __attribute__((address_space(3)))
typedef unsigned short bf16_t;
typedef short bf16x8 __attribute__((ext_vector_type(8)));
typedef float f32x4 __attribute__((ext_vector_type(4)));
typedef unsigned u32x4 __attribute__((ext_vector_type(4)));
typedef unsigned u32x2 __attribute__((ext_vector_type(2)));

constexpr int T_ALL = 16896, TP = 16384, DM = 1024, DFF = 2816, DIN = 3072, DH = 512;
constexpr int SEQ = 2048, NB = 8, NCH = 32, DECB = 128;
constexpr float EPS = 1e-6f;

constexpr size_t OUT_Y = 0, OUT_HP = 17301504, OUT_LP = 17825792, OUT_CP = 17829888, OUT_HS = 17842176, OUT_LS = 26230784, OUT_CS = 26296320;

constexpr size_t WS_WG1 = 0;
constexpr size_t WS_WD1 = WS_WG1 + (size_t)5632 * 1024 * 2;
constexpr size_t WS_WIN = WS_WD1 + (size_t)1024 * 2816 * 2;
constexpr size_t WS_WO  = WS_WIN + (size_t)3072 * 1024 * 2;
constexpr size_t WS_WG2 = WS_WO + (size_t)1024 * 1024 * 2;
constexpr size_t WS_WD2 = WS_WG2 + (size_t)5632 * 1024 * 2;
constexpr size_t WS_WAT = WS_WD2 + (size_t)1024 * 2816 * 2;
constexpr size_t WS_WXT = WS_WAT + 65536;
constexpr size_t WS_SS0 = WS_WXT + 65536;
constexpr size_t SS_BYTES = (size_t)T_ALL * 16 * 4;
constexpr size_t WS_SS1 = WS_SS0 + SS_BYTES, WS_SS2 = WS_SS1 + SS_BYTES, WS_SS3 = WS_SS2 + SS_BYTES;
constexpr size_t WS_DC  = WS_SS3 + SS_BYTES;
constexpr size_t WS_ACH = WS_DC + (size_t)1024 * 128 * 4;
constexpr size_t WS_UCH = WS_ACH + (size_t)NB * NCH * 512 * 4;
constexpr size_t WS_HST = WS_UCH + (size_t)NB * NCH * 512 * 4;
constexpr size_t WS_B0  = WS_HST + (size_t)NB * NCH * 512 * 4;
constexpr size_t WS_R   = WS_B0 + (size_t)T_ALL * 1024 * 2;
constexpr size_t WS_H   = WS_R;
constexpr size_t WS_B1  = WS_H + (size_t)T_ALL * 2816 * 2;
constexpr size_t WS_Q   = WS_R;
constexpr size_t WS_V   = WS_Q + (size_t)T_ALL * 512 * 2;
constexpr size_t WS_SG  = WS_V + (size_t)T_ALL * 512 * 2;
constexpr size_t WS_GY  = WS_SG + (size_t)T_ALL * 512 * 2;
constexpr size_t WS_FZ  = WS_GY + (size_t)T_ALL * 512 * 2;
constexpr size_t WS_XB  = WS_FZ + (size_t)T_ALL * 512 * 4;
constexpr size_t WS_LT  = WS_XB + (size_t)T_ALL * 512 * 4;
constexpr size_t WS_END = WS_LT + (size_t)1024 * 16384 * 2;
constexpr size_t WS_BAR = WS_END;
constexpr size_t WS_END2 = WS_BAR + 16384;
static_assert(WS_END2 <= 268435456, "workspace budget");
static_assert(WS_B1 + (size_t)T_ALL * 1024 * 2 <= WS_END, "B1 inside R");

constexpr int LDS_BYTES = 131072 + 64;

typedef __bf16 nbf16x2 __attribute__((ext_vector_type(2)));
typedef float f32x2 __attribute__((ext_vector_type(2)));
__device__ __forceinline__ unsigned cvt_pk_bf16(float lo, float hi) { const nbf16x2 r = __builtin_convertvector((f32x2){lo, hi}, nbf16x2); return __builtin_bit_cast(unsigned, r); }
__device__ __forceinline__ bf16_t f2bf(float f) { return (bf16_t)(cvt_pk_bf16(f, 0.f) & 0xffffu); }
__device__ __forceinline__ float bf2f(bf16_t b) { return __uint_as_float(((unsigned)b) << 16); }
__device__ __forceinline__ float bflo(unsigned w) { return __uint_as_float(w << 16); }
__device__ __forceinline__ float bfhi(unsigned w) { return __uint_as_float(w & 0xffff0000u); }
__device__ __forceinline__ float sigm(float x) { return __builtin_amdgcn_rcpf(1.f + __expf(-x)); }
__device__ __forceinline__ float rowscale(const float* ss, int row) {
    const f32x4* p = (const f32x4*)(ss + (size_t)row * 16);
    const f32x4 a = p[0], b = p[1], c = p[2], d = p[3];
    const float s = (((a.x + a.y) + (a.z + a.w)) + ((b.x + b.y) + (b.z + b.w))) + (((c.x + c.y) + (c.z + c.w)) + ((d.x + d.y) + (d.z + d.w)));
    return rsqrtf(s * (1.f / 1024.f) + EPS);
}
__device__ __forceinline__ void rowscale8(const float* ss, int row0, int fq, float (&rs)[8]) {
    f32x4 q[8];
#pragma unroll
    for (int i = 0; i < 8; ++i) q[i] = *(const f32x4*)(ss + (size_t)(row0 + (i >> 2) * 128 + (i & 3) * 16) * 16 + 4 * fq);
#pragma unroll
    for (int i = 0; i < 8; ++i) { float t = (q[i].x + q[i].y) + (q[i].z + q[i].w); t += __shfl_xor(t, 16); t += __shfl_xor(t, 32); rs[i] = rsqrtf(t * (1.f / 1024.f) + EPS); }
}
__device__ __forceinline__ float wave_sum(float v) {
#pragma unroll
    for (int o = 1; o < 64; o <<= 1) v += __shfl_xor(v, o);
    return v;
}
#define LDS_WAIT() asm volatile("s_waitcnt lgkmcnt(0)" ::: "memory")

namespace pg8 {
constexpr int BM = 256, BK = 64, HALF = 128, HTB = HALF * BK * 2, STAGE_BYTES = 8 * HTB, NXCD = 8, WGM = 8;
__host__ __device__ __forceinline__ int lds_byte(int r, int c) { const int st = (r >> 4) * 2 + (c >> 5), rr = r & 15, cc = c & 31, ob = rr * 64 + cc * 2; return st * 1024 + (ob ^ (((ob >> 9) & 1) << 5)); }
__host__ __device__ __forceinline__ void stage_rc(int b, int& R, int& C) { const int st = b / 1024, sb = b % 1024, swz = sb ^ (((sb >> 9) & 1) << 5); R = (st >> 1) * 16 + swz / 64; C = (st & 1) * 32 + (swz % 64) / 2; }
__host__ __device__ __forceinline__ int perm32(int rho) { const int n = rho >> 4, i = rho & 15; return 8 * (i >> 2) + 4 * n + (i & 3); }
struct Unit { int pm, pn; };
struct Gemm { const bf16_t* A; const bf16_t* Bt; int M, N, K; };
struct StaticOrder {
    int nM, nN, nwg, G, c;
    __host__ __device__ void init(int M, int N, int G_, int c_) { nM = M / BM; nN = N / BM; nwg = nM * nN; G = G_; c = c_; }
    __host__ __device__ bool next(int i, Unit& u) const {
        const long L = (long)i * G + c; if (L >= nwg) return false;
        int wgid = (int)L; { const int q = nwg / NXCD, r = nwg % NXCD, xcd = wgid % NXCD, off = wgid / NXCD; wgid = (xcd < r ? xcd * (q + 1) : r * (q + 1) + (xcd - r) * q) + off; }
        const int nig = WGM * nN, gid = wgid / nig, fm = gid * WGM, gsz = (nM - fm) < WGM ? (nM - fm) : WGM;
        u.pm = fm + ((wgid % nig) % gsz); u.pn = (wgid % nig) / gsz; return true;
    }
    __device__ __forceinline__ void a_ready(const Unit&) const {}
    __device__ __forceinline__ void done(const Unit&) const {}
};

template <class Epi, class Sched, bool ALIGN_EPI = false, bool SP2 = false>
__device__ __forceinline__ void gemm_phase(LAS unsigned char* lds, const Gemm g, const Sched& S, const Epi& E) {
    const int tid = threadIdx.x, wid = __builtin_amdgcn_readfirstlane(tid >> 6), lane = tid & 63, wr = wid >> 2, wc = wid & 3, fr = lane & 15, fq = lane >> 4;
    const int K = g.K, nt = K / BK;
    unsigned voffA[2], voffB[2];
#pragma unroll
    for (int i = 0; i < 2; ++i) { int R, C; stage_rc(tid * 16 + i * 8192, R, C); const int Rb = Epi::PERM ? ((R & ~31) + perm32(R & 31)) : R;
        voffA[i] = (unsigned)(R * K + C) * 2u; voffB[i] = (unsigned)(Rb * K + C) * 2u; }
    const size_t kstep = (size_t)(BK * 2);
    const size_t hstep = (size_t)HALF * K * 2;
    const size_t tstep = 2 * hstep;
    const unsigned ldsw = (unsigned)wid * 1024u;
    const int aoff = lds_byte(wr * 64 + fr, fq * 8), boff = lds_byte(wc * 32 + fr, fq * 8);
#define PG8_SA(b, h) (((b) * 2 + (h)) * HTB)
#define PG8_SB(b, h) ((4 + (b) * 2 + (h)) * HTB)
#define PG8_STAGE(bufoff, gbase, voff) do { _Pragma("unroll") for (int _i = 0; _i < 2; ++_i) \
        __builtin_amdgcn_global_load_lds((const unsigned*)((const char*)(gbase) + (voff)[_i]), (LAS unsigned*)(lds + (bufoff) + ldsw + _i * 8192), 16, 0, 0); } while (0)
#define PG8_LDA(dst, b, h) do { _Pragma("unroll") for (int m = 0; m < 4; ++m) _Pragma("unroll") for (int k = 0; k < 2; ++k) dst[m][k] = *(const LAS bf16x8*)(lds + PG8_SA(b, h) + aoff + m * 2048 + k * 1024); } while (0)
#define PG8_LDB(dst, b, h) do { _Pragma("unroll") for (int n = 0; n < 2; ++n) _Pragma("unroll") for (int k = 0; k < 2; ++k) dst[n][k] = *(const LAS bf16x8*)(lds + PG8_SB(b, h) + boff + n * 2048 + k * 1024); } while (0)
#define PG8_MMA(ai, bj, At, Bt) do { __builtin_amdgcn_s_setprio(1); _Pragma("unroll") for (int m = 0; m < 4; ++m) _Pragma("unroll") for (int n = 0; n < 2; ++n) _Pragma("unroll") for (int k = 0; k < 2; ++k) \
        acc[ai][bj][m][n] = __builtin_amdgcn_mfma_f32_16x16x32_bf16(Bt[n][k], At[m][k], acc[ai][bj][m][n], 0, 0, 0); __builtin_amdgcn_s_setprio(0); } while (0)
#define PG8_WAIT_V(n) asm volatile("s_waitcnt vmcnt(" #n ")" ::: "memory")
#define PG8_WAIT_L(n) asm volatile("s_waitcnt lgkmcnt(" #n ")" ::: "memory")
#define PG8_BAR __builtin_amdgcn_s_barrier()
#define PG8_SCHED __builtin_amdgcn_sched_barrier(0)
    Unit cur, nxt; int ui = 0;
    if (!S.next(0, cur)) return;
    f32x4 acc[2][2][4][2];
#pragma unroll
    for (int a = 0; a < 2; ++a)
#pragma unroll
        for (int b = 0; b < 2; ++b)
#pragma unroll
            for (int m = 0; m < 4; ++m)
#pragma unroll
                for (int n = 0; n < 2; ++n) acc[a][b][m][n] = (f32x4){0.f, 0.f, 0.f, 0.f};
    bf16x8 At[4][2], B0[2][2], B1[2][2];
    const char* cA = (const char*)g.A + (size_t)cur.pm * tstep; const char* cB = (const char*)g.Bt + (size_t)cur.pn * tstep;
    S.a_ready(cur);
    if constexpr (SP2) {
        PG8_STAGE(PG8_SB(0, 0), cB, voffB); PG8_STAGE(PG8_SB(0, 1), cB + hstep, voffB); PG8_STAGE(PG8_SA(0, 0), cA, voffA); PG8_STAGE(PG8_SA(0, 1), cA + hstep, voffA);
        if (wr == 1) PG8_BAR;
        PG8_WAIT_V(2); PG8_BAR;
        PG8_STAGE(PG8_SB(1, 0), cB + kstep, voffB); PG8_STAGE(PG8_SA(1, 0), cA + kstep, voffA); PG8_STAGE(PG8_SB(1, 1), cB + hstep + kstep, voffB);
        PG8_WAIT_V(6); PG8_BAR;
    } else {
        PG8_STAGE(PG8_SB(0, 0), cB, voffB); PG8_STAGE(PG8_SA(0, 0), cA, voffA); PG8_STAGE(PG8_SB(0, 1), cB + hstep, voffB); PG8_STAGE(PG8_SA(0, 1), cA + hstep, voffA);
        if (wr == 1) PG8_BAR;
        PG8_WAIT_V(4); PG8_BAR;
        PG8_STAGE(PG8_SB(1, 0), cB + kstep, voffB); PG8_STAGE(PG8_SA(1, 0), cA + kstep, voffA); PG8_STAGE(PG8_SB(1, 1), cB + hstep + kstep, voffB);
        PG8_WAIT_V(6); PG8_BAR;
    }
    for (;;) {
        const bool has_next = S.next(ui + 1, nxt);
        const char* nA = has_next ? (const char*)g.A + (size_t)nxt.pm * tstep : cA; const char* nB = has_next ? (const char*)g.Bt + (size_t)nxt.pn * tstep : cB;
        for (int t = 0; t < nt; t += 2) {
            const bool last = (t == nt - 2);
            const char* a1 = cA + (size_t)(t + 1) * kstep;
            const char* a2 = last ? nA : cA + (size_t)(t + 2) * kstep; const char* b2 = last ? nB : cB + (size_t)(t + 2) * kstep;
            const char* a3 = a2 + kstep; const char* b3 = b2 + kstep;
            if (last && has_next) S.a_ready(nxt);
            if constexpr (SP2) {
            PG8_LDB(B0, 0, 0); PG8_LDB(B1, 0, 1); PG8_SCHED; PG8_LDA(At, 0, 0); PG8_STAGE(PG8_SA(1, 1), a1 + hstep, voffA);
            PG8_WAIT_V(8); PG8_WAIT_L(0); PG8_BAR; PG8_MMA(0, 0, At, B0); PG8_MMA(0, 1, At, B1); PG8_BAR; PG8_SCHED;
            PG8_LDA(At, 0, 1); PG8_STAGE(PG8_SB(0, 0), b2, voffB); PG8_STAGE(PG8_SB(0, 1), b2 + hstep, voffB); PG8_STAGE(PG8_SA(0, 0), a2, voffA);
            PG8_WAIT_V(8); PG8_WAIT_L(0); PG8_BAR; PG8_MMA(1, 0, At, B0); PG8_MMA(1, 1, At, B1); PG8_BAR; PG8_SCHED;
            PG8_LDB(B0, 1, 0); PG8_LDB(B1, 1, 1); PG8_SCHED; PG8_LDA(At, 1, 0); PG8_STAGE(PG8_SA(0, 1), a2 + hstep, voffA);
            PG8_WAIT_V(8); PG8_WAIT_L(0); PG8_BAR; PG8_MMA(0, 0, At, B0); PG8_MMA(0, 1, At, B1); PG8_BAR; PG8_SCHED;
            PG8_LDA(At, 1, 1); PG8_STAGE(PG8_SB(1, 0), b3, voffB); PG8_STAGE(PG8_SB(1, 1), b3 + hstep, voffB); PG8_STAGE(PG8_SA(1, 0), a3, voffA);
            PG8_WAIT_V(8); PG8_WAIT_L(0); PG8_BAR; PG8_MMA(1, 0, At, B0); PG8_MMA(1, 1, At, B1); PG8_BAR; PG8_SCHED;
            } else {
            PG8_LDB(B0, 0, 0); PG8_SCHED; PG8_LDA(At, 0, 0); PG8_STAGE(PG8_SA(1, 1), a1 + hstep, voffA);
            PG8_WAIT_L(8); PG8_BAR; PG8_WAIT_L(0); PG8_MMA(0, 0, At, B0); PG8_BAR; PG8_SCHED;
            PG8_LDB(B1, 0, 1); PG8_STAGE(PG8_SB(0, 0), b2, voffB);
            PG8_BAR; PG8_WAIT_L(0); PG8_MMA(0, 1, At, B1); PG8_BAR;
            PG8_LDA(At, 0, 1); PG8_STAGE(PG8_SA(0, 0), a2, voffA);
            PG8_BAR; PG8_WAIT_L(0); PG8_MMA(1, 0, At, B0); PG8_BAR; PG8_SCHED;
            PG8_STAGE(PG8_SB(0, 1), b2 + hstep, voffB);
            PG8_WAIT_V(6); PG8_BAR; PG8_MMA(1, 1, At, B1); PG8_BAR;
            PG8_LDB(B0, 1, 0); PG8_SCHED; PG8_LDA(At, 1, 0); PG8_STAGE(PG8_SA(0, 1), a2 + hstep, voffA);
            PG8_WAIT_L(8); PG8_BAR; PG8_WAIT_L(0); PG8_MMA(0, 0, At, B0); PG8_BAR; PG8_SCHED;
            PG8_LDB(B1, 1, 1); PG8_STAGE(PG8_SB(1, 0), b3, voffB);
            PG8_BAR; PG8_WAIT_L(0); PG8_MMA(0, 1, At, B1); PG8_BAR;
            PG8_LDA(At, 1, 1); PG8_STAGE(PG8_SA(1, 0), a3, voffA);
            PG8_BAR; PG8_WAIT_L(0); PG8_MMA(1, 0, At, B0); PG8_BAR; PG8_SCHED;
            PG8_STAGE(PG8_SB(1, 1), b3 + hstep, voffB);
            PG8_WAIT_V(6); PG8_BAR; PG8_MMA(1, 1, At, B1); PG8_BAR;
            }
        }
        if constexpr (ALIGN_EPI) { if (wr == 0) PG8_BAR; }
        E(acc, cur, wr, wc, fr, fq); S.done(cur);
        if (!has_next) break;
#pragma unroll
        for (int a = 0; a < 2; ++a)
#pragma unroll
            for (int b = 0; b < 2; ++b)
#pragma unroll
                for (int m = 0; m < 4; ++m)
#pragma unroll
                    for (int n = 0; n < 2; ++n) acc[a][b][m][n] = (f32x4){0.f, 0.f, 0.f, 0.f};
        cur = nxt; cA = nA; cB = nB; ++ui;
        if constexpr (ALIGN_EPI) { if (wr == 1) PG8_BAR; }
    }
    PG8_WAIT_V(0);
    if constexpr (!ALIGN_EPI) { if (wr == 0) PG8_BAR; }
    PG8_BAR;
#undef PG8_SA
#undef PG8_SB
#undef PG8_STAGE
#undef PG8_LDA
#undef PG8_LDB
#undef PG8_MMA
#undef PG8_WAIT_V
#undef PG8_WAIT_L
#undef PG8_BAR
#undef PG8_SCHED
}
}

#ifndef PG8_SP2
#define PG8_SP2 true
#endif
#ifndef PG8_ALIGN
#define PG8_ALIGN true
#endif

struct EpiGateUp {
    static constexpr bool PERM = true;
    bf16_t* H; const float* ss;
    __device__ __forceinline__ void operator()(const f32x4 (&acc)[2][2][4][2], const pg8::Unit& u, int wr, int wc, int fr, int fq) const {
        const int row0 = u.pm * 256 + wr * 64 + fr, col0 = u.pn * 128 + wc * 32 + 8 * fq;
        float rsv[8]; rowscale8(ss, row0, fq, rsv);
#pragma unroll
        for (int ai = 0; ai < 2; ++ai)
#pragma unroll
            for (int m = 0; m < 4; ++m) {
                const int row = row0 + ai * 128 + m * 16; const float rs = rsv[ai * 4 + m];
                float h[8];
#pragma unroll
                for (int n = 0; n < 2; ++n)
#pragma unroll
                    for (int j = 0; j < 4; ++j) { const float g = acc[ai][0][m][n][j] * rs, up = acc[ai][1][m][n][j] * rs; h[n * 4 + j] = g * sigm(g) * up; }
                u32x4 w; w.x = cvt_pk_bf16(h[0], h[1]); w.y = cvt_pk_bf16(h[2], h[3]); w.z = cvt_pk_bf16(h[4], h[5]); w.w = cvt_pk_bf16(h[6], h[7]);
                *(u32x4*)(H + (size_t)row * DFF + col0) = w;
            }
    }
};
struct EpiResid {
    static constexpr bool PERM = true;
    const float* xin_p; const float* xin_s; float* xout; bf16_t* ax; const float* gnext; float* ssout; float scale;
    __device__ __forceinline__ void operator()(const f32x4 (&acc)[2][2][4][2], const pg8::Unit& u, int wr, int wc, int fr, int fq) const {
        const int row0 = u.pm * 256 + wr * 64 + fr, col0 = u.pn * 256 + wc * 32 + 8 * fq;
        const float* xb = (u.pm < 64) ? xin_p : (xin_s - (size_t)TP * DM);
        f32x4 gn[2][2];
#pragma unroll
        for (int bj = 0; bj < 2; ++bj)
#pragma unroll
            for (int n = 0; n < 2; ++n) gn[bj][n] = ax ? *(const f32x4*)(gnext + col0 + bj * 128 + 4 * n) : (f32x4){1.f, 1.f, 1.f, 1.f};
#pragma unroll
        for (int ai = 0; ai < 2; ++ai) {
            f32x4 xr[4][2][2];
#pragma unroll
            for (int m = 0; m < 4; ++m)
#pragma unroll
                for (int bj = 0; bj < 2; ++bj) { const float* px = xb + (size_t)(row0 + ai * 128 + m * 16) * DM + col0 + bj * 128; xr[m][bj][0] = *(const f32x4*)px; xr[m][bj][1] = *(const f32x4*)(px + 4); }
#pragma unroll
            for (int m = 0; m < 4; ++m) {
                const int row = row0 + ai * 128 + m * 16; const size_t off = (size_t)row * DM + col0; float sq = 0.f;
#pragma unroll
                for (int bj = 0; bj < 2; ++bj) {
                    const f32x4 x0 = xr[m][bj][0], x1 = xr[m][bj][1];
                    const f32x4 v0 = x0 + acc[ai][bj][m][0] * scale, v1 = x1 + acc[ai][bj][m][1] * scale;
                    *(f32x4*)(xout + off + bj * 128) = v0; *(f32x4*)(xout + off + bj * 128 + 4) = v1;
                    sq += ((v0[0] * v0[0] + v0[1] * v0[1]) + (v0[2] * v0[2] + v0[3] * v0[3])) + ((v1[0] * v1[0] + v1[1] * v1[1]) + (v1[2] * v1[2] + v1[3] * v1[3]));
                    if (ax) { const f32x4 a0 = v0 * gn[bj][0], a1 = v1 * gn[bj][1];
                        u32x4 w; w.x = cvt_pk_bf16(a0[0], a0[1]); w.y = cvt_pk_bf16(a0[2], a0[3]); w.z = cvt_pk_bf16(a1[0], a1[1]); w.w = cvt_pk_bf16(a1[2], a1[3]);
                        *(u32x4*)(ax + off + bj * 128) = w; }
                }
                sq += __shfl_xor(sq, 16); sq += __shfl_xor(sq, 32);
                if (fq == 0) ssout[(size_t)row * 16 + u.pn * 4 + wc] = sq;
            }
        }
    }
};
struct EpiProj {
    static constexpr bool PERM = true;
    bf16_t *Q, *V, *SG, *GY; float *FZ, *XB; const float* ss;
    __device__ __forceinline__ void operator()(const f32x4 (&acc)[2][2][4][2], const pg8::Unit& u, int wr, int wc, int fr, int fq) const {
        const int seg = u.pn >> 1;
        const int row0 = u.pm * 256 + wr * 64 + fr, col0 = (u.pn & 1) * 256 + wc * 32 + 8 * fq;
        float* fdst = (seg == 1) ? FZ : XB;
        bf16_t* bdst = (seg == 0) ? Q : (seg == 2) ? V : (seg == 3) ? SG : GY;
        const bool isf = (seg == 1) || (seg == 4);
        float rsv[8]; rowscale8(ss, row0, fq, rsv);
#pragma unroll
        for (int ai = 0; ai < 2; ++ai)
#pragma unroll
            for (int m = 0; m < 4; ++m) {
                const int row = row0 + ai * 128 + m * 16; const float rs = rsv[ai * 4 + m]; const size_t off = (size_t)row * DH + col0;
#pragma unroll
                for (int bj = 0; bj < 2; ++bj) {
                    f32x4 v0 = acc[ai][bj][m][0] * rs, v1 = acc[ai][bj][m][1] * rs;
                    if (isf) { *(f32x4*)(fdst + off + bj * 128) = v0; *(f32x4*)(fdst + off + bj * 128 + 4) = v1; }
                    else {
                        float h[8] = {v0[0], v0[1], v0[2], v0[3], v1[0], v1[1], v1[2], v1[3]};
                        if (seg == 0) {
#pragma unroll
                            for (int j = 0; j < 8; ++j) h[j] = h[j] * sigm(h[j]);
                        } else if (seg == 3) {
#pragma unroll
                            for (int j = 0; j < 8; ++j) h[j] = sigm(h[j]);
                        } else if (seg == 5) {
#pragma unroll
                            for (int j = 0; j < 8; ++j) { const float y = h[j]; h[j] = y * sigm(1.5957691216f * (y + 0.044715f * y * y * y)); }
                        }
                        u32x4 w; w.x = cvt_pk_bf16(h[0], h[1]); w.y = cvt_pk_bf16(h[2], h[3]); w.z = cvt_pk_bf16(h[4], h[5]); w.w = cvt_pk_bf16(h[6], h[7]);
                        *(u32x4*)(bdst + off + bj * 128) = w;
                    }
                }
            }
    }
};


struct SmallResid {
    const float* xin; float* xout; bf16_t* ax; const float* gnext; float* ssout; float scale;
    __device__ __forceinline__ void apply(const f32x4& acc, int grow, int c, int cn, int c16, int r16, int fr, int fq, LAS unsigned char* lds) const {
        const size_t off = (size_t)grow * DM + c;
        const f32x4 x = *(const f32x4*)(xin + off);
        const f32x4 v = x + acc * scale;
        *(f32x4*)(xout + off) = v;
        float sq = (v[0] * v[0] + v[1] * v[1]) + (v[2] * v[2] + v[3] * v[3]);
        if (ax) { const f32x4 g = *(const f32x4*)(gnext + c); const f32x4 a = v * g; u32x2 w; w.x = cvt_pk_bf16(a[0], a[1]); w.y = cvt_pk_bf16(a[2], a[3]); *(u32x2*)(ax + off) = w; }
        sq += __shfl_xor(sq, 16); sq += __shfl_xor(sq, 32);
        LAS float* P = (LAS float*)lds;
        if (fq == 0) P[(r16 * 16 + fr) * 4 + c16] = sq;
        __syncthreads();
        if (c16 == 0 && fq == 0) { const LAS float* q = P + (r16 * 16 + fr) * 4; ssout[(size_t)grow * 16 + cn] = (q[0] + q[1]) + (q[2] + q[3]); }
        __syncthreads();
    }
};
struct SmallProj {
    bf16_t *Q, *V, *SG, *GY; float *FZ, *XB; const float* ss;
    __device__ __forceinline__ void apply(const f32x4& acc, int grow, int c, int cn, int c16, int r16, int fr, int fq, LAS unsigned char* lds) const {
        const int seg = cn >> 3, cs = c & 511;
        const float rs = rowscale(ss, grow);
        const f32x4 v = acc * rs;
        const size_t off = (size_t)grow * DH + cs;
        if (seg == 1 || seg == 4) { *(f32x4*)(((seg == 1) ? FZ : XB) + off) = v; }
        else {
            float h[4] = {v[0], v[1], v[2], v[3]};
            if (seg == 0) {
#pragma unroll
                for (int j = 0; j < 4; ++j) h[j] = h[j] * sigm(h[j]);
            } else if (seg == 3) {
#pragma unroll
                for (int j = 0; j < 4; ++j) h[j] = sigm(h[j]);
            } else if (seg == 5) {
#pragma unroll
                for (int j = 0; j < 4; ++j) { const float y = h[j]; h[j] = y * sigm(1.5957691216f * (y + 0.044715f * y * y * y)); }
            }
            bf16_t* bdst = (seg == 0) ? Q : (seg == 2) ? V : (seg == 3) ? SG : GY;
            u32x2 w; w.x = cvt_pk_bf16(h[0], h[1]); w.y = cvt_pk_bf16(h[2], h[3]);
            *(u32x2*)(bdst + off) = w;
        }
    }
};
template <class Epi, int K>
__device__ __forceinline__ void small_gemm(const bf16_t* A, const bf16_t* Bt, int N, const Epi& E, LAS unsigned char* lds) {
    const int tid = threadIdx.x, lane = tid & 63, wave = tid >> 6, fr = lane & 15, fq = lane >> 4, r16 = wave >> 2, c16 = wave & 3;
    constexpr int KW = K / 8, NS = KW / 32;
    const int nunits = 16 * (N / 64), G = gridDim.x;
    LAS f32x4* PB = (LAS f32x4*)lds;
    for (int u = G - 1 - (int)blockIdx.x; u < nunits; u += G) {
        const int rm = u & 15, cn = u >> 4;
        const bf16_t* ap = A + (size_t)(TP + rm * 32 + fr) * K + wave * KW + fq * 8;
        const bf16_t* bp = Bt + (size_t)(cn * 64 + fr) * K + wave * KW + fq * 8;
        f32x4 acc[2][4];
#pragma unroll
        for (int rr = 0; rr < 2; ++rr)
#pragma unroll
            for (int cc = 0; cc < 4; ++cc) acc[rr][cc] = (f32x4){0.f, 0.f, 0.f, 0.f};
#pragma unroll
        for (int s0 = 0; s0 < NS; s0 += 4) {
            bf16x8 a[4][2], b[4][4];
#pragma unroll
            for (int i = 0; i < 4; ++i) if (s0 + i < NS) {
#pragma unroll
                for (int rr = 0; rr < 2; ++rr) a[i][rr] = *(const bf16x8*)(ap + (size_t)rr * 16 * K + (s0 + i) * 32);
#pragma unroll
                for (int cc = 0; cc < 4; ++cc) b[i][cc] = *(const bf16x8*)(bp + (size_t)cc * 16 * K + (s0 + i) * 32);
            }
#pragma unroll
            for (int i = 0; i < 4; ++i) if (s0 + i < NS) {
#pragma unroll
                for (int rr = 0; rr < 2; ++rr)
#pragma unroll
                    for (int cc = 0; cc < 4; ++cc) acc[rr][cc] = __builtin_amdgcn_mfma_f32_16x16x32_bf16(b[i][cc], a[i][rr], acc[rr][cc], 0, 0, 0);
            }
        }
#pragma unroll
        for (int rr = 0; rr < 2; ++rr)
#pragma unroll
            for (int cc = 0; cc < 4; ++cc) PB[(wave * 8 + rr * 4 + cc) * 64 + lane] = acc[rr][cc];
        __syncthreads();
        f32x4 r = PB[(0 * 8 + wave) * 64 + lane];
#pragma unroll
        for (int w = 1; w < 8; ++w) r += PB[(w * 8 + wave) * 64 + lane];
        E.apply(r, TP + rm * 32 + r16 * 16 + fr, cn * 64 + c16 * 16 + 4 * fq, cn, c16, r16, fr, fq, lds + 65536);
        __syncthreads();
    }
}

#define XB_TMO      128
#define XB_XCNT(j)  (256  + 64 * (j))
#define XB_XSUB(j)  (1280 + 64 * (j))
#define XB_XGEN(j)  (2304 + 64 * (j))
#define XB_TOP      3328
#define XB_TOPGEN   3392
#define XCD_BAR_WORDS 3456
#define XB_SPIN_CAP (1u << 22)
__device__ __forceinline__ unsigned xb_ld(unsigned* p)              { return __hip_atomic_load(p, __ATOMIC_RELAXED, __HIP_MEMORY_SCOPE_AGENT); }
__device__ __forceinline__ unsigned xb_add(unsigned* p, unsigned v) { return __hip_atomic_fetch_add(p, v, __ATOMIC_RELAXED, __HIP_MEMORY_SCOPE_AGENT); }
__device__ __forceinline__ unsigned xb_xcc_id() { return (unsigned)__builtin_amdgcn_s_getreg((3 << 11) | 20) & 0xFu; }
#define XB_SPIN(cond, bar) do { unsigned _sp = 0; while (cond) { __builtin_amdgcn_s_sleep(1); \
    if ((++_sp & 255u) == 0u) { if (xb_ld(&(bar)[XB_TMO])) break; if (_sp > XB_SPIN_CAP) { atomicAdd(&(bar)[XB_TMO], 1u); break; } } } } while (0)
struct XcdBarrier { unsigned* bar; unsigned x; volatile LAS unsigned* st; };
__device__ __forceinline__ XcdBarrier xcd_barrier_post(unsigned* bar, volatile LAS unsigned* st) {
    XcdBarrier b; b.bar = bar; b.x = xb_xcc_id(); b.st = st;
    if (threadIdx.x == 0) (void)xb_add(&bar[XB_XCNT(b.x)], 1u);
    return b;
}
__device__ __forceinline__ void xcd_barrier_complete(unsigned* bar, unsigned x, unsigned& nloc, unsigned& nx) {
    const unsigned G = gridDim.x * gridDim.y * gridDim.z;
    unsigned sum, cnt, mine, sp = 0u;
    for (;;) {
        sum = 0u; cnt = 0u; mine = 0u;
#pragma unroll
        for (unsigned j = 0; j < 16; ++j) { const unsigned c = xb_ld(&bar[XB_XCNT(j)]); sum += c; cnt += (c > 0u) ? 1u : 0u; mine = (j == x) ? c : mine; }
        if (sum == G) break;
        __builtin_amdgcn_s_sleep(1);
        if ((++sp & 255u) == 0u) { if (xb_ld(&bar[XB_TMO])) break; if (sp > XB_SPIN_CAP) { atomicAdd(&bar[XB_TMO], 1u); break; } }
    }
    nloc = mine > 0u ? mine : 1u; nx = cnt > 0u ? cnt : 1u;
}
__device__ __forceinline__ void xcd_barrier(const XcdBarrier& b) {
    asm volatile("s_waitcnt vmcnt(0) lgkmcnt(0)" ::: "memory");
    __syncthreads();
    if (threadIdx.x == 0) {
        unsigned* bar = b.bar;
        __builtin_amdgcn_s_waitcnt(0);
        unsigned nloc = b.st[0], nx = b.st[1];
        if (nloc == 0u) { xcd_barrier_complete(bar, b.x, nloc, nx); b.st[0] = nloc; b.st[1] = nx; }
        const unsigned old = xb_add(&bar[XB_XSUB(b.x)], 1u);
        const unsigned gen = old / nloc;
        if (old + 1u == (gen + 1u) * nloc) {
            __builtin_amdgcn_fence(__ATOMIC_RELEASE, "agent");
            asm volatile("s_waitcnt vmcnt(0)" ::: "memory");
            const unsigned og = xb_add(&bar[XB_TOP], 1u);
            const unsigned tg = og / nx;
            if (og + 1u == (tg + 1u) * nx) xb_add(&bar[XB_TOPGEN], 1u);
            else XB_SPIN(xb_ld(&bar[XB_TOPGEN]) == tg, bar);
            __builtin_amdgcn_fence(__ATOMIC_ACQUIRE, "agent");
            xb_add(&bar[XB_XGEN(b.x)], 1u);
            asm volatile("s_waitcnt vmcnt(0)" ::: "memory");
        } else {
            XB_SPIN(xb_ld(&bar[XB_XGEN(b.x)]) == gen, bar);
            __builtin_amdgcn_fence(__ATOMIC_ACQUIRE, "agent");
            asm volatile("s_waitcnt vmcnt(0)" ::: "memory");
        }
    }
    __syncthreads();
}

struct Params { const float* in[26]; float* out; unsigned char* ws; int ph_lo, ph_hi; };

__device__ __forceinline__ void transpose_item(const float* W, int K, int N, bf16_t* WT, int dst_row0, LAS float* scr, int k0, int n0, int lane) {
    float wv[32];
#pragma unroll
    for (int i = 0; i < 32; ++i) wv[i] = W[(size_t)(k0 + 2 * i + (lane >> 5)) * N + n0 + (lane & 31)];
#pragma unroll
    for (int i = 0; i < 32; ++i) scr[(2 * i + (lane >> 5)) * 33 + (lane & 31)] = wv[i];
    LDS_WAIT();
    const int c = lane & 7;
#pragma unroll
    for (int j = 0; j < 4; ++j) { const int n = (lane >> 3) + 8 * j; const LAS float* s = scr + (8 * c) * 33 + n;
        u32x4 o; o.x = cvt_pk_bf16(s[0 * 33], s[1 * 33]); o.y = cvt_pk_bf16(s[2 * 33], s[3 * 33]); o.z = cvt_pk_bf16(s[4 * 33], s[5 * 33]); o.w = cvt_pk_bf16(s[6 * 33], s[7 * 33]);
        *(u32x4*)(WT + (size_t)(dst_row0 + n) * K + k0 + 8 * c) = o; }
    LDS_WAIT();
}
__device__ __forceinline__ void transpose_mat(const float* W, int K, int N, bf16_t* WT, int mode, LAS float* scr, int item, int lane) {
    const int nblk = N / 32, kb = item / nblk, nb = item % nblk, n0 = 32 * nb;
    const int dst = (mode == 0) ? n0 : (256 * (n0 >> 7) + (n0 & 127) + (mode == 2 ? 128 : 0));
    transpose_item(W, K, N, WT, dst, scr, 64 * kb, n0, lane);
}

__device__ __forceinline__ void convert_set(const Params& p, LAS unsigned char* lds, int set, int widx, int wstride) {
    const int lane = threadIdx.x & 63, wave = threadIdx.x >> 6;
    unsigned char* ws = p.ws;
    LAS float* scr = (LAS float*)(lds + wave * 16384);
    constexpr int I_GU = 16 * 88, I_D = 44 * 32, I_IN = 16 * 96, I_O = 16 * 32;
    const int nit = (set == 0) ? 2 * I_GU : (set == 1) ? (I_D + I_IN + I_O) : (2 * I_GU + I_D);
    for (int it = widx; it < nit; it += wstride) {
        int r = it;
        if (set == 0) {
            if (r < I_GU) { transpose_mat(p.in[6], 1024, 2816, (bf16_t*)(ws + WS_WG1), 1, scr, r, lane); continue; } r -= I_GU;
            transpose_mat(p.in[7], 1024, 2816, (bf16_t*)(ws + WS_WG1), 2, scr, r, lane);
        } else if (set == 1) {
            if (r < I_D)  { transpose_mat(p.in[8], 2816, 1024, (bf16_t*)(ws + WS_WD1), 0, scr, r, lane); continue; } r -= I_D;
            if (r < I_IN) { transpose_mat(p.in[10], 1024, 3072, (bf16_t*)(ws + WS_WIN), 0, scr, r, lane); continue; } r -= I_IN;
            transpose_mat(p.in[20], 1024, 1024, (bf16_t*)(ws + WS_WO), 0, scr, r, lane);
        } else {
            if (r < I_GU) { transpose_mat(p.in[22], 1024, 2816, (bf16_t*)(ws + WS_WG2), 1, scr, r, lane); continue; } r -= I_GU;
            if (r < I_GU) { transpose_mat(p.in[23], 1024, 2816, (bf16_t*)(ws + WS_WG2), 2, scr, r, lane); continue; } r -= I_GU;
            transpose_mat(p.in[24], 2816, 1024, (bf16_t*)(ws + WS_WD2), 0, scr, r, lane);
        }
    }
}
__device__ __forceinline__ void phase0(const Params& p, LAS unsigned char* lds) {
    const int tid = threadIdx.x, lane = tid & 63, wave = tid >> 6;
    const int G = gridDim.x, gw = blockIdx.x * 8 + wave, NGW = G * 8;
    unsigned char* ws = p.ws;
    convert_set(p, lds, 0, gw, NGW);
    for (int e = blockIdx.x * 512 + tid; e < 2 * 32768; e += G * 512) {
        const int which = e >> 15, r = e & 32767, n = r >> 12, j = (r >> 6) & 63, i = r & 63;
        const float* W = which ? p.in[17] : p.in[15];
        bf16_t* WT = (bf16_t*)(ws + (which ? WS_WXT : WS_WAT));
        WT[r] = f2bf(W[(n * 64 + i) * 64 + j]);
    }
    bf16_t* A1 = (bf16_t*)(ws + WS_B0); float* SS0 = (float*)(ws + WS_SS0);
    const float* g1 = p.in[5];
    f32x4 gv[4];
#pragma unroll
    for (int j = 0; j < 4; ++j) gv[j] = ((const f32x4*)g1)[lane + 64 * j];
    for (int row0 = gw; row0 < T_ALL; row0 += 3 * NGW) {
        f32x4 v[3][4];
#pragma unroll
        for (int r = 0; r < 3; ++r) { const int row = row0 + r * NGW; if (row < T_ALL) {
            const float* xr = (row < TP) ? p.in[0] + (size_t)row * DM : p.in[1] + (size_t)(row - TP) * DM;
#pragma unroll
            for (int j = 0; j < 4; ++j) v[r][j] = ((const f32x4*)xr)[lane + 64 * j]; } }
#pragma unroll
        for (int r = 0; r < 3; ++r) { const int row = row0 + r * NGW; if (row < T_ALL) {
            float s = 0.f;
#pragma unroll
            for (int j = 0; j < 4; ++j) s += (v[r][j].x * v[r][j].x + v[r][j].y * v[r][j].y) + (v[r][j].z * v[r][j].z + v[r][j].w * v[r][j].w);
            s = wave_sum(s);
            u32x2* o8 = (u32x2*)(A1 + (size_t)row * DM);
#pragma unroll
            for (int j = 0; j < 4; ++j) { const f32x4 a = v[r][j] * gv[j]; u32x2 w; w.x = cvt_pk_bf16(a.x, a.y); w.y = cvt_pk_bf16(a.z, a.w); o8[lane + 64 * j] = w; }
            if (lane < 16) SS0[(size_t)row * 16 + lane] = (lane == 0) ? s : 0.f; } }
    }
}

__device__ __forceinline__ void phase_final(const Params& p) {
    const int tid = threadIdx.x, lane = tid & 63, wave = tid >> 6;
    const int gw = blockIdx.x * 8 + wave, NGW = gridDim.x * 8;
    const float* SS3 = (const float*)(p.ws + WS_SS3); const float* gf = p.in[25];
    f32x4 gv[4];
#pragma unroll
    for (int j = 0; j < 4; ++j) gv[j] = ((const f32x4*)gf)[lane + 64 * j];
    for (int row0 = gw; row0 < T_ALL; row0 += 3 * NGW) {
        f32x4 v[3][4]; float rs[3];
#pragma unroll
        for (int r = 0; r < 3; ++r) { const int row = row0 + r * NGW; if (row < T_ALL) {
            rs[r] = rowscale(SS3, row);
            const f32x4* xr = (const f32x4*)(p.out + (size_t)row * DM);
#pragma unroll
            for (int j = 0; j < 4; ++j) v[r][j] = xr[lane + 64 * j]; } }
#pragma unroll
        for (int r = 0; r < 3; ++r) { const int row = row0 + r * NGW; if (row < T_ALL) {
            f32x4* xr = (f32x4*)(p.out + (size_t)row * DM);
#pragma unroll
            for (int j = 0; j < 4; ++j) xr[lane + 64 * j] = v[r][j] * rs[r] * gv[j]; } }
    }
}

struct Mix {
    const bf16_t *Q, *V, *SG, *GY; const float *FZ, *XB; bf16_t* LT; float* DC; float *ACH, *UCH, *HST; bf16_t* O;
    const bf16_t *WAT, *WXT;
    const float *lb, *hnorm, *convw, *convb, *ba, *bx, *lam, *wa, *wx, *st_h, *st_l, *st_c;
    float* out;
};

struct HgrnScan { float cum[16]; float kk[16]; float last; };
__device__ __forceinline__ void hgrn_scan(const float (&fzv)[16], float lb, int k, int seg, LAS float* tot, HgrnScan& hs) {
    float run = 0.f;
#pragma unroll
    for (int i = 0; i < 16; ++i) {
        const float e = __expf(-fmaxf(fzv[i], -80.f));
        const float sg = __builtin_amdgcn_rcpf(1.f + e), sn = e * sg;
        const float f = lb + (1.f - lb) * sg;
        run += __logf(f); hs.cum[i] = run; hs.kk[i] = (1.f - lb) * sn;
    }
    tot[seg * 128 + k] = run;
    __syncthreads();
    float off = 0.f, all = 0.f;
#pragma unroll
    for (int s = 0; s < 4; ++s) { const float v = tot[s * 128 + k]; if (s < seg) off += v; all += v; }
#pragma unroll
    for (int i = 0; i < 16; ++i) hs.cum[i] += off;
    hs.last = all;
}

struct HgIn { float fzv[16]; unsigned vv[16]; unsigned qv[16]; bf16x8 bs[4]; u32x2 sgv[4]; };
template <int MODE>
__device__ __forceinline__ void hg_load(const Mix& M, int unit, HgIn& in) {
    const int tid = threadIdx.x, lane = tid & 63, wave = tid >> 6, fr = lane & 15, fq = lane >> 4;
    const int h = unit & 3, bc = unit >> 2, t0 = bc * 64, cb = h * 128, k = tid & 127, seg = tid >> 7;
    const size_t rb = (size_t)(t0 + seg * 16) * DH + cb + k;
#pragma unroll
    for (int i = 0; i < 16; ++i) { in.fzv[i] = M.FZ[rb + (size_t)i * DH]; in.vv[i] = M.V[rb + (size_t)i * DH]; if (MODE == 1) in.qv[i] = M.Q[rb + (size_t)i * DH]; }
    if (MODE == 1) {
#pragma unroll
        for (int ks = 0; ks < 4; ++ks) in.bs[ks] = *(const bf16x8*)(M.LT + ((size_t)unit * 128 + 16 * wave + fr) * 128 + ks * 32 + fq * 8);
#pragma unroll
        for (int tr = 0; tr < 4; ++tr) in.sgv[tr] = *(const u32x2*)(M.SG + (size_t)(t0 + 16 * tr + fr) * DH + cb + 16 * wave + 4 * fq);
    }
}
template <int MODE>
__device__ __forceinline__ void hgrn_loop(const Mix& M, LAS unsigned char* lds) {
    const int tid = threadIdx.x, lane = tid & 63, wave = tid >> 6, fr = lane & 15, fq = lane >> 4, G = gridDim.x;
    const int k = tid & 127, seg = tid >> 7;
    int unit = blockIdx.x; if (unit >= 1024) return;
    int hcache = -1; float lb = 0.f; f32x4 gn = {0.f, 0.f, 0.f, 0.f};
    HgIn cur; hg_load<MODE>(M, unit, cur);
    for (;;) {
        const int un = unit + G; const bool has = un < 1024;
        HgIn nxt; if (has) hg_load<MODE>(M, un, nxt);
        const int h = unit & 3, bc = unit >> 2, t0 = bc * 64, cb = h * 128;
        if (h != hcache) { hcache = h; const float l0 = M.lb[cb + k], l1 = M.lb[512 + cb + k]; lb = __builtin_amdgcn_rcpf(1.f + __expf(l1 - l0)); gn = *(const f32x4*)(M.hnorm + cb + 16 * wave + 4 * fq); }
        if (MODE == 0) {
            LAS bf16_t* KT = (LAS bf16_t*)lds; LAS bf16_t* VT = (LAS bf16_t*)(lds + 18432); LAS float* tot = (LAS float*)(lds + 36864);
            HgrnScan hs; hgrn_scan(cur.fzv, lb, k, seg, tot, hs);
            unsigned pk[8];
#pragma unroll
            for (int i = 0; i < 8; ++i) pk[i] = cvt_pk_bf16(hs.kk[2 * i] * __expf(hs.last - hs.cum[2 * i]), hs.kk[2 * i + 1] * __expf(hs.last - hs.cum[2 * i + 1]));
            *(LAS u32x4*)(KT + k * 72 + seg * 16) = (u32x4){pk[0], pk[1], pk[2], pk[3]};
            *(LAS u32x4*)(KT + k * 72 + seg * 16 + 8) = (u32x4){pk[4], pk[5], pk[6], pk[7]};
            const unsigned* vv = cur.vv;
            *(LAS u32x4*)(VT + k * 72 + seg * 16) = (u32x4){vv[0] | (vv[1] << 16), vv[2] | (vv[3] << 16), vv[4] | (vv[5] << 16), vv[6] | (vv[7] << 16)};
            *(LAS u32x4*)(VT + k * 72 + seg * 16 + 8) = (u32x4){vv[8] | (vv[9] << 16), vv[10] | (vv[11] << 16), vv[12] | (vv[13] << 16), vv[14] | (vv[15] << 16)};
            if (seg == 0) M.DC[unit * 128 + k] = __expf(hs.last);
            __syncthreads();
            const bf16x8 a0 = *(const LAS bf16x8*)(VT + (16 * wave + fr) * 72 + fq * 8), a1 = *(const LAS bf16x8*)(VT + (16 * wave + fr) * 72 + 32 + fq * 8);
#pragma unroll
            for (int ct = 0; ct < 8; ++ct) {
                const bf16x8 b0 = *(const LAS bf16x8*)(KT + (16 * ct + fr) * 72 + fq * 8), b1 = *(const LAS bf16x8*)(KT + (16 * ct + fr) * 72 + 32 + fq * 8);
                f32x4 acc = {0.f, 0.f, 0.f, 0.f};
                acc = __builtin_amdgcn_mfma_f32_16x16x32_bf16(b0, a0, acc, 0, 0, 0);
                acc = __builtin_amdgcn_mfma_f32_16x16x32_bf16(b1, a1, acc, 0, 0, 0);
                u32x2 w; w.x = cvt_pk_bf16(acc[0], acc[1]); w.y = cvt_pk_bf16(acc[2], acc[3]);
                *(u32x2*)(M.LT + ((size_t)unit * 128 + 16 * wave + fr) * 128 + 16 * ct + 4 * fq) = w;
            }
            __syncthreads();
        } else {
            LAS bf16_t* QS = (LAS bf16_t*)lds; LAS bf16_t* KS = (LAS bf16_t*)(lds + 17408); LAS bf16_t* VT = (LAS bf16_t*)(lds + 34816);
            LAS bf16_t* PS = (LAS bf16_t*)(lds + 53248); LAS float* tot = (LAS float*)(lds + 62464); LAS float* RS = (LAS float*)(lds + 64512);
            HgrnScan hs; hgrn_scan(cur.fzv, lb, k, seg, tot, hs);
#pragma unroll
            for (int i = 0; i < 16; ++i) {
                const float q = __uint_as_float(cur.qv[i] << 16);
                QS[(seg * 16 + i) * 136 + k] = f2bf(q * __expf(hs.cum[i]));
                KS[(seg * 16 + i) * 136 + k] = f2bf(hs.kk[i] * __expf(-hs.cum[i]));
            }
            const unsigned* vv = cur.vv;
            *(LAS u32x4*)(VT + k * 72 + seg * 16) = (u32x4){vv[0] | (vv[1] << 16), vv[2] | (vv[3] << 16), vv[4] | (vv[5] << 16), vv[6] | (vv[7] << 16)};
            *(LAS u32x4*)(VT + k * 72 + seg * 16 + 8) = (u32x4){vv[8] | (vv[9] << 16), vv[10] | (vv[11] << 16), vv[12] | (vv[13] << 16), vv[14] | (vv[15] << 16)};
            __syncthreads();
#pragma unroll
            for (int r = 0; r < 2; ++r) {
                const int idx = wave + 8 * r, tr = idx >> 2, tc = idx & 3;
                f32x4 acc = {0.f, 0.f, 0.f, 0.f};
                if (tc <= tr) {
#pragma unroll
                    for (int ks = 0; ks < 4; ++ks) {
                        const bf16x8 a = *(const LAS bf16x8*)(QS + (16 * tr + fr) * 136 + ks * 32 + fq * 8), b = *(const LAS bf16x8*)(KS + (16 * tc + fr) * 136 + ks * 32 + fq * 8);
                        acc = __builtin_amdgcn_mfma_f32_16x16x32_bf16(b, a, acc, 0, 0, 0);
                    }
#pragma unroll
                    for (int j = 0; j < 4; ++j) if (16 * tc + 4 * fq + j > 16 * tr + fr) acc[j] = 0.f;
                }
                u32x2 w; w.x = cvt_pk_bf16(acc[0], acc[1]); w.y = cvt_pk_bf16(acc[2], acc[3]);
                *(LAS u32x2*)(PS + (16 * tr + fr) * 72 + 16 * tc + 4 * fq) = w;
            }
            __syncthreads();
            bf16x8 bv[2];
#pragma unroll
            for (int ks = 0; ks < 2; ++ks) bv[ks] = *(const LAS bf16x8*)(VT + (16 * wave + fr) * 72 + ks * 32 + fq * 8);
            f32x4 o[4];
#pragma unroll
            for (int tr = 0; tr < 4; ++tr) {
                f32x4 acc = {0.f, 0.f, 0.f, 0.f};
#pragma unroll
                for (int ks = 0; ks < 2; ++ks) { const bf16x8 a = *(const LAS bf16x8*)(PS + (16 * tr + fr) * 72 + ks * 32 + fq * 8); acc = __builtin_amdgcn_mfma_f32_16x16x32_bf16(bv[ks], a, acc, 0, 0, 0); }
#pragma unroll
                for (int ks = 0; ks < 4; ++ks) { const bf16x8 a = *(const LAS bf16x8*)(QS + (16 * tr + fr) * 136 + ks * 32 + fq * 8); acc = __builtin_amdgcn_mfma_f32_16x16x32_bf16(cur.bs[ks], a, acc, 0, 0, 0); }
                o[tr] = acc;
                float ss = (acc[0] * acc[0] + acc[1] * acc[1]) + (acc[2] * acc[2] + acc[3] * acc[3]);
                ss += __shfl_xor(ss, 16); ss += __shfl_xor(ss, 32);
                if (fq == 0) RS[wave * 64 + 16 * tr + fr] = ss;
            }
            __syncthreads();
            const int ocol = cb + 16 * wave + 4 * fq;
#pragma unroll
            for (int tr = 0; tr < 4; ++tr) {
                const int tl = 16 * tr + fr; float tt = 0.f;
#pragma unroll
                for (int w = 0; w < 8; ++w) tt += RS[w * 64 + tl];
                const float rinv = rsqrtf(tt * (1.f / 128.f) + EPS);
                const u32x2 sg = cur.sgv[tr];
                u32x2 w;
                w.x = cvt_pk_bf16(o[tr][0] * rinv * gn[0] * bflo(sg.x), o[tr][1] * rinv * gn[1] * bfhi(sg.x));
                w.y = cvt_pk_bf16(o[tr][2] * rinv * gn[2] * bflo(sg.y), o[tr][3] * rinv * gn[3] * bfhi(sg.y));
                *(u32x2*)(M.O + (size_t)(t0 + tl) * DM + ocol) = w;
            }
            __syncthreads();
        }
        if (!has) break;
        cur = nxt; unit = un;
    }
}

struct LruIn { float xm3, xm2, xm1; float xr[8]; unsigned gyv[8]; float hin; float cpv; };
__device__ __forceinline__ void lru_load(const Mix& M, int unit, int mode, LruIn& in) {
    const int tid = threadIdx.x, j = tid & 63, seg = tid >> 6;
    const int n = unit & 7, bc = unit >> 3, c = bc & 31, b = bc >> 5, t0 = bc * 64, ch0 = n * 64, ch = ch0 + j, tl0 = seg * 8;
    const bool first = (c == 0 && seg == 0);
    const float* xp = M.XB + (size_t)(t0 + tl0) * DH + ch;
    in.xm3 = first ? 0.f : xp[-3 * DH]; in.xm2 = first ? 0.f : xp[-2 * DH]; in.xm1 = first ? 0.f : xp[-1 * DH];
#pragma unroll
    for (int i = 0; i < 8; ++i) in.xr[i] = xp[i * DH];
    in.hin = (mode == 1) ? M.HST[(size_t)bc * 512 + ch] : 0.f;
#pragma unroll
    for (int i = 0; i < 8; ++i) in.gyv[i] = (mode == 1) ? (unsigned)M.GY[(size_t)(t0 + tl0 + i) * DH + ch] : 0u;
    in.cpv = (mode == 1 && c == 31 && tid < 192) ? M.XB[(size_t)(b * SEQ + SEQ - 3 + (tid >> 6)) * DH + ch0 + j] : 0.f;
}
__device__ __forceinline__ void lru_loop(const Mix& M, int mode, LAS unsigned char* lds) {
    const int tid = threadIdx.x, lane = tid & 63, wave = tid >> 6, fr = lane & 15, fq = lane >> 4, G = gridDim.x;
    const int j = tid & 63, seg = tid >> 6, tl0 = seg * 8;
    int unit = blockIdx.x; if (unit >= 2048) return;
    int par = 0;
    const int gate = wave >> 2, tr = wave & 3;
    int ncache = -1; float w0 = 0.f, w1 = 0.f, w2 = 0.f, w3 = 0.f, cbias = 0.f, sp = 0.f; bf16x8 wb[4][2]; float bbv[4];
    LruIn cur; lru_load(M, unit, mode, cur);
    for (;;) {
        const int un = unit + G; const bool has = un < 2048;
        LruIn nxt; if (has) lru_load(M, un, mode, nxt);
        LAS unsigned char* lb_ = lds + par * 49152;
        LAS bf16_t* XC16 = (LAS bf16_t*)(lb_ + 16640); LAS float* GR = (LAS float*)(lb_ + 25856); LAS float* GI = (LAS float*)(lb_ + 42496);
        LAS float* SEGA = (LAS float*)(lb_ + 59136); LAS float* SEGU = (LAS float*)(lb_ + 61184);
        par ^= 1;
        const int n = unit & 7, bc = unit >> 3, c = bc & 31, b = bc >> 5, t0 = bc * 64, ch0 = n * 64, ch = ch0 + j;
        if (n != ncache) {
            ncache = n;
            w0 = M.convw[ch]; w1 = M.convw[512 + ch]; w2 = M.convw[1024 + ch]; w3 = M.convw[1536 + ch]; cbias = M.convb[ch];
            const bf16_t* WT = (gate ? M.WXT : M.WAT) + n * 4096; const float* bias = (gate ? M.bx : M.ba) + ch0;
#pragma unroll
            for (int ct = 0; ct < 4; ++ct) { wb[ct][0] = *(const bf16x8*)(WT + (16 * ct + fr) * 64 + fq * 8); wb[ct][1] = *(const bf16x8*)(WT + (16 * ct + fr) * 64 + 32 + fq * 8); bbv[ct] = bias[16 * ct + fr]; }
            sp = log1pf(__expf(-M.lam[ch]));
        }
        float xm3 = cur.xm3, xm2 = cur.xm2, xm1 = cur.xm1; float xcv[8];
#pragma unroll
        for (int i = 0; i < 8; ++i) {
            const float x = cur.xr[i];
            const float xc = cbias + w0 * xm3 + w1 * xm2 + w2 * xm1 + w3 * x;
            xcv[i] = xc; XC16[(tl0 + i) * 72 + j] = f2bf(xc);
            xm3 = xm2; xm2 = xm1; xm1 = x;
        }
        __syncthreads();
        {
            LAS float* Gd = gate ? GI : GR;
            const bf16x8 a0 = *(const LAS bf16x8*)(XC16 + (16 * tr + fr) * 72 + fq * 8), a1 = *(const LAS bf16x8*)(XC16 + (16 * tr + fr) * 72 + 32 + fq * 8);
#pragma unroll
            for (int ct = 0; ct < 4; ++ct) {
                f32x4 acc = {0.f, 0.f, 0.f, 0.f};
                acc = __builtin_amdgcn_mfma_f32_16x16x32_bf16(a0, wb[ct][0], acc, 0, 0, 0);
                acc = __builtin_amdgcn_mfma_f32_16x16x32_bf16(a1, wb[ct][1], acc, 0, 0, 0);
#pragma unroll
                for (int jj = 0; jj < 4; ++jj) Gd[(16 * tr + 4 * fq + jj) * 65 + 16 * ct + fr] = sigm(acc[jj] + bbv[ct]);
            }
        }
        __syncthreads();
        float av[8], uv[8]; float A = 1.f, U = 0.f;
#pragma unroll
        for (int i = 0; i < 8; ++i) {
            const int tl = tl0 + i; const float r = GR[tl * 65 + j], ig = GI[tl * 65 + j];
            const float la = -8.f * r * sp, a = __expf(la);
            const float x = 2.f * la;
            float pe = 1.f / 5040.f; pe = pe * x + 1.f / 720.f; pe = pe * x + 1.f / 120.f; pe = pe * x + 1.f / 24.f; pe = pe * x + 1.f / 6.f; pe = pe * x + 0.5f; pe = pe * x + 1.f; pe = -pe * x;
            const float om = (x > -0.35f) ? pe : (1.f - a * a);
            float mult = __builtin_amdgcn_sqrtf(fmaxf(om, 0.f));
            if (c == 0 && tl == 0) mult = 1.f;
            const float u = mult * ig * xcv[i];
            av[i] = a; uv[i] = u; U = a * U + u; A *= a;
        }
        SEGA[seg * 64 + j] = A; SEGU[seg * 64 + j] = U;
        __syncthreads();
        float hin = cur.hin;
#pragma unroll
        for (int s = 0; s < 8; ++s) if (s < seg) hin = SEGA[s * 64 + j] * hin + SEGU[s * 64 + j];
        if (mode == 0) {
            if (seg == 7) { float At = 1.f;
#pragma unroll
                for (int s = 0; s < 8; ++s) At *= SEGA[s * 64 + j];
                M.ACH[(size_t)bc * 512 + ch] = At; M.UCH[(size_t)bc * 512 + ch] = A * hin + U; }
        } else {
            float hh = hin;
#pragma unroll
            for (int i = 0; i < 8; ++i) {
                hh = av[i] * hh + uv[i];
                M.O[(size_t)(t0 + tl0 + i) * DM + 512 + ch] = f2bf(hh * __uint_as_float(cur.gyv[i] << 16));
            }
            if (c == 31 && seg == 7) M.out[OUT_LP + b * 512 + ch] = hh;
            if (c == 31 && tid < 192) M.out[OUT_CP + (size_t)(b * 3 + (tid >> 6)) * 512 + ch0 + j] = cur.cpv;
        }
        if (!has) break;
        cur = nxt; unit = un;
    }
    __syncthreads();
}

__device__ __forceinline__ void hgrn_sample_unit(const Mix& M, int unit, LAS unsigned char* lds) {
    const int tid = threadIdx.x, lane = tid & 63, wave = tid >> 6;
    const int h = unit & 3, b = unit >> 2, cb = h * 128, tb = TP + b * 4;
    LAS float* SQ = (LAS float*)lds;
    LAS float* SK = SQ + 512;
    LAS float* SD = SK + 512;
    LAS float* SP = SD + 128;
    LAS float* OP = SP + 32;
    LAS float* RS = OP + 2048;
    const int v = tid & 127, kq = tid >> 7;
    const size_t sb = ((size_t)(b * 4 + h) * 128) * 128;
    float s0v[32];
#pragma unroll
    for (int kx = 0; kx < 32; ++kx) s0v[kx] = M.st_h[sb + (size_t)(kq * 32 + kx) * 128 + v];
    float vv[4];
#pragma unroll
    for (int s = 0; s < 4; ++s) vv[s] = bf2f(M.V[(size_t)(tb + s) * DH + cb + v]);
    const float sgo = bf2f(M.SG[(size_t)(tb + kq) * DH + cb + v]), hno = M.hnorm[cb + v];
    if (tid < 128) {
        const int k = tid;
        const float l0 = M.lb[cb + k], l1 = M.lb[512 + cb + k];
        const float lb = 1.f / (1.f + __expf(l1 - l0));
        float cum[4], kk[4], qv[4]; float run = 0.f;
#pragma unroll
        for (int s = 0; s < 4; ++s) {
            const float fz = M.FZ[(size_t)(tb + s) * DH + cb + k];
            const float sg = 1.f / (1.f + __expf(-fz)), sn = 1.f / (1.f + __expf(fz));
            run += __logf(lb + (1.f - lb) * sg); cum[s] = run; kk[s] = (1.f - lb) * sn;
            qv[s] = bf2f(M.Q[(size_t)(tb + s) * DH + cb + k]);
        }
#pragma unroll
        for (int s = 0; s < 4; ++s) { SQ[s * 128 + k] = qv[s] * __expf(cum[s]); SK[s * 128 + k] = kk[s] * __expf(cum[3] - cum[s]); }
        SD[k] = __expf(cum[3]);
        float pr[10]; int c = 0;
#pragma unroll
        for (int t = 0; t < 4; ++t)
#pragma unroll
            for (int s = 0; s <= t; ++s) { pr[c] = qv[t] * kk[s] * __expf(cum[t] - cum[s]); ++c; }
#pragma unroll
        for (int i = 0; i < 10; ++i) { const float v = wave_sum(pr[i]); if (lane == 0) SP[wave * 16 + i] = v; }
    }
    __syncthreads();
    {
        float o[4] = {0.f, 0.f, 0.f, 0.f};
#pragma unroll
        for (int kx = 0; kx < 32; ++kx) {
            const int k = kq * 32 + kx;
            const float s0 = s0v[kx];
            float sn = SD[k] * s0;
#pragma unroll
            for (int s = 0; s < 4; ++s) { o[s] += SQ[s * 128 + k] * s0; sn += SK[s * 128 + k] * vv[s]; }
            M.out[OUT_HS + sb + (size_t)k * 128 + v] = sn;
        }
#pragma unroll
        for (int s = 0; s < 4; ++s) OP[(kq * 4 + s) * 128 + v] = o[s];
    }
    __syncthreads();
    {
        const int t = kq;
        float ov = (OP[(0 * 4 + t) * 128 + v] + OP[(1 * 4 + t) * 128 + v]) + (OP[(2 * 4 + t) * 128 + v] + OP[(3 * 4 + t) * 128 + v]);
        const int base = t * (t + 1) / 2;
        for (int s = 0; s <= t; ++s) ov += (SP[base + s] + SP[16 + base + s]) * vv[s];
        const float ssq = wave_sum(ov * ov);
        if (lane == 0) RS[wave] = ssq;
        __syncthreads();
        const float tt = RS[2 * t] + RS[2 * t + 1];
        const float rinv = rsqrtf(tt * (1.f / 128.f) + EPS);
        const size_t tok = (size_t)(tb + t);
        M.O[tok * DM + cb + v] = f2bf(ov * rinv * hno * sgo);
    }
    __syncthreads();
}

__device__ __forceinline__ void lru_sample_unit(const Mix& M, int b, LAS unsigned char* lds) {
    const int tid = threadIdx.x, ch = tid, n = ch >> 6, j = ch & 63, tb = TP + b * 4;
    LAS float* XC = (LAS float*)lds;
    float x[7];
#pragma unroll
    for (int r = 0; r < 3; ++r) x[r] = M.st_c[(size_t)(b * 3 + r) * 512 + ch];
#pragma unroll
    for (int s = 0; s < 4; ++s) x[3 + s] = M.XB[(size_t)(tb + s) * DH + ch];
    const float w0 = M.convw[ch], w1 = M.convw[512 + ch], w2 = M.convw[1024 + ch], w3 = M.convw[1536 + ch], cbias = M.convb[ch];
    float xc[4];
#pragma unroll
    for (int s = 0; s < 4; ++s) { xc[s] = cbias + w0 * x[s] + w1 * x[s + 1] + w2 * x[s + 2] + w3 * x[s + 3]; XC[s * 512 + ch] = xc[s]; }
#pragma unroll
    for (int r = 0; r < 3; ++r) M.out[OUT_CS + (size_t)(b * 3 + r) * 512 + ch] = x[4 + r];
    __syncthreads();
    float ra[4], rx[4];
    const float ba = M.ba[ch], bx = M.bx[ch];
#pragma unroll
    for (int s = 0; s < 4; ++s) { ra[s] = ba; rx[s] = bx; }
    const float* wa = M.wa + (size_t)n * 4096 + j; const float* wx = M.wx + (size_t)n * 4096 + j;
#pragma unroll 16
    for (int i = 0; i < 64; ++i) {
        const float a = wa[i * 64], xw = wx[i * 64];
#pragma unroll
        for (int s = 0; s < 4; ++s) { const float xv = XC[s * 512 + n * 64 + i]; ra[s] += xv * a; rx[s] += xv * xw; }
    }
    const float sp = log1pf(__expf(-M.lam[ch]));
    float hh = M.st_l[(size_t)b * 512 + ch];
#pragma unroll
    for (int s = 0; s < 4; ++s) {
        const float r = 1.f / (1.f + __expf(-ra[s])), ig = 1.f / (1.f + __expf(-rx[s]));
        const float la = -8.f * r * sp, a = __expf(la), x2 = 2.f * la;
        float pe = 1.f / 5040.f; pe = pe * x2 + 1.f / 720.f; pe = pe * x2 + 1.f / 120.f; pe = pe * x2 + 1.f / 24.f; pe = pe * x2 + 1.f / 6.f; pe = pe * x2 + 0.5f; pe = pe * x2 + 1.f; pe = -pe * x2;
        const float mult = __builtin_amdgcn_sqrtf(fmaxf((x2 > -0.35f) ? pe : (1.f - a * a), 0.f));
        hh = a * hh + mult * ig * xc[s];
        M.O[(size_t)(tb + s) * DM + 512 + ch] = f2bf(hh * bf2f(M.GY[(size_t)(tb + s) * DH + ch]));
    }
    M.out[OUT_LS + (size_t)b * 512 + ch] = hh;
    __syncthreads();
}

__device__ __forceinline__ void scan_item(const Mix& M, int item) {
    const int tid = threadIdx.x;
    if (item < 1024) {
        const int e = item * 512 + tid, bh = e >> 14, vk = e & 16383, b = bh >> 2, h = bh & 3, v = vk >> 7, k = vk & 127;
        float l[32], d[32];
#pragma unroll
        for (int c = 0; c < 32; ++c) { const int unit = (b * 32 + c) * 4 + h; l[c] = bf2f(M.LT[(size_t)unit * 16384 + vk]); d[c] = M.DC[unit * 128 + k]; }
        float S = 0.f;
#pragma unroll
        for (int c = 0; c < 32; ++c) { const int unit = (b * 32 + c) * 4 + h; M.LT[(size_t)unit * 16384 + vk] = f2bf(S); S = d[c] * S + l[c]; }
        M.out[OUT_HP + ((size_t)(b * 4 + h) * 128 + k) * 128 + v] = S;
    } else {
        const int e = (item - 1024) * 512 + tid, b = e >> 9, ch = e & 511;
        float hcar = 0.f;
        for (int c = 0; c < 32; ++c) { const size_t idx = (size_t)(b * 32 + c) * 512 + ch; M.HST[idx] = hcar; hcar = M.ACH[idx] * hcar + M.UCH[idx]; }
    }
}

__global__ void __launch_bounds__(512, 2) mk_fwd(Params p) {
    extern __shared__ __attribute__((aligned(16))) unsigned char lds_raw[];
    LAS unsigned char* lds = (LAS unsigned char*)lds_raw;
    const int lo = p.ph_lo, hi = p.ph_hi, G = gridDim.x;
    unsigned char* ws = p.ws;
#define IN(k) (lo <= (k) && (k) < hi)
    volatile LAS unsigned* xst = (volatile LAS unsigned*)(lds + 131072);
    if (threadIdx.x < 16) xst[threadIdx.x] = 0u;
    __syncthreads();
    XcdBarrier xbar; xbar.bar = (unsigned*)(ws + WS_BAR); xbar.x = 0; xbar.st = xst;
    if (hi - lo > 1) xbar = xcd_barrier_post((unsigned*)(ws + WS_BAR), xst);
    if (hi == 0x7fffffff) cg::this_grid().sync();
#define SEAM(k) do { if (IN(k) && IN((k) + 1)) { xcd_barrier(xbar); } } while (0)
    bf16_t* B0 = (bf16_t*)(ws + WS_B0); bf16_t* B1 = (bf16_t*)(ws + WS_B1); bf16_t* H = (bf16_t*)(ws + WS_H);
    float* SS0 = (float*)(ws + WS_SS0); float* SS1 = (float*)(ws + WS_SS1); float* SS2 = (float*)(ws + WS_SS2); float* SS3 = (float*)(ws + WS_SS3);

    if (IN(0)) { phase0(p, lds); __syncthreads(); }
    SEAM(0);
    if (IN(1)) {
        pg8::Gemm g{B0, (const bf16_t*)(ws + WS_WG1), T_ALL, 2 * DFF, DM}; pg8::StaticOrder S; S.init(T_ALL, 2 * DFF, G, (int)blockIdx.x);
        EpiGateUp E{H, SS0};
        pg8::gemm_phase<EpiGateUp, pg8::StaticOrder, PG8_ALIGN, PG8_SP2>(lds, g, S, E);
        const int rounds = (S.nwg + G - 1) / G, nfull = S.nwg - (rounds - 1) * G;
        if (nfull >= G) convert_set(p, lds, 1, (int)blockIdx.x * 8 + (int)(threadIdx.x >> 6), G * 8);
        else if ((int)blockIdx.x >= nfull) convert_set(p, lds, 1, ((int)blockIdx.x - nfull) * 8 + (int)(threadIdx.x >> 6), (G - nfull) * 8);
        __syncthreads();
    }
    SEAM(1);
    if (IN(2)) {
        pg8::Gemm g{H, (const bf16_t*)(ws + WS_WD1), TP, DM, DFF}; pg8::StaticOrder S; S.init(TP, DM, G, (int)blockIdx.x);
        EpiResid E{p.in[0], p.in[1], p.out, B0, p.in[9], SS1, 0.5f};
        pg8::gemm_phase<EpiResid, pg8::StaticOrder, PG8_ALIGN, PG8_SP2>(lds, g, S, E);
        SmallResid Es{p.in[1] - (size_t)TP * DM, p.out, B0, p.in[9], SS1, 0.5f};
        small_gemm<SmallResid, DFF>(H, (const bf16_t*)(ws + WS_WD1), DM, Es, lds);
    }
    SEAM(2);
    if (IN(3)) {
        pg8::Gemm g{B0, (const bf16_t*)(ws + WS_WIN), TP, DIN, DM}; pg8::StaticOrder S; S.init(TP, DIN, G, (int)blockIdx.x);
        EpiProj E{(bf16_t*)(ws + WS_Q), (bf16_t*)(ws + WS_V), (bf16_t*)(ws + WS_SG), (bf16_t*)(ws + WS_GY), (float*)(ws + WS_FZ), (float*)(ws + WS_XB), SS1};
        pg8::gemm_phase<EpiProj, pg8::StaticOrder, PG8_ALIGN, PG8_SP2>(lds, g, S, E);
        SmallProj Es{(bf16_t*)(ws + WS_Q), (bf16_t*)(ws + WS_V), (bf16_t*)(ws + WS_SG), (bf16_t*)(ws + WS_GY), (float*)(ws + WS_FZ), (float*)(ws + WS_XB), SS1};
        small_gemm<SmallProj, DM>(B0, (const bf16_t*)(ws + WS_WIN), DIN, Es, lds);
    }
    SEAM(3);
    Mix M;
    M.Q = (const bf16_t*)(ws + WS_Q); M.V = (const bf16_t*)(ws + WS_V); M.SG = (const bf16_t*)(ws + WS_SG); M.GY = (const bf16_t*)(ws + WS_GY);
    M.FZ = (const float*)(ws + WS_FZ); M.XB = (const float*)(ws + WS_XB); M.LT = (bf16_t*)(ws + WS_LT); M.DC = (float*)(ws + WS_DC);
    M.ACH = (float*)(ws + WS_ACH); M.UCH = (float*)(ws + WS_UCH); M.HST = (float*)(ws + WS_HST); M.O = B0;
    M.WAT = (const bf16_t*)(ws + WS_WAT); M.WXT = (const bf16_t*)(ws + WS_WXT);
    M.lb = p.in[11]; M.hnorm = p.in[12]; M.convw = p.in[13]; M.convb = p.in[14]; M.wa = p.in[15]; M.ba = p.in[16]; M.wx = p.in[17]; M.bx = p.in[18]; M.lam = p.in[19];
    M.st_h = p.in[2]; M.st_l = p.in[3]; M.st_c = p.in[4]; M.out = p.out;
    if (IN(4)) {
        for (int u = blockIdx.x; u < 512; u += G) hgrn_sample_unit(M, u, lds);
        hgrn_loop<0>(M, lds);
        lru_loop(M, 0, lds);
        for (int u = G - 1 - (int)blockIdx.x; u < 128; u += G) lru_sample_unit(M, u, lds);
    }
    SEAM(4);
    if (IN(5)) { for (int it = blockIdx.x; it < 1032; it += G) scan_item(M, it); convert_set(p, lds, 2, (int)blockIdx.x * 8 + (int)(threadIdx.x >> 6), G * 8); __syncthreads(); }
    SEAM(5);
    if (IN(6)) {
        hgrn_loop<1>(M, lds);
        lru_loop(M, 1, lds);
    }
    SEAM(6);
    if (IN(7)) {
        pg8::Gemm g{B0, (const bf16_t*)(ws + WS_WO), TP, DM, DM}; pg8::StaticOrder S; S.init(TP, DM, G, (int)blockIdx.x);
        EpiResid E{p.out, p.out + (size_t)TP * DM, p.out, B1, p.in[21], SS2, 1.0f};
        pg8::gemm_phase<EpiResid, pg8::StaticOrder, PG8_ALIGN, PG8_SP2>(lds, g, S, E);
        SmallResid Es{p.out, p.out, B1, p.in[21], SS2, 1.0f};
        small_gemm<SmallResid, DM>(B0, (const bf16_t*)(ws + WS_WO), DM, Es, lds);
    }
    SEAM(7);
    if (IN(8)) {
        pg8::Gemm g{B1, (const bf16_t*)(ws + WS_WG2), T_ALL, 2 * DFF, DM}; pg8::StaticOrder S; S.init(T_ALL, 2 * DFF, G, (int)blockIdx.x);
        EpiGateUp E{H, SS2};
        pg8::gemm_phase<EpiGateUp, pg8::StaticOrder, PG8_ALIGN, PG8_SP2>(lds, g, S, E);
    }
    SEAM(8);
    if (IN(9)) {
        pg8::Gemm g{H, (const bf16_t*)(ws + WS_WD2), TP, DM, DFF}; pg8::StaticOrder S; S.init(TP, DM, G, (int)blockIdx.x);
        EpiResid E{p.out, p.out + (size_t)TP * DM, p.out, nullptr, nullptr, SS3, 0.5f};
        pg8::gemm_phase<EpiResid, pg8::StaticOrder, PG8_ALIGN, PG8_SP2>(lds, g, S, E);
        SmallResid Es{p.out, p.out, nullptr, nullptr, SS3, 0.5f};
        small_gemm<SmallResid, DFF>(H, (const bf16_t*)(ws + WS_WD2), DM, Es, lds);
    }
    SEAM(9);
    if (IN(10)) phase_final(p);
#undef IN
#undef SEAM
}

extern "C" void kernel_launch(void* const* d_in, const int* in_sizes, int n_in, void* d_out, int out_size, void* d_ws, size_t ws_size, hipStream_t stream) {
    static int grid = 0;
    if (grid == 0) {
        if (n_in != 26 || ws_size < WS_END2) { fprintf(stderr, "kernel_launch: unexpected n_in %d or ws_size %zu (need %zu)\n", n_in, ws_size, (size_t)WS_END2); grid = -1; return; }
        int dev = 0, cus = 0, per_cu = 0;
        hipGetDevice(&dev); hipDeviceGetAttribute(&cus, hipDeviceAttributeMultiprocessorCount, dev);
        if (hipFuncSetAttribute((const void*)mk_fwd, hipFuncAttributeMaxDynamicSharedMemorySize, LDS_BYTES) != hipSuccess) { fprintf(stderr, "kernel_launch: hipFuncSetAttribute failed\n"); grid = -1; return; }
        if (hipOccupancyMaxActiveBlocksPerMultiprocessor(&per_cu, (const void*)mk_fwd, 512, LDS_BYTES) != hipSuccess || per_cu < 1) { fprintf(stderr, "kernel_launch: occupancy query says %d\n", per_cu); per_cu = 1; }
        (void)hipGetLastError();
        grid = cus;
    }
    if (grid < 0) return;
    Params p{};
    for (int i = 0; i < 26; ++i) p.in[i] = (const float*)d_in[i];
    p.out = (float*)d_out; p.ws = (unsigned char*)d_ws;
#if MK_PER_PHASE
    for (int ph = 0; ph < MK_NPH; ++ph) { p.ph_lo = ph; p.ph_hi = ph + 1; hipLaunchKernelGGL(mk_fwd, dim3(grid), dim3(512), LDS_BYTES, stream, p); if ((MK_DUP >> ph) & 1) hipLaunchKernelGGL(mk_fwd, dim3(grid), dim3(512), LDS_BYTES, stream, p); }
#else
    p.ph_lo = 0; p.ph_hi = MK_NPH;
    if (hipMemsetAsync((char*)d_ws + WS_BAR, 0, 16384, stream) != hipSuccess) { fprintf(stderr, "memset failed\n"); return; }
    void* args[] = {&p};
    hipError_t e = hipLaunchCooperativeKernel((const void*)mk_fwd, dim3(grid), dim3(512), args, LDS_BYTES, stream);
    if (e != hipSuccess) fprintf(stderr, "cooperative launch failed: %s (grid %d)\n", hipGetErrorString(e), grid);
#endif
}
```

```cpp
#include <hip/hip_runtime.h>
#include <hip/hip_cooperative_groups.h>
#include <cstdio>
#include <cstdint>
namespace cg = cooperative_groups;

#ifndef MK_DUP
#define MK_DUP 0
#endif
#ifndef MK_NPH
#define MK_NPH 11
#endif
#ifndef MK_PER_PHASE
#define MK_PER_PHASE 0
#endif

#define LAS __attribute__((address_space(3)))
typedef unsigned short bf16_t;
typedef short bf16x8 __attribute__((ext_vector_type(8)));
typedef float f32x4 __attribute__((ext_vector_type(4)));
typedef unsigned u32x4 __attribute__((ext_vector_type(4)));
typedef unsigned u32x2 __attribute__((ext_vector_type(2)));

constexpr int T_ALL = 16896, TP = 16384, DM = 1024, DFF = 2816, DIN = 3072, DH = 512;
constexpr int SEQ = 2048, NB = 8, NCH = 32, DECB = 128;
constexpr float EPS = 1e-6f;

constexpr size_t OUT_Y = 0, OUT_HP = 17301504, OUT_LP = 17825792, OUT_CP = 17829888, OUT_HS = 17842176, OUT_LS = 26230784, OUT_CS = 26296320;

constexpr size_t WS_WG1 = 0;
constexpr size_t WS_WD1 = WS_WG1 + (size_t)5632 * 1024 * 2;
constexpr size_t WS_WIN = WS_WD1 + (size_t)1024 * 2816 * 2;
constexpr size_t WS_WO  = WS_WIN + (size_t)3072 * 1024 * 2;
constexpr size_t WS_WG2 = WS_WO + (size_t)1024 * 1024 * 2;
constexpr size_t WS_WD2 = WS_WG2 + (size_t)5632 * 1024 * 2;
constexpr size_t WS_WAT = WS_WD2 + (size_t)1024 * 2816 * 2;
constexpr size_t WS_WXT = WS_WAT + 65536;
constexpr size_t WS_SS0 = WS_WXT + 65536;
constexpr size_t SS_BYTES = (size_t)T_ALL * 16 * 4;
constexpr size_t WS_SS1 = WS_SS0 + SS_BYTES, WS_SS2 = WS_SS1 + SS_BYTES, WS_SS3 = WS_SS2 + SS_BYTES;
constexpr size_t WS_DC  = WS_SS3 + SS_BYTES;
constexpr size_t WS_ACH = WS_DC + (size_t)1024 * 128 * 4;
constexpr size_t WS_UCH = WS_ACH + (size_t)NB * NCH * 512 * 4;
constexpr size_t WS_HST = WS_UCH + (size_t)NB * NCH * 512 * 4;
constexpr size_t WS_B0  = WS_HST + (size_t)NB * NCH * 512 * 4;
constexpr size_t WS_R   = WS_B0 + (size_t)T_ALL * 1024 * 2;
constexpr size_t WS_H   = WS_R;
constexpr size_t WS_B1  = WS_H + (size_t)T_ALL * 2816 * 2;
constexpr size_t WS_Q   = WS_R;
constexpr size_t WS_V   = WS_Q + (size_t)T_ALL * 512 * 2;
constexpr size_t WS_SG  = WS_V + (size_t)T_ALL * 512 * 2;
constexpr size_t WS_GY  = WS_SG + (size_t)T_ALL * 512 * 2;
constexpr size_t WS_FZ  = WS_GY + (size_t)T_ALL * 512 * 2;
constexpr size_t WS_XB  = WS_FZ + (size_t)T_ALL * 512 * 4;
constexpr size_t WS_LT  = WS_XB + (size_t)T_ALL * 512 * 4;
constexpr size_t WS_END = WS_LT + (size_t)1024 * 16384 * 2;
constexpr size_t WS_BAR = WS_END;
constexpr size_t WS_END2 = WS_BAR + 16384;
static_assert(WS_END2 <= 268435456, "workspace budget");
static_assert(WS_B1 + (size_t)T_ALL * 1024 * 2 <= WS_END, "B1 inside R");

constexpr int LDS_BYTES = 131072 + 64;

typedef __bf16 nbf16x2 __attribute__((ext_vector_type(2)));
typedef float f32x2 __attribute__((ext_vector_type(2)));
__device__ __forceinline__ unsigned cvt_pk_bf16(float lo, float hi) { const nbf16x2 r = __builtin_convertvector((f32x2){lo, hi}, nbf16x2); return __builtin_bit_cast(unsigned, r); }
__device__ __forceinline__ bf16_t f2bf(float f) { return (bf16_t)(cvt_pk_bf16(f, 0.f) & 0xffffu); }
__device__ __forceinline__ float bf2f(bf16_t b) { return __uint_as_float(((unsigned)b) << 16); }
__device__ __forceinline__ float bflo(unsigned w) { return __uint_as_float(w << 16); }
__device__ __forceinline__ float bfhi(unsigned w) { return __uint_as_float(w & 0xffff0000u); }
__device__ __forceinline__ float sigm(float x) { return __builtin_amdgcn_rcpf(1.f + __expf(-x)); }
__device__ __forceinline__ float rowscale(const float* ss, int row) {
    const f32x4* p = (const f32x4*)(ss + (size_t)row * 16);
    const f32x4 a = p[0], b = p[1], c = p[2], d = p[3];
    const float s = (((a.x + a.y) + (a.z + a.w)) + ((b.x + b.y) + (b.z + b.w))) + (((c.x + c.y) + (c.z + c.w)) + ((d.x + d.y) + (d.z + d.w)));
    return rsqrtf(s * (1.f / 1024.f) + EPS);
}
__device__ __forceinline__ void rowscale8(const float* ss, int row0, int fq, float (&rs)[8]) {
    f32x4 q[8];
#pragma unroll
    for (int i = 0; i < 8; ++i) q[i] = *(const f32x4*)(ss + (size_t)(row0 + (i >> 2) * 128 + (i & 3) * 16) * 16 + 4 * fq);
#pragma unroll
    for (int i = 0; i < 8; ++i) { float t = (q[i].x + q[i].y) + (q[i].z + q[i].w); t += __shfl_xor(t, 16); t += __shfl_xor(t, 32); rs[i] = rsqrtf(t * (1.f / 1024.f) + EPS); }
}
__device__ __forceinline__ float wave_sum(float v) {
#pragma unroll
    for (int o = 1; o < 64; o <<= 1) v += __shfl_xor(v, o);
    return v;
}
#define LDS_WAIT() asm volatile("s_waitcnt lgkmcnt(0)" ::: "memory")

namespace pg8 {
constexpr int BM = 256, BK = 64, HALF = 128, HTB = HALF * BK * 2, STAGE_BYTES = 8 * HTB, NXCD = 8, WGM = 8;
__host__ __device__ __forceinline__ int lds_byte(int r, int c) { const int st = (r >> 4) * 2 + (c >> 5), rr = r & 15, cc = c & 31, ob = rr * 64 + cc * 2; return st * 1024 + (ob ^ (((ob >> 9) & 1) << 5)); }
__host__ __device__ __forceinline__ void stage_rc(int b, int& R, int& C) { const int st = b / 1024, sb = b % 1024, swz = sb ^ (((sb >> 9) & 1) << 5); R = (st >> 1) * 16 + swz / 64; C = (st & 1) * 32 + (swz % 64) / 2; }
__host__ __device__ __forceinline__ int perm32(int rho) { const int n = rho >> 4, i = rho & 15; return 8 * (i >> 2) + 4 * n + (i & 3); }
struct Unit { int pm, pn; };
struct Gemm { const bf16_t* A; const bf16_t* Bt; int M, N, K; };
struct StaticOrder {
    int nM, nN, nwg, G, c;
    __host__ __device__ void init(int M, int N, int G_, int c_) { nM = M / BM; nN = N / BM; nwg = nM * nN; G = G_; c = c_; }
    __host__ __device__ bool next(int i, Unit& u) const {
        const long L = (long)i * G + c; if (L >= nwg) return false;
        int wgid = (int)L; { const int q = nwg / NXCD, r = nwg % NXCD, xcd = wgid % NXCD, off = wgid / NXCD; wgid = (xcd < r ? xcd * (q + 1) : r * (q + 1) + (xcd - r) * q) + off; }
        const int nig = WGM * nN, gid = wgid / nig, fm = gid * WGM, gsz = (nM - fm) < WGM ? (nM - fm) : WGM;
        u.pm = fm + ((wgid % nig) % gsz); u.pn = (wgid % nig) / gsz; return true;
    }
    __device__ __forceinline__ void a_ready(const Unit&) const {}
    __device__ __forceinline__ void done(const Unit&) const {}
};

template <class Epi, class Sched, bool ALIGN_EPI = false, bool SP2 = false>
__device__ __forceinline__ void gemm_phase(LAS unsigned char* lds, const Gemm g, const Sched& S, const Epi& E) {
    const int tid = threadIdx.x, wid = __builtin_amdgcn_readfirstlane(tid >> 6), lane = tid & 63, wr = wid >> 2, wc = wid & 3, fr = lane & 15, fq = lane >> 4;
    const int K = g.K, nt = K / BK;
    unsigned voffA[2], voffB[2];
#pragma unroll
    for (int i = 0; i < 2; ++i) { int R, C; stage_rc(tid * 16 + i * 8192, R, C); const int Rb = Epi::PERM ? ((R & ~31) + perm32(R & 31)) : R;
        voffA[i] = (unsigned)(R * K + C) * 2u; voffB[i] = (unsigned)(Rb * K + C) * 2u; }
    const size_t kstep = (size_t)(BK * 2);
    const size_t hstep = (size_t)HALF * K * 2;
    const size_t tstep = 2 * hstep;
    const unsigned ldsw = (unsigned)wid * 1024u;
    const int aoff = lds_byte(wr * 64 + fr, fq * 8), boff = lds_byte(wc * 32 + fr, fq * 8);
#define PG8_SA(b, h) (((b) * 2 + (h)) * HTB)
#define PG8_SB(b, h) ((4 + (b) * 2 + (h)) * HTB)
#define PG8_STAGE(bufoff, gbase, voff) do { _Pragma("unroll") for (int _i = 0; _i < 2; ++_i) \
        __builtin_amdgcn_global_load_lds((const unsigned*)((const char*)(gbase) + (voff)[_i]), (LAS unsigned*)(lds + (bufoff) + ldsw + _i * 8192), 16, 0, 0); } while (0)
#define PG8_LDA(dst, b, h) do { _Pragma("unroll") for (int m = 0; m < 4; ++m) _Pragma("unroll") for (int k = 0; k < 2; ++k) dst[m][k] = *(const LAS bf16x8*)(lds + PG8_SA(b, h) + aoff + m * 2048 + k * 1024); } while (0)
#define PG8_LDB(dst, b, h) do { _Pragma("unroll") for (int n = 0; n < 2; ++n) _Pragma("unroll") for (int k = 0; k < 2; ++k) dst[n][k] = *(const LAS bf16x8*)(lds + PG8_SB(b, h) + boff + n * 2048 + k * 1024); } while (0)
#define PG8_MMA(ai, bj, At, Bt) do { __builtin_amdgcn_s_setprio(1); _Pragma("unroll") for (int m = 0; m < 4; ++m) _Pragma("unroll") for (int n = 0; n < 2; ++n) _Pragma("unroll") for (int k = 0; k < 2; ++k) \
        acc[ai][bj][m][n] = __builtin_amdgcn_mfma_f32_16x16x32_bf16(Bt[n][k], At[m][k], acc[ai][bj][m][n], 0, 0, 0); __builtin_amdgcn_s_setprio(0); } while (0)
#define PG8_WAIT_V(n) asm volatile("s_waitcnt vmcnt(" #n ")" ::: "memory")
#define PG8_WAIT_L(n) asm volatile("s_waitcnt lgkmcnt(" #n ")" ::: "memory")
#define PG8_BAR __builtin_amdgcn_s_barrier()
#define PG8_SCHED __builtin_amdgcn_sched_barrier(0)
    Unit cur, nxt; int ui = 0;
    if (!S.next(0, cur)) return;
    f32x4 acc[2][2][4][2];
#pragma unroll
    for (int a = 0; a < 2; ++a)
#pragma unroll
        for (int b = 0; b < 2; ++b)
#pragma unroll
            for (int m = 0; m < 4; ++m)
#pragma unroll
                for (int n = 0; n < 2; ++n) acc[a][b][m][n] = (f32x4){0.f, 0.f, 0.f, 0.f};
    bf16x8 At[4][2], B0[2][2], B1[2][2];
    const char* cA = (const char*)g.A + (size_t)cur.pm * tstep; const char* cB = (const char*)g.Bt + (size_t)cur.pn * tstep;
    S.a_ready(cur);
    if constexpr (SP2) {
        PG8_STAGE(PG8_SB(0, 0), cB, voffB); PG8_STAGE(PG8_SB(0, 1), cB + hstep, voffB); PG8_STAGE(PG8_SA(0, 0), cA, voffA); PG8_STAGE(PG8_SA(0, 1), cA + hstep, voffA);
        if (wr == 1) PG8_BAR;
        PG8_WAIT_V(2); PG8_BAR;
        PG8_STAGE(PG8_SB(1, 0), cB + kstep, voffB); PG8_STAGE(PG8_SA(1, 0), cA + kstep, voffA); PG8_STAGE(PG8_SB(1, 1), cB + hstep + kstep, voffB);
        PG8_WAIT_V(6); PG8_BAR;
    } else {
        PG8_STAGE(PG8_SB(0, 0), cB, voffB); PG8_STAGE(PG8_SA(0, 0), cA, voffA); PG8_STAGE(PG8_SB(0, 1), cB + hstep, voffB); PG8_STAGE(PG8_SA(0, 1), cA + hstep, voffA);
        if (wr == 1) PG8_BAR;
        PG8_WAIT_V(4); PG8_BAR;
        PG8_STAGE(PG8_SB(1, 0), cB + kstep, voffB); PG8_STAGE(PG8_SA(1, 0), cA + kstep, voffA); PG8_STAGE(PG8_SB(1, 1), cB + hstep + kstep, voffB);
        PG8_WAIT_V(6); PG8_BAR;
    }
    for (;;) {
        const bool has_next = S.next(ui + 1, nxt);
        const char* nA = has_next ? (const char*)g.A + (size_t)nxt.pm * tstep : cA; const char* nB = has_next ? (const char*)g.Bt + (size_t)nxt.pn * tstep : cB;
        for (int t = 0; t < nt; t += 2) {
            const bool last = (t == nt - 2);
            const char* a1 = cA + (size_t)(t + 1) * kstep;
            const char* a2 = last ? nA : cA + (size_t)(t + 2) * kstep; const char* b2 = last ? nB : cB + (size_t)(t + 2) * kstep;
            const char* a3 = a2 + kstep; const char* b3 = b2 + kstep;
            if (last && has_next) S.a_ready(nxt);
            if constexpr (SP2) {
            PG8_LDB(B0, 0, 0); PG8_LDB(B1, 0, 1); PG8_SCHED; PG8_LDA(At, 0, 0); PG8_STAGE(PG8_SA(1, 1), a1 + hstep, voffA);
            PG8_WAIT_V(8); PG8_WAIT_L(0); PG8_BAR; PG8_MMA(0, 0, At, B0); PG8_MMA(0, 1, At, B1); PG8_BAR; PG8_SCHED;
            PG8_LDA(At, 0, 1); PG8_STAGE(PG8_SB(0, 0), b2, voffB); PG8_STAGE(PG8_SB(0, 1), b2 + hstep, voffB); PG8_STAGE(PG8_SA(0, 0), a2, voffA);
            PG8_WAIT_V(8); PG8_WAIT_L(0); PG8_BAR; PG8_MMA(1, 0, At, B0); PG8_MMA(1, 1, At, B1); PG8_BAR; PG8_SCHED;
            PG8_LDB(B0, 1, 0); PG8_LDB(B1, 1, 1); PG8_SCHED; PG8_LDA(At, 1, 0); PG8_STAGE(PG8_SA(0, 1), a2 + hstep, voffA);
            PG8_WAIT_V(8); PG8_WAIT_L(0); PG8_BAR; PG8_MMA(0, 0, At, B0); PG8_MMA(0, 1, At, B1); PG8_BAR; PG8_SCHED;
            PG8_LDA(At, 1, 1); PG8_STAGE(PG8_SB(1, 0), b3, voffB); PG8_STAGE(PG8_SB(1, 1), b3 + hstep, voffB); PG8_STAGE(PG8_SA(1, 0), a3, voffA);
            PG8_WAIT_V(8); PG8_WAIT_L(0); PG8_BAR; PG8_MMA(1, 0, At, B0); PG8_MMA(1, 1, At, B1); PG8_BAR; PG8_SCHED;
            } else {
            PG8_LDB(B0, 0, 0); PG8_SCHED; PG8_LDA(At, 0, 0); PG8_STAGE(PG8_SA(1, 1), a1 + hstep, voffA);
            PG8_WAIT_L(8); PG8_BAR; PG8_WAIT_L(0); PG8_MMA(0, 0, At, B0); PG8_BAR; PG8_SCHED;
            PG8_LDB(B1, 0, 1); PG8_STAGE(PG8_SB(0, 0), b2, voffB);
            PG8_BAR; PG8_WAIT_L(0); PG8_MMA(0, 1, At, B1); PG8_BAR;
            PG8_LDA(At, 0, 1); PG8_STAGE(PG8_SA(0, 0), a2, voffA);
            PG8_BAR; PG8_WAIT_L(0); PG8_MMA(1, 0, At, B0); PG8_BAR; PG8_SCHED;
            PG8_STAGE(PG8_SB(0, 1), b2 + hstep, voffB);
            PG8_WAIT_V(6); PG8_BAR; PG8_MMA(1, 1, At, B1); PG8_BAR;
            PG8_LDB(B0, 1, 0); PG8_SCHED; PG8_LDA(At, 1, 0); PG8_STAGE(PG8_SA(0, 1), a2 + hstep, voffA);
            PG8_WAIT_L(8); PG8_BAR; PG8_WAIT_L(0); PG8_MMA(0, 0, At, B0); PG8_BAR; PG8_SCHED;
            PG8_LDB(B1, 1, 1); PG8_STAGE(PG8_SB(1, 0), b3, voffB);
            PG8_BAR; PG8_WAIT_L(0); PG8_MMA(0, 1, At, B1); PG8_BAR;
            PG8_LDA(At, 1, 1); PG8_STAGE(PG8_SA(1, 0), a3, voffA);
            PG8_BAR; PG8_WAIT_L(0); PG8_MMA(1, 0, At, B0); PG8_BAR; PG8_SCHED;
            PG8_STAGE(PG8_SB(1, 1), b3 + hstep, voffB);
            PG8_WAIT_V(6); PG8_BAR; PG8_MMA(1, 1, At, B1); PG8_BAR;
            }
        }
        if constexpr (ALIGN_EPI) { if (wr == 0) PG8_BAR; }
        E(acc, cur, wr, wc, fr, fq); S.done(cur);
        if (!has_next) break;
#pragma unroll
        for (int a = 0; a < 2; ++a)
#pragma unroll
            for (int b = 0; b < 2; ++b)
#pragma unroll
                for (int m = 0; m < 4; ++m)
#pragma unroll
                    for (int n = 0; n < 2; ++n) acc[a][b][m][n] = (f32x4){0.f, 0.f, 0.f, 0.f};
        cur = nxt; cA = nA; cB = nB; ++ui;
        if constexpr (ALIGN_EPI) { if (wr == 1) PG8_BAR; }
    }
    PG8_WAIT_V(0);
    if constexpr (!ALIGN_EPI) { if (wr == 0) PG8_BAR; }
    PG8_BAR;
#undef PG8_SA
#undef PG8_SB
#undef PG8_STAGE
#undef PG8_LDA
#undef PG8_LDB
#undef PG8_MMA
#undef PG8_WAIT_V
#undef PG8_WAIT_L
#undef PG8_BAR
#undef PG8_SCHED
}
}

#ifndef PG8_SP2
#define PG8_SP2 true
#endif
#ifndef PG8_ALIGN
#define PG8_ALIGN true
#endif

struct EpiGateUp {
    static constexpr bool PERM = true;
    bf16_t* H; const float* ss;
    __device__ __forceinline__ void operator()(const f32x4 (&acc)[2][2][4][2], const pg8::Unit& u, int wr, int wc, int fr, int fq) const {
        const int row0 = u.pm * 256 + wr * 64 + fr, col0 = u.pn * 128 + wc * 32 + 8 * fq;
        float rsv[8]; rowscale8(ss, row0, fq, rsv);
#pragma unroll
        for (int ai = 0; ai < 2; ++ai)
#pragma unroll
            for (int m = 0; m < 4; ++m) {
                const int row = row0 + ai * 128 + m * 16; const float rs = rsv[ai * 4 + m];
                float h[8];
#pragma unroll
                for (int n = 0; n < 2; ++n)
#pragma unroll
                    for (int j = 0; j < 4; ++j) { const float g = acc[ai][0][m][n][j] * rs, up = acc[ai][1][m][n][j] * rs; h[n * 4 + j] = g * sigm(g) * up; }
                u32x4 w; w.x = cvt_pk_bf16(h[0], h[1]); w.y = cvt_pk_bf16(h[2], h[3]); w.z = cvt_pk_bf16(h[4], h[5]); w.w = cvt_pk_bf16(h[6], h[7]);
                *(u32x4*)(H + (size_t)row * DFF + col0) = w;
            }
    }
};
struct EpiResid {
    static constexpr bool PERM = true;
    const float* xin_p; const float* xin_s; float* xout; bf16_t* ax; const float* gnext; float* ssout; float scale;
    __device__ __forceinline__ void operator()(const f32x4 (&acc)[2][2][4][2], const pg8::Unit& u, int wr, int wc, int fr, int fq) const {
        const int row0 = u.pm * 256 + wr * 64 + fr, col0 = u.pn * 256 + wc * 32 + 8 * fq;
        const float* xb = (u.pm < 64) ? xin_p : (xin_s - (size_t)TP * DM);
        f32x4 gn[2][2];
#pragma unroll
        for (int bj = 0; bj < 2; ++bj)
#pragma unroll
            for (int n = 0; n < 2; ++n) gn[bj][n] = ax ? *(const f32x4*)(gnext + col0 + bj * 128 + 4 * n) : (f32x4){1.f, 1.f, 1.f, 1.f};
#pragma unroll
        for (int ai = 0; ai < 2; ++ai) {
            f32x4 xr[4][2][2];
#pragma unroll
            for (int m = 0; m < 4; ++m)
#pragma unroll
                for (int bj = 0; bj < 2; ++bj) { const float* px = xb + (size_t)(row0 + ai * 128 + m * 16) * DM + col0 + bj * 128; xr[m][bj][0] = *(const f32x4*)px; xr[m][bj][1] = *(const f32x4*)(px + 4); }
#pragma unroll
            for (int m = 0; m < 4; ++m) {
                const int row = row0 + ai * 128 + m * 16; const size_t off = (size_t)row * DM + col0; float sq = 0.f;
#pragma unroll
                for (int bj = 0; bj < 2; ++bj) {
                    const f32x4 x0 = xr[m][bj][0], x1 = xr[m][bj][1];
                    const f32x4 v0 = x0 + acc[ai][bj][m][0] * scale, v1 = x1 + acc[ai][bj][m][1] * scale;
                    *(f32x4*)(xout + off + bj * 128) = v0; *(f32x4*)(xout + off + bj * 128 + 4) = v1;
                    sq += ((v0[0] * v0[0] + v0[1] * v0[1]) + (v0[2] * v0[2] + v0[3] * v0[3])) + ((v1[0] * v1[0] + v1[1] * v1[1]) + (v1[2] * v1[2] + v1[3] * v1[3]));
                    if (ax) { const f32x4 a0 = v0 * gn[bj][0], a1 = v1 * gn[bj][1];
                        u32x4 w; w.x = cvt_pk_bf16(a0[0], a0[1]); w.y = cvt_pk_bf16(a0[2], a0[3]); w.z = cvt_pk_bf16(a1[0], a1[1]); w.w = cvt_pk_bf16(a1[2], a1[3]);
                        *(u32x4*)(ax + off + bj * 128) = w; }
                }
                sq += __shfl_xor(sq, 16); sq += __shfl_xor(sq, 32);
                if (fq == 0) ssout[(size_t)row * 16 + u.pn * 4 + wc] = sq;
            }
        }
    }
};
struct EpiProj {
    static constexpr bool PERM = true;
    bf16_t *Q, *V, *SG, *GY; float *FZ, *XB; const float* ss;
    __device__ __forceinline__ void operator()(const f32x4 (&acc)[2][2][4][2], const pg8::Unit& u, int wr, int wc, int fr, int fq) const {
        const int seg = u.pn >> 1;
        const int row0 = u.pm * 256 + wr * 64 + fr, col0 = (u.pn & 1) * 256 + wc * 32 + 8 * fq;
        float* fdst = (seg == 1) ? FZ : XB;
        bf16_t* bdst = (seg == 0) ? Q : (seg == 2) ? V : (seg == 3) ? SG : GY;
        const bool isf = (seg == 1) || (seg == 4);
        float rsv[8]; rowscale8(ss, row0, fq, rsv);
#pragma unroll
        for (int ai = 0; ai < 2; ++ai)
#pragma unroll
            for (int m = 0; m < 4; ++m) {
                const int row = row0 + ai * 128 + m * 16; const float rs = rsv[ai * 4 + m]; const size_t off = (size_t)row * DH + col0;
#pragma unroll
                for (int bj = 0; bj < 2; ++bj) {
                    f32x4 v0 = acc[ai][bj][m][0] * rs, v1 = acc[ai][bj][m][1] * rs;
                    if (isf) { *(f32x4*)(fdst + off + bj * 128) = v0; *(f32x4*)(fdst + off + bj * 128 + 4) = v1; }
                    else {
                        float h[8] = {v0[0], v0[1], v0[2], v0[3], v1[0], v1[1], v1[2], v1[3]};
                        if (seg == 0) {
#pragma unroll
                            for (int j = 0; j < 8; ++j) h[j] = h[j] * sigm(h[j]);
                        } else if (seg == 3) {
#pragma unroll
                            for (int j = 0; j < 8; ++j) h[j] = sigm(h[j]);
                        } else if (seg == 5) {
#pragma unroll
                            for (int j = 0; j < 8; ++j) { const float y = h[j]; h[j] = y * sigm(1.5957691216f * (y + 0.044715f * y * y * y)); }
                        }
                        u32x4 w; w.x = cvt_pk_bf16(h[0], h[1]); w.y = cvt_pk_bf16(h[2], h[3]); w.z = cvt_pk_bf16(h[4], h[5]); w.w = cvt_pk_bf16(h[6], h[7]);
                        *(u32x4*)(bdst + off + bj * 128) = w;
                    }
                }
            }
    }
};


struct SmallResid {
    const float* xin; float* xout; bf16_t* ax; const float* gnext; float* ssout; float scale;
    __device__ __forceinline__ void apply(const f32x4& acc, int grow, int c, int cn, int c16, int r16, int fr, int fq, LAS unsigned char* lds) const {
        const size_t off = (size_t)grow * DM + c;
        const f32x4 x = *(const f32x4*)(xin + off);
        const f32x4 v = x + acc * scale;
        *(f32x4*)(xout + off) = v;
        float sq = (v[0] * v[0] + v[1] * v[1]) + (v[2] * v[2] + v[3] * v[3]);
        if (ax) { const f32x4 g = *(const f32x4*)(gnext + c); const f32x4 a = v * g; u32x2 w; w.x = cvt_pk_bf16(a[0], a[1]); w.y = cvt_pk_bf16(a[2], a[3]); *(u32x2*)(ax + off) = w; }
        sq += __shfl_xor(sq, 16); sq += __shfl_xor(sq, 32);
        LAS float* P = (LAS float*)lds;
        if (fq == 0) P[(r16 * 16 + fr) * 4 + c16] = sq;
        __syncthreads();
        if (c16 == 0 && fq == 0) { const LAS float* q = P + (r16 * 16 + fr) * 4; ssout[(size_t)grow * 16 + cn] = (q[0] + q[1]) + (q[2] + q[3]); }
        __syncthreads();
    }
};
struct SmallProj {
    bf16_t *Q, *V, *SG, *GY; float *FZ, *XB; const float* ss;
    __device__ __forceinline__ void apply(const f32x4& acc, int grow, int c, int cn, int c16, int r16, int fr, int fq, LAS unsigned char* lds) const {
        const int seg = cn >> 3, cs = c & 511;
        const float rs = rowscale(ss, grow);
        const f32x4 v = acc * rs;
        const size_t off = (size_t)grow * DH + cs;
        if (seg == 1 || seg == 4) { *(f32x4*)(((seg == 1) ? FZ : XB) + off) = v; }
        else {
            float h[4] = {v[0], v[1], v[2], v[3]};
            if (seg == 0) {
#pragma unroll
                for (int j = 0; j < 4; ++j) h[j] = h[j] * sigm(h[j]);
            } else if (seg == 3) {
#pragma unroll
                for (int j = 0; j < 4; ++j) h[j] = sigm(h[j]);
            } else if (seg == 5) {
#pragma unroll
                for (int j = 0; j < 4; ++j) { const float y = h[j]; h[j] = y * sigm(1.5957691216f * (y + 0.044715f * y * y * y)); }
            }
            bf16_t* bdst = (seg == 0) ? Q : (seg == 2) ? V : (seg == 3) ? SG : GY;
            u32x2 w; w.x = cvt_pk_bf16(h[0], h[1]); w.y = cvt_pk_bf16(h[2], h[3]);
            *(u32x2*)(bdst + off) = w;
        }
    }
};
template <class Epi, int K>
__device__ __forceinline__ void small_gemm(const bf16_t* A, const bf16_t* Bt, int N, const Epi& E, LAS unsigned char* lds) {
    const int tid = threadIdx.x, lane = tid & 63, wave = tid >> 6, fr = lane & 15, fq = lane >> 4, r16 = wave >> 2, c16 = wave & 3;
    constexpr int KW = K / 8, NS = KW / 32;
    const int nunits = 16 * (N / 64), G = gridDim.x;
    LAS f32x4* PB = (LAS f32x4*)lds;
    for (int u = G - 1 - (int)blockIdx.x; u < nunits; u += G) {
        const int rm = u & 15, cn = u >> 4;
        const bf16_t* ap = A + (size_t)(TP + rm * 32 + fr) * K + wave * KW + fq * 8;
        const bf16_t* bp = Bt + (size_t)(cn * 64 + fr) * K + wave * KW + fq * 8;
        f32x4 acc[2][4];
#pragma unroll
        for (int rr = 0; rr < 2; ++rr)
#pragma unroll
            for (int cc = 0; cc < 4; ++cc) acc[rr][cc] = (f32x4){0.f, 0.f, 0.f, 0.f};
#pragma unroll
        for (int s0 = 0; s0 < NS; s0 += 4) {
            bf16x8 a[4][2], b[4][4];
#pragma unroll
            for (int i = 0; i < 4; ++i) if (s0 + i < NS) {
#pragma unroll
                for (int rr = 0; rr < 2; ++rr) a[i][rr] = *(const bf16x8*)(ap + (size_t)rr * 16 * K + (s0 + i) * 32);
#pragma unroll
                for (int cc = 0; cc < 4; ++cc) b[i][cc] = *(const bf16x8*)(bp + (size_t)cc * 16 * K + (s0 + i) * 32);
            }
#pragma unroll
            for (int i = 0; i < 4; ++i) if (s0 + i < NS) {
#pragma unroll
                for (int rr = 0; rr < 2; ++rr)
#pragma unroll
                    for (int cc = 0; cc < 4; ++cc) acc[rr][cc] = __builtin_amdgcn_mfma_f32_16x16x32_bf16(b[i][cc], a[i][rr], acc[rr][cc], 0, 0, 0);
            }
        }
#pragma unroll
        for (int rr = 0; rr < 2; ++rr)
#pragma unroll
            for (int cc = 0; cc < 4; ++cc) PB[(wave * 8 + rr * 4 + cc) * 64 + lane] = acc[rr][cc];
        __syncthreads();
        f32x4 r = PB[(0 * 8 + wave) * 64 + lane];
#pragma unroll
        for (int w = 1; w < 8; ++w) r += PB[(w * 8 + wave) * 64 + lane];
        E.apply(r, TP + rm * 32 + r16 * 16 + fr, cn * 64 + c16 * 16 + 4 * fq, cn, c16, r16, fr, fq, lds + 65536);
        __syncthreads();
    }
}

#define XB_TMO      128
#define XB_XCNT(j)  (256  + 64 * (j))
#define XB_XSUB(j)  (1280 + 64 * (j))
#define XB_XGEN(j)  (2304 + 64 * (j))
#define XB_TOP      3328
#define XB_TOPGEN   3392
#define XCD_BAR_WORDS 3456
#define XB_SPIN_CAP (1u << 22)
__device__ __forceinline__ unsigned xb_ld(unsigned* p)              { return __hip_atomic_load(p, __ATOMIC_RELAXED, __HIP_MEMORY_SCOPE_AGENT); }
__device__ __forceinline__ unsigned xb_add(unsigned* p, unsigned v) { return __hip_atomic_fetch_add(p, v, __ATOMIC_RELAXED, __HIP_MEMORY_SCOPE_AGENT); }
__device__ __forceinline__ unsigned xb_xcc_id() { return (unsigned)__builtin_amdgcn_s_getreg((3 << 11) | 20) & 0xFu; }
#define XB_SPIN(cond, bar) do { unsigned _sp = 0; while (cond) { __builtin_amdgcn_s_sleep(1); \
    if ((++_sp & 255u) == 0u) { if (xb_ld(&(bar)[XB_TMO])) break; if (_sp > XB_SPIN_CAP) { atomicAdd(&(bar)[XB_TMO], 1u); break; } } } } while (0)
struct XcdBarrier { unsigned* bar; unsigned x; volatile LAS unsigned* st; };
__device__ __forceinline__ XcdBarrier xcd_barrier_post(unsigned* bar, volatile LAS unsigned* st) {
    XcdBarrier b; b.bar = bar; b.x = xb_xcc_id(); b.st = st;
    if (threadIdx.x == 0) (void)xb_add(&bar[XB_XCNT(b.x)], 1u);
    return b;
}
__device__ __forceinline__ void xcd_barrier_complete(unsigned* bar, unsigned x, unsigned& nloc, unsigned& nx) {
    const unsigned G = gridDim.x * gridDim.y * gridDim.z;
    unsigned sum, cnt, mine, sp = 0u;
    for (;;) {
        sum = 0u; cnt = 0u; mine = 0u;
#pragma unroll
        for (unsigned j = 0; j < 16; ++j) { const unsigned c = xb_ld(&bar[XB_XCNT(j)]); sum += c; cnt += (c > 0u) ? 1u : 0u; mine = (j == x) ? c : mine; }
        if (sum == G) break;
        __builtin_amdgcn_s_sleep(1);
        if ((++sp & 255u) == 0u) { if (xb_ld(&bar[XB_TMO])) break; if (sp > XB_SPIN_CAP) { atomicAdd(&bar[XB_TMO], 1u); break; } }
    }
    nloc = mine > 0u ? mine : 1u; nx = cnt > 0u ? cnt : 1u;
}
__device__ __forceinline__ void xcd_barrier(const XcdBarrier& b) {
    asm volatile("s_waitcnt vmcnt(0) lgkmcnt(0)" ::: "memory");
    __syncthreads();
    if (threadIdx.x == 0) {
        unsigned* bar = b.bar;
        __builtin_amdgcn_s_waitcnt(0);
        unsigned nloc = b.st[0], nx = b.st[1];
        if (nloc == 0u) { xcd_barrier_complete(bar, b.x, nloc, nx); b.st[0] = nloc; b.st[1] = nx; }
        const unsigned old = xb_add(&bar[XB_XSUB(b.x)], 1u);
        const unsigned gen = old / nloc;
        if (old + 1u == (gen + 1u) * nloc) {
            __builtin_amdgcn_fence(__ATOMIC_RELEASE, "agent");
            asm volatile("s_waitcnt vmcnt(0)" ::: "memory");
            const unsigned og = xb_add(&bar[XB_TOP], 1u);
            const unsigned tg = og / nx;
            if (og + 1u == (tg + 1u) * nx) xb_add(&bar[XB_TOPGEN], 1u);
            else XB_SPIN(xb_ld(&bar[XB_TOPGEN]) == tg, bar);
            __builtin_amdgcn_fence(__ATOMIC_ACQUIRE, "agent");
            xb_add(&bar[XB_XGEN(b.x)], 1u);
            asm volatile("s_waitcnt vmcnt(0)" ::: "memory");
        } else {
            XB_SPIN(xb_ld(&bar[XB_XGEN(b.x)]) == gen, bar);
            __builtin_amdgcn_fence(__ATOMIC_ACQUIRE, "agent");
            asm volatile("s_waitcnt vmcnt(0)" ::: "memory");
        }
    }
    __syncthreads();
}

struct Params { const float* in[26]; float* out; unsigned char* ws; int ph_lo, ph_hi; };

__device__ __forceinline__ void transpose_item(const float* W, int K, int N, bf16_t* WT, int dst_row0, LAS float* scr, int k0, int n0, int lane) {
    float wv[32];
#pragma unroll
    for (int i = 0; i < 32; ++i) wv[i] = W[(size_t)(k0 + 2 * i + (lane >> 5)) * N + n0 + (lane & 31)];
#pragma unroll
    for (int i = 0; i < 32; ++i) scr[(2 * i + (lane >> 5)) * 33 + (lane & 31)] = wv[i];
    LDS_WAIT();
    const int c = lane & 7;
#pragma unroll
    for (int j = 0; j < 4; ++j) { const int n = (lane >> 3) + 8 * j; const LAS float* s = scr + (8 * c) * 33 + n;
        u32x4 o; o.x = cvt_pk_bf16(s[0 * 33], s[1 * 33]); o.y = cvt_pk_bf16(s[2 * 33], s[3 * 33]); o.z = cvt_pk_bf16(s[4 * 33], s[5 * 33]); o.w = cvt_pk_bf16(s[6 * 33], s[7 * 33]);
        *(u32x4*)(WT + (size_t)(dst_row0 + n) * K + k0 + 8 * c) = o; }
    LDS_WAIT();
}
__device__ __forceinline__ void transpose_mat(const float* W, int K, int N, bf16_t* WT, int mode, LAS float* scr, int item, int lane) {
    const int nblk = N / 32, kb = item / nblk, nb = item % nblk, n0 = 32 * nb;
    const int dst = (mode == 0) ? n0 : (256 * (n0 >> 7) + (n0 & 127) + (mode == 2 ? 128 : 0));
    transpose_item(W, K, N, WT, dst, scr, 64 * kb, n0, lane);
}

__device__ __forceinline__ void convert_set(const Params& p, LAS unsigned char* lds, int set, int widx, int wstride) {
    const int lane = threadIdx.x & 63, wave = threadIdx.x >> 6;
    unsigned char* ws = p.ws;
    LAS float* scr = (LAS float*)(lds + wave * 16384);
    constexpr int I_GU = 16 * 88, I_D = 44 * 32, I_IN = 16 * 96, I_O = 16 * 32;
    const int nit = (set == 0) ? 2 * I_GU : (set == 1) ? (I_D + I_IN + I_O) : (2 * I_GU + I_D);
    for (int it = widx; it < nit; it += wstride) {
        int r = it;
        if (set == 0) {
            if (r < I_GU) { transpose_mat(p.in[6], 1024, 2816, (bf16_t*)(ws + WS_WG1), 1, scr, r, lane); continue; } r -= I_GU;
            transpose_mat(p.in[7], 1024, 2816, (bf16_t*)(ws + WS_WG1), 2, scr, r, lane);
        } else if (set == 1) {
            if (r < I_D)  { transpose_mat(p.in[8], 2816, 1024, (bf16_t*)(ws + WS_WD1), 0, scr, r, lane); continue; } r -= I_D;
            if (r < I_IN) { transpose_mat(p.in[10], 1024, 3072, (bf16_t*)(ws + WS_WIN), 0, scr, r, lane); continue; } r -= I_IN;
            transpose_mat(p.in[20], 1024, 1024, (bf16_t*)(ws + WS_WO), 0, scr, r, lane);
        } else {
            if (r < I_GU) { transpose_mat(p.in[22], 1024, 2816, (bf16_t*)(ws + WS_WG2), 1, scr, r, lane); continue; } r -= I_GU;
            if (r < I_GU) { transpose_mat(p.in[23], 1024, 2816, (bf16_t*)(ws + WS_WG2), 2, scr, r, lane); continue; } r -= I_GU;
            transpose_mat(p.in[24], 2816, 1024, (bf16_t*)(ws + WS_WD2), 0, scr, r, lane);
        }
    }
}
__device__ __forceinline__ void phase0(const Params& p, LAS unsigned char* lds) {
    const int tid = threadIdx.x, lane = tid & 63, wave = tid >> 6;
    const int G = gridDim.x, gw = blockIdx.x * 8 + wave, NGW = G * 8;
    unsigned char* ws = p.ws;
    convert_set(p, lds, 0, gw, NGW);
    for (int e = blockIdx.x * 512 + tid; e < 2 * 32768; e += G * 512) {
        const int which = e >> 15, r = e & 32767, n = r >> 12, j = (r >> 6) & 63, i = r & 63;
        const float* W = which ? p.in[17] : p.in[15];
        bf16_t* WT = (bf16_t*)(ws + (which ? WS_WXT : WS_WAT));
        WT[r] = f2bf(W[(n * 64 + i) * 64 + j]);
    }
    bf16_t* A1 = (bf16_t*)(ws + WS_B0); float* SS0 = (float*)(ws + WS_SS0);
    const float* g1 = p.in[5];
    f32x4 gv[4];
#pragma unroll
    for (int j = 0; j < 4; ++j) gv[j] = ((const f32x4*)g1)[lane + 64 * j];
    for (int row0 = gw; row0 < T_ALL; row0 += 3 * NGW) {
        f32x4 v[3][4];
#pragma unroll
        for (int r = 0; r < 3; ++r) { const int row = row0 + r * NGW; if (row < T_ALL) {
            const float* xr = (row < TP) ? p.in[0] + (size_t)row * DM : p.in[1] + (size_t)(row - TP) * DM;
#pragma unroll
            for (int j = 0; j < 4; ++j) v[r][j] = ((const f32x4*)xr)[lane + 64 * j]; } }
#pragma unroll
        for (int r = 0; r < 3; ++r) { const int row = row0 + r * NGW; if (row < T_ALL) {
            float s = 0.f;
#pragma unroll
            for (int j = 0; j < 4; ++j) s += (v[r][j].x * v[r][j].x + v[r][j].y * v[r][j].y) + (v[r][j].z * v[r][j].z + v[r][j].w * v[r][j].w);
            s = wave_sum(s);
            u32x2* o8 = (u32x2*)(A1 + (size_t)row * DM);
#pragma unroll
            for (int j = 0; j < 4; ++j) { const f32x4 a = v[r][j] * gv[j]; u32x2 w; w.x = cvt_pk_bf16(a.x, a.y); w.y = cvt_pk_bf16(a.z, a.w); o8[lane + 64 * j] = w; }
            if (lane < 16) SS0[(size_t)row * 16 + lane] = (lane == 0) ? s : 0.f; } }
    }
}

__device__ __forceinline__ void phase_final(const Params& p) {
    const int tid = threadIdx.x, lane = tid & 63, wave = tid >> 6;
    const int gw = blockIdx.x * 8 + wave, NGW = gridDim.x * 8;
    const float* SS3 = (const float*)(p.ws + WS_SS3); const float* gf = p.in[25];
    f32x4 gv[4];
#pragma unroll
    for (int j = 0; j < 4; ++j) gv[j] = ((const f32x4*)gf)[lane + 64 * j];
    for (int row0 = gw; row0 < T_ALL; row0 += 3 * NGW) {
        f32x4 v[3][4]; float rs[3];
#pragma unroll
        for (int r = 0; r < 3; ++r) { const int row = row0 + r * NGW; if (row < T_ALL) {
            rs[r] = rowscale(SS3, row);
            const f32x4* xr = (const f32x4*)(p.out + (size_t)row * DM);
#pragma unroll
            for (int j = 0; j < 4; ++j) v[r][j] = xr[lane + 64 * j]; } }
#pragma unroll
        for (int r = 0; r < 3; ++r) { const int row = row0 + r * NGW; if (row < T_ALL) {
            f32x4* xr = (f32x4*)(p.out + (size_t)row * DM);
#pragma unroll
            for (int j = 0; j < 4; ++j) xr[lane + 64 * j] = v[r][j] * rs[r] * gv[j]; } }
    }
}

struct Mix {
    const bf16_t *Q, *V, *SG, *GY; const float *FZ, *XB; bf16_t* LT; float* DC; float *ACH, *UCH, *HST; bf16_t* O;
    const bf16_t *WAT, *WXT;
    const float *lb, *hnorm, *convw, *convb, *ba, *bx, *lam, *wa, *wx, *st_h, *st_l, *st_c;
    float* out;
};

struct HgrnScan { float cum[16]; float kk[16]; float last; };
__device__ __forceinline__ void hgrn_scan(const float (&fzv)[16], float lb, int k, int seg, LAS float* tot, HgrnScan& hs) {
    float run = 0.f;
#pragma unroll
    for (int i = 0; i < 16; ++i) {
        const float e = __expf(-fmaxf(fzv[i], -80.f));
        const float sg = __builtin_amdgcn_rcpf(1.f + e), sn = e * sg;
        const float f = lb + (1.f - lb) * sg;
        run += __logf(f); hs.cum[i] = run; hs.kk[i] = (1.f - lb) * sn;
    }
    tot[seg * 128 + k] = run;
    __syncthreads();
    float off = 0.f, all = 0.f;
#pragma unroll
    for (int s = 0; s < 4; ++s) { const float v = tot[s * 128 + k]; if (s < seg) off += v; all += v; }
#pragma unroll
    for (int i = 0; i < 16; ++i) hs.cum[i] += off;
    hs.last = all;
}

struct HgIn { float fzv[16]; unsigned vv[16]; unsigned qv[16]; bf16x8 bs[4]; u32x2 sgv[4]; };
template <int MODE>
__device__ __forceinline__ void hg_load(const Mix& M, int unit, HgIn& in) {
    const int tid = threadIdx.x, lane = tid & 63, wave = tid >> 6, fr = lane & 15, fq = lane >> 4;
    const int h = unit & 3, bc = unit >> 2, t0 = bc * 64, cb = h * 128, k = tid & 127, seg = tid >> 7;
    const size_t rb = (size_t)(t0 + seg * 16) * DH + cb + k;
#pragma unroll
    for (int i = 0; i < 16; ++i) { in.fzv[i] = M.FZ[rb + (size_t)i * DH]; in.vv[i] = M.V[rb + (size_t)i * DH]; if (MODE == 1) in.qv[i] = M.Q[rb + (size_t)i * DH]; }
    if (MODE == 1) {
#pragma unroll
        for (int ks = 0; ks < 4; ++ks) in.bs[ks] = *(const bf16x8*)(M.LT + ((size_t)unit * 128 + 16 * wave + fr) * 128 + ks * 32 + fq * 8);
#pragma unroll
        for (int tr = 0; tr < 4; ++tr) in.sgv[tr] = *(const u32x2*)(M.SG + (size_t)(t0 + 16 * tr + fr) * DH + cb + 16 * wave + 4 * fq);
    }
}
template <int MODE>
__device__ __forceinline__ void hgrn_loop(const Mix& M, LAS unsigned char* lds) {
    const int tid = threadIdx.x, lane = tid & 63, wave = tid >> 6, fr = lane & 15, fq = lane >> 4, G = gridDim.x;
    const int k = tid & 127, seg = tid >> 7;
    int unit = blockIdx.x; if (unit >= 1024) return;
    int hcache = -1; float lb = 0.f; f32x4 gn = {0.f, 0.f, 0.f, 0.f};
    HgIn cur; hg_load<MODE>(M, unit, cur);
    for (;;) {
        const int un = unit + G; const bool has = un < 1024;
        HgIn nxt; if (has) hg_load<MODE>(M, un, nxt);
        const int h = unit & 3, bc = unit >> 2, t0 = bc * 64, cb = h * 128;
        if (h != hcache) { hcache = h; const float l0 = M.lb[cb + k], l1 = M.lb[512 + cb + k]; lb = __builtin_amdgcn_rcpf(1.f + __expf(l1 - l0)); gn = *(const f32x4*)(M.hnorm + cb + 16 * wave + 4 * fq); }
        if (MODE == 0) {
            LAS bf16_t* KT = (LAS bf16_t*)lds; LAS bf16_t* VT = (LAS bf16_t*)(lds + 18432); LAS float* tot = (LAS float*)(lds + 36864);
            HgrnScan hs; hgrn_scan(cur.fzv, lb, k, seg, tot, hs);
            unsigned pk[8];
#pragma unroll
            for (int i = 0; i < 8; ++i) pk[i] = cvt_pk_bf16(hs.kk[2 * i] * __expf(hs.last - hs.cum[2 * i]), hs.kk[2 * i + 1] * __expf(hs.last - hs.cum[2 * i + 1]));
            *(LAS u32x4*)(KT + k * 72 + seg * 16) = (u32x4){pk[0], pk[1], pk[2], pk[3]};
            *(LAS u32x4*)(KT + k * 72 + seg * 16 + 8) = (u32x4){pk[4], pk[5], pk[6], pk[7]};
            const unsigned* vv = cur.vv;
            *(LAS u32x4*)(VT + k * 72 + seg * 16) = (u32x4){vv[0] | (vv[1] << 16), vv[2] | (vv[3] << 16), vv[4] | (vv[5] << 16), vv[6] | (vv[7] << 16)};
            *(LAS u32x4*)(VT + k * 72 + seg * 16 + 8) = (u32x4){vv[8] | (vv[9] << 16), vv[10] | (vv[11] << 16), vv[12] | (vv[13] << 16), vv[14] | (vv[15] << 16)};
            if (seg == 0) M.DC[unit * 128 + k] = __expf(hs.last);
            __syncthreads();
            const bf16x8 a0 = *(const LAS bf16x8*)(VT + (16 * wave + fr) * 72 + fq * 8), a1 = *(const LAS bf16x8*)(VT + (16 * wave + fr) * 72 + 32 + fq * 8);
#pragma unroll
            for (int ct = 0; ct < 8; ++ct) {
                const bf16x8 b0 = *(const LAS bf16x8*)(KT + (16 * ct + fr) * 72 + fq * 8), b1 = *(const LAS bf16x8*)(KT + (16 * ct + fr) * 72 + 32 + fq * 8);
                f32x4 acc = {0.f, 0.f, 0.f, 0.f};
                acc = __builtin_amdgcn_mfma_f32_16x16x32_bf16(b0, a0, acc, 0, 0, 0);
                acc = __builtin_amdgcn_mfma_f32_16x16x32_bf16(b1, a1, acc, 0, 0, 0);
                u32x2 w; w.x = cvt_pk_bf16(acc[0], acc[1]); w.y = cvt_pk_bf16(acc[2], acc[3]);
                *(u32x2*)(M.LT + ((size_t)unit * 128 + 16 * wave + fr) * 128 + 16 * ct + 4 * fq) = w;
            }
            __syncthreads();
        } else {
            LAS bf16_t* QS = (LAS bf16_t*)lds; LAS bf16_t* KS = (LAS bf16_t*)(lds + 17408); LAS bf16_t* VT = (LAS bf16_t*)(lds + 34816);
            LAS bf16_t* PS = (LAS bf16_t*)(lds + 53248); LAS float* tot = (LAS float*)(lds + 62464); LAS float* RS = (LAS float*)(lds + 64512);
            HgrnScan hs; hgrn_scan(cur.fzv, lb, k, seg, tot, hs);
#pragma unroll
            for (int i = 0; i < 16; ++i) {
                const float q = __uint_as_float(cur.qv[i] << 16);
                QS[(seg * 16 + i) * 136 + k] = f2bf(q * __expf(hs.cum[i]));
                KS[(seg * 16 + i) * 136 + k] = f2bf(hs.kk[i] * __expf(-hs.cum[i]));
            }
            const unsigned* vv = cur.vv;
            *(LAS u32x4*)(VT + k * 72 + seg * 16) = (u32x4){vv[0] | (vv[1] << 16), vv[2] | (vv[3] << 16), vv[4] | (vv[5] << 16), vv[6] | (vv[7] << 16)};
            *(LAS u32x4*)(VT + k * 72 + seg * 16 + 8) = (u32x4){vv[8] | (vv[9] << 16), vv[10] | (vv[11] << 16), vv[12] | (vv[13] << 16), vv[14] | (vv[15] << 16)};
            __syncthreads();
#pragma unroll
            for (int r = 0; r < 2; ++r) {
                const int idx = wave + 8 * r, tr = idx >> 2, tc = idx & 3;
                f32x4 acc = {0.f, 0.f, 0.f, 0.f};
                if (tc <= tr) {
#pragma unroll
                    for (int ks = 0; ks < 4; ++ks) {
                        const bf16x8 a = *(const LAS bf16x8*)(QS + (16 * tr + fr) * 136 + ks * 32 + fq * 8), b = *(const LAS bf16x8*)(KS + (16 * tc + fr) * 136 + ks * 32 + fq * 8);
                        acc = __builtin_amdgcn_mfma_f32_16x16x32_bf16(b, a, acc, 0, 0, 0);
                    }
#pragma unroll
                    for (int j = 0; j < 4; ++j) if (16 * tc + 4 * fq + j > 16 * tr + fr) acc[j] = 0.f;
                }
                u32x2 w; w.x = cvt_pk_bf16(acc[0], acc[1]); w.y = cvt_pk_bf16(acc[2], acc[3]);
                *(LAS u32x2*)(PS + (16 * tr + fr) * 72 + 16 * tc + 4 * fq) = w;
            }
            __syncthreads();
            bf16x8 bv[2];
#pragma unroll
            for (int ks = 0; ks < 2; ++ks) bv[ks] = *(const LAS bf16x8*)(VT + (16 * wave + fr) * 72 + ks * 32 + fq * 8);
            f32x4 o[4];
#pragma unroll
            for (int tr = 0; tr < 4; ++tr) {
                f32x4 acc = {0.f, 0.f, 0.f, 0.f};
#pragma unroll
                for (int ks = 0; ks < 2; ++ks) { const bf16x8 a = *(const LAS bf16x8*)(PS + (16 * tr + fr) * 72 + ks * 32 + fq * 8); acc = __builtin_amdgcn_mfma_f32_16x16x32_bf16(bv[ks], a, acc, 0, 0, 0); }
#pragma unroll
                for (int ks = 0; ks < 4; ++ks) { const bf16x8 a = *(const LAS bf16x8*)(QS + (16 * tr + fr) * 136 + ks * 32 + fq * 8); acc = __builtin_amdgcn_mfma_f32_16x16x32_bf16(cur.bs[ks], a, acc, 0, 0, 0); }
                o[tr] = acc;
                float ss = (acc[0] * acc[0] + acc[1] * acc[1]) + (acc[2] * acc[2] + acc[3] * acc[3]);
                ss += __shfl_xor(ss, 16); ss += __shfl_xor(ss, 32);
                if (fq == 0) RS[wave * 64 + 16 * tr + fr] = ss;
            }
            __syncthreads();
            const int ocol = cb + 16 * wave + 4 * fq;
#pragma unroll
            for (int tr = 0; tr < 4; ++tr) {
                const int tl = 16 * tr + fr; float tt = 0.f;
#pragma unroll
                for (int w = 0; w < 8; ++w) tt += RS[w * 64 + tl];
                const float rinv = rsqrtf(tt * (1.f / 128.f) + EPS);
                const u32x2 sg = cur.sgv[tr];
                u32x2 w;
                w.x = cvt_pk_bf16(o[tr][0] * rinv * gn[0] * bflo(sg.x), o[tr][1] * rinv * gn[1] * bfhi(sg.x));
                w.y = cvt_pk_bf16(o[tr][2] * rinv * gn[2] * bflo(sg.y), o[tr][3] * rinv * gn[3] * bfhi(sg.y));
                *(u32x2*)(M.O + (size_t)(t0 + tl) * DM + ocol) = w;
            }
            __syncthreads();
        }
        if (!has) break;
        cur = nxt; unit = un;
    }
}

struct LruIn { float xm3, xm2, xm1; float xr[8]; unsigned gyv[8]; float hin; float cpv; };
__device__ __forceinline__ void lru_load(const Mix& M, int unit, int mode, LruIn& in) {
    const int tid = threadIdx.x, j = tid & 63, seg = tid >> 6;
    const int n = unit & 7, bc = unit >> 3, c = bc & 31, b = bc >> 5, t0 = bc * 64, ch0 = n * 64, ch = ch0 + j, tl0 = seg * 8;
    const bool first = (c == 0 && seg == 0);
    const float* xp = M.XB + (size_t)(t0 + tl0) * DH + ch;
    in.xm3 = first ? 0.f : xp[-3 * DH]; in.xm2 = first ? 0.f : xp[-2 * DH]; in.xm1 = first ? 0.f : xp[-1 * DH];
#pragma unroll
    for (int i = 0; i < 8; ++i) in.xr[i] = xp[i * DH];
    in.hin = (mode == 1) ? M.HST[(size_t)bc * 512 + ch] : 0.f;
#pragma unroll
    for (int i = 0; i < 8; ++i) in.gyv[i] = (mode == 1) ? (unsigned)M.GY[(size_t)(t0 + tl0 + i) * DH + ch] : 0u;
    in.cpv = (mode == 1 && c == 31 && tid < 192) ? M.XB[(size_t)(b * SEQ + SEQ - 3 + (tid >> 6)) * DH + ch0 + j] : 0.f;
}
__device__ __forceinline__ void lru_loop(const Mix& M, int mode, LAS unsigned char* lds) {
    const int tid = threadIdx.x, lane = tid & 63, wave = tid >> 6, fr = lane & 15, fq = lane >> 4, G = gridDim.x;
    const int j = tid & 63, seg = tid >> 6, tl0 = seg * 8;
    int unit = blockIdx.x; if (unit >= 2048) return;
    int par = 0;
    const int gate = wave >> 2, tr = wave & 3;
    int ncache = -1; float w0 = 0.f, w1 = 0.f, w2 = 0.f, w3 = 0.f, cbias = 0.f, sp = 0.f; bf16x8 wb[4][2]; float bbv[4];
    LruIn cur; lru_load(M, unit, mode, cur);
    for (;;) {
        const int un = unit + G; const bool has = un < 2048;
        LruIn nxt; if (has) lru_load(M, un, mode, nxt);
        LAS unsigned char* lb_ = lds + par * 49152;
        LAS bf16_t* XC16 = (LAS bf16_t*)(lb_ + 16640); LAS float* GR = (LAS float*)(lb_ + 25856); LAS float* GI = (LAS float*)(lb_ + 42496);
        LAS float* SEGA = (LAS float*)(lb_ + 59136); LAS float* SEGU = (LAS float*)(lb_ + 61184);
        par ^= 1;
        const int n = unit & 7, bc = unit >> 3, c = bc & 31, b = bc >> 5, t0 = bc * 64, ch0 = n * 64, ch = ch0 + j;
        if (n != ncache) {
            ncache = n;
            w0 = M.convw[ch]; w1 = M.convw[512 + ch]; w2 = M.convw[1024 + ch]; w3 = M.convw[1536 + ch]; cbias = M.convb[ch];
            const bf16_t* WT = (gate ? M.WXT : M.WAT) + n * 4096; const float* bias = (gate ? M.bx : M.ba) + ch0;
#pragma unroll
            for (int ct = 0; ct < 4; ++ct) { wb[ct][0] = *(const bf16x8*)(WT + (16 * ct + fr) * 64 + fq * 8); wb[ct][1] = *(const bf16x8*)(WT + (16 * ct + fr) * 64 + 32 + fq * 8); bbv[ct] = bias[16 * ct + fr]; }
            sp = log1pf(__expf(-M.lam[ch]));
        }
        float xm3 = cur.xm3, xm2 = cur.xm2, xm1 = cur.xm1; float xcv[8];
#pragma unroll
        for (int i = 0; i < 8; ++i) {
            const float x = cur.xr[i];
            const float xc = cbias + w0 * xm3 + w1 * xm2 + w2 * xm1 + w3 * x;
            xcv[i] = xc; XC16[(tl0 + i) * 72 + j] = f2bf(xc);
            xm3 = xm2; xm2 = xm1; xm1 = x;
        }
        __syncthreads();
        {
            LAS float* Gd = gate ? GI : GR;
            const bf16x8 a0 = *(const LAS bf16x8*)(XC16 + (16 * tr + fr) * 72 + fq * 8), a1 = *(const LAS bf16x8*)(XC16 + (16 * tr + fr) * 72 + 32 + fq * 8);
#pragma unroll
            for (int ct = 0; ct < 4; ++ct) {
                f32x4 acc = {0.f, 0.f, 0.f, 0.f};
                acc = __builtin_amdgcn_mfma_f32_16x16x32_bf16(a0, wb[ct][0], acc, 0, 0, 0);
                acc = __builtin_amdgcn_mfma_f32_16x16x32_bf16(a1, wb[ct][1], acc, 0, 0, 0);
#pragma unroll
                for (int jj = 0; jj < 4; ++jj) Gd[(16 * tr + 4 * fq + jj) * 65 + 16 * ct + fr] = sigm(acc[jj] + bbv[ct]);
            }
        }
        __syncthreads();
        float av[8], uv[8]; float A = 1.f, U = 0.f;
#pragma unroll
        for (int i = 0; i < 8; ++i) {
            const int tl = tl0 + i; const float r = GR[tl * 65 + j], ig = GI[tl * 65 + j];
            const float la = -8.f * r * sp, a = __expf(la);
            const float x = 2.f * la;
            float pe = 1.f / 5040.f; pe = pe * x + 1.f / 720.f; pe = pe * x + 1.f / 120.f; pe = pe * x + 1.f / 24.f; pe = pe * x + 1.f / 6.f; pe = pe * x + 0.5f; pe = pe * x + 1.f; pe = -pe * x;
            const float om = (x > -0.35f) ? pe : (1.f - a * a);
            float mult = __builtin_amdgcn_sqrtf(fmaxf(om, 0.f));
            if (c == 0 && tl == 0) mult = 1.f;
            const float u = mult * ig * xcv[i];
            av[i] = a; uv[i] = u; U = a * U + u; A *= a;
        }
        SEGA[seg * 64 + j] = A; SEGU[seg * 64 + j] = U;
        __syncthreads();
        float hin = cur.hin;
#pragma unroll
        for (int s = 0; s < 8; ++s) if (s < seg) hin = SEGA[s * 64 + j] * hin + SEGU[s * 64 + j];
        if (mode == 0) {
            if (seg == 7) { float At = 1.f;
#pragma unroll
                for (int s = 0; s < 8; ++s) At *= SEGA[s * 64 + j];
                M.ACH[(size_t)bc * 512 + ch] = At; M.UCH[(size_t)bc * 512 + ch] = A * hin + U; }
        } else {
            float hh = hin;
#pragma unroll
            for (int i = 0; i < 8; ++i) {
                hh = av[i] * hh + uv[i];
                M.O[(size_t)(t0 + tl0 + i) * DM + 512 + ch] = f2bf(hh * __uint_as_float(cur.gyv[i] << 16));
            }
            if (c == 31 && seg == 7) M.out[OUT_LP + b * 512 + ch] = hh;
            if (c == 31 && tid < 192) M.out[OUT_CP + (size_t)(b * 3 + (tid >> 6)) * 512 + ch0 + j] = cur.cpv;
        }
        if (!has) break;
        cur = nxt; unit = un;
    }
    __syncthreads();
}

__device__ __forceinline__ void hgrn_sample_unit(const Mix& M, int unit, LAS unsigned char* lds) {
    const int tid = threadIdx.x, lane = tid & 63, wave = tid >> 6;
    const int h = unit & 3, b = unit >> 2, cb = h * 128, tb = TP + b * 4;
    LAS float* SQ = (LAS float*)lds;
    LAS float* SK = SQ + 512;
    LAS float* SD = SK + 512;
    LAS float* SP = SD + 128;
    LAS float* OP = SP + 32;
    LAS float* RS = OP + 2048;
    const int v = tid & 127, kq = tid >> 7;
    const size_t sb = ((size_t)(b * 4 + h) * 128) * 128;
    float s0v[32];
#pragma unroll
    for (int kx = 0; kx < 32; ++kx) s0v[kx] = M.st_h[sb + (size_t)(kq * 32 + kx) * 128 + v];
    float vv[4];
#pragma unroll
    for (int s = 0; s < 4; ++s) vv[s] = bf2f(M.V[(size_t)(tb + s) * DH + cb + v]);
    const float sgo = bf2f(M.SG[(size_t)(tb + kq) * DH + cb + v]), hno = M.hnorm[cb + v];
    if (tid < 128) {
        const int k = tid;
        const float l0 = M.lb[cb + k], l1 = M.lb[512 + cb + k];
        const float lb = 1.f / (1.f + __expf(l1 - l0));
        float cum[4], kk[4], qv[4]; float run = 0.f;
#pragma unroll
        for (int s = 0; s < 4; ++s) {
            const float fz = M.FZ[(size_t)(tb + s) * DH + cb + k];
            const float sg = 1.f / (1.f + __expf(-fz)), sn = 1.f / (1.f + __expf(fz));
            run += __logf(lb + (1.f - lb) * sg); cum[s] = run; kk[s] = (1.f - lb) * sn;
            qv[s] = bf2f(M.Q[(size_t)(tb + s) * DH + cb + k]);
        }
#pragma unroll
        for (int s = 0; s < 4; ++s) { SQ[s * 128 + k] = qv[s] * __expf(cum[s]); SK[s * 128 + k] = kk[s] * __expf(cum[3] - cum[s]); }
        SD[k] = __expf(cum[3]);
        float pr[10]; int c = 0;
#pragma unroll
        for (int t = 0; t < 4; ++t)
#pragma unroll
            for (int s = 0; s <= t; ++s) { pr[c] = qv[t] * kk[s] * __expf(cum[t] - cum[s]); ++c; }
#pragma unroll
        for (int i = 0; i < 10; ++i) { const float v = wave_sum(pr[i]); if (lane == 0) SP[wave * 16 + i] = v; }
    }
    __syncthreads();
    {
        float o[4] = {0.f, 0.f, 0.f, 0.f};
#pragma unroll
        for (int kx = 0; kx < 32; ++kx) {
            const int k = kq * 32 + kx;
            const float s0 = s0v[kx];
            float sn = SD[k] * s0;
#pragma unroll
            for (int s = 0; s < 4; ++s) { o[s] += SQ[s * 128 + k] * s0; sn += SK[s * 128 + k] * vv[s]; }
            M.out[OUT_HS + sb + (size_t)k * 128 + v] = sn;
        }
#pragma unroll
        for (int s = 0; s < 4; ++s) OP[(kq * 4 + s) * 128 + v] = o[s];
    }
    __syncthreads();
    {
        const int t = kq;
        float ov = (OP[(0 * 4 + t) * 128 + v] + OP[(1 * 4 + t) * 128 + v]) + (OP[(2 * 4 + t) * 128 + v] + OP[(3 * 4 + t) * 128 + v]);
        const int base = t * (t + 1) / 2;
        for (int s = 0; s <= t; ++s) ov += (SP[base + s] + SP[16 + base + s]) * vv[s];
        const float ssq = wave_sum(ov * ov);
        if (lane == 0) RS[wave] = ssq;
        __syncthreads();
        const float tt = RS[2 * t] + RS[2 * t + 1];
        const float rinv = rsqrtf(tt * (1.f / 128.f) + EPS);
        const size_t tok = (size_t)(tb + t);
        M.O[tok * DM + cb + v] = f2bf(ov * rinv * hno * sgo);
    }
    __syncthreads();
}

__device__ __forceinline__ void lru_sample_unit(const Mix& M, int unit, LAS unsigned char* lds) {
    const int tid = threadIdx.x, b = unit >> 1, half = unit & 1, chl = tid & 255, part = tid >> 8, ch = half * 256 + chl, n = ch >> 6, j = ch & 63, tb = TP + b * 4;
    LAS float* XC = (LAS float*)lds;
    LAS float* RP = XC + 1024;
    float wav[32], wxv[32];
    const float* wa = M.wa + (size_t)n * 4096 + (size_t)(part * 32) * 64 + j; const float* wx = M.wx + (size_t)n * 4096 + (size_t)(part * 32) * 64 + j;
#pragma unroll
    for (int i = 0; i < 32; ++i) { wav[i] = wa[i * 64]; wxv[i] = wx[i * 64]; }
    float x[7];
#pragma unroll
    for (int r = 0; r < 3; ++r) x[r] = M.st_c[(size_t)(b * 3 + r) * 512 + ch];
#pragma unroll
    for (int s = 0; s < 4; ++s) x[3 + s] = M.XB[(size_t)(tb + s) * DH + ch];
    const float w0 = M.convw[ch], w1 = M.convw[512 + ch], w2 = M.convw[1024 + ch], w3 = M.convw[1536 + ch], cbias = M.convb[ch];
    const float ba = M.ba[ch], bx = M.bx[ch], lamv = M.lam[ch], h0 = M.st_l[(size_t)b * 512 + ch];
    float gy[4];
#pragma unroll
    for (int s = 0; s < 4; ++s) gy[s] = bf2f(M.GY[(size_t)(tb + s) * DH + ch]);
    float xc[4];
#pragma unroll
    for (int s = 0; s < 4; ++s) { xc[s] = cbias + w0 * x[s] + w1 * x[s + 1] + w2 * x[s + 2] + w3 * x[s + 3]; if (part == 0) XC[s * 256 + chl] = xc[s]; }
    if (part == 0) {
#pragma unroll
        for (int r = 0; r < 3; ++r) M.out[OUT_CS + (size_t)(b * 3 + r) * 512 + ch] = x[4 + r];
    }
    __syncthreads();
    float ra[4] = {0.f, 0.f, 0.f, 0.f}, rx[4] = {0.f, 0.f, 0.f, 0.f};
    const int xi0 = (n * 64 - half * 256) + part * 32;
#pragma unroll
    for (int i = 0; i < 32; ++i) {
#pragma unroll
        for (int s = 0; s < 4; ++s) { const float xv = XC[s * 256 + xi0 + i]; ra[s] += xv * wav[i]; rx[s] += xv * wxv[i]; }
    }
    if (part == 1) {
#pragma unroll
        for (int s = 0; s < 4; ++s) { RP[s * 256 + chl] = ra[s]; RP[(4 + s) * 256 + chl] = rx[s]; }
    }
    __syncthreads();
    if (part == 0) {
        const float sp = log1pf(__expf(-lamv));
        float hh = h0;
#pragma unroll
        for (int s = 0; s < 4; ++s) {
            const float pa = ra[s] + RP[s * 256 + chl] + ba, px = rx[s] + RP[(4 + s) * 256 + chl] + bx;
            const float r = 1.f / (1.f + __expf(-pa)), ig = 1.f / (1.f + __expf(-px));
            const float la = -8.f * r * sp, a = __expf(la), x2 = 2.f * la;
            float pe = 1.f / 5040.f; pe = pe * x2 + 1.f / 720.f; pe = pe * x2 + 1.f / 120.f; pe = pe * x2 + 1.f / 24.f; pe = pe * x2 + 1.f / 6.f; pe = pe * x2 + 0.5f; pe = pe * x2 + 1.f; pe = -pe * x2;
            const float mult = __builtin_amdgcn_sqrtf(fmaxf((x2 > -0.35f) ? pe : (1.f - a * a), 0.f));
            hh = a * hh + mult * ig * xc[s];
            M.O[(size_t)(tb + s) * DM + 512 + ch] = f2bf(hh * gy[s]);
        }
        M.out[OUT_LS + (size_t)b * 512 + ch] = hh;
    }
    __syncthreads();
}

__device__ __forceinline__ void scan_item(const Mix& M, int item) {
    const int tid = threadIdx.x;
    if (item < 1024) {
        const int e = item * 512 + tid, bh = e >> 14, vk = e & 16383, b = bh >> 2, h = bh & 3, v = vk >> 7, k = vk & 127;
        float l[32], d[32];
#pragma unroll
        for (int c = 0; c < 32; ++c) { const int unit = (b * 32 + c) * 4 + h; l[c] = bf2f(M.LT[(size_t)unit * 16384 + vk]); d[c] = M.DC[unit * 128 + k]; }
        float S = 0.f;
#pragma unroll
        for (int c = 0; c < 32; ++c) { const int unit = (b * 32 + c) * 4 + h; M.LT[(size_t)unit * 16384 + vk] = f2bf(S); S = d[c] * S + l[c]; }
        M.out[OUT_HP + ((size_t)(b * 4 + h) * 128 + k) * 128 + v] = S;
    } else {
        const int e = (item - 1024) * 512 + tid, b = e >> 9, ch = e & 511;
        float hcar = 0.f;
        for (int c = 0; c < 32; ++c) { const size_t idx = (size_t)(b * 32 + c) * 512 + ch; M.HST[idx] = hcar; hcar = M.ACH[idx] * hcar + M.UCH[idx]; }
    }
}

__global__ void __launch_bounds__(512, 2) mk_fwd(Params p) {
    extern __shared__ __attribute__((aligned(16))) unsigned char lds_raw[];
    LAS unsigned char* lds = (LAS unsigned char*)lds_raw;
    const int lo = p.ph_lo, hi = p.ph_hi, G = gridDim.x;
    unsigned char* ws = p.ws;
#define IN(k) (lo <= (k) && (k) < hi)
    volatile LAS unsigned* xst = (volatile LAS unsigned*)(lds + 131072);
    if (threadIdx.x < 16) xst[threadIdx.x] = 0u;
    __syncthreads();
    XcdBarrier xbar; xbar.bar = (unsigned*)(ws + WS_BAR); xbar.x = 0; xbar.st = xst;
    if (hi - lo > 1) xbar = xcd_barrier_post((unsigned*)(ws + WS_BAR), xst);
    if (hi == 0x7fffffff) cg::this_grid().sync();
#define SEAM(k) do { if (IN(k) && IN((k) + 1)) { xcd_barrier(xbar); } } while (0)
    bf16_t* B0 = (bf16_t*)(ws + WS_B0); bf16_t* B1 = (bf16_t*)(ws + WS_B1); bf16_t* H = (bf16_t*)(ws + WS_H);
    float* SS0 = (float*)(ws + WS_SS0); float* SS1 = (float*)(ws + WS_SS1); float* SS2 = (float*)(ws + WS_SS2); float* SS3 = (float*)(ws + WS_SS3);

    if (IN(0)) { phase0(p, lds); __syncthreads(); }
    SEAM(0);
    if (IN(1)) {
        pg8::Gemm g{B0, (const bf16_t*)(ws + WS_WG1), T_ALL, 2 * DFF, DM}; pg8::StaticOrder S; S.init(T_ALL, 2 * DFF, G, (int)blockIdx.x);
        EpiGateUp E{H, SS0};
        pg8::gemm_phase<EpiGateUp, pg8::StaticOrder, PG8_ALIGN, PG8_SP2>(lds, g, S, E);
        const int rounds = (S.nwg + G - 1) / G, nfull = S.nwg - (rounds - 1) * G;
        if (nfull >= G) convert_set(p, lds, 1, (int)blockIdx.x * 8 + (int)(threadIdx.x >> 6), G * 8);
        else if ((int)blockIdx.x >= nfull) convert_set(p, lds, 1, ((int)blockIdx.x - nfull) * 8 + (int)(threadIdx.x >> 6), (G - nfull) * 8);
        __syncthreads();
    }
    SEAM(1);
    if (IN(2)) {
        pg8::Gemm g{H, (const bf16_t*)(ws + WS_WD1), TP, DM, DFF}; pg8::StaticOrder S; S.init(TP, DM, G, (int)blockIdx.x);
        EpiResid E{p.in[0], p.in[1], p.out, B0, p.in[9], SS1, 0.5f};
        pg8::gemm_phase<EpiResid, pg8::StaticOrder, PG8_ALIGN, PG8_SP2>(lds, g, S, E);
        SmallResid Es{p.in[1] - (size_t)TP * DM, p.out, B0, p.in[9], SS1, 0.5f};
        small_gemm<SmallResid, DFF>(H, (const bf16_t*)(ws + WS_WD1), DM, Es, lds);
    }
    SEAM(2);
    if (IN(3)) {
        pg8::Gemm g{B0, (const bf16_t*)(ws + WS_WIN), TP, DIN, DM}; pg8::StaticOrder S; S.init(TP, DIN, G, (int)blockIdx.x);
        EpiProj E{(bf16_t*)(ws + WS_Q), (bf16_t*)(ws + WS_V), (bf16_t*)(ws + WS_SG), (bf16_t*)(ws + WS_GY), (float*)(ws + WS_FZ), (float*)(ws + WS_XB), SS1};
        pg8::gemm_phase<EpiProj, pg8::StaticOrder, PG8_ALIGN, PG8_SP2>(lds, g, S, E);
        SmallProj Es{(bf16_t*)(ws + WS_Q), (bf16_t*)(ws + WS_V), (bf16_t*)(ws + WS_SG), (bf16_t*)(ws + WS_GY), (float*)(ws + WS_FZ), (float*)(ws + WS_XB), SS1};
        small_gemm<SmallProj, DM>(B0, (const bf16_t*)(ws + WS_WIN), DIN, Es, lds);
    }
    SEAM(3);
    Mix M;
    M.Q = (const bf16_t*)(ws + WS_Q); M.V = (const bf16_t*)(ws + WS_V); M.SG = (const bf16_t*)(ws + WS_SG); M.GY = (const bf16_t*)(ws + WS_GY);
    M.FZ = (const float*)(ws + WS_FZ); M.XB = (const float*)(ws + WS_XB); M.LT = (bf16_t*)(ws + WS_LT); M.DC = (float*)(ws + WS_DC);
    M.ACH = (float*)(ws + WS_ACH); M.UCH = (float*)(ws + WS_UCH); M.HST = (float*)(ws + WS_HST); M.O = B0;
    M.WAT = (const bf16_t*)(ws + WS_WAT); M.WXT = (const bf16_t*)(ws + WS_WXT);
    M.lb = p.in[11]; M.hnorm = p.in[12]; M.convw = p.in[13]; M.convb = p.in[14]; M.wa = p.in[15]; M.ba = p.in[16]; M.wx = p.in[17]; M.bx = p.in[18]; M.lam = p.in[19];
    M.st_h = p.in[2]; M.st_l = p.in[3]; M.st_c = p.in[4]; M.out = p.out;
    if (IN(4)) {
        for (int u = blockIdx.x; u < 512; u += G) hgrn_sample_unit(M, u, lds);
        hgrn_loop<0>(M, lds);
        lru_loop(M, 0, lds);
        for (int u = G - 1 - (int)blockIdx.x; u < 256; u += G) lru_sample_unit(M, u, lds);
    }
    SEAM(4);
    if (IN(5)) { for (int it = blockIdx.x; it < 1032; it += G) scan_item(M, it); convert_set(p, lds, 2, (int)blockIdx.x * 8 + (int)(threadIdx.x >> 6), G * 8); __syncthreads(); }
    SEAM(5);
    if (IN(6)) {
        hgrn_loop<1>(M, lds);
        lru_loop(M, 1, lds);
    }
    SEAM(6);
    if (IN(7)) {
        pg8::Gemm g{B0, (const bf16_t*)(ws + WS_WO), TP, DM, DM}; pg8::StaticOrder S; S.init(TP, DM, G, (int)blockIdx.x);
        EpiResid E{p.out, p.out + (size_t)TP * DM, p.out, B1, p.in[21], SS2, 1.0f};
        pg8::gemm_phase<EpiResid, pg8::StaticOrder, PG8_ALIGN, PG8_SP2>(lds, g, S, E);
        SmallResid Es{p.out, p.out, B1, p.in[21], SS2, 1.0f};
        small_gemm<SmallResid, DM>(B0, (const bf16_t*)(ws + WS_WO), DM, Es, lds);
    }
    SEAM(7);
    if (IN(8)) {
        pg8::Gemm g{B1, (const bf16_t*)(ws + WS_WG2), T_ALL, 2 * DFF, DM}; pg8::StaticOrder S; S.init(T_ALL, 2 * DFF, G, (int)blockIdx.x);
        EpiGateUp E{H, SS2};
        pg8::gemm_phase<EpiGateUp, pg8::StaticOrder, PG8_ALIGN, PG8_SP2>(lds, g, S, E);
    }
    SEAM(8);
    if (IN(9)) {
        pg8::Gemm g{H, (const bf16_t*)(ws + WS_WD2), TP, DM, DFF}; pg8::StaticOrder S; S.init(TP, DM, G, (int)blockIdx.x);
        EpiResid E{p.out, p.out + (size_t)TP * DM, p.out, nullptr, nullptr, SS3, 0.5f};
        pg8::gemm_phase<EpiResid, pg8::StaticOrder, PG8_ALIGN, PG8_SP2>(lds, g, S, E);
        SmallResid Es{p.out, p.out, nullptr, nullptr, SS3, 0.5f};
        small_gemm<SmallResid, DFF>(H, (const bf16_t*)(ws + WS_WD2), DM, Es, lds);
    }
    SEAM(9);
    if (IN(10)) phase_final(p);
#undef IN
#undef SEAM
}

extern "C" void kernel_launch(void* const* d_in, const int* in_sizes, int n_in, void* d_out, int out_size, void* d_ws, size_t ws_size, hipStream_t stream) {
    static int grid = 0;
    if (grid == 0) {
        if (n_in != 26 || ws_size < WS_END2) { fprintf(stderr, "kernel_launch: unexpected n_in %d or ws_size %zu (need %zu)\n", n_in, ws_size, (size_t)WS_END2); grid = -1; return; }
        int dev = 0, cus = 0, per_cu = 0;
        hipGetDevice(&dev); hipDeviceGetAttribute(&cus, hipDeviceAttributeMultiprocessorCount, dev);
        if (hipFuncSetAttribute((const void*)mk_fwd, hipFuncAttributeMaxDynamicSharedMemorySize, LDS_BYTES) != hipSuccess) { fprintf(stderr, "kernel_launch: hipFuncSetAttribute failed\n"); grid = -1; return; }
        if (hipOccupancyMaxActiveBlocksPerMultiprocessor(&per_cu, (const void*)mk_fwd, 512, LDS_BYTES) != hipSuccess || per_cu < 1) { fprintf(stderr, "kernel_launch: occupancy query says %d\n", per_cu); per_cu = 1; }
        (void)hipGetLastError();
        grid = cus;
    }
    if (grid < 0) return;
    Params p{};
    for (int i = 0; i < 26; ++i) p.in[i] = (const float*)d_in[i];
    p.out = (float*)d_out; p.ws = (unsigned char*)d_ws;
#if MK_PER_PHASE
    for (int ph = 0; ph < MK_NPH; ++ph) { p.ph_lo = ph; p.ph_hi = ph + 1; hipLaunchKernelGGL(mk_fwd, dim3(grid), dim3(512), LDS_BYTES, stream, p); if ((MK_DUP >> ph) & 1) hipLaunchKernelGGL(mk_fwd, dim3(grid), dim3(512), LDS_BYTES, stream, p); }
#else
    p.ph_lo = 0; p.ph_hi = MK_NPH;
    if (hipMemsetAsync((char*)d_ws + WS_BAR, 0, 16384, stream) != hipSuccess) { fprintf(stderr, "memset failed\n"); return; }
    void* args[] = {&p};
    hipError_t e = hipLaunchCooperativeKernel((const void*)mk_fwd, dim3(grid), dim3(512), args, LDS_BYTES, stream);
    if (e != hipSuccess) fprintf(stderr, "cooperative launch failed: %s (grid %d)\n", hipGetErrorString(e), grid);
#endif
}
```
